# Optimizing an MI355X kernel written in HIP

```python
import jax, jax.numpy as jnp
from jax import lax
import numpy as np

D_MODEL = 1024
BATCH = 2
SEQ = 8192
DEPTH = 1

HEAD_DIM = 64
ROT_DIM = HEAD_DIM // 4
ROPE_THETA = 500000.0
N_HEADS_A = 8
MOBA_BLOCK = 256
MOBA_TOPK = 3
MOBA_CHUNK = 64
DIL_PAIRS = ((128, 1), (512, 4), (2048, 16))
HEADS_PER_GROUP_B = 4
N_HEADS_B = HEADS_PER_GROUP_B * len(DIL_PAIRS)
WIDTH_A = N_HEADS_A * HEAD_DIM
WIDTH_B = N_HEADS_B * HEAD_DIM
WIDTH_B_OUT = HEADS_PER_GROUP_B * HEAD_DIM
IN_COLS = 3 * WIDTH_A + 3 * WIDTH_B + 2 * D_MODEL
N_EXPERTS = 32
TOP_K = 4
D_FF = D_MODEL
SWIGLU_LIMIT = 7.0
SWIGLU_ALPHA = 1.702
EXPERT_BLOCK = 128
NORM_EPS = 1e-5

kernel_name = "moba_dilated_gated_moe_hybrid"


def rmsnorm(x, g):
    xf = x.astype(jnp.float32)
    y = xf * lax.rsqrt(jnp.mean(xf * xf, axis=-1, keepdims=True) + NORM_EPS)
    return (y * g.astype(jnp.float32)).astype(x.dtype)


def partial_rope(x, pos):
    half = ROT_DIM // 2
    inv = jnp.float32(ROPE_THETA) ** (-jnp.arange(half, dtype=jnp.float32) / half)
    ang = pos.astype(jnp.float32)[:, None] * inv[None, :]
    cos = jnp.cos(ang)[None, :, None, :]
    sin = jnp.sin(ang)[None, :, None, :]
    xr = x[..., :ROT_DIM].astype(jnp.float32)
    x1, x2 = xr[..., :half], xr[..., half:]
    rot = jnp.concatenate([x1 * cos - x2 * sin, x2 * cos + x1 * sin], axis=-1).astype(x.dtype)
    return jnp.concatenate([rot, x[..., ROT_DIM:]], axis=-1)


def attend(s, mask, v, eq):
    s = jnp.where(mask, s, -jnp.inf)
    m = jnp.max(s, axis=-1, keepdims=True)
    m = jnp.where(jnp.isfinite(m), m, 0.0)
    p = jnp.exp(s - m)
    l = jnp.sum(p, axis=-1, keepdims=True)
    o = jnp.einsum(eq, p, v.astype(jnp.float32)) / jnp.maximum(l, 1.0)
    lse = jnp.where(l[..., 0] > 0, m[..., 0] + jnp.log(jnp.maximum(l[..., 0], 1.0)), -jnp.inf)
    return o, lse


def moba_attention(q, k, v):
    B_, S_, H, Dh = q.shape
    nb = -(-S_ // MOBA_BLOCK)
    S_p = nb * MOBA_BLOCK
    pad = ((0, 0), (0, S_p - S_), (0, 0), (0, 0))
    q, k, v = [jnp.pad(t, pad).transpose(0, 2, 1, 3) for t in (q, k, v)]
    scale = HEAD_DIM ** -0.5
    qb = q.reshape(B_, H, nb, MOBA_BLOCK, Dh)
    kb = k.reshape(B_, H, nb, MOBA_BLOCK, Dh)
    vb = v.reshape(B_, H, nb, MOBA_BLOCK, Dh)
    s_own = jnp.einsum('bhnqd,bhnkd->bhnqk', qb, kb).astype(jnp.float32) * scale
    causal = jnp.tril(jnp.ones((MOBA_BLOCK, MOBA_BLOCK), dtype=bool))
    o_own, lse_own = attend(s_own, causal, vb, 'bhnqk,bhnkd->bhnqd')
    o_own = o_own.reshape(B_, H, S_p, Dh)
    lse_own = lse_own.reshape(B_, H, S_p)
    k_mean = jnp.mean(kb.astype(jnp.float32), axis=3)
    gate = jnp.einsum('bhsd,bhnd->bhsn', q.astype(jnp.float32), k_mean)
    q_blk = jnp.arange(S_p) // MOBA_BLOCK
    past = jnp.arange(nb)[None, :] < q_blk[:, None]
    gate = jnp.where(past, gate, -jnp.inf)
    k_sel = min(MOBA_TOPK, nb)
    g_val, g_idx = lax.top_k(gate, k_sel)
    g_ok = jnp.isfinite(g_val)
    nc = S_p // MOBA_CHUNK

    def to_chunks(t):
        return jnp.moveaxis(t.reshape(B_, H, nc, MOBA_CHUNK, *t.shape[3:]), 2, 0)

    gather_blocks = jax.vmap(jax.vmap(lambda blocks, idx: blocks[idx]))

    def past_chunk(args):
        qc, ic, okc = args
        kg = gather_blocks(kb, ic).reshape(B_, H, MOBA_CHUNK, k_sel * MOBA_BLOCK, Dh)
        vg = gather_blocks(vb, ic).reshape(B_, H, MOBA_CHUNK, k_sel * MOBA_BLOCK, Dh)
        s = jnp.einsum('bhqd,bhqnd->bhqn', qc, kg).astype(jnp.float32) * scale
        mask = jnp.repeat(okc, MOBA_BLOCK, axis=-1)
        return attend(s, mask, vg, 'bhqn,bhqnd->bhqd')

    o_past, lse_past = lax.map(past_chunk, (to_chunks(q), to_chunks(g_idx), to_chunks(g_ok)))
    o_past = jnp.moveaxis(o_past, 0, 2).reshape(B_, H, S_p, Dh)
    lse_past = jnp.moveaxis(lse_past, 0, 2).reshape(B_, H, S_p)
    lse = jnp.logaddexp(lse_own, lse_past)
    o = o_own * jnp.exp(lse_own - lse)[..., None] + o_past * jnp.exp(lse_past - lse)[..., None]
    return o.transpose(0, 2, 1, 3)[:, :S_].reshape(B_, S_, H * Dh).astype(v.dtype)


def dilated_group(q, k, v, window, dilation):
    B_, S_, Hg, Dh = q.shape
    band = window // dilation
    span = dilation * band
    S_p = -(-S_ // span) * span
    L = S_p // dilation
    nb = L // band
    scale = HEAD_DIM ** -0.5

    def to_sub(t):
        t = jnp.pad(t, ((0, 0), (0, S_p - S_), (0, 0), (0, 0)))
        t = t.reshape(B_, L, dilation, Hg, Dh).transpose(0, 2, 3, 1, 4)
        return t.reshape(B_, dilation, Hg, nb, band, Dh)

    def with_prev(t):
        prev = jnp.pad(t, ((0, 0), (0, 0), (0, 0), (1, 0), (0, 0), (0, 0)))[:, :, :, :-1]
        return jnp.concatenate([prev, t], axis=4)

    qs, ks, vs = to_sub(q), to_sub(k), to_sub(v)
    kw, vw = with_prev(ks), with_prev(vs)
    s = jnp.einsum('brhnqd,brhnkd->brhnqk', qs, kw).astype(jnp.float32) * scale
    qi = jnp.arange(band)[:, None]
    kj = jnp.arange(2 * band)[None, :]
    dist = qi + band - kj
    in_band = (dist >= 0) & (dist <= band)
    no_prev = (jnp.arange(nb) == 0)[:, None, None] & (kj < band)[None]
    mask = in_band[None] & ~no_prev
    o, lse = attend(s, mask, vw, 'brhnqk,brhnkd->brhnqd')
    o = o.reshape(B_, dilation, Hg, L, Dh).transpose(0, 3, 1, 2, 4).reshape(B_, S_p, Hg, Dh)[:, :S_]
    lse = lse.reshape(B_, dilation, Hg, L).transpose(0, 3, 1, 2).reshape(B_, S_p, Hg)[:, :S_]
    return o, lse


def dilated_attention(q, k, v):
    B_, S_ = q.shape[:2]
    outs, lses = [], []
    for g, (win, dil) in enumerate(DIL_PAIRS):
        sl = slice(g * HEADS_PER_GROUP_B, (g + 1) * HEADS_PER_GROUP_B)
        o, l = dilated_group(q[:, :, sl], k[:, :, sl], v[:, :, sl], win, dil)
        outs.append(o)
        lses.append(l)
    o = jnp.stack(outs)
    wts = jax.nn.softmax(jnp.stack(lses), axis=0)
    out = jnp.sum(wts[..., None] * o, axis=0)
    return out.reshape(B_, S_, WIDTH_B_OUT).astype(v.dtype)


def moe_ffn(h, w_router, b_router, w_gate, b_gate, w_up, b_up, w_down, b_down):
    B_, S_, D = h.shape
    T = B_ * S_
    xt = h.reshape(T, D)
    logits = (xt @ w_router).astype(jnp.float32) + b_router.astype(jnp.float32)
    top_val, top_idx = lax.top_k(logits, TOP_K)
    probs = jax.nn.softmax(top_val, axis=-1)
    n_assign = T * TOP_K
    flat_e = top_idx.reshape(-1)
    flat_tok = jnp.repeat(jnp.arange(T, dtype=jnp.int32), TOP_K)
    flat_p = probs.reshape(-1)
    order = jnp.argsort(flat_e)
    e_sorted = flat_e[order]
    counts = jnp.bincount(flat_e, length=N_EXPERTS)
    padded = (counts + EXPERT_BLOCK - 1) // EXPERT_BLOCK * EXPERT_BLOCK
    start = jnp.cumsum(counts) - counts
    pend = jnp.cumsum(padded)
    pstart = pend - padded
    dest = pstart[e_sorted] + (jnp.arange(n_assign) - start[e_sorted])
    n_rows = -(-n_assign // EXPERT_BLOCK) * EXPERT_BLOCK + N_EXPERTS * EXPERT_BLOCK
    row_tok = jnp.zeros((n_rows,), jnp.int32).at[dest].set(flat_tok[order])
    row_p = jnp.zeros((n_rows,), jnp.float32).at[dest].set(flat_p[order])
    n_blk = n_rows // EXPERT_BLOCK
    blk_expert = jnp.minimum(jnp.searchsorted(pend, jnp.arange(n_blk) * EXPERT_BLOCK, side='right'),
                             N_EXPERTS - 1)
    x_rows = xt[row_tok].reshape(n_blk, EXPERT_BLOCK, D)

    def expert_block(args):
        xb, e = args
        g = xb @ w_gate[e] + b_gate[e]
        u = xb @ w_up[e] + b_up[e]
        g = jnp.minimum(g, SWIGLU_LIMIT)
        u = jnp.clip(u, -SWIGLU_LIMIT, SWIGLU_LIMIT)
        a = g * jax.nn.sigmoid(SWIGLU_ALPHA * g) * (u + 1.0)
        return a @ w_down[e] + b_down[e]

    y_rows = lax.map(expert_block, (x_rows, blk_expert)).reshape(n_rows, D)
    y = jax.ops.segment_sum(y_rows * row_p[:, None].astype(y_rows.dtype), row_tok, num_segments=T)
    return y.reshape(B_, S_, D).astype(h.dtype)


def setup_inputs(seed: int = 0) -> dict:
    key = jax.random.key(seed)
    ks = jax.random.split(key, 20)
    f32 = jnp.float32
    nrm = lambda k, shape, s: jax.random.normal(k, shape, f32) * s
    L, D, E, F = DEPTH, D_MODEL, N_EXPERTS, D_FF
    return {
        "x": nrm(ks[0], (BATCH, SEQ, D), 1.0),
        "ln_mix_g": 1.0 + nrm(ks[1], (L, D), 0.02),
        "w_in": nrm(ks[2], (L, D, IN_COLS), D ** -0.5),
        "b_gate_a": nrm(ks[3], (L, D), 0.02),
        "b_gate_b": nrm(ks[4], (L, D), 0.02),
        "w_o_a": nrm(ks[5], (L, WIDTH_A, D), WIDTH_A ** -0.5),
        "w_o_b": nrm(ks[6], (L, WIDTH_B_OUT, D), WIDTH_B_OUT ** -0.5),
        "w_out": nrm(ks[7], (L, D, D), D ** -0.5),
        "ln_ffn_g": 1.0 + nrm(ks[8], (L, D), 0.02),
        "w_router": nrm(ks[9], (L, D, E), D ** -0.5),
        "b_router": nrm(ks[10], (L, E), 0.01),
        "w_gate": nrm(ks[11], (L, E, D, F), D ** -0.5),
        "b_gate": nrm(ks[12], (L, E, F), 0.01),
        "w_up": nrm(ks[13], (L, E, D, F), D ** -0.5),
        "b_up": nrm(ks[14], (L, E, F), 0.01),
        "w_down": nrm(ks[15], (L, E, F, D), F ** -0.5),
        "b_down": nrm(ks[16], (L, E, D), 0.01),
        "ln_final_g": 1.0 + nrm(ks[17], (D,), 0.02),
    }


def reference(x, ln_mix_g, w_in, b_gate_a, b_gate_b, w_o_a, w_o_b, w_out, ln_ffn_g,
              w_router, b_router, w_gate, b_gate, w_up, b_up, w_down, b_down, ln_final_g):
    B_, S_, _ = x.shape
    pos = jnp.arange(S_)
    splits = [WIDTH_A, 2 * WIDTH_A, 3 * WIDTH_A,
              3 * WIDTH_A + WIDTH_B, 3 * WIDTH_A + 2 * WIDTH_B, 3 * WIDTH_A + 3 * WIDTH_B,
              3 * WIDTH_A + 3 * WIDTH_B + D_MODEL]
    for l in range(DEPTH):
        h = rmsnorm(x, ln_mix_g[l])
        proj = h @ w_in[l]
        qa, ka, va, qb, kb, vb, ga, gb = jnp.split(proj, splits, axis=-1)
        heads = lambda t, n: t.reshape(B_, S_, n, HEAD_DIM)
        qa = partial_rope(heads(qa, N_HEADS_A), pos)
        ka = partial_rope(heads(ka, N_HEADS_A), pos)
        qb = partial_rope(heads(qb, N_HEADS_B), pos)
        kb = partial_rope(heads(kb, N_HEADS_B), pos)
        o_a = moba_attention(qa, ka, heads(va, N_HEADS_A))
        o_b = dilated_attention(qb, kb, heads(vb, N_HEADS_B))
        mix = (jax.nn.sigmoid(ga + b_gate_a[l]) * (o_a @ w_o_a[l])
               + jax.nn.sigmoid(gb + b_gate_b[l]) * (o_b @ w_o_b[l]))
        x = x + mix @ w_out[l]
        h = rmsnorm(x, ln_ffn_g[l])
        x = x + moe_ffn(h, w_router[l], b_router[l], w_gate[l], b_gate[l], w_up[l], b_up[l],
                        w_down[l], b_down[l])
    return rmsnorm(x, ln_final_g)
```

```cpp
#include <hip/hip_runtime.h>
#include <hip/hip_cooperative_groups.h>
namespace cg = cooperative_groups;
#include <stdint.h>
#include <math.h>

typedef unsigned short bf16;
typedef float f32x4 __attribute__((ext_vector_type(4)));
typedef unsigned u32x4 __attribute__((ext_vector_type(4)));
typedef unsigned u32x2 __attribute__((ext_vector_type(2)));

__device__ __forceinline__ float bf2f(bf16 v) { return __uint_as_float(((unsigned)v) << 16); }
__device__ __forceinline__ unsigned f2bf(float f) { unsigned u = __float_as_uint(f); return (u + 0x7fffu + ((u >> 16) & 1u)) >> 16; }
__device__ __forceinline__ unsigned pk2(float lo, float hi) { return f2bf(lo) | (f2bf(hi) << 16); }

typedef bf16 act;
__device__ __forceinline__ float ldact(const act* p) { return bf2f(*p); }
__device__ __forceinline__ void stact(act* p, float v) { *p = (bf16)f2bf(v); }
__device__ __forceinline__ void ldact8(const act* p, float (&o)[8]) { const u32x4 a = *(const u32x4*)p;
#pragma unroll
    for (int i = 0; i < 4; ++i) { o[2 * i] = __uint_as_float(a[i] << 16); o[2 * i + 1] = __uint_as_float(a[i] & 0xffff0000u); } }
constexpr int NB = 2, S = 8192, T = NB * S, D = 1024, HD = 64;
constexpr int NHA = 8, NHB = 12, WA = 512, WB = 768, WBO = 256, NCOL = 5888;
constexpr int MBLK = 256, NBLK = S / MBLK;
constexpr int NE = 32, TOPK = 4, FF = 1024;
constexpr int A2ROWS = 73728;
constexpr int C_QA = 0, C_KA = 512, C_VA = 1024, C_QB = 1536, C_KB = 2304, C_VB = 3072, C_GA = 3840, C_GB = 4864;
constexpr float NORM_EPS = 1e-5f;

constexpr size_t MiB = 1u << 20;
constexpr size_t WS_CTL = 0;
constexpr size_t WS_WIN = 1 * MiB;
constexpr size_t WS_WOA = 13 * MiB;
constexpr size_t WS_WOB = 14 * MiB;
constexpr size_t WS_WOUT = 15 * MiB;
constexpr size_t WS_WGU = 17 * MiB;
constexpr size_t WS_WD = 145 * MiB;
constexpr size_t WS_ROPE = 209 * MiB;
constexpr size_t WS_KMEAN = WS_ROPE + 512 * 1024;
constexpr size_t WS_H = 210 * MiB;
constexpr size_t WS_QA = 242 * MiB, WS_KA = 258 * MiB, WS_VA = 274 * MiB;
constexpr size_t WS_QB = 290 * MiB, WS_KB = 314 * MiB, WS_VB = 338 * MiB;
constexpr size_t WS_SA = 362 * MiB, WS_SB = 394 * MiB;
constexpr size_t WS_SEL = 426 * MiB;
constexpr size_t WS_OB = 434 * MiB;
constexpr size_t WS_OA = 490 * MiB;
constexpr size_t WS_MIX = 242 * MiB;
constexpr size_t WS_A2 = 242 * MiB;
constexpr size_t WS_ELIST = 386 * MiB;
constexpr size_t WS_EP = 388 * MiB;
constexpr size_t WS_ROWTOK = 390 * MiB;
constexpr size_t WS_ROWP = 391 * MiB;
constexpr size_t WS_TILEE = 392 * MiB;
constexpr size_t WS_Y = 17 * MiB;
constexpr size_t WS_END = 512 * MiB;
constexpr int CW_ECNT = 64;

struct Params {
    const float *x, *ln_mix_g, *w_in, *b_gate_a, *b_gate_b, *w_o_a, *w_o_b, *w_out, *ln_ffn_g, *w_router, *b_router,
        *w_gate, *b_gate, *w_up, *b_up, *w_down, *b_down, *ln_final_g;
    float* out; unsigned char* ws;
    float inv_freq[8];
};

template <int MAP> __device__ __forceinline__ int rowmap(int n) { return MAP == 0 ? n : (32 * (n >> 4) + (n & 15) + (MAP == 2 ? 16 : 0)); }
template <int MAP> __device__ __forceinline__ void transpose_item(const float* W, int K, int N, bf16* WT, float* scr, int item, int lane) {
    const int nblk = N / 32, kb = item / nblk, nb = item % nblk, k0 = 64 * kb, n0 = 32 * nb;
#pragma unroll 8
    for (int i = 0; i < 32; ++i) { const int kk = 2 * i + (lane >> 5); scr[kk * 33 + (lane & 31)] = W[(size_t)(k0 + kk) * N + n0 + (lane & 31)]; }
    asm volatile("s_waitcnt lgkmcnt(0)" ::: "memory");
    const int c = lane & 7;
#pragma unroll
    for (int j = 0; j < 4; ++j) { const int n = (lane >> 3) + 8 * j; const float* s = scr + (8 * c) * 33 + n;
        u32x4 o; o.x = pk2(s[0 * 33], s[1 * 33]); o.y = pk2(s[2 * 33], s[3 * 33]); o.z = pk2(s[4 * 33], s[5 * 33]); o.w = pk2(s[6 * 33], s[7 * 33]);
        *(u32x4*)(WT + (size_t)rowmap<MAP>(n0 + n) * K + k0 + 8 * c) = o; }
    asm volatile("s_waitcnt lgkmcnt(0)" ::: "memory");
}
__device__ __forceinline__ float wave_sum(float v) {
#pragma unroll
    for (int o = 1; o < 64; o <<= 1) v += __shfl_xor(v, o);
    return v;
}
__device__ __forceinline__ void sincos_acc(float ang, float& c, float& s) {
    const double a = (double)ang; const double k = rint(a * 0.63661977236758134308); const double y = a - k * 1.57079632679489661923; const double y2 = y * y;
    const double sn = y * (1.0 + y2 * (-1.0 / 6 + y2 * (1.0 / 120 + y2 * (-1.0 / 5040 + y2 * (1.0 / 362880 + y2 * (-1.0 / 39916800))))));
    const double cs = 1.0 + y2 * (-0.5 + y2 * (1.0 / 24 + y2 * (-1.0 / 720 + y2 * (1.0 / 40320 + y2 * (-1.0 / 3628800 + y2 * (1.0 / 479001600))))));
    const int q = ((int)k) & 3;
    const double ss = (q == 0) ? sn : (q == 1) ? cs : (q == 2) ? -sn : -cs;
    const double cc = (q == 0) ? cs : (q == 1) ? -sn : (q == 2) ? -cs : sn;
    c = (float)cc; s = (float)ss;
}
__device__ __forceinline__ void phase_prep(const Params& p, int bid, int nb, unsigned char* lds) {
    const int tid = threadIdx.x, lane = tid & 63, wave = tid >> 6;
    const int gw = bid * 8 + wave, NGW = nb * 8;
    unsigned char* ws = p.ws;
    float* scr = (float*)lds + wave * (64 * 33);
    constexpr int I_IN = (D / 64) * (NCOL / 32), I_OA = (WA / 64) * (D / 32), I_OB = (WBO / 64) * (D / 32), I_OUT = (D / 64) * (D / 32), I_E = (D / 64) * (FF / 32);
    constexpr int NITEMS = I_IN + I_OA + I_OB + I_OUT + 3 * NE * I_E;
    for (int it = gw; it < NITEMS; it += NGW) {
        int r = it;
        if (r < I_IN) { transpose_item<0>(p.w_in, D, NCOL, (bf16*)(ws + WS_WIN), scr, r, lane); continue; } r -= I_IN;
        if (r < I_OA) { transpose_item<0>(p.w_o_a, WA, D, (bf16*)(ws + WS_WOA), scr, r, lane); continue; } r -= I_OA;
        if (r < I_OB) { transpose_item<0>(p.w_o_b, WBO, D, (bf16*)(ws + WS_WOB), scr, r, lane); continue; } r -= I_OB;
        if (r < I_OUT) { transpose_item<0>(p.w_out, D, D, (bf16*)(ws + WS_WOUT), scr, r, lane); continue; } r -= I_OUT;
        const int which = r / (NE * I_E); r -= which * (NE * I_E); const int e = r / I_E; r -= e * I_E;
        if (which == 0) transpose_item<1>(p.w_gate + (size_t)e * D * FF, D, FF, (bf16*)(ws + WS_WGU) + (size_t)e * 2 * FF * D, scr, r, lane);
        else if (which == 1) transpose_item<2>(p.w_up + (size_t)e * D * FF, D, FF, (bf16*)(ws + WS_WGU) + (size_t)e * 2 * FF * D, scr, r, lane);
        else transpose_item<0>(p.w_down + (size_t)e * FF * D, FF, D, (bf16*)(ws + WS_WD) + (size_t)e * D * FF, scr, r, lane);
    }
    for (int m = gw; m < T; m += NGW) {
        const f32x4* xr = (const f32x4*)(p.x + (size_t)m * D) + lane; const f32x4* gr = (const f32x4*)p.ln_mix_g + lane;
        f32x4 v[4]; float s = 0.f;
#pragma unroll
        for (int j = 0; j < 4; ++j) { v[j] = xr[64 * j]; s += (v[j].x * v[j].x + v[j].y * v[j].y) + (v[j].z * v[j].z + v[j].w * v[j].w); }
        const float rstd = 1.0f / sqrtf(wave_sum(s) * (1.0f / D) + NORM_EPS);
#pragma unroll
        for (int j = 0; j < 4; ++j) { const f32x4 g = gr[64 * j]; f32x4 hv; hv.x = v[j].x * rstd * g.x; hv.y = v[j].y * rstd * g.y; hv.z = v[j].z * rstd * g.z; hv.w = v[j].w * rstd * g.w;
            u32x2 o; o.x = pk2(hv.x, hv.y); o.y = pk2(hv.z, hv.w); ((u32x2*)((bf16*)(ws + WS_H) + (size_t)m * D))[lane + 64 * j] = o;
        }
    }
    float2* rope = (float2*)(ws + WS_ROPE);
    for (int i = bid * 512 + tid; i < S * 8; i += nb * 512) { const int s = i >> 3, f = i & 7; const float ang = (float)s * p.inv_freq[f]; float c, sn; sincos_acc(ang, c, sn); rope[i] = make_float2(c, sn); }
}

__device__ __forceinline__ int cl(int tx, int j) { return (tx & 7) + 8 * j + 32 * (tx >> 3); }
template <class F> __device__ __forceinline__ void phase_naive_gemm(const F& f, int M, int N, int bid, int nb, unsigned char* lds) {
    const int half = threadIdx.x >> 8, tid = threadIdx.x & 255, tx = tid & 15, ty = tid >> 4;
    float (*As)[33] = (float (*)[33])(lds + half * (2 * 64 * 33 * 4)); float (*Bs)[33] = As + 64;
    const int nN = N / 64, ntiles = (M / 64) * nN, stride = nb * 2;
    const int nround = (ntiles + stride - 1) / stride;
    const int lr = tid >> 2, lk = (tid & 3) * 8;
    for (int r = 0; r < nround; ++r) {
        const int it = r * stride + bid * 2 + half;
        const bool valid = it < ntiles;
        const int m0 = valid ? (it / nN) * 64 : 0, n0 = valid ? (it % nN) * 64 : 0;
        const bool act_ = valid && f.active(m0);
        float acc[F::NPASS][4][4];
#pragma unroll
        for (int ps = 0; ps < F::NPASS; ++ps)
#pragma unroll
            for (int i = 0; i < 4; ++i)
#pragma unroll
                for (int j = 0; j < 4; ++j) acc[ps][i][j] = 0.f;
#pragma unroll
        for (int ps = 0; ps < F::NPASS; ++ps) {
            const int K = f.K(ps);
            const bf16* ap = act_ ? f.arow(ps, m0 + lr) : nullptr; const bf16* bp = act_ ? f.brow(ps, m0, n0 + lr) : nullptr;
            for (int k0 = 0; k0 < K; k0 += 32) {
                float av[8], bv[8];
                if (act_) { ldact8(ap + k0 + lk, av); ldact8(bp + k0 + lk, bv); }
                else {
#pragma unroll
                    for (int i = 0; i < 8; ++i) { av[i] = 0.f; bv[i] = 0.f; } }
                __syncthreads();
#pragma unroll
                for (int i = 0; i < 8; ++i) { As[lr][lk + i] = av[i]; Bs[lr][lk + i] = bv[i]; }
                __syncthreads();
#pragma unroll 8
                for (int kk = 0; kk < 32; ++kk) {
                    float a[4], b[4];
#pragma unroll
                    for (int i = 0; i < 4; ++i) { a[i] = As[ty * 4 + i][kk]; b[i] = Bs[cl(tx, i)][kk]; }
#pragma unroll
                    for (int i = 0; i < 4; ++i)
#pragma unroll
                        for (int j = 0; j < 4; ++j) acc[ps][i][j] += a[i] * b[j];
                }
            }
        }
        if (act_) {
#pragma unroll
            for (int i = 0; i < 4; ++i) f.epi(m0 + ty * 4 + i, n0, tx, acc[0][i], acc[F::NPASS - 1][i]);
        }
    }
}

struct InProjN {
    static constexpr int NPASS = 1; Params p;
    __device__ __forceinline__ bool active(int) const { return true; }
    __device__ __forceinline__ int K(int) const { return D; }
    __device__ __forceinline__ int ldb(int) const { return NCOL; }
    __device__ __forceinline__ const act* arow(int, int m) const { return (const act*)(p.ws + WS_H) + (size_t)m * D; }
    __device__ __forceinline__ const bf16* brow(int, int, int n) const { return (const bf16*)(p.ws + WS_WIN) + (size_t)n * D; }
    __device__ __forceinline__ void epi(int m, int n0, int tx, float (&v)[4], float (&)[4]) const {
        unsigned char* ws = p.ws;
        act* dst; int ld, cb; bool rope = false; const float* gbias = nullptr;
        if (n0 < C_KA) { dst = (act*)(ws + WS_QA); ld = WA; cb = n0 - C_QA; rope = true; }
        else if (n0 < C_VA) { dst = (act*)(ws + WS_KA); ld = WA; cb = n0 - C_KA; rope = true; }
        else if (n0 < C_QB) { dst = (act*)(ws + WS_VA); ld = WA; cb = n0 - C_VA; }
        else if (n0 < C_KB) { dst = (act*)(ws + WS_QB); ld = WB; cb = n0 - C_QB; rope = true; }
        else if (n0 < C_VB) { dst = (act*)(ws + WS_KB); ld = WB; cb = n0 - C_KB; rope = true; }
        else if (n0 < C_GA) { dst = (act*)(ws + WS_VB); ld = WB; cb = n0 - C_VB; }
        else if (n0 < C_GB) { dst = (act*)(ws + WS_SA); ld = D; cb = n0 - C_GA; gbias = p.b_gate_a; }
        else { dst = (act*)(ws + WS_SB); ld = D; cb = n0 - C_GB; gbias = p.b_gate_b; }
        if (rope && (tx >> 3) == 0) {
            const float2 cs = ((const float2*)(ws + WS_ROPE))[(m % S) * 8 + (tx & 7)];
            const float x1 = v[0], x2 = v[1]; v[0] = x1 * cs.x - x2 * cs.y; v[1] = x2 * cs.x + x1 * cs.y;
        }
#pragma unroll
        for (int j = 0; j < 4; ++j) { const int c = cb + cl(tx, j); float o = v[j];
            if (gbias) { o = 1.0f / (1.0f + expf(-(o + gbias[c]))); }
            stact(dst + (size_t)m * ld + c, o); }
    }
};
struct MixN {
    static constexpr int NPASS = 2; Params p;
    __device__ __forceinline__ bool active(int) const { return true; }
    __device__ __forceinline__ int K(int ps) const { return ps == 0 ? WA : WBO; }
    __device__ __forceinline__ int ldb(int) const { return D; }
    __device__ __forceinline__ const act* arow(int ps, int m) const { return ps == 0 ? (const act*)(p.ws + WS_OA) + (size_t)m * WA : (const act*)(p.ws + WS_OB) + (size_t)m * WBO; }
    __device__ __forceinline__ const bf16* brow(int ps, int, int n) const { return ps == 0 ? (const bf16*)(p.ws + WS_WOA) + (size_t)n * WA : (const bf16*)(p.ws + WS_WOB) + (size_t)n * WBO; }
    __device__ __forceinline__ void epi(int m, int n0, int tx, float (&a)[4], float (&b)[4]) const {
#pragma unroll
        for (int j = 0; j < 4; ++j) { const int c = n0 + cl(tx, j); const size_t o = (size_t)m * D + c;
            const float sa = ldact((const act*)(p.ws + WS_SA) + o), sb = ldact((const act*)(p.ws + WS_SB) + o);
            stact((act*)(p.ws + WS_MIX) + o, sa * a[j] + sb * b[j]); }
    }
};
struct OutN {
    static constexpr int NPASS = 1; Params p;
    __device__ __forceinline__ bool active(int) const { return true; }
    __device__ __forceinline__ int K(int) const { return D; }
    __device__ __forceinline__ int ldb(int) const { return D; }
    __device__ __forceinline__ const act* arow(int, int m) const { return (const act*)(p.ws + WS_MIX) + (size_t)m * D; }
    __device__ __forceinline__ const bf16* brow(int, int, int n) const { return (const bf16*)(p.ws + WS_WOUT) + (size_t)n * D; }
    __device__ __forceinline__ void epi(int m, int n0, int tx, float (&a)[4], float (&)[4]) const {
#pragma unroll
        for (int j = 0; j < 4; ++j) { const size_t o = (size_t)m * D + n0 + cl(tx, j); p.out[o] = p.x[o] + a[j]; }
    }
};
struct GateUpN {
    static constexpr int NPASS = 2; Params p;
    __device__ __forceinline__ bool active(int m0) const { return ((const int*)(p.ws + WS_TILEE))[m0 >> 8] >= 0; }
    __device__ __forceinline__ int K(int) const { return D; }
    __device__ __forceinline__ int ldb(int) const { return FF; }
    __device__ __forceinline__ const act* arow(int, int m) const { int a = ((const int*)(p.ws + WS_ROWTOK))[m]; if (a < 0) a = 0; return (const act*)(p.ws + WS_H) + (size_t)(a >> 2) * D; }
    __device__ __forceinline__ const bf16* brow(int ps, int m0, int n) const { const int e = ((const int*)(p.ws + WS_TILEE))[m0 >> 8];
        return (const bf16*)(p.ws + WS_WGU) + ((size_t)e * 2 * FF + 32 * (n >> 4) + (n & 15) + 16 * ps) * D;
    }
    __device__ __forceinline__ void epi(int m, int n0, int tx, float (&ga)[4], float (&ua)[4]) const {
        const int e = ((const int*)(p.ws + WS_TILEE))[m >> 8];
#pragma unroll
        for (int j = 0; j < 4; ++j) { const int c = n0 + cl(tx, j);
            float g = ga[j] + p.b_gate[e * FF + c], u = ua[j] + p.b_up[e * FF + c];
            g = fminf(g, 7.0f); u = fminf(fmaxf(u, -7.0f), 7.0f);
            const float a = g * (1.0f / (1.0f + expf(-1.702f * g))) * (u + 1.0f);
            stact((act*)(p.ws + WS_A2) + (size_t)m * FF + c, a); }
    }
};
struct DownN {
    static constexpr int NPASS = 1; Params p;
    __device__ __forceinline__ bool active(int m0) const { return ((const int*)(p.ws + WS_TILEE))[m0 >> 8] >= 0; }
    __device__ __forceinline__ int K(int) const { return FF; }
    __device__ __forceinline__ int ldb(int) const { return D; }
    __device__ __forceinline__ const act* arow(int, int m) const { return (const act*)(p.ws + WS_A2) + (size_t)m * FF; }
    __device__ __forceinline__ const bf16* brow(int, int m0, int n) const { const int e = ((const int*)(p.ws + WS_TILEE))[m0 >> 8];
        return (const bf16*)(p.ws + WS_WD) + ((size_t)e * D + n) * FF;
    }
    __device__ __forceinline__ void epi(int m, int n0, int tx, float (&a)[4], float (&)[4]) const {
        const int asg = ((const int*)(p.ws + WS_ROWTOK))[m]; if (asg < 0) return;
        const int e = ((const int*)(p.ws + WS_TILEE))[m >> 8]; const float pw = ((const float*)(p.ws + WS_ROWP))[m];
#pragma unroll
        for (int j = 0; j < 4; ++j) { const int c = n0 + cl(tx, j); const float y = (a[j] + p.b_down[e * D + c]) * pw;
            ((bf16*)(p.ws + WS_Y))[(size_t)asg * D + c] = (bf16)f2bf(y);
        }
    }
};


__device__ __forceinline__ void phase_kmean(const Params& p, int gw, int ngw, int lane) {
    for (int it = gw; it < NB * NHA * NBLK; it += ngw) {
        const int n = it % NBLK, h = (it / NBLK) % NHA, b = it / (NBLK * NHA), d = lane;
        const bf16* k = (const bf16*)(p.ws + WS_KA) + ((size_t)b * S + (size_t)n * MBLK) * WA + h * HD + d;
        float s = 0.f; for (int r = 0; r < MBLK; ++r) s += bf2f(k[(size_t)r * WA]);
        ((float*)(p.ws + WS_KMEAN))[(size_t)it * HD + d] = s * (1.0f / MBLK);
    }
}
__device__ __forceinline__ void phase_select(const Params& p, int gtid, int ngt) {
    for (int idx = gtid; idx < T * NHA; idx += ngt) {
        const int h = idx % NHA, t = idx / NHA, b = t / S, s = t % S, blk = s / MBLK;
        const bf16* q = (const bf16*)(p.ws + WS_QA) + (size_t)t * WA + h * HD;
        const float* km = (const float*)(p.ws + WS_KMEAN) + (size_t)(b * NHA + h) * NBLK * HD;
        float best0 = -INFINITY, best1 = -INFINITY, best2 = -INFINITY; int b0 = -1, b1 = -1, b2 = -1;
        for (int n = 0; n < blk; ++n) {
            float g = 0.f; for (int d = 0; d < HD; ++d) g += bf2f(q[d]) * km[n * HD + d];
            if (g > best0) { best2 = best1; b2 = b1; best1 = best0; b1 = b0; best0 = g; b0 = n; }
            else if (g > best1) { best2 = best1; b2 = b1; best1 = g; b1 = n; }
            else if (g > best2) { best2 = g; b2 = n; }
        }
        signed char* sel = (signed char*)(p.ws + WS_SEL) + (size_t)idx * 4;
        sel[0] = (signed char)b0; sel[1] = (signed char)b1; sel[2] = (signed char)b2; sel[3] = -1;
    }
}
__device__ __forceinline__ float dot64(const float* qs, const bf16* kr) {
    float a = 0.f;
    for (int d8 = 0; d8 < 8; ++d8) { float kv[8]; ldact8(kr + d8 * 8, kv);
#pragma unroll
        for (int i = 0; i < 8; ++i) a += qs[d8 * 8 + i] * kv[i]; }
    return a;
}
#define WAVE_LDS_FENCE() asm volatile("s_waitcnt lgkmcnt(0)" ::: "memory")
__device__ __forceinline__ void phase_moba_naive(const Params& p, int gw, int ngw, int lane, float* wl) {
    float* qs = wl; float* sc = wl + 64;
    for (int it = gw; it < T * NHA; it += ngw) {
        const int h = it % NHA, t = it / NHA, b = t / S, s = t % S, blk = s / MBLK;
        WAVE_LDS_FENCE();
        qs[lane] = bf2f(((const bf16*)(p.ws + WS_QA))[(size_t)t * WA + h * HD + lane]);
        WAVE_LDS_FENCE();
        const signed char* sel = (const signed char*)(p.ws + WS_SEL) + ((size_t)t * NHA + h) * 4;
        const int kb0 = blk, kb1 = sel[0], kb2 = sel[1], kb3 = sel[2];
        const bf16* K = (const bf16*)(p.ws + WS_KA) + (size_t)b * S * WA + h * HD; const bf16* V = (const bf16*)(p.ws + WS_VA) + (size_t)b * S * WA + h * HD;
        float mx = -INFINITY;
        for (int g = 0; g < 4; ++g) { const int kbg = g == 0 ? kb0 : g == 1 ? kb1 : g == 2 ? kb2 : kb3;
            for (int c = 0; c < 4; ++c) {
                const int kk = c * 64 + lane; float v = -INFINITY;
                if (kbg >= 0) { const int key = kbg * MBLK + kk; if (g > 0 || key <= s) v = dot64(qs, K + (size_t)key * WA) * 0.125f; }
                sc[g * 256 + kk] = v; mx = fmaxf(mx, v);
            } }
#pragma unroll
        for (int o = 1; o < 64; o <<= 1) mx = fmaxf(mx, __shfl_xor(mx, o));
        WAVE_LDS_FENCE();
        float l = 0.f;
        for (int i = lane; i < 1024; i += 64) { const float e = (sc[i] == -INFINITY) ? 0.f : expf(sc[i] - mx); sc[i] = e; l += e; }
        l = wave_sum(l);
        WAVE_LDS_FENCE();
        float o = 0.f;
        for (int g = 0; g < 4; ++g) { const int kbg = g == 0 ? kb0 : g == 1 ? kb1 : g == 2 ? kb2 : kb3; if (kbg < 0) continue;
            for (int kk = 0; kk < 256; ++kk) { const float pr = sc[g * 256 + kk]; if (pr != 0.f) o += pr * bf2f(V[(size_t)(kbg * MBLK + kk) * WA + lane]); } }
        ((bf16*)(p.ws + WS_OA))[(size_t)t * WA + h * HD + lane] = (bf16)f2bf(o / l);
    }
}
__device__ __forceinline__ void phase_dil_naive(const Params& p, int gw, int ngw, int lane, float* wl) {
    float* qs = wl; float* sc = wl + 192;
    for (int it = gw; it < T * 4; it += ngw) {
        const int j = it % 4, t = it / 4, b = t / S, s = t % S;
        WAVE_LDS_FENCE();
        for (int g = 0; g < 3; ++g) qs[g * 64 + lane] = bf2f(((const bf16*)(p.ws + WS_QB))[(size_t)t * WB + (4 * g + j) * HD + lane]);
        WAVE_LDS_FENCE();
        float mx = -INFINITY;
        for (int g = 0; g < 3; ++g) { const int dl = g == 0 ? 1 : g == 1 ? 4 : 16; const bf16* K = (const bf16*)(p.ws + WS_KB) + (size_t)b * S * WB + (4 * g + j) * HD;
            for (int i = lane; i <= 128; i += 64) { const int key = s - i * dl; float v = -INFINITY;
                if (key >= 0) v = dot64(qs + g * 64, K + (size_t)key * WB) * 0.125f;
                sc[g * 129 + i] = v; mx = fmaxf(mx, v); } }
#pragma unroll
        for (int o = 1; o < 64; o <<= 1) mx = fmaxf(mx, __shfl_xor(mx, o));
        WAVE_LDS_FENCE();
        float l = 0.f;
        for (int i = lane; i < 3 * 129; i += 64) { const float e = (sc[i] == -INFINITY) ? 0.f : expf(sc[i] - mx); sc[i] = e; l += e; }
        l = wave_sum(l);
        WAVE_LDS_FENCE();
        float o = 0.f;
        for (int g = 0; g < 3; ++g) { const int dl = g == 0 ? 1 : g == 1 ? 4 : 16; const bf16* V = (const bf16*)(p.ws + WS_VB) + (size_t)b * S * WB + (4 * g + j) * HD;
            for (int i = 0; i <= 128; ++i) { const float pr = sc[g * 129 + i]; const int key = s - i * dl; if (key >= 0 && pr != 0.f) o += pr * bf2f(V[(size_t)key * WB + lane]); } }
        ((bf16*)(p.ws + WS_OB))[(size_t)t * WBO + j * HD + lane] = (bf16)f2bf(o / l);
    }
}

__device__ __forceinline__ void phase_router(const Params& p, int gw, int ngw, int lane) {
    for (int t = gw; t < T; t += ngw) {
        const f32x4* xr = (const f32x4*)(p.out + (size_t)t * D) + lane; const f32x4* gr = (const f32x4*)p.ln_ffn_g + lane;
        f32x4 v[4]; float ss = 0.f;
#pragma unroll
        for (int j = 0; j < 4; ++j) { v[j] = xr[64 * j]; ss += (v[j].x * v[j].x + v[j].y * v[j].y) + (v[j].z * v[j].z + v[j].w * v[j].w); }
        const float rstd = 1.0f / sqrtf(wave_sum(ss) * (1.0f / D) + NORM_EPS);
        float cur[32];
#pragma unroll
        for (int e = 0; e < 32; ++e) cur[e] = 0.f;
#pragma unroll
        for (int j = 0; j < 4; ++j) { const f32x4 g = gr[64 * j]; f32x4 hv; hv.x = v[j].x * rstd * g.x; hv.y = v[j].y * rstd * g.y; hv.z = v[j].z * rstd * g.z; hv.w = v[j].w * rstd * g.w;
            u32x2 o; o.x = pk2(hv.x, hv.y); o.y = pk2(hv.z, hv.w); ((u32x2*)((bf16*)(p.ws + WS_H) + (size_t)t * D))[lane + 64 * j] = o;
#pragma unroll
            for (int i = 0; i < 4; ++i) { const float* wr = p.w_router + (size_t)(4 * (lane + 64 * j) + i) * NE; const float hh = hv[i];
#pragma unroll
                for (int e4 = 0; e4 < 8; ++e4) { const f32x4 w = *(const f32x4*)(wr + 4 * e4); cur[4 * e4] += hh * w.x; cur[4 * e4 + 1] += hh * w.y; cur[4 * e4 + 2] += hh * w.z; cur[4 * e4 + 3] += hh * w.w; } } }
#define RSTEP(C, M) { const bool hi_ = (lane & M) != 0; _Pragma("unroll") for (int i = 0; i < C / 2; ++i) { const float send = hi_ ? cur[i] : cur[i + C / 2]; const float keep = hi_ ? cur[i + C / 2] : cur[i]; cur[i] = keep + __shfl_xor(send, M); } }
        RSTEP(32, 32) RSTEP(16, 16) RSTEP(8, 8) RSTEP(4, 4) RSTEP(2, 2)
#undef RSTEP
        float lg = cur[0] + __shfl_xor(cur[0], 1);
        const int e = lane >> 1; lg += p.b_router[e];
        float w = lg, val0 = 0.f, mv = 0.f, den = 0.f; int ek = 0;
#pragma unroll
        for (int k = 0; k < 4; ++k) { float m = w;
#pragma unroll
            for (int o = 1; o < 64; o <<= 1) m = fmaxf(m, __shfl_xor(m, o));
            const unsigned long long bal = __ballot(w == m); const int fl = __ffsll((long long)bal) - 1;
            if (k == 0) val0 = m;
            den += expf(m - val0);
            if (lane == k) { ek = fl >> 1; mv = m; }
            if (e == (fl >> 1)) w = -INFINITY; }
        if (lane < 4) { const float pk = expf(mv - val0) / den;
            const int pos = atomicAdd((int*)(p.ws + WS_CTL) + CW_ECNT + ek, 1);
            ((int*)(p.ws + WS_ELIST))[ek * T + pos] = t * 4 + lane; ((float*)(p.ws + WS_EP))[ek * T + pos] = pk; }
    }
}
__device__ __forceinline__ void phase_rows(const Params& p, int gtid, int ngt) {
    const int* cnt = (const int*)(p.ws + WS_CTL) + CW_ECNT;
    for (int m = gtid; m < A2ROWS; m += ngt) {
        int start = 0, e = -1, pos = 0;
        for (int i = 0; i < NE; ++i) { const int c = __hip_atomic_load(cnt + i, __ATOMIC_RELAXED, __HIP_MEMORY_SCOPE_AGENT), pad = (c + 255) & ~255; if (m >= start && m < start + pad) { e = i; pos = m - start; } start += pad; }
        int asg = -1; float pw = 0.f;
        if (e >= 0 && pos < __hip_atomic_load(cnt + e, __ATOMIC_RELAXED, __HIP_MEMORY_SCOPE_AGENT)) { asg = ((const int*)(p.ws + WS_ELIST))[e * T + pos]; pw = ((const float*)(p.ws + WS_EP))[e * T + pos]; }
        ((int*)(p.ws + WS_ROWTOK))[m] = asg; ((float*)(p.ws + WS_ROWP))[m] = pw;
        if ((m & 255) == 0) ((int*)(p.ws + WS_TILEE))[m >> 8] = e;
    }
}
__device__ __forceinline__ void phase_final(const Params& p, int gw, int ngw, int lane) {
    for (int t = gw; t < T; t += ngw) {
        f32x4* xr = (f32x4*)(p.out + (size_t)t * D) + lane; const f32x4* gr = (const f32x4*)p.ln_final_g + lane;
        f32x4 v[4]; float ss = 0.f;
#pragma unroll
        for (int j = 0; j < 4; ++j) { v[j] = xr[64 * j];
#pragma unroll
            for (int k = 0; k < 4; ++k) { const u32x2 y = ((const u32x2*)((const bf16*)(p.ws + WS_Y) + ((size_t)t * 4 + k) * D))[lane + 64 * j];
                v[j].x += __uint_as_float(y.x << 16); v[j].y += __uint_as_float(y.x & 0xffff0000u); v[j].z += __uint_as_float(y.y << 16); v[j].w += __uint_as_float(y.y & 0xffff0000u); }
            ss += (v[j].x * v[j].x + v[j].y * v[j].y) + (v[j].z * v[j].z + v[j].w * v[j].w); }
        const float rstd = 1.0f / sqrtf(wave_sum(ss) * (1.0f / D) + NORM_EPS);
#pragma unroll
        for (int j = 0; j < 4; ++j) { const f32x4 g = gr[64 * j]; f32x4 o; o.x = v[j].x * rstd * g.x; o.y = v[j].y * rstd * g.y; o.z = v[j].z * rstd * g.z; o.w = v[j].w * rstd * g.w; xr[64 * j] = o; }
    }
}

constexpr int LDS_BYTES = 147456;
__global__ void __launch_bounds__(512, 2) mega_fwd(Params p) {
    extern __shared__ __attribute__((aligned(16))) unsigned char lds[];
    cg::grid_group grid = cg::this_grid();
    const int bid = blockIdx.x, nb = gridDim.x, tid = threadIdx.x, lane = tid & 63, wave = tid >> 6;
    const int gw = bid * 8 + wave, ngw = nb * 8, gtid = bid * 512 + tid, ngt = nb * 512;
    float* wl = (float*)lds + wave * 1152;
    phase_prep(p, bid, nb, lds);
    grid.sync();
    { InProjN f{p}; phase_naive_gemm(f, T, NCOL, bid, nb, lds); }
    grid.sync();
    phase_kmean(p, gw, ngw, lane);
    grid.sync();
    phase_select(p, gtid, ngt);
    grid.sync();
    phase_moba_naive(p, gw, ngw, lane, wl);
    phase_dil_naive(p, gw, ngw, lane, wl);
    grid.sync();
    { MixN f{p}; phase_naive_gemm(f, T, D, bid, nb, lds); }
    grid.sync();
    { OutN f{p}; phase_naive_gemm(f, T, D, bid, nb, lds); }
    grid.sync();
    phase_router(p, gw, ngw, lane);
    grid.sync();
    phase_rows(p, gtid, ngt);
    grid.sync();
    { GateUpN f{p}; phase_naive_gemm(f, A2ROWS, FF, bid, nb, lds); }
    grid.sync();
    { DownN f{p}; phase_naive_gemm(f, A2ROWS, D, bid, nb, lds); }
    grid.sync();
    phase_final(p, gw, ngw, lane);
}

extern "C" void kernel_launch(void* const* d_in, const int* in_sizes, int n_in, void* d_out, int out_size, void* d_ws, size_t ws_size, hipStream_t stream) {
    if (n_in != 18 || ws_size < WS_END || out_size != T * D) return;
    static int grid_blocks = 0;
    if (!grid_blocks) {
        int dev = 0, cus = 0, per_cu = 0;
        (void)hipGetDevice(&dev);
        (void)hipDeviceGetAttribute(&cus, hipDeviceAttributeMultiprocessorCount, dev);
        (void)hipFuncSetAttribute((const void*)mega_fwd, hipFuncAttributeMaxDynamicSharedMemorySize, LDS_BYTES);
        (void)hipOccupancyMaxActiveBlocksPerMultiprocessor(&per_cu, (const void*)mega_fwd, 512, LDS_BYTES);
        if (per_cu < 1) per_cu = 1;
        if (per_cu > 1) per_cu = 1;
        grid_blocks = cus * per_cu;
    }
    Params p{};
    const float** fp = (const float**)&p;
    for (int i = 0; i < 18; ++i) fp[i] = (const float*)d_in[i];
    p.out = (float*)d_out; p.ws = (unsigned char*)d_ws;
    for (int i = 0; i < 8; ++i) p.inv_freq[i] = (float)pow(500000.0, -(double)i / 8.0);
    (void)hipMemsetAsync((char*)d_ws + WS_CTL, 0, 1 * MiB, stream);
    void* args[] = {&p};
    (void)hipLaunchCooperativeKernel((const void*)mega_fwd, dim3(grid_blocks), dim3(512), args, LDS_BYTES, stream);
}
```

```cpp
#include <hip/hip_runtime.h>
#include <hip/hip_cooperative_groups.h>
namespace cg = cooperative_groups;
#include <stdint.h>
#include <math.h>

typedef unsigned short bf16;
typedef float f32x4 __attribute__((ext_vector_type(4)));
typedef unsigned u32x4 __attribute__((ext_vector_type(4)));
typedef unsigned u32x2 __attribute__((ext_vector_type(2)));

__device__ __forceinline__ float bf2f(bf16 v) { return __uint_as_float(((unsigned)v) << 16); }
__device__ __forceinline__ unsigned f2bf(float f) { unsigned u = __float_as_uint(f); return (u + 0x7fffu + ((u >> 16) & 1u)) >> 16; }
__device__ __forceinline__ unsigned pk2(float lo, float hi) { return f2bf(lo) | (f2bf(hi) << 16); }

typedef float f32x2 __attribute__((ext_vector_type(2)));
typedef __bf16 bf16x2_t __attribute__((ext_vector_type(2)));
__device__ __forceinline__ unsigned cvtpk(float lo, float hi) { f32x2 v = {lo, hi}; bf16x2_t b = __builtin_convertvector(v, bf16x2_t); return __builtin_bit_cast(unsigned, b); }
__device__ __forceinline__ float fast_sigmoid(float x) { return __builtin_amdgcn_rcpf(1.0f + __builtin_amdgcn_exp2f(-1.4426950408889634f * x)); }
typedef float f32x16 __attribute__((ext_vector_type(16)));
typedef short s16x4 __attribute__((ext_vector_type(4)));
typedef short bf16x8v __attribute__((ext_vector_type(8)));
__device__ __forceinline__ int crow(int r, int h) { return (r & 3) + 8 * (r >> 2) + 4 * h; }
#define GAS __attribute__((address_space(1)))
#define LAS __attribute__((address_space(3)))
typedef bf16 act;
__device__ __forceinline__ float ldact(const act* p) { return bf2f(*p); }
__device__ __forceinline__ void stact(act* p, float v) { *p = (bf16)f2bf(v); }
__device__ __forceinline__ void ldact8(const act* p, float (&o)[8]) { const u32x4 a = *(const u32x4*)p;
#pragma unroll
    for (int i = 0; i < 4; ++i) { o[2 * i] = __uint_as_float(a[i] << 16); o[2 * i + 1] = __uint_as_float(a[i] & 0xffff0000u); } }
#ifndef FP8_GU
#define FP8_GU 1
#endif
#ifndef FP8_DN
#define FP8_DN 1
#endif
#ifndef FP8_IN
#define FP8_IN 0
#endif
#ifndef FP8_MOE
#define FP8_MOE 1
#endif
constexpr int NB = 2, S = 8192, T = NB * S, D = 1024, HD = 64;
constexpr int NHA = 8, NHB = 12, WA = 512, WB = 768, WBO = 256, NCOL = 5888;
constexpr int MBLK = 256, NBLK = S / MBLK;
constexpr int NE = 32, TOPK = 4, FF = 1024;
constexpr int A2ROWS = 73728;
constexpr int C_QA = 0, C_KA = 512, C_VA = 1024, C_QB = 1536, C_KB = 2304, C_VB = 3072, C_GA = 3840, C_GB = 4864;
constexpr float NORM_EPS = 1e-5f;

constexpr size_t MiB = 1u << 20;
constexpr size_t WS_CTL = 0;
constexpr size_t WS_WIN = 1 * MiB;
constexpr size_t WS_WOA = 13 * MiB;
constexpr size_t WS_WOB = 14 * MiB;
constexpr size_t WS_WOUT = 15 * MiB;
constexpr size_t WS_WGU = 17 * MiB;
constexpr size_t WS_WD = 145 * MiB;
constexpr size_t WS_ROPE = 209 * MiB;
constexpr size_t WS_KMEAN = WS_ROPE + 512 * 1024;
constexpr size_t WS_H = 210 * MiB;
constexpr size_t WS_QA = 242 * MiB, WS_KA = 258 * MiB, WS_VA = 274 * MiB;
constexpr size_t WS_QB = 290 * MiB, WS_KB = 314 * MiB, WS_VB = 338 * MiB;
constexpr size_t WS_SA = 362 * MiB, WS_SB = 394 * MiB;
constexpr size_t WS_PARTB = 210 * MiB;
constexpr size_t WS_LSEB = 234 * MiB;
constexpr size_t WS_LSEA = 235 * MiB;
constexpr size_t WS_SEL = 236 * MiB + 512 * 1024;
constexpr size_t WS_LIST = 426 * MiB;
constexpr size_t WS_PARTA = 442 * MiB;
constexpr int LIST_CAP = 8192;
constexpr size_t WS_OB = 434 * MiB;
constexpr size_t WS_OA = 490 * MiB;
constexpr size_t WS_MIX = 242 * MiB;
constexpr size_t WS_A2 = 242 * MiB;
constexpr size_t WS_ELIST = 386 * MiB;
constexpr size_t WS_EP = 388 * MiB;
constexpr size_t WS_ROWTOK = 390 * MiB;
constexpr size_t WS_ROWP = 391 * MiB;
constexpr size_t WS_TILEE = 392 * MiB;
constexpr size_t WS_Y = 17 * MiB;
constexpr size_t WS_END = 512 * MiB;
#ifndef TIMEB_LO
#define TIMEB_LO -1
#endif
#ifndef TIMEB_HI
#define TIMEB_HI -1
#endif
#ifndef TIMEB_GAIN
#define TIMEB_GAIN 1.0f
#endif
#ifndef DBG
#define DBG 0
#endif
#ifndef DBG_SUB
#define DBG_SUB 0
#endif
#ifndef DBG_GAIN
#define DBG_GAIN 100.0f
#endif
constexpr int CW_DNUM = 192, CW_DDEN = 193;
constexpr int CW_ECNT = 8192;
constexpr int CW_BAR = 4096;
constexpr int CW_LCNT = 12288;
constexpr int CW_HQ = 224;
constexpr int CW_NMT = 160;

struct Params {
    const float *x, *ln_mix_g, *w_in, *b_gate_a, *b_gate_b, *w_o_a, *w_o_b, *w_out, *ln_ffn_g, *w_router, *b_router,
        *w_gate, *b_gate, *w_up, *b_up, *w_down, *b_down, *ln_final_g;
    float* out; unsigned char* ws;
    float inv_freq[8];
    int use_cg, pad0;
};

template <int MAP> __device__ __forceinline__ int rowmap(int n) { return MAP == 0 ? n : (32 * (n >> 4) + (n & 15) + (MAP == 2 ? 16 : 0)); }
template <int MAP> __device__ __forceinline__ void transpose_item(const float* W, int K, int N, bf16* WT, float* scr, int item, int lane) {
    const int nblk = N / 64, kb = item / nblk, nb = item % nblk, k0 = 64 * kb, n0 = 64 * nb;
    f32x4 v[16];
#pragma unroll
    for (int i = 0; i < 16; ++i) v[i] = *(const f32x4*)(W + (size_t)(k0 + (lane >> 4) + 4 * i) * N + n0 + 4 * (lane & 15));
#pragma unroll
    for (int i = 0; i < 16; ++i) { float* d = scr + ((lane >> 4) + 4 * i) * 65 + 4 * (lane & 15); d[0] = v[i].x; d[1] = v[i].y; d[2] = v[i].z; d[3] = v[i].w; }
    asm volatile("s_waitcnt lgkmcnt(0)" ::: "memory");
    const int c = lane & 7;
#pragma unroll
    for (int j = 0; j < 8; ++j) { const int n = (lane >> 3) + 8 * j; const float* q = scr + (8 * c) * 65 + n;
        u32x4 o; o.x = cvtpk(q[0 * 65], q[1 * 65]); o.y = cvtpk(q[2 * 65], q[3 * 65]); o.z = cvtpk(q[4 * 65], q[5 * 65]); o.w = cvtpk(q[6 * 65], q[7 * 65]);
        *(u32x4*)(WT + (size_t)rowmap<MAP>(n0 + n) * K + k0 + 8 * c) = o; }
    asm volatile("s_waitcnt lgkmcnt(0)" ::: "memory");
}
__device__ __forceinline__ float wave_sum(float v) {
#pragma unroll
    for (int o = 1; o < 64; o <<= 1) v += __shfl_xor(v, o);
    return v;
}
__device__ __forceinline__ void sincos_acc(float ang, float& c, float& s) {
    const double a = (double)ang; const double k = rint(a * 0.63661977236758134308); const double y = a - k * 1.57079632679489661923; const double y2 = y * y;
    const double sn = y * (1.0 + y2 * (-1.0 / 6 + y2 * (1.0 / 120 + y2 * (-1.0 / 5040 + y2 * (1.0 / 362880 + y2 * (-1.0 / 39916800))))));
    const double cs = 1.0 + y2 * (-0.5 + y2 * (1.0 / 24 + y2 * (-1.0 / 720 + y2 * (1.0 / 40320 + y2 * (-1.0 / 3628800 + y2 * (1.0 / 479001600))))));
    const int q = ((int)k) & 3;
    const double ss = (q == 0) ? sn : (q == 1) ? cs : (q == 2) ? -sn : -cs;
    const double cc = (q == 0) ? cs : (q == 1) ? -sn : (q == 2) ? -cs : sn;
    c = (float)cc; s = (float)ss;
}
struct TItem { const float* W; bf16* WT; int K, N, map, k0, n0, f8, kd; };
__device__ __forceinline__ TItem titem_decode(const Params& p, int it) {
    constexpr int I_OA = (WA / 64) * (D / 32), I_OB = (WBO / 64) * (D / 32), I_OUT = (D / 64) * (D / 32), I_E = (D / 64) * (FF / 32);
    static_assert(I_E == 512 && D == 1024 && FF == 1024, "the expert-matrix decode below uses shifts");
    unsigned char* ws = p.ws; TItem t; int r = it; t.f8 = 0; t.kd = 0; t.N = D; t.map = 0;
    if (r >= I_OA + I_OB + I_OUT) {
        r -= I_OA + I_OB + I_OUT; const int which = r >> 14  , e = (r >> 9) & 31; r &= 511; t.K = D;
        t.f8 = (which == 2) ? (FP8_DN ? 1 : 0) : (FP8_GU ? 1 : 0); const size_t esz = t.f8 ? 1 : 2;
        if (which == 0) { t.W = p.w_gate + (size_t)e * D * FF; t.WT = (bf16*)(ws + WS_WGU + (size_t)e * 2 * FF * D * esz); t.map = 1; }
        else if (which == 1) { t.W = p.w_up + (size_t)e * D * FF; t.WT = (bf16*)(ws + WS_WGU + (size_t)e * 2 * FF * D * esz); t.map = 2; }
        else { t.W = p.w_down + (size_t)e * FF * D; t.WT = (bf16*)(ws + WS_WD + (size_t)e * D * FF * esz); }
    }
    else if (r < I_OA) { t.W = p.w_o_a; t.WT = (bf16*)(ws + WS_WOA); t.K = WA + WBO; }
    else if ((r -= I_OA) < I_OB) { t.W = p.w_o_b; t.WT = (bf16*)(ws + WS_WOA); t.K = WA + WBO; t.kd = WA; }
    else { r -= I_OB; t.W = p.w_out; t.WT = (bf16*)(ws + WS_WOUT); t.K = D; }
    const int pr_ = r >> 1; t.k0 = 64 * (2 * (pr_ >> 5) + (r & 1)); t.n0 = 32 * (pr_ & 31);
    return t;
}
__device__ __forceinline__ void titem_load(const TItem& t, f32x4 (&v)[8], int lane) {
#pragma unroll
    for (int i = 0; i < 8; ++i) v[i] = __builtin_nontemporal_load((const f32x4*)(t.W + (size_t)(t.k0 + (lane >> 3) + 8 * i) * t.N + t.n0 + 4 * (lane & 7)));
}
__device__ __forceinline__ void titem_store(const TItem& t, const f32x4 (&v)[8], float* scr, int lane) {
#pragma unroll
    for (int i = 0; i < 8; ++i) { float* d = scr + ((lane >> 3) + 8 * i) * 33 + 4 * (lane & 7); d[0] = v[i].x; d[1] = v[i].y; d[2] = v[i].z; d[3] = v[i].w; }
    asm volatile("s_waitcnt lgkmcnt(0)" ::: "memory");
    const int c = (lane & 3) + 4 * (lane >> 5);
#pragma unroll
    for (int j = 0; j < 4; ++j) { const int n = ((lane >> 2) & 7) + 8 * j; const float* q = scr + (8 * c) * 33 + n; const int nn = t.n0 + n;
        const int row = t.map == 0 ? nn : (32 * (nn >> 4) + (nn & 15) + (t.map == 2 ? 16 : 0));
        if (t.f8) { int w0 = __builtin_amdgcn_cvt_pk_fp8_f32(q[0 * 33] * 64.f, q[1 * 33] * 64.f, 0, false); w0 = __builtin_amdgcn_cvt_pk_fp8_f32(q[2 * 33] * 64.f, q[3 * 33] * 64.f, w0, true);
            int w1 = __builtin_amdgcn_cvt_pk_fp8_f32(q[4 * 33] * 64.f, q[5 * 33] * 64.f, 0, false); w1 = __builtin_amdgcn_cvt_pk_fp8_f32(q[6 * 33] * 64.f, q[7 * 33] * 64.f, w1, true);
            u32x2 o; o.x = (unsigned)w0; o.y = (unsigned)w1; *(u32x2*)((unsigned char*)t.WT + (size_t)row * t.K + t.kd + t.k0 + 8 * c) = o; }
        else { u32x4 o; o.x = cvtpk(q[0 * 33], q[1 * 33]); o.y = cvtpk(q[2 * 33], q[3 * 33]); o.z = cvtpk(q[4 * 33], q[5 * 33]); o.w = cvtpk(q[6 * 33], q[7 * 33]);
            *(u32x4*)(t.WT + (size_t)row * t.K + t.kd + t.k0 + 8 * c) = o; } }
    asm volatile("s_waitcnt lgkmcnt(0)" ::: "memory");
}
__device__ __forceinline__ void phase_prep_a(const Params& p, int bid, int nb, unsigned char* lds) {
    int tid = threadIdx.x; asm volatile("" : "+v"(tid)); const int lane = tid & 63, wave = tid >> 6;
    const int gw = bid * 8 + wave, NGW = nb * 8;
    unsigned char* ws = p.ws;
    float* scr = (float*)lds + wave * (64 * 33);
    constexpr int I_IN = (D / 64) * (NCOL / 32);
    for (int it = gw; it < I_IN; it += NGW) {
        TItem t; t.W = p.w_in; t.WT = (bf16*)(ws + WS_WIN); t.K = D; t.N = NCOL; t.map = 0; t.f8 = FP8_IN; t.kd = 0; t.k0 = 64 * (it / (NCOL / 32)); t.n0 = 32 * (it % (NCOL / 32));
        f32x4 v[8]; titem_load(t, v, lane); titem_store(t, v, scr, lane);
    }
    for (int m = gw; m < T; m += NGW) {
        const f32x4* xr = (const f32x4*)(p.x + (size_t)m * D) + lane; const f32x4* gr = (const f32x4*)p.ln_mix_g + lane;
        f32x4 v[4]; float s = 0.f;
#pragma unroll
        for (int j = 0; j < 4; ++j) { v[j] = xr[64 * j]; s += (v[j].x * v[j].x + v[j].y * v[j].y) + (v[j].z * v[j].z + v[j].w * v[j].w); }
        const float rstd = 1.0f / sqrtf(wave_sum(s) * (1.0f / D) + NORM_EPS);
#pragma unroll
        for (int j = 0; j < 4; ++j) { const f32x4 g = gr[64 * j];
#if FP8_IN
            int o = __builtin_amdgcn_cvt_pk_fp8_f32(v[j].x * rstd * g.x, v[j].y * rstd * g.y, 0, false); o = __builtin_amdgcn_cvt_pk_fp8_f32(v[j].z * rstd * g.z, v[j].w * rstd * g.w, o, true);
            ((int*)((unsigned char*)(ws + WS_H) + (size_t)m * D))[lane + 64 * j] = o;
#else
            u32x2 o; o.x = cvtpk(v[j].x * rstd * g.x, v[j].y * rstd * g.y); o.y = cvtpk(v[j].z * rstd * g.z, v[j].w * rstd * g.w); ((u32x2*)((bf16*)(ws + WS_H) + (size_t)m * D))[lane + 64 * j] = o;
#endif
        }
    }
    float2* rope = (float2*)(ws + WS_ROPE);
    for (int i = bid * 512 + tid; i < S * 8; i += nb * 512) { const int s = i >> 3, f = i & 7; const float ang = (float)s * p.inv_freq[f]; float c, sn; sincos_acc(ang, c, sn); rope[i] = make_float2(c, sn); }
    for (int i = bid * 512 + tid; i < NB * NHA * NBLK * HD; i += nb * 512) ((float*)(ws + WS_KMEAN))[i] = 0.f;
}
__device__ __forceinline__ void phase_prep_b(const Params& p, unsigned char* lds) {
    int tid = threadIdx.x; asm volatile("" : "+v"(tid)); const int lane = tid & 63, wave = tid >> 6;
    float* scr = (float*)lds + wave * (64 * 33);
    constexpr int NITEMS = (WA / 64) * (D / 32) + (WBO / 64) * (D / 32) + (D / 64) * (D / 32) + 3 * NE * (D / 64) * (FF / 32);
    int* ctr = (int*)(p.ws + WS_CTL) + CW_HQ;
    int qcur = 0, qend = 0; bool qdone = false;
#define TQ_NEXT(dst) do { if (qcur == qend && !qdone) { int b_ = 0; if (lane == 0) b_ = atomicAdd(ctr, 8); b_ = __builtin_amdgcn_readfirstlane(b_); \
        if (b_ >= NITEMS) qdone = true; else { qcur = b_; qend = (b_ + 8 < NITEMS) ? b_ + 8 : NITEMS; } } \
        if (qcur < qend) dst = qcur++; else dst = -1; } while (0)
    TItem ta, tb, tc; f32x4 va[8], vb[8], vc[8];
    int ia, ib, ic;
    TQ_NEXT(ia); if (ia >= 0) { ta = titem_decode(p, ia); titem_load(ta, va, lane); }
    TQ_NEXT(ib); if (ib >= 0) { tb = titem_decode(p, ib); titem_load(tb, vb, lane); }
    while (ia >= 0) {
        TQ_NEXT(ic); if (ic >= 0) { tc = titem_decode(p, ic); titem_load(tc, vc, lane); }
        titem_store(ta, va, scr, lane);
        if (ib < 0) break;
        TQ_NEXT(ia); if (ia >= 0) { ta = titem_decode(p, ia); titem_load(ta, va, lane); }
        titem_store(tb, vb, scr, lane);
        if (ic < 0) break;
        TQ_NEXT(ib); if (ib >= 0) { tb = titem_decode(p, ib); titem_load(tb, vb, lane); }
        titem_store(tc, vc, scr, lane);
    }
#undef TQ_NEXT
}

__device__ __forceinline__ int cl(int tx, int j) { return (tx & 7) + 8 * j + 32 * (tx >> 3); }
template <class F> __device__ __forceinline__ void phase_naive_gemm(const F& f, int M, int N, int bid, int nb, unsigned char* lds) {
    const int half = threadIdx.x >> 8, tid = threadIdx.x & 255, tx = tid & 15, ty = tid >> 4;
    float (*As)[33] = (float (*)[33])(lds + half * (2 * 64 * 33 * 4)); float (*Bs)[33] = As + 64;
    const int nN = N / 64, ntiles = (M / 64) * nN, stride = nb * 2;
    const int nround = (ntiles + stride - 1) / stride;
    const int lr = tid >> 2, lk = (tid & 3) * 8;
    for (int r = 0; r < nround; ++r) {
        const int it = r * stride + bid * 2 + half;
        const bool valid = it < ntiles;
        const int m0 = valid ? (it / nN) * 64 : 0, n0 = valid ? (it % nN) * 64 : 0;
        const bool act_ = valid && f.active(m0);
        float acc[F::NPASS][4][4];
#pragma unroll
        for (int ps = 0; ps < F::NPASS; ++ps)
#pragma unroll
            for (int i = 0; i < 4; ++i)
#pragma unroll
                for (int j = 0; j < 4; ++j) acc[ps][i][j] = 0.f;
#pragma unroll
        for (int ps = 0; ps < F::NPASS; ++ps) {
            const int K = f.K(ps);
            const bf16* ap = act_ ? f.arow(ps, m0 + lr) : nullptr; const bf16* bp = act_ ? f.brow(ps, m0, n0 + lr) : nullptr;
            for (int k0 = 0; k0 < K; k0 += 32) {
                float av[8], bv[8];
                if (act_) { ldact8(ap + k0 + lk, av); ldact8(bp + k0 + lk, bv); }
                else {
#pragma unroll
                    for (int i = 0; i < 8; ++i) { av[i] = 0.f; bv[i] = 0.f; } }
                __syncthreads();
#pragma unroll
                for (int i = 0; i < 8; ++i) { As[lr][lk + i] = av[i]; Bs[lr][lk + i] = bv[i]; }
                __syncthreads();
#pragma unroll 8
                for (int kk = 0; kk < 32; ++kk) {
                    float a[4], b[4];
#pragma unroll
                    for (int i = 0; i < 4; ++i) { a[i] = As[ty * 4 + i][kk]; b[i] = Bs[cl(tx, i)][kk]; }
#pragma unroll
                    for (int i = 0; i < 4; ++i)
#pragma unroll
                        for (int j = 0; j < 4; ++j) acc[ps][i][j] += a[i] * b[j];
                }
            }
        }
        if (act_) {
#pragma unroll
            for (int i = 0; i < 4; ++i) f.epi(m0 + ty * 4 + i, n0, tx, acc[0][i], acc[F::NPASS - 1][i]);
        }
    }
}

struct InProjN {
    static constexpr int NPASS = 1; Params p; bool alt;
    __device__ __forceinline__ bool active(int) const { return true; }
    __device__ __forceinline__ int K(int) const { return D; }
    __device__ __forceinline__ int ldb(int) const { return NCOL; }
    __device__ __forceinline__ const act* arow(int, int m) const { return (const act*)(p.ws + WS_H) + (size_t)m * D; }
    __device__ __forceinline__ const bf16* brow(int, int, int n) const { return (const bf16*)(p.ws + WS_WIN) + (size_t)n * D; }
    __device__ __forceinline__ void epi(int m, int n0, int tx, float (&v)[4], float (&)[4]) const {
        unsigned char* ws = p.ws;
        act* dst; int ld, cb; bool rope = false; const float* gbias = nullptr;
        if (n0 < C_KA) { dst = (act*)(ws + (alt ? 426 * MiB : WS_QA)); ld = WA; cb = n0 - C_QA; rope = true; }
        else if (n0 < C_VA) { dst = (act*)(ws + (alt ? 442 * MiB : WS_KA)); ld = WA; cb = n0 - C_KA; rope = true; }
        else if (n0 < C_QB) { if (alt) return; dst = (act*)(ws + WS_VA); ld = WA; cb = n0 - C_VA; }
        else if (n0 < C_KB) { dst = (act*)(ws + (alt ? 458 * MiB : WS_QB)); ld = WB; cb = n0 - C_QB; rope = true; }
        else if (n0 < C_VB) { dst = (act*)(ws + (alt ? 482 * MiB : WS_KB)); ld = WB; cb = n0 - C_KB; rope = true; }
        else if (alt) { return; }
        else if (n0 < C_GA) { dst = (act*)(ws + WS_VB); ld = WB; cb = n0 - C_VB; }
        else if (n0 < C_GB) { dst = (act*)(ws + WS_SA); ld = D; cb = n0 - C_GA; gbias = p.b_gate_a; }
        else { dst = (act*)(ws + WS_SB); ld = D; cb = n0 - C_GB; gbias = p.b_gate_b; }
        if (rope && (tx >> 3) == 0) {
            const float2 cs = ((const float2*)(ws + WS_ROPE))[(m % S) * 8 + (tx & 7)];
            const float x1 = v[0], x2 = v[1]; v[0] = x1 * cs.x - x2 * cs.y; v[1] = x2 * cs.x + x1 * cs.y;
        }
#pragma unroll
        for (int j = 0; j < 4; ++j) { const int c = cb + cl(tx, j); float o = v[j];
            if (gbias) { o = 1.0f / (1.0f + expf(-(o + gbias[c]))); }
            stact(dst + (size_t)m * ld + c, o); }
    }
};
struct MixN {
    static constexpr int NPASS = 2; Params p;
    __device__ __forceinline__ bool active(int) const { return true; }
    __device__ __forceinline__ int K(int ps) const { return ps == 0 ? WA : WBO; }
    __device__ __forceinline__ int ldb(int) const { return D; }
    __device__ __forceinline__ const act* arow(int ps, int m) const { return ps == 0 ? (const act*)(p.ws + WS_OA) + (size_t)m * WA : (const act*)(p.ws + WS_OB) + (size_t)m * WBO; }
    __device__ __forceinline__ const bf16* brow(int ps, int, int n) const { return ps == 0 ? (const bf16*)(p.ws + WS_WOA) + (size_t)n * WA : (const bf16*)(p.ws + WS_WOB) + (size_t)n * WBO; }
    __device__ __forceinline__ void epi(int m, int n0, int tx, float (&a)[4], float (&b)[4]) const {
#pragma unroll
        for (int j = 0; j < 4; ++j) { const int c = n0 + cl(tx, j); const size_t o = (size_t)m * D + c;
            const float sa = ldact((const act*)(p.ws + WS_SA) + o), sb = ldact((const act*)(p.ws + WS_SB) + o);
            stact((act*)(p.ws + WS_MIX) + o, sa * a[j] + sb * b[j]); }
    }
};
struct OutN {
    static constexpr int NPASS = 1; Params p;
    __device__ __forceinline__ bool active(int) const { return true; }
    __device__ __forceinline__ int K(int) const { return D; }
    __device__ __forceinline__ int ldb(int) const { return D; }
    __device__ __forceinline__ const act* arow(int, int m) const { return (const act*)(p.ws + WS_MIX) + (size_t)m * D; }
    __device__ __forceinline__ const bf16* brow(int, int, int n) const { return (const bf16*)(p.ws + WS_WOUT) + (size_t)n * D; }
    __device__ __forceinline__ void epi(int m, int n0, int tx, float (&a)[4], float (&)[4]) const {
#pragma unroll
        for (int j = 0; j < 4; ++j) { const size_t o = (size_t)m * D + n0 + cl(tx, j); p.out[o] = p.x[o] + a[j]; }
    }
};


namespace pg8 {
#define PG8_LAS __attribute__((address_space(3)))
typedef short bf16x8 __attribute__((ext_vector_type(8)));
typedef int v4i_t __attribute__((ext_vector_type(4)));
typedef int v8i_t __attribute__((ext_vector_type(8)));
constexpr int BM = 256, BK = 64, HALF = 128, HTB = HALF * BK * 2  , STAGE_BYTES = 8 * HTB, NXCD = 8, WGM = 8;
__device__ __forceinline__ int lds_byte(int r, int c) { const int st = (r >> 4) * 2 + (c >> 5), rr = r & 15, cc = c & 31, ob = rr * 64 + cc * 2; return st * 1024 + (ob ^ (((ob >> 9) & 1) << 5)); }
__device__ __forceinline__ void stage_rc(int b, int& R, int& C) { const int st = b / 1024, sb = b % 1024, swz = sb ^ (((sb >> 9) & 1) << 5); R = (st >> 1) * 16 + swz / 64; C = (st & 1) * 32 + (swz % 64) / 2; }
__device__ __forceinline__ int perm32(int rho) { const int n = rho >> 4, i = rho & 15; return 8 * (i >> 2) + 4 * n + (i & 3); }
struct Unit { int pm, pn, slot; };
struct Order {
    int nM, nN, nwg, G, c;
    __device__ __forceinline__ void init(int nM_, int nN_, int G_, int c_) { nM = nM_; nN = nN_; nwg = nM * nN; G = G_; c = c_; }
    __device__ __forceinline__ bool next(int i, Unit& u) const {
        const long L = (long)i * G + c; if (L >= nwg) return false;
        int wgid = (int)L; { const int q = nwg / NXCD, r = nwg % NXCD, xcd = wgid % NXCD, off = wgid / NXCD; wgid = (xcd < r ? xcd * (q + 1) : r * (q + 1) + (xcd - r) * q) + off; }
        const int nig = WGM * nN, gid = wgid / nig, fm = gid * WGM, gsz = (nM - fm) < WGM ? (nM - fm) : WGM;
        u.pm = fm + ((wgid % nig) % gsz); u.pn = (wgid % nig) / gsz; u.slot = i; return true;
    }
};
template <class Epi, class Prob, bool ALIGN_EPI>
__device__ __forceinline__ void gemm_phase(PG8_LAS unsigned char* lds, const Prob& P, const Order& S, const Epi& E) {
    int tid = threadIdx.x; asm volatile("" : "+v"(tid)); const int wid = __builtin_amdgcn_readfirstlane(tid >> 6), lane = tid & 63, wr = wid >> 2, wc = wid & 3, fr = lane & 15, fq = lane >> 4;
    constexpr bool GATHER = Prob::GATHER; constexpr bool FP8 = Prob::FP8;
    const int K = P.K, nt = K / BK;
    unsigned voffA[2], voffB[2];
#pragma unroll
    for (int i = 0; i < 2; ++i) { int R, C; stage_rc(tid * 16 + i * 8192, R, C); const int Rb = Epi::PERM ? ((R & ~31) + perm32(R & 31)) : R; voffA[i] = (unsigned)(R * K + C) * 2u; voffB[i] = (unsigned)(Rb * K + C) * 2u; }
    const size_t kstep = (size_t)(BK * 2);
    const size_t hstep = (size_t)HALF * K * 2;
    const unsigned ldsw = (unsigned)wid * 1024u;
    const int aoff = lds_byte(wr * 64 + fr, fq * 8), boff = lds_byte(wc * 32 + fr, fq * 8);
    const char* const Ab = (const char*)P.abase();
#define PG8_SA(b, h) (((b) * 2 + (h)) * HTB)
#define PG8_SB(b, h) ((4 + (b) * 2 + (h)) * HTB)
#define PG8_GLDS(src, bufoff, i) __builtin_amdgcn_global_load_lds((const unsigned*)(src), (PG8_LAS unsigned*)(lds + (bufoff) + ldsw + (i) * 8192), 16, 0, 0)
#define PG8_STAGE_B(bufoff, gbase) do { PG8_GLDS((const char*)(gbase) + voffB[0], bufoff, 0); PG8_GLDS((const char*)(gbase) + voffB[1], bufoff, 1); } while (0)
#define PG8_STAGE_A(bufoff, h, kb) do { if constexpr (GATHER) { PG8_GLDS(Ab + (size_t)g[h][0] + (kb), bufoff, 0); PG8_GLDS(Ab + (size_t)g[h][1] + (kb), bufoff, 1); } \
        else { PG8_GLDS(cA + (h) * hstep + (kb) + voffA[0], bufoff, 0); PG8_GLDS(cA + (h) * hstep + (kb) + voffA[1], bufoff, 1); } } while (0)
#define PG8_CAT(x0, x1) __builtin_shufflevector(x0, x1, 0, 1, 2, 3, 4, 5, 6, 7)
#define PG8_LO(x) __builtin_bit_cast(bf16x8, __builtin_shufflevector(x, x, 0, 1, 2, 3))
#define PG8_HI(x) __builtin_bit_cast(bf16x8, __builtin_shufflevector(x, x, 4, 5, 6, 7))
#define PG8_LDA(dst, b, h) do { _Pragma("unroll") for (int m = 0; m < 4; ++m) dst[m] = PG8_CAT(*(const PG8_LAS v4i_t*)(lds + PG8_SA(b, h) + aoff + m * 2048), *(const PG8_LAS v4i_t*)(lds + PG8_SA(b, h) + aoff + m * 2048 + 1024)); } while (0)
#define PG8_LDB(dst, b, h) do { _Pragma("unroll") for (int n = 0; n < 2; ++n) dst[n] = PG8_CAT(*(const PG8_LAS v4i_t*)(lds + PG8_SB(b, h) + boff + n * 2048), *(const PG8_LAS v4i_t*)(lds + PG8_SB(b, h) + boff + n * 2048 + 1024)); } while (0)
#define PG8_MMA(ai, bj, At, Bt) do { __builtin_amdgcn_s_setprio(1); _Pragma("unroll") for (int m = 0; m < 4; ++m) _Pragma("unroll") for (int n = 0; n < 2; ++n) { \
        if constexpr (FP8) acc[ai][bj][m][n] = __builtin_amdgcn_mfma_scale_f32_16x16x128_f8f6f4(Bt[n], At[m], acc[ai][bj][m][n], 0, 0, 0, 0x79797979, 0, 0x7f7f7f7f); \
        else { acc[ai][bj][m][n] = __builtin_amdgcn_mfma_f32_16x16x32_bf16(PG8_LO(Bt[n]), PG8_LO(At[m]), acc[ai][bj][m][n], 0, 0, 0); \
               acc[ai][bj][m][n] = __builtin_amdgcn_mfma_f32_16x16x32_bf16(PG8_HI(Bt[n]), PG8_HI(At[m]), acc[ai][bj][m][n], 0, 0, 0); } } \
        __builtin_amdgcn_s_setprio(0); } while (0)
#define PG8_WAIT_V(n) asm volatile("s_waitcnt vmcnt(" #n ")" ::: "memory")
#define PG8_WAIT_L(n) asm volatile("s_waitcnt lgkmcnt(" #n ")" ::: "memory")
#define PG8_BAR __builtin_amdgcn_s_barrier()
#define PG8_SCHED __builtin_amdgcn_sched_barrier(0)
    Unit cur, nxt; int ui = 0;
    if (!S.next(0, cur)) return;
    f32x4 acc[2][2][4][2];
#pragma unroll
    for (int a = 0; a < 2; ++a)
#pragma unroll
        for (int b = 0; b < 2; ++b)
#pragma unroll
            for (int m = 0; m < 4; ++m)
#pragma unroll
                for (int n = 0; n < 2; ++n) acc[a][b][m][n] = (f32x4){0.f, 0.f, 0.f, 0.f};
    v8i_t At[4], B0[2], B1[2];
    unsigned g[2][2], gn[2][2];
    const char* cA = Ab; const char* nA = Ab;
    if constexpr (GATHER) {
#pragma unroll
        for (int h = 0; h < 2; ++h)
#pragma unroll
            for (int i = 0; i < 2; ++i) { g[h][i] = P.goff(cur, h, voffA[i]); gn[h][i] = g[h][i]; }
    } else { cA = Ab + P.aoff(cur); nA = cA; }
    const char* cB = (const char*)P.bbase(cur);
    PG8_STAGE_B(PG8_SB(0, 0), cB); PG8_STAGE_B(PG8_SB(0, 1), cB + hstep); PG8_STAGE_A(PG8_SA(0, 0), 0, 0); PG8_STAGE_A(PG8_SA(0, 1), 1, 0);
    if (wr == 1) PG8_BAR;
    PG8_WAIT_V(2); PG8_BAR;
    PG8_STAGE_B(PG8_SB(1, 0), cB + kstep); PG8_STAGE_A(PG8_SA(1, 0), 0, kstep); PG8_STAGE_B(PG8_SB(1, 1), cB + hstep + kstep);
    PG8_WAIT_V(6); PG8_BAR;
    for (;;) {
        const bool has_next = S.next(ui + 1, nxt);
        const char* nB = cB;
        if (has_next) { nB = (const char*)P.bbase(nxt);
            if constexpr (GATHER) {
#pragma unroll
                for (int h = 0; h < 2; ++h)
#pragma unroll
                    for (int i = 0; i < 2; ++i) gn[h][i] = P.goff(nxt, h, voffA[i]);
            } else nA = Ab + P.aoff(nxt); }
        for (int t = 0; t < nt; t += 2) {
            const bool last = (t == nt - 2);
            const size_t k1 = (size_t)(t + 1) * kstep;
            const size_t k2 = last ? 0 : (size_t)(t + 2) * kstep, k3 = k2 + kstep;
            if constexpr (Epi::MID_T > 0) { if (t == Epi::MID_T) E.mid(acc, cur, wr, wc, fr, fq); }
            PG8_LDB(B0, 0, 0); PG8_LDB(B1, 0, 1); PG8_SCHED; PG8_LDA(At, 0, 0); PG8_STAGE_A(PG8_SA(1, 1), 1, k1);
            if (last) { cB = nB; if constexpr (GATHER) { g[0][0] = gn[0][0]; g[0][1] = gn[0][1]; g[1][0] = gn[1][0]; g[1][1] = gn[1][1]; } else cA = nA; }
            PG8_WAIT_V(8); PG8_WAIT_L(0); PG8_BAR; PG8_MMA(0, 0, At, B0); PG8_MMA(0, 1, At, B1); PG8_BAR; PG8_SCHED;
            PG8_LDA(At, 0, 1); PG8_STAGE_B(PG8_SB(0, 0), cB + k2); PG8_STAGE_B(PG8_SB(0, 1), cB + k2 + hstep); PG8_STAGE_A(PG8_SA(0, 0), 0, k2);
            PG8_WAIT_V(8); PG8_WAIT_L(0); PG8_BAR; PG8_MMA(1, 0, At, B0); PG8_MMA(1, 1, At, B1); PG8_BAR; PG8_SCHED;
            PG8_LDB(B0, 1, 0); PG8_LDB(B1, 1, 1); PG8_SCHED; PG8_LDA(At, 1, 0); PG8_STAGE_A(PG8_SA(0, 1), 1, k2);
            PG8_WAIT_V(8); PG8_WAIT_L(0); PG8_BAR; PG8_MMA(0, 0, At, B0); PG8_MMA(0, 1, At, B1); PG8_BAR; PG8_SCHED;
            PG8_LDA(At, 1, 1); PG8_STAGE_B(PG8_SB(1, 0), cB + k3); PG8_STAGE_B(PG8_SB(1, 1), cB + k3 + hstep); PG8_STAGE_A(PG8_SA(1, 0), 0, k3);
            PG8_WAIT_V(8); PG8_WAIT_L(0); PG8_BAR; PG8_MMA(1, 0, At, B0); PG8_MMA(1, 1, At, B1); PG8_BAR; PG8_SCHED;
        }
        if constexpr (ALIGN_EPI) { if (wr == 0) PG8_BAR; }
        E(acc, cur, wr, wc, fr, fq);
        if (!has_next) break;
#pragma unroll
        for (int a = 0; a < 2; ++a)
#pragma unroll
            for (int b = 0; b < 2; ++b)
#pragma unroll
                for (int m = 0; m < 4; ++m)
#pragma unroll
                    for (int n = 0; n < 2; ++n) acc[a][b][m][n] = (f32x4){0.f, 0.f, 0.f, 0.f};
        cur = nxt; ++ui;
        if constexpr (ALIGN_EPI) { if (wr == 1) PG8_BAR; }
    }
    PG8_WAIT_V(0);
    if constexpr (!ALIGN_EPI) { if (wr == 0) PG8_BAR; }
    PG8_BAR;
#undef PG8_SA
#undef PG8_SB
#undef PG8_GLDS
#undef PG8_STAGE_A
#undef PG8_STAGE_B
#undef PG8_LDA
#undef PG8_LDB
#undef PG8_MMA
#undef PG8_CAT
#undef PG8_LO
#undef PG8_HI
#undef PG8_WAIT_V
#undef PG8_WAIT_L
#undef PG8_BAR
#undef PG8_SCHED
}
}


constexpr int MT_OFF = 131072;
struct MoeTab { const LAS int* e_of; const LAS int* rt; const LAS float* rp; };
template <bool WITH_P> __device__ __forceinline__ int moe_tables(const Params& p, unsigned char* lds, int tid, int nN, int nb, int bid, MoeTab& mt) {
    LAS int* cnt = (LAS int*)(lds + MT_OFF); LAS int* pstart = cnt + 32; LAS int* e_of = cnt + 72; constexpr int MAXU = WITH_P ? 5 : 9;
    LAS int* rt = cnt + 112; LAS float* rp = (LAS float*)(rt + MAXU * 256);
    __syncthreads();
    if (tid < NE) cnt[tid] = __hip_atomic_load((const int*)(p.ws + WS_CTL) + CW_ECNT + 64 * tid, __ATOMIC_RELAXED, __HIP_MEMORY_SCOPE_AGENT);
    __syncthreads();
    if (tid == 0) { int st = 0; for (int e = 0; e < NE; ++e) { pstart[e] = st; st += (cnt[e] + 255) & ~255; } pstart[32] = st; }
    __syncthreads();
    const int n_mt = __builtin_amdgcn_readfirstlane(pstart[32] >> 8);
    pg8::Order O; O.init(n_mt, nN, nb, bid);
    LAS int* pm_of = cnt + 88;
    if (tid < MAXU) { pg8::Unit u; int e = 0, pm = -1;
        if (O.next(tid, u)) { pm = u.pm; for (int q = 1; q < NE; ++q) if (pm * 256 >= pstart[q]) e = q; }
        e_of[tid] = e; pm_of[tid] = pm; }
    __syncthreads();
    for (int idx = tid; idx < MAXU * 256; idx += 512) { const int i = idx >> 8, r = idx & 255, pm = pm_of[i];
        if (pm >= 0) { const int e = e_of[i]; const int pos = pm * 256 + r - pstart[e]; const bool ok = pos < cnt[e];
            rt[idx] = ok ? ((const int*)(p.ws + WS_ELIST))[e * T + pos] : -1;
            if (WITH_P) rp[idx] = ok ? ((const float*)(p.ws + WS_EP))[e * T + pos] : 0.f; } }
    __syncthreads();
    mt.e_of = e_of; mt.rt = rt; mt.rp = rp;
    return n_mt;
}
struct ProbPlain {
    static constexpr bool GATHER = false, FP8 = false;
    const bf16* A; const bf16* Bt; int K;
    __device__ __forceinline__ const bf16* abase() const { return A; }
    __device__ __forceinline__ size_t aoff(const pg8::Unit& u) const { return (size_t)u.pm * 256 * K * 2; }
    __device__ __forceinline__ unsigned goff(const pg8::Unit&, int, unsigned) const { return 0u; }
    __device__ __forceinline__ const bf16* bbase(const pg8::Unit& u) const { return Bt + (size_t)u.pn * 256 * K; }
};
struct ProbPlainOff {
    static constexpr bool GATHER = true, FP8 = false;
    const bf16* A; const bf16* Bt; int K;
    __device__ __forceinline__ const bf16* abase() const { return A; }
    __device__ __forceinline__ size_t aoff(const pg8::Unit& u) const { return (size_t)u.pm * 256 * K * 2; }
    __device__ __forceinline__ unsigned goff(const pg8::Unit& u, int h, unsigned voff) const { return (unsigned)(u.pm * 256 + h * 128) * ((unsigned)K * 2u) + voff; }
    __device__ __forceinline__ const bf16* bbase(const pg8::Unit& u) const { return Bt + (size_t)u.pn * 256 * K; }
};
struct ProbPlainF8 {
    static constexpr bool GATHER = true, FP8 = true;
    const bf16* A; const bf16* Bt; int K;
    __device__ __forceinline__ const bf16* abase() const { return A; }
    __device__ __forceinline__ size_t aoff(const pg8::Unit& u) const { return (size_t)u.pm * 256 * K * 2; }
    __device__ __forceinline__ unsigned goff(const pg8::Unit& u, int h, unsigned voff) const { return (unsigned)(u.pm * 256 + h * 128) * ((unsigned)K * 2u) + voff; }
    __device__ __forceinline__ const bf16* bbase(const pg8::Unit& u) const { return Bt + (size_t)u.pn * 256 * K; }
};
template <bool G, bool F8> struct ProbMoE {
    static constexpr bool GATHER = true, FP8 = F8;
    const bf16* A; const bf16* Bt; int K; MoeTab mt; int rows_e;
    __device__ __forceinline__ const bf16* abase() const { return A; }
    __device__ __forceinline__ size_t aoff(const pg8::Unit& u) const { return (size_t)u.pm * 256 * K * 2; }
    __device__ __forceinline__ unsigned goff(const pg8::Unit& u, int h, unsigned voff) const {
        const unsigned pitch = (unsigned)K * 2u;
        if constexpr (!G) return (unsigned)(u.pm * 256 + h * 128) * pitch + voff;
        const unsigned R = voff / pitch, inrow = voff - R * pitch;
        const int a = mt.rt[u.slot * 256 + h * 128 + (int)R]; const int row = a < 0 ? 0 : (a >> 2);
        return (unsigned)row * pitch + inrow; }
    __device__ __forceinline__ const bf16* bbase(const pg8::Unit& u) const { const int e = __builtin_amdgcn_readfirstlane(mt.e_of[u.slot]); return Bt + ((size_t)e * rows_e + (size_t)u.pn * 256) * K; }
};
struct EpiInProj {
    static constexpr int MID_T = 0; static constexpr bool PERM = true; Params p;
    __device__ __forceinline__ void operator()(const f32x4 (&acc)[2][2][4][2], const pg8::Unit& u, int wr, int wc, int fr, int fq) const {
        unsigned char* ws = p.ws; const int pn = u.pn;
        bf16* dst; int ld, ct; int kind = 0; const float* gb = nullptr;
        if (pn < 2) { dst = (bf16*)(ws + WS_QA); ld = WA; ct = pn * 256; kind = 1; }
        else if (pn < 4) { dst = (bf16*)(ws + WS_KA); ld = WA; ct = (pn - 2) * 256; kind = 1; }
        else if (pn < 6) { dst = (bf16*)(ws + WS_VA); ld = WA; ct = (pn - 4) * 256; }
        else if (pn < 9) { dst = (bf16*)(ws + WS_QB); ld = WB; ct = (pn - 6) * 256; kind = 1; }
        else if (pn < 12) { dst = (bf16*)(ws + WS_KB); ld = WB; ct = (pn - 9) * 256; kind = 1; }
        else if (pn < 15) { dst = (bf16*)(ws + WS_VB); ld = WB; ct = (pn - 12) * 256; }
        else if (pn < 19) { dst = (bf16*)(ws + WS_SA); ld = D; ct = (pn - 15) * 256; kind = 2; gb = p.b_gate_a; }
        else { dst = (bf16*)(ws + WS_SB); ld = D; ct = (pn - 19) * 256; kind = 2; gb = p.b_gate_b; }
        const int row0 = u.pm * 256 + wr * 64 + fr, col0 = ct + wc * 32 + 8 * fq;
        f32x4 bv[2][2];
#pragma unroll
        for (int bj = 0; bj < 2; ++bj)
#pragma unroll
            for (int n = 0; n < 2; ++n) bv[bj][n] = (kind == 2) ? *(const f32x4*)(gb + col0 + bj * 128 + 4 * n) : (f32x4){0.f, 0.f, 0.f, 0.f};
        const bool dorope = (kind == 1) && ((wc & 1) == 0);
        const bool dokm = (pn == 2) || (pn == 3);
        f32x4 ks[2][2];
#pragma unroll
        for (int bj = 0; bj < 2; ++bj) { ks[bj][0] = (f32x4){0.f, 0.f, 0.f, 0.f}; ks[bj][1] = (f32x4){0.f, 0.f, 0.f, 0.f}; }
        const float sgn = (fq == 0) ? -1.0f : 1.0f; const bool rl = fq < 2;
#pragma unroll
        for (int ai = 0; ai < 2; ++ai)
#pragma unroll
            for (int m = 0; m < 4; ++m) {
                const int row = row0 + ai * 128 + m * 16;
                f32x4 cs[4];
                if (dorope) { const f32x4* rp = (const f32x4*)(ws + WS_ROPE) + (size_t)(row % S) * 4;
#pragma unroll
                    for (int i = 0; i < 4; ++i) cs[i] = rp[i]; }
                bf16* rowp = dst + (size_t)row * ld + col0;
#pragma unroll
                for (int bj = 0; bj < 2; ++bj) {
                    f32x4 v0 = acc[ai][bj][m][0], v1 = acc[ai][bj][m][1];
                    if (dorope) {
                        f32x4 q0, q1;
#pragma unroll
                        for (int j = 0; j < 4; ++j) { q0[j] = __shfl_xor(v0[j], 16); q1[j] = __shfl_xor(v1[j], 16); }
                        if (rl) {
                            v0[0] = v0[0] * cs[0][0] + sgn * q0[0] * cs[0][1]; v0[1] = v0[1] * cs[0][2] + sgn * q0[1] * cs[0][3];
                            v0[2] = v0[2] * cs[1][0] + sgn * q0[2] * cs[1][1]; v0[3] = v0[3] * cs[1][2] + sgn * q0[3] * cs[1][3];
                            v1[0] = v1[0] * cs[2][0] + sgn * q1[0] * cs[2][1]; v1[1] = v1[1] * cs[2][2] + sgn * q1[1] * cs[2][3];
                            v1[2] = v1[2] * cs[3][0] + sgn * q1[2] * cs[3][1]; v1[3] = v1[3] * cs[3][2] + sgn * q1[3] * cs[3][3]; }
                    }
                    if (dokm) { ks[bj][0] += v0; ks[bj][1] += v1; }
                    if (kind == 2) {
                        v0 = v0 + bv[bj][0]; v1 = v1 + bv[bj][1];
#pragma unroll
                        for (int j = 0; j < 4; ++j) { v0[j] = fast_sigmoid(v0[j]); v1[j] = fast_sigmoid(v1[j]); } }
                    u32x4 w; w.x = cvtpk(v0[0], v0[1]); w.y = cvtpk(v0[2], v0[3]); w.z = cvtpk(v1[0], v1[1]); w.w = cvtpk(v1[2], v1[3]);
                    *(u32x4*)(rowp + bj * 128) = w;
                }
            }
        if (dokm) {
            float* km = (float*)(ws + WS_KMEAN) + (size_t)((u.pm >> 5) * NHA * NBLK + (u.pm & 31)) * HD;
#pragma unroll
            for (int bj = 0; bj < 2; ++bj)
#pragma unroll
                for (int n = 0; n < 2; ++n)
#pragma unroll
                    for (int j = 0; j < 4; ++j) { float v = ks[bj][n][j]; v += __shfl_xor(v, 1); v += __shfl_xor(v, 2); v += __shfl_xor(v, 4); v += __shfl_xor(v, 8);
                        if (fr == 0) { const int c = col0 + bj * 128 + 4 * n + j; atomicAdd(km + (size_t)(c >> 6) * NBLK * HD + (c & 63), v * (1.0f / MBLK)); } }
        }
    }
};
template <int PASS> struct EpiMix {
    static constexpr int MID_T = 0; static constexpr bool PERM = true; Params p;
    __device__ __forceinline__ void operator()(const f32x4 (&acc)[2][2][4][2], const pg8::Unit& u, int wr, int wc, int fr, int fq) const {
        const int row0 = u.pm * 256 + wr * 64 + fr, col0 = u.pn * 256 + wc * 32 + 8 * fq;
        const bf16* G = (const bf16*)(p.ws + (PASS == 0 ? WS_SA : WS_SB)); bf16* M = (bf16*)(p.ws + WS_MIX);
#pragma unroll
        for (int ai = 0; ai < 2; ++ai)
#pragma unroll
            for (int m = 0; m < 4; ++m) {
                const size_t ro = (size_t)(row0 + ai * 128 + m * 16) * D + col0;
#pragma unroll
                for (int bj = 0; bj < 2; ++bj) {
                    const u32x4 g = *(const u32x4*)(G + ro + bj * 128);
                    f32x4 v0 = acc[ai][bj][m][0], v1 = acc[ai][bj][m][1];
                    v0[0] *= __uint_as_float(g.x << 16); v0[1] *= __uint_as_float(g.x & 0xffff0000u); v0[2] *= __uint_as_float(g.y << 16); v0[3] *= __uint_as_float(g.y & 0xffff0000u);
                    v1[0] *= __uint_as_float(g.z << 16); v1[1] *= __uint_as_float(g.z & 0xffff0000u); v1[2] *= __uint_as_float(g.w << 16); v1[3] *= __uint_as_float(g.w & 0xffff0000u);
                    if (PASS == 1) { const u32x4 t = *(const u32x4*)(M + ro + bj * 128);
                        v0[0] += __uint_as_float(t.x << 16); v0[1] += __uint_as_float(t.x & 0xffff0000u); v0[2] += __uint_as_float(t.y << 16); v0[3] += __uint_as_float(t.y & 0xffff0000u);
                        v1[0] += __uint_as_float(t.z << 16); v1[1] += __uint_as_float(t.z & 0xffff0000u); v1[2] += __uint_as_float(t.w << 16); v1[3] += __uint_as_float(t.w & 0xffff0000u); }
                    u32x4 w; w.x = cvtpk(v0[0], v0[1]); w.y = cvtpk(v0[2], v0[3]); w.z = cvtpk(v1[0], v1[1]); w.w = cvtpk(v1[2], v1[3]);
                    *(u32x4*)(M + ro + bj * 128) = w;
                }
            }
    }
};
struct EpiMixCat {
    static constexpr int MID_T = 8; static constexpr bool PERM = true; Params p;
    __device__ __forceinline__ void mid(f32x4 (&acc)[2][2][4][2], const pg8::Unit& u, int wr, int wc, int fr, int fq) const {
        int row0 = u.pm * 256 + wr * 64 + fr, col0 = u.pn * 256 + wc * 32 + 8 * fq;
        asm volatile("" : "+v"(row0), "+v"(col0));
        const bf16* GA = (const bf16*)(p.ws + WS_SA); const bf16* GB = (const bf16*)(p.ws + WS_SB);
#pragma unroll
        for (int ai = 0; ai < 2; ++ai)
#pragma unroll
            for (int m = 0; m < 4; ++m) {
                const size_t ro = (size_t)(row0 + ai * 128 + m * 16) * D + col0;
#pragma unroll
                for (int bj = 0; bj < 2; ++bj) {
                    const u32x4 a = *(const u32x4*)(GA + ro + bj * 128), b = *(const u32x4*)(GB + ro + bj * 128);
#pragma unroll
                    for (int j = 0; j < 4; ++j) { const float r0 = __uint_as_float(a[j] << 16) * __builtin_amdgcn_rcpf(__uint_as_float(b[j] << 16)), r1 = __uint_as_float(a[j] & 0xffff0000u) * __builtin_amdgcn_rcpf(__uint_as_float(b[j] & 0xffff0000u));
                        if (j < 2) { acc[ai][bj][m][0][2 * j] *= r0; acc[ai][bj][m][0][2 * j + 1] *= r1; } else { acc[ai][bj][m][1][2 * j - 4] *= r0; acc[ai][bj][m][1][2 * j - 3] *= r1; } }
                }
                asm volatile("" ::: "memory");
            }
    }
    __device__ __forceinline__ void operator()(const f32x4 (&acc)[2][2][4][2], const pg8::Unit& u, int wr, int wc, int fr, int fq) const {
        const int row0 = u.pm * 256 + wr * 64 + fr, col0 = u.pn * 256 + wc * 32 + 8 * fq;
        const bf16* GB = (const bf16*)(p.ws + WS_SB); bf16* M = (bf16*)(p.ws + WS_MIX);
#pragma unroll
        for (int ai = 0; ai < 2; ++ai)
#pragma unroll
            for (int m = 0; m < 4; ++m) {
                const size_t ro = (size_t)(row0 + ai * 128 + m * 16) * D + col0;
#pragma unroll
                for (int bj = 0; bj < 2; ++bj) {
                    const u32x4 g = *(const u32x4*)(GB + ro + bj * 128);
                    f32x4 v0 = acc[ai][bj][m][0], v1 = acc[ai][bj][m][1];
                    v0[0] *= __uint_as_float(g.x << 16); v0[1] *= __uint_as_float(g.x & 0xffff0000u); v0[2] *= __uint_as_float(g.y << 16); v0[3] *= __uint_as_float(g.y & 0xffff0000u);
                    v1[0] *= __uint_as_float(g.z << 16); v1[1] *= __uint_as_float(g.z & 0xffff0000u); v1[2] *= __uint_as_float(g.w << 16); v1[3] *= __uint_as_float(g.w & 0xffff0000u);
                    u32x4 w; w.x = cvtpk(v0[0], v0[1]); w.y = cvtpk(v0[2], v0[3]); w.z = cvtpk(v1[0], v1[1]); w.w = cvtpk(v1[2], v1[3]);
                    *(u32x4*)(M + ro + bj * 128) = w;
                }
            }
    }
};
struct EpiOut {
    static constexpr int MID_T = 0; static constexpr bool PERM = false; Params p;
    __device__ __forceinline__ void operator()(const f32x4 (&acc)[2][2][4][2], const pg8::Unit& u, int wr, int wc, int fr, int fq) const {
        const int row0 = u.pm * 256 + wr * 64 + fr, col0 = u.pn * 256 + wc * 32 + 4 * fq;
#pragma unroll
        for (int ai = 0; ai < 2; ++ai)
#pragma unroll
            for (int m = 0; m < 4; ++m) { const size_t ro = (size_t)(row0 + ai * 128 + m * 16) * D + col0;
#pragma unroll
                for (int bj = 0; bj < 2; ++bj)
#pragma unroll
                    for (int n = 0; n < 2; ++n) { const size_t o = ro + bj * 128 + n * 16; *(f32x4*)(p.out + o) = *(const f32x4*)(p.x + o) + acc[ai][bj][m][n]; } }
    }
};
struct EpiGateUp {
    static constexpr int MID_T = 0; static constexpr bool PERM = false; Params p; MoeTab mt;
    __device__ __forceinline__ void operator()(const f32x4 (&acc)[2][2][4][2], const pg8::Unit& u, int wr, int wc, int fr, int fq) const {
        const int e = __builtin_amdgcn_readfirstlane(mt.e_of[u.slot]);
        const int row0 = u.pm * 256 + wr * 64 + fr;
        f32x4 bg[2], bu[2]; int cc[2];
#pragma unroll
        for (int bj = 0; bj < 2; ++bj) { cc[bj] = 16 * (8 * u.pn + 4 * bj + wc) + 4 * fq; bg[bj] = *(const f32x4*)(p.b_gate + e * FF + cc[bj]); bu[bj] = *(const f32x4*)(p.b_up + e * FF + cc[bj]); }
#pragma unroll
        for (int ai = 0; ai < 2; ++ai)
#pragma unroll
            for (int m = 0; m < 4; ++m) { bf16* rowp = (bf16*)(p.ws + WS_A2) + (size_t)(row0 + ai * 128 + m * 16) * FF;
#pragma unroll
                for (int bj = 0; bj < 2; ++bj) { f32x4 g = acc[ai][bj][m][0] + bg[bj], uu = acc[ai][bj][m][1] + bu[bj], a;
#pragma unroll
                    for (int j = 0; j < 4; ++j) { const float gg = fminf(g[j], 7.0f), uc = fminf(fmaxf(uu[j], -7.0f), 7.0f); a[j] = gg * fast_sigmoid(1.702f * gg) * (uc + 1.0f); }
#if FP8_DN
                    int w = __builtin_amdgcn_cvt_pk_fp8_f32(a[0], a[1], 0, false); w = __builtin_amdgcn_cvt_pk_fp8_f32(a[2], a[3], w, true);
                    *(int*)((unsigned char*)(p.ws + WS_A2) + (size_t)(row0 + ai * 128 + m * 16) * FF + cc[bj]) = w; (void)rowp;
#else
                    u32x2 w; w.x = cvtpk(a[0], a[1]); w.y = cvtpk(a[2], a[3]); *(u32x2*)(rowp + cc[bj]) = w;
#endif
                } }
    }
};
struct EpiDown {
    static constexpr int MID_T = 0; static constexpr bool PERM = true; Params p; MoeTab mt;
    __device__ __forceinline__ void operator()(const f32x4 (&acc)[2][2][4][2], const pg8::Unit& u, int wr, int wc, int fr, int fq) const {
        const int e = __builtin_amdgcn_readfirstlane(mt.e_of[u.slot]);
        const int row0 = u.pm * 256 + wr * 64 + fr, col0 = u.pn * 256 + wc * 32 + 8 * fq;
        const float* bd = p.b_down + e * D + col0;
        int asg[2][4]; float pw[2][4];
#pragma unroll
        for (int ai = 0; ai < 2; ++ai)
#pragma unroll
            for (int m = 0; m < 4; ++m) { const int rl = u.slot * 256 + wr * 64 + fr + ai * 128 + m * 16; asg[ai][m] = mt.rt[rl]; pw[ai][m] = mt.rp[rl]; }
        f32x4 bv[2][2];
#pragma unroll
        for (int bj = 0; bj < 2; ++bj) { bv[bj][0] = *(const f32x4*)(bd + bj * 128); bv[bj][1] = *(const f32x4*)(bd + bj * 128 + 4); }
#pragma unroll
        for (int ai = 0; ai < 2; ++ai)
#pragma unroll
            for (int m = 0; m < 4; ++m) {
                if (asg[ai][m] >= 0) { bf16* rowp = (bf16*)(p.ws + WS_Y) + (size_t)asg[ai][m] * D + col0; const float pp = pw[ai][m];
#pragma unroll
                    for (int bj = 0; bj < 2; ++bj) { const f32x4 v0 = (acc[ai][bj][m][0] + bv[bj][0]) * pp, v1 = (acc[ai][bj][m][1] + bv[bj][1]) * pp;
                        u32x4 w; w.x = cvtpk(v0[0], v0[1]); w.y = cvtpk(v0[2], v0[3]); w.z = cvtpk(v1[0], v1[1]); w.w = cvtpk(v1[2], v1[3]);
                        *(u32x4*)(rowp + bj * 128) = w; } } }
    }
};

__device__ __forceinline__ void phase_kmean(const Params& p, int gw, int ngw, int lane) {
    for (int it = gw; it < NB * NHA * NBLK; it += ngw) {
        const int n = it % NBLK, h = (it / NBLK) % NHA, b = it / (NBLK * NHA), d = lane;
        const bf16* k = (const bf16*)(p.ws + WS_KA) + ((size_t)b * S + (size_t)n * MBLK) * WA + h * HD + d;
        float s = 0.f; for (int r = 0; r < MBLK; ++r) s += bf2f(k[(size_t)r * WA]);
        ((float*)(p.ws + WS_KMEAN))[(size_t)it * HD + d] = s * (1.0f / MBLK);
    }
}
__device__ __forceinline__ void phase_select(const Params& p, int gtid, int ngt) {
    for (int idx = gtid; idx < T * NHA; idx += ngt) {
        const int h = idx % NHA, t = idx / NHA, b = t / S, s = t % S, blk = s / MBLK;
        const bf16* q = (const bf16*)(p.ws + WS_QA) + (size_t)t * WA + h * HD;
        const float* km = (const float*)(p.ws + WS_KMEAN) + (size_t)(b * NHA + h) * NBLK * HD;
        float best0 = -INFINITY, best1 = -INFINITY, best2 = -INFINITY; int b0 = -1, b1 = -1, b2 = -1;
        for (int n = 0; n < blk; ++n) {
            float g = 0.f; for (int d = 0; d < HD; ++d) g += bf2f(q[d]) * km[n * HD + d];
            if (g > best0) { best2 = best1; b2 = b1; best1 = best0; b1 = b0; best0 = g; b0 = n; }
            else if (g > best1) { best2 = best1; b2 = b1; best1 = g; b1 = n; }
            else if (g > best2) { best2 = g; b2 = n; }
        }
        signed char* sel = (signed char*)(p.ws + WS_SEL) + (size_t)idx * 4;
        sel[0] = (signed char)b0; sel[1] = (signed char)b1; sel[2] = (signed char)b2; sel[3] = -1;
    }
}
__device__ __forceinline__ float dot64(const float* qs, const bf16* kr) {
    float a = 0.f;
    for (int d8 = 0; d8 < 8; ++d8) { float kv[8]; ldact8(kr + d8 * 8, kv);
#pragma unroll
        for (int i = 0; i < 8; ++i) a += qs[d8 * 8 + i] * kv[i]; }
    return a;
}
#define WAVE_LDS_FENCE() asm volatile("s_waitcnt lgkmcnt(0)" ::: "memory")
__device__ __forceinline__ void phase_moba_naive(const Params& p, int gw, int ngw, int lane, float* wl, bf16* oa_dst) {
    float* qs = wl; float* sc = wl + 64;
    for (int it = gw; it < T * NHA; it += ngw) {
        const int h = it % NHA, t = it / NHA, b = t / S, s = t % S, blk = s / MBLK;
        WAVE_LDS_FENCE();
        qs[lane] = bf2f(((const bf16*)(p.ws + WS_QA))[(size_t)t * WA + h * HD + lane]);
        WAVE_LDS_FENCE();
        const signed char* sel = (const signed char*)(p.ws + WS_SEL) + ((size_t)t * NHA + h) * 4;
        const int kb0 = blk, kb1 = sel[0], kb2 = sel[1], kb3 = sel[2];
        const bf16* K = (const bf16*)(p.ws + WS_KA) + (size_t)b * S * WA + h * HD; const bf16* V = (const bf16*)(p.ws + WS_VA) + (size_t)b * S * WA + h * HD;
        float mx = -INFINITY;
        for (int g = 0; g < 4; ++g) { const int kbg = g == 0 ? kb0 : g == 1 ? kb1 : g == 2 ? kb2 : kb3;
            for (int c = 0; c < 4; ++c) {
                const int kk = c * 64 + lane; float v = -INFINITY;
                if (kbg >= 0) { const int key = kbg * MBLK + kk; if (g > 0 || key <= s) v = dot64(qs, K + (size_t)key * WA) * 0.125f; }
                sc[g * 256 + kk] = v; mx = fmaxf(mx, v);
            } }
#pragma unroll
        for (int o = 1; o < 64; o <<= 1) mx = fmaxf(mx, __shfl_xor(mx, o));
        WAVE_LDS_FENCE();
        float l = 0.f;
        for (int i = lane; i < 1024; i += 64) { const float e = (sc[i] == -INFINITY) ? 0.f : expf(sc[i] - mx); sc[i] = e; l += e; }
        l = wave_sum(l);
        WAVE_LDS_FENCE();
        float o = 0.f;
        for (int g = 0; g < 4; ++g) { const int kbg = g == 0 ? kb0 : g == 1 ? kb1 : g == 2 ? kb2 : kb3; if (kbg < 0) continue;
            for (int kk = 0; kk < 256; ++kk) { const float pr = sc[g * 256 + kk]; if (pr != 0.f) o += pr * bf2f(V[(size_t)(kbg * MBLK + kk) * WA + lane]); } }
        oa_dst[(size_t)t * WA + h * HD + lane] = (bf16)f2bf(o / l);
    }
}
__device__ __forceinline__ void phase_dil_naive(const Params& p, int gw, int ngw, int lane, float* wl, bf16* ob_dst) {
    float* qs = wl; float* sc = wl + 192;
    for (int it = gw; it < T * 4; it += ngw) {
        const int j = it % 4, t = it / 4, b = t / S, s = t % S;
        WAVE_LDS_FENCE();
        for (int g = 0; g < 3; ++g) qs[g * 64 + lane] = bf2f(((const bf16*)(p.ws + WS_QB))[(size_t)t * WB + (4 * g + j) * HD + lane]);
        WAVE_LDS_FENCE();
        float mx = -INFINITY;
        for (int g = 0; g < 3; ++g) { const int dl = g == 0 ? 1 : g == 1 ? 4 : 16; const bf16* K = (const bf16*)(p.ws + WS_KB) + (size_t)b * S * WB + (4 * g + j) * HD;
            for (int i = lane; i <= 128; i += 64) { const int key = s - i * dl; float v = -INFINITY;
                if (key >= 0) v = dot64(qs + g * 64, K + (size_t)key * WB) * 0.125f;
                sc[g * 129 + i] = v; mx = fmaxf(mx, v); } }
#pragma unroll
        for (int o = 1; o < 64; o <<= 1) mx = fmaxf(mx, __shfl_xor(mx, o));
        WAVE_LDS_FENCE();
        float l = 0.f;
        for (int i = lane; i < 3 * 129; i += 64) { const float e = (sc[i] == -INFINITY) ? 0.f : expf(sc[i] - mx); sc[i] = e; l += e; }
        l = wave_sum(l);
        WAVE_LDS_FENCE();
        float o = 0.f;
        for (int g = 0; g < 3; ++g) { const int dl = g == 0 ? 1 : g == 1 ? 4 : 16; const bf16* V = (const bf16*)(p.ws + WS_VB) + (size_t)b * S * WB + (4 * g + j) * HD;
            for (int i = 0; i <= 128; ++i) { const float pr = sc[g * 129 + i]; const int key = s - i * dl; if (key >= 0 && pr != 0.f) o += pr * bf2f(V[(size_t)key * WB + lane]); } }
        ob_dst[(size_t)t * WBO + j * HD + lane] = (bf16)f2bf(o / l);
    }
}

__device__ __forceinline__ void phase_router(const Params& p, int bid, int nb, unsigned char* lds, int tid) {
    const int lane = tid & 63, w = tid >> 6, h = lane >> 5, r32 = lane & 31;
    float* part = (float*)lds;
    float* ssqp = (float*)(lds + 65536);
    float* rstd_s = (float*)(lds + 65536 + 2048);
    int4* rec = (int4*)(lds + 65536 + 4096);
    int* lc = (int*)(lds + 65536 + 8192); int* gbase = lc + 32;
    bf16x8v whi[8], wlo[8];
#pragma unroll
    for (int sidx = 0; sidx < 8; ++sidx) { const int k0 = 128 * w + 16 * sidx + 8 * h; float wv[8];
        const f32x4 g0 = *(const f32x4*)(p.ln_ffn_g + k0), g1 = *(const f32x4*)(p.ln_ffn_g + k0 + 4);
#pragma unroll
        for (int j = 0; j < 8; ++j) wv[j] = p.w_router[(size_t)(k0 + j) * NE + r32] * (j < 4 ? g0[j] : g1[j - 4]);
        u32x4 hi, lo;
#pragma unroll
        for (int j = 0; j < 4; ++j) { const unsigned hp = cvtpk(wv[2 * j], wv[2 * j + 1]); hi[j] = hp;
            lo[j] = cvtpk(wv[2 * j] - __uint_as_float(hp << 16), wv[2 * j + 1] - __uint_as_float(hp & 0xffff0000u)); }
        whi[sidx] = __builtin_bit_cast(bf16x8v, hi); wlo[sidx] = __builtin_bit_cast(bf16x8v, lo); }
    for (int tg = bid; tg < T / 64; tg += nb) {
        __syncthreads();
        if (tid < 256) rec[tid] = make_int4(-1, 0, 0, 0);
        if (tid < 32) lc[tid] = 0;
#pragma unroll
        for (int tt = 0; tt < 2; ++tt) {
            const float* xr = p.out + (size_t)(tg * 64 + 32 * tt + r32) * D + 128 * w + 8 * h;
            f32x16 acc = {0.f, 0.f, 0.f, 0.f, 0.f, 0.f, 0.f, 0.f, 0.f, 0.f, 0.f, 0.f, 0.f, 0.f, 0.f, 0.f}; float ssq = 0.f;
#pragma unroll
            for (int sidx = 0; sidx < 8; ++sidx) { const f32x4 x0 = *(const f32x4*)(xr + 16 * sidx), x1 = *(const f32x4*)(xr + 16 * sidx + 4);
                ssq += (x0.x * x0.x + x0.y * x0.y) + (x0.z * x0.z + x0.w * x0.w) + (x1.x * x1.x + x1.y * x1.y) + (x1.z * x1.z + x1.w * x1.w);
                u32x4 hi, lo;
                hi.x = cvtpk(x0.x, x0.y); hi.y = cvtpk(x0.z, x0.w); hi.z = cvtpk(x1.x, x1.y); hi.w = cvtpk(x1.z, x1.w);
                lo.x = cvtpk(x0.x - __uint_as_float(hi.x << 16), x0.y - __uint_as_float(hi.x & 0xffff0000u)); lo.y = cvtpk(x0.z - __uint_as_float(hi.y << 16), x0.w - __uint_as_float(hi.y & 0xffff0000u));
                lo.z = cvtpk(x1.x - __uint_as_float(hi.z << 16), x1.y - __uint_as_float(hi.z & 0xffff0000u)); lo.w = cvtpk(x1.z - __uint_as_float(hi.w << 16), x1.w - __uint_as_float(hi.w & 0xffff0000u));
                const bf16x8v xh = __builtin_bit_cast(bf16x8v, hi), xl = __builtin_bit_cast(bf16x8v, lo);
                acc = __builtin_amdgcn_mfma_f32_32x32x16_bf16(xh, whi[sidx], acc, 0, 0, 0);
                acc = __builtin_amdgcn_mfma_f32_32x32x16_bf16(xh, wlo[sidx], acc, 0, 0, 0);
                acc = __builtin_amdgcn_mfma_f32_32x32x16_bf16(xl, whi[sidx], acc, 0, 0, 0); }
#pragma unroll
            for (int r = 0; r < 16; ++r) part[(w * 64 + 32 * tt + crow(r, h)) * 32 + r32] = acc[r];
            ssq += __shfl_xor(ssq, 32);
            if (h == 0) ssqp[w * 64 + 32 * tt + r32] = ssq;
        }
        __syncthreads();
        if (tid < 64) {
            const int t = tg * 64 + tid;
            float sq = 0.f;
#pragma unroll
            for (int i = 0; i < 8; ++i) sq += ssqp[i * 64 + tid];
            const float rstd = 1.0f / sqrtf(sq * (1.0f / D) + NORM_EPS); rstd_s[tid] = rstd;
            float v0 = -INFINITY, v1 = -INFINITY, v2 = -INFINITY, v3 = -INFINITY; int e0 = 0, e1 = 0, e2 = 0, e3 = 0;
            for (int e = 0; e < NE; ++e) { float a = 0.f;
#pragma unroll
                for (int i = 0; i < 8; ++i) a += part[(i * 64 + tid) * 32 + ((e + tid) & 31)];
                const int ee = (e + tid) & 31; const float lg = a * rstd + p.b_router[ee];
                if (lg > v0 || (lg == v0 && ee < e0)) { v3 = v2; e3 = e2; v2 = v1; e2 = e1; v1 = v0; e1 = e0; v0 = lg; e0 = ee; }
                else if (lg > v1 || (lg == v1 && ee < e1)) { v3 = v2; e3 = e2; v2 = v1; e2 = e1; v1 = lg; e1 = ee; }
                else if (lg > v2 || (lg == v2 && ee < e2)) { v3 = v2; e3 = e2; v2 = lg; e2 = ee; }
                else if (lg > v3 || (lg == v3 && ee < e3)) { v3 = lg; e3 = ee; } }
            const float x1 = expf(v1 - v0), x2 = expf(v2 - v0), x3 = expf(v3 - v0); const float inv = 1.0f / (1.0f + x1 + x2 + x3);
            { const int lp = atomicAdd(&lc[e0], 1); rec[tid * 4 + 0] = make_int4(e0, lp, t * 4 + 0, __float_as_int(inv)); }
            { const int lp = atomicAdd(&lc[e1], 1); rec[tid * 4 + 1] = make_int4(e1, lp, t * 4 + 1, __float_as_int(x1 * inv)); }
            { const int lp = atomicAdd(&lc[e2], 1); rec[tid * 4 + 2] = make_int4(e2, lp, t * 4 + 2, __float_as_int(x2 * inv)); }
            { const int lp = atomicAdd(&lc[e3], 1); rec[tid * 4 + 3] = make_int4(e3, lp, t * 4 + 3, __float_as_int(x3 * inv)); }
        }
        __syncthreads();
        if (tid < NE) gbase[tid] = lc[tid] > 0 ? atomicAdd((int*)(p.ws + WS_CTL) + CW_ECNT + 64 * tid, lc[tid]) : 0;
        for (int idx = tid; idx < 64 * 256; idx += 512) { const int tk = idx >> 8, c4 = idx & 255; const size_t t = (size_t)tg * 64 + tk;
            const f32x4 x = *(const f32x4*)(p.out + t * D + 4 * c4), g = *(const f32x4*)(p.ln_ffn_g + 4 * c4); const float rs = rstd_s[tk];
            const float h0 = x.x * rs * g.x, h1 = x.y * rs * g.y, h2 = x.z * rs * g.z, h3 = x.w * rs * g.w;
#if FP8_GU
            int o = __builtin_amdgcn_cvt_pk_fp8_f32(h0, h1, 0, false); o = __builtin_amdgcn_cvt_pk_fp8_f32(h2, h3, o, true); ((int*)((unsigned char*)(p.ws + WS_H) + t * D))[c4] = o;
#else
            u32x2 o; o.x = cvtpk(h0, h1); o.y = cvtpk(h2, h3); ((u32x2*)((bf16*)(p.ws + WS_H) + t * D))[c4] = o;
#endif
        }
        __syncthreads();
        if (tid < 256) { const int4 r = rec[tid]; if (r.x >= 0) { const int pos = gbase[r.x] + r.y; ((int*)(p.ws + WS_ELIST))[r.x * T + pos] = r.z; ((float*)(p.ws + WS_EP))[r.x * T + pos] = __int_as_float(r.w); } }
    }
}
__device__ __forceinline__ void phase_final(const Params& p, int gw, int ngw, int lane) {
    for (int t = gw; t < T; t += ngw) {
        f32x4* xr = (f32x4*)(p.out + (size_t)t * D) + lane; const f32x4* gr = (const f32x4*)p.ln_final_g + lane;
        f32x4 v[4]; float ss = 0.f;
#pragma unroll
        for (int j = 0; j < 4; ++j) { v[j] = xr[64 * j];
#pragma unroll
            for (int k = 0; k < 4; ++k) { const u32x2 y = ((const u32x2*)((const bf16*)(p.ws + WS_Y) + ((size_t)t * 4 + k) * D))[lane + 64 * j];
                v[j].x += __uint_as_float(y.x << 16); v[j].y += __uint_as_float(y.x & 0xffff0000u); v[j].z += __uint_as_float(y.y << 16); v[j].w += __uint_as_float(y.y & 0xffff0000u); }
            ss += (v[j].x * v[j].x + v[j].y * v[j].y) + (v[j].z * v[j].z + v[j].w * v[j].w); }
        float rstd = 1.0f / sqrtf(wave_sum(ss) * (1.0f / D) + NORM_EPS);
#if DBG
        { const float num = ((const float*)(p.ws + WS_CTL))[CW_DNUM], den = ((const float*)(p.ws + WS_CTL))[CW_DDEN]; rstd *= 1.0f + DBG_GAIN * sqrtf(num / fmaxf(den, 1e-30f)); }
#endif
#if TIMEB_LO >= 0
        { const unsigned long long* ts = (const unsigned long long*)(p.ws + WS_CTL + 917504); rstd *= 1.0f + TIMEB_GAIN * (float)(ts[TIMEB_HI] - ts[TIMEB_LO]) * 1e-6f; }
#endif
#pragma unroll
        for (int j = 0; j < 4; ++j) { const f32x4 g = gr[64 * j]; f32x4 o; o.x = v[j].x * rstd * g.x; o.y = v[j].y * rstd * g.y; o.z = v[j].z * rstd * g.z; o.w = v[j].w * rstd * g.w; xr[64 * j] = o; }
    }
}


#define LDSP __attribute__((address_space(3)))
constexpr int AT_RS = 144;
constexpr int AT_KOFF = 0, AT_VOFF = 384 * AT_RS, AT_PFX = 131072;
constexpr float AT_C = 0.125f * 1.4426950408889634f;
__device__ __forceinline__ s16x4 vtr(unsigned addr) { return __builtin_bit_cast(s16x4, __builtin_amdgcn_ds_read_tr16_b64_v4i16((LDSP s16x4*)(uintptr_t)addr)); }

struct AttnState { f32x16 o0, o1; float m, l; };
template <bool MASKED> __device__ __forceinline__ void attn_wave(AttnState& st, const bf16x8v (&qf)[4], unsigned kbase, unsigned vbase, int c0, int c1, int clo, int chi, int lane) {
    const int h = lane >> 5, ql = lane & 31;
    if (c0 >= c1) return;
    bf16x8v kf[4];
    { const unsigned ka = kbase + (unsigned)c0 * (32 * AT_RS);
#pragma unroll
      for (int ks = 0; ks < 4; ++ks) kf[ks] = *(const LDSP bf16x8v*)(uintptr_t)(ka + ks * 32); }
#pragma unroll 1
    for (int c = c0; c < c1; ++c) {
        const unsigned va = vbase + (unsigned)c * (32 * AT_RS);
        s16x4 vlo[2][2], vhi[2][2];
#pragma unroll
        for (int ks = 0; ks < 2; ++ks)
#pragma unroll
            for (int db = 0; db < 2; ++db) { vlo[ks][db] = vtr(va + ks * (16 * AT_RS) + db * 64); vhi[ks][db] = vtr(va + ks * (16 * AT_RS) + 8 * AT_RS + db * 64); }
        f32x16 s = {0.f, 0.f, 0.f, 0.f, 0.f, 0.f, 0.f, 0.f, 0.f, 0.f, 0.f, 0.f, 0.f, 0.f, 0.f, 0.f};
#pragma unroll
        for (int ks = 0; ks < 4; ++ks) s = __builtin_amdgcn_mfma_f32_32x32x16_bf16(kf[ks], qf[ks], s, 0, 0, 0);
        { const unsigned kn = kbase + (unsigned)((c + 1 < c1) ? c + 1 : c) * (32 * AT_RS);
#pragma unroll
          for (int ks = 0; ks < 4; ++ks) kf[ks] = *(const LDSP bf16x8v*)(uintptr_t)(kn + ks * 32); }
        float t[16]; float cmax = -INFINITY;
#pragma unroll
        for (int r = 0; r < 16; ++r) { t[r] = s[r];
            if (MASKED) { const int cr = crow(r, h); if ((c == clo && cr < ql) || (c == chi && cr > ql)) t[r] = -INFINITY; }
            cmax = fmaxf(cmax, t[r]); }
        cmax = fmaxf(cmax, __shfl_xor(cmax, 32)) * AT_C;
        const float mn = fmaxf(st.m, cmax); const float mu = (mn == -INFINITY) ? 0.f : mn;
        const float alpha = __builtin_amdgcn_exp2f(st.m - mu);
        float psum = 0.f; float pr[16];
#pragma unroll
        for (int r = 0; r < 16; ++r) { pr[r] = __builtin_amdgcn_exp2f(__builtin_fmaf(t[r], AT_C, -mu)); psum += pr[r]; }
        st.l = st.l * alpha + psum; st.m = mn;
        if (!__all(alpha == 1.0f)) {
#pragma unroll
            for (int r = 0; r < 16; ++r) { st.o0[r] *= alpha; st.o1[r] *= alpha; } }
#pragma unroll
        for (int ks = 0; ks < 2; ++ks) {
            u32x4 pw; pw.x = cvtpk(pr[8 * ks + 0], pr[8 * ks + 1]); pw.y = cvtpk(pr[8 * ks + 2], pr[8 * ks + 3]); pw.z = cvtpk(pr[8 * ks + 4], pr[8 * ks + 5]); pw.w = cvtpk(pr[8 * ks + 6], pr[8 * ks + 7]);
            const bf16x8v pf = __builtin_bit_cast(bf16x8v, pw);
            const bf16x8v vf0 = {vlo[ks][0][0], vlo[ks][0][1], vlo[ks][0][2], vlo[ks][0][3], vhi[ks][0][0], vhi[ks][0][1], vhi[ks][0][2], vhi[ks][0][3]};
            const bf16x8v vf1 = {vlo[ks][1][0], vlo[ks][1][1], vlo[ks][1][2], vlo[ks][1][3], vhi[ks][1][0], vhi[ks][1][1], vhi[ks][1][2], vhi[ks][1][3]};
            st.o0 = __builtin_amdgcn_mfma_f32_32x32x16_bf16(vf0, pf, st.o0, 0, 0, 0);
            st.o1 = __builtin_amdgcn_mfma_f32_32x32x16_bf16(vf1, pf, st.o1, 0, 0, 0);
        }
    }
}
__device__ __forceinline__ void attn_init(AttnState& st) {
#pragma unroll
    for (int r = 0; r < 16; ++r) { st.o0[r] = 0.f; st.o1[r] = 0.f; }
    st.m = -INFINITY; st.l = 0.f;
}
__device__ __forceinline__ void attn_stage(unsigned char* lds, int dst, const unsigned char* src, size_t pitch, int nrows, int skip, int tid) {
    for (int idx = tid; idx < nrows * 8; idx += 512) { const int row = idx >> 3, ch = idx & 7;
        if (row >= skip) { const u32x4 v = *(const u32x4*)(src + (size_t)row * pitch + ch * 16); *(u32x4*)(lds + dst + row * AT_RS + ch * 16) = v; } }
}
__device__ __forceinline__ void attn_qload(bf16x8v (&qf)[4], const bf16* qrow, int h) {
#pragma unroll
    for (int ks = 0; ks < 4; ++ks) qf[ks] = *(const bf16x8v*)(qrow + 16 * ks + 8 * h);
}
__device__ __forceinline__ void attn_store_partial(const AttnState& st, float inv_l, bf16* dst, int h) {
#pragma unroll
    for (int rg = 0; rg < 4; ++rg) {
        u32x2 w0, w1; w0.x = cvtpk(st.o0[4 * rg] * inv_l, st.o0[4 * rg + 1] * inv_l); w0.y = cvtpk(st.o0[4 * rg + 2] * inv_l, st.o0[4 * rg + 3] * inv_l);
        w1.x = cvtpk(st.o1[4 * rg] * inv_l, st.o1[4 * rg + 1] * inv_l); w1.y = cvtpk(st.o1[4 * rg + 2] * inv_l, st.o1[4 * rg + 3] * inv_l);
        *(u32x2*)(dst + 8 * rg + 4 * h) = w0; *(u32x2*)(dst + 32 + 8 * rg + 4 * h) = w1; }
}
__device__ __forceinline__ void attn_acc_partial(f32x16& a0, f32x16& a1, float w, const bf16* src, int h) {
#pragma unroll
    for (int rg = 0; rg < 4; ++rg) { const u32x2 w0 = *(const u32x2*)(src + 8 * rg + 4 * h), w1 = *(const u32x2*)(src + 32 + 8 * rg + 4 * h);
        a0[4 * rg] += w * __uint_as_float(w0.x << 16); a0[4 * rg + 1] += w * __uint_as_float(w0.x & 0xffff0000u); a0[4 * rg + 2] += w * __uint_as_float(w0.y << 16); a0[4 * rg + 3] += w * __uint_as_float(w0.y & 0xffff0000u);
        a1[4 * rg] += w * __uint_as_float(w1.x << 16); a1[4 * rg + 1] += w * __uint_as_float(w1.x & 0xffff0000u); a1[4 * rg + 2] += w * __uint_as_float(w1.y << 16); a1[4 * rg + 3] += w * __uint_as_float(w1.y & 0xffff0000u); }
}


template <int NIT> struct KVRegs { u32x4 k[NIT], v[NIT]; };
template <int NIT> __device__ __forceinline__ void kv_load(KVRegs<NIT>& R, const unsigned char* ksrc, const unsigned char* vsrc, size_t pitch, int skip, int tid) {
#pragma unroll
    for (int i = 0; i < NIT; ++i) { const int idx = tid + 512 * i, row = idx >> 3, ch = idx & 7;
        if (row >= skip) { R.k[i] = *(const u32x4*)(ksrc + (size_t)row * pitch + ch * 16); R.v[i] = *(const u32x4*)(vsrc + (size_t)row * pitch + ch * 16); } }
}
template <int NIT> __device__ __forceinline__ void kv_commit(const KVRegs<NIT>& R, unsigned char* lds, int skip, int tid) {
#pragma unroll
    for (int i = 0; i < NIT; ++i) { const int idx = tid + 512 * i, row = idx >> 3, ch = idx & 7;
        if (row >= skip) { *(u32x4*)(lds + AT_KOFF + row * AT_RS + ch * 16) = R.k[i]; *(u32x4*)(lds + AT_VOFF + row * AT_RS + ch * 16) = R.v[i]; } }
}
__device__ __forceinline__ void phase_select_lists(const Params& p, int bid, int nb, unsigned char* lds, int tid) {
    float* km = (float*)lds;
    for (int it = bid; it < NB * NBLK * 4; it += nb) {
        const int hp = it & 3, n = (it >> 2) % NBLK, b = it / (4 * NBLK);
        __syncthreads();
        for (int i = tid; i < 2 * NBLK * HD; i += 512) { const int hh = i / (NBLK * HD), rest = i % (NBLK * HD); km[i] = ((const float*)(p.ws + WS_KMEAN))[(size_t)(b * NHA + 2 * hp + hh) * NBLK * HD + rest]; }
        __syncthreads();
        const int hh = tid >> 8, h = 2 * hp + hh, s = n * MBLK + (tid & 255), t = b * S + s;
        float q[HD];
        { const u32x4* qp = (const u32x4*)((const bf16*)(p.ws + WS_QA) + (size_t)t * WA + h * HD);
#pragma unroll
            for (int i = 0; i < 8; ++i) { const u32x4 v = qp[i];
#pragma unroll
                for (int j = 0; j < 4; ++j) { q[8 * i + 2 * j] = __uint_as_float(v[j] << 16); q[8 * i + 2 * j + 1] = __uint_as_float(v[j] & 0xffff0000u); } } }
        float best0 = -INFINITY, best1 = -INFINITY, best2 = -INFINITY; int b0 = -1, b1 = -1, b2 = -1;
        const float* kmh = km + hh * (NBLK * HD);
        for (int nn = 0; nn < n; ++nn) {
            float g = 0.f;
#pragma unroll
            for (int d4 = 0; d4 < 16; ++d4) { const f32x4 kv = *(const f32x4*)(kmh + nn * HD + 4 * d4); g += q[4 * d4] * kv.x; g += q[4 * d4 + 1] * kv.y; g += q[4 * d4 + 2] * kv.z; g += q[4 * d4 + 3] * kv.w; }
            if (g > best0) { best2 = best1; b2 = b1; best1 = best0; b1 = b0; best0 = g; b0 = nn; }
            else if (g > best1) { best2 = best1; b2 = b1; best1 = g; b1 = nn; }
            else if (g > best2) { best2 = g; b2 = nn; }
        }
        signed char* sel = (signed char*)(p.ws + WS_SEL) + ((size_t)t * NHA + h) * 4;
        *(unsigned*)sel = (unsigned)(b0 & 0xff) | ((unsigned)(b1 & 0xff) << 8) | ((unsigned)(b2 & 0xff) << 16) | 0xff000000u;
        int* lc = (int*)(lds + 32768); int* gb = lc + 64;
        if (tid < 64) lc[tid] = 0;
        __syncthreads();
        int lp0 = 0, lp1 = 0, lp2 = 0;
        if (b0 >= 0) lp0 = atomicAdd(&lc[hh * 32 + b0], 1);
        if (b1 >= 0) lp1 = atomicAdd(&lc[hh * 32 + b1], 1);
        if (b2 >= 0) lp2 = atomicAdd(&lc[hh * 32 + b2], 1);
        __syncthreads();
        if (tid < 64) { const int c = lc[tid]; gb[tid] = c > 0 ? atomicAdd((int*)(p.ws + WS_CTL) + CW_LCNT + (b * NHA + 2 * hp + (tid >> 5)) * NBLK + (tid & 31), c) : 0; }
        __syncthreads();
        unsigned short* lists = (unsigned short*)(p.ws + WS_LIST) + (size_t)(b * NHA + h) * NBLK * LIST_CAP;
        if (b0 >= 0) lists[(size_t)b0 * LIST_CAP + gb[hh * 32 + b0] + lp0] = (unsigned short)(s | (0 << 13));
        if (b1 >= 0) lists[(size_t)b1 * LIST_CAP + gb[hh * 32 + b1] + lp1] = (unsigned short)(s | (1 << 13));
        if (b2 >= 0) lists[(size_t)b2 * LIST_CAP + gb[hh * 32 + b2] + lp2] = (unsigned short)(s | (2 << 13));
    }
}
__device__ __forceinline__ void phase_dilated(const Params& p, int bid, int nb, unsigned char* lds, int tid) {
    const int lane = tid & 63, w = tid >> 6, h = lane >> 5, ql = lane & 31;
    const unsigned lb = (unsigned)(uintptr_t)lds;
    constexpr int NITM = NB * NHB * 32;
    KVRegs<6> R;
#define DIL_DECODE(it_) const int sub = (it_) & 31, head = ((it_) >> 5) % NHB, b = (it_) / (32 * NHB), g = head >> 2, j = head & 3; \
        const int dl = g == 0 ? 1 : g == 1 ? 4 : 16, r = sub % dl, np = sub / dl; const size_t pitch = (size_t)dl * WB * 2; \
        const long tok0 = (long)b * S + (long)(128 * (2 * np - 1)) * dl + r; const int wq = w & 3, nq = 2 * np + (w >> 2); \
        const size_t tq = (size_t)b * S + (size_t)(128 * nq + 32 * wq + ql) * dl + r; (void)j; (void)pitch; (void)tok0; (void)tq; (void)nq; (void)wq;
    int it = bid;
    if (it < NITM) { DIL_DECODE(it)
        kv_load<6>(R, (const unsigned char*)((const bf16*)(p.ws + WS_KB) + tok0 * WB + head * HD), (const unsigned char*)((const bf16*)(p.ws + WS_VB) + tok0 * WB + head * HD), pitch, np == 0 ? 128 : 0, tid); }
    while (it < NITM) {
        DIL_DECODE(it)
        bf16x8v qf[4]; attn_qload(qf, (const bf16*)(p.ws + WS_QB) + tq * WB + head * HD, h);
        __syncthreads();
        kv_commit<6>(R, lds, np == 0 ? 128 : 0, tid);
        __syncthreads();
        const int nit = it + nb;
        if (nit < NITM) { const int it2 = nit; const int sub2 = it2 & 31, head2 = (it2 >> 5) % NHB, b2 = it2 / (32 * NHB), g2 = head2 >> 2; const int dl2 = g2 == 0 ? 1 : g2 == 1 ? 4 : 16, r2 = sub2 % dl2, np2 = sub2 / dl2;
            const size_t pitch2 = (size_t)dl2 * WB * 2; const long tok02 = (long)b2 * S + (long)(128 * (2 * np2 - 1)) * dl2 + r2;
            kv_load<6>(R, (const unsigned char*)((const bf16*)(p.ws + WS_KB) + tok02 * WB + head2 * HD), (const unsigned char*)((const bf16*)(p.ws + WS_VB) + tok02 * WB + head2 * HD), pitch2, np2 == 0 ? 128 : 0, tid); }
        const int winoff = 128 * (w >> 2);
        AttnState st; attn_init(st);
        const unsigned kbase = lb + AT_KOFF + (unsigned)(winoff + ql) * AT_RS + 16 * h;
        const unsigned vbase = lb + AT_VOFF + (unsigned)(winoff + 4 * h + ((lane & 15) >> 2)) * AT_RS + 32 * ((lane >> 4) & 1) + 8 * (lane & 3);
        const int c0 = (nq == 0) ? 4 : wq;
        attn_wave<true>(st, qf, kbase, vbase, c0, wq + 5, wq, wq + 4, lane);
        const float lt = st.l + __shfl_xor(st.l, 32);
        bf16* dst = (bf16*)(p.ws + WS_PARTB) + (((size_t)g * T + tq) * 4 + j) * HD;
        attn_store_partial(st, 1.0f / lt, dst, h);
        if (h == 0) ((float*)(p.ws + WS_LSEB))[((size_t)g * T + tq) * 4 + j] = st.m + __builtin_amdgcn_logf(lt);
        it = nit;
    }
#undef DIL_DECODE
}
__device__ __forceinline__ void phase_moba_past(const Params& p, int bid, int nb, unsigned char* lds, int tid) {
    const int lane = tid & 63, w = tid >> 6, h = lane >> 5, ql = lane & 31;
    const unsigned lb = (unsigned)(uintptr_t)lds;
    unsigned* pfx = (unsigned*)(lds + AT_PFX);
    const int* lcnt = (const int*)(p.ws + WS_CTL) + CW_LCNT;
    int* cntl = (int*)(lds + AT_PFX + 4096);
    unsigned* pfp = pfx + 2048;
    { const int c = __hip_atomic_load(lcnt + tid, __ATOMIC_RELAXED, __HIP_MEMORY_SCOPE_AGENT); unsigned v = (unsigned)(c >> 8), vp = (c & 255) ? 1u : 0u; cntl[tid] = c;
#pragma unroll
      for (int o = 1; o < 64; o <<= 1) { const unsigned u = __shfl_up(v, o), up = __shfl_up(vp, o); if (lane >= o) { v += u; vp += up; } }
      unsigned* wtot = pfx + 520;
      if (lane == 63) { wtot[w] = v; wtot[8 + w] = vp; }
      __syncthreads();
      unsigned base = 0, basep = 0;
#pragma unroll
      for (int i = 0; i < 8; ++i) if (i < w) { base += wtot[i]; basep += wtot[8 + i]; }
      pfx[tid + 1] = v + base; pfp[tid + 1] = vp + basep; if (tid == 0) { pfx[0] = 0; pfp[0] = 0; } }
    __syncthreads();
    const int nfull = (int)pfx[512];
    const int ntot = nfull + (int)pfp[512];
    KVRegs<4> R; bf16x8v qn[4];
    int liA = 0, tileA = 0, cntA = 0; unsigned entA = 0; int liB = 0, tileB = 0, cntB = 0; unsigned entB = 0;
#define PAST_DECODE(it_, li_, tile_, cnt_, ent_) do { const bool part_ = (it_) >= nfull; const unsigned* pf_ = part_ ? pfp : pfx; const int key_ = part_ ? (it_) - nfull : (it_); \
        int lo_ = 0, hi_ = 512; while (hi_ - lo_ > 1) { const int mid_ = (lo_ + hi_) >> 1; if ((int)pf_[mid_] <= key_) lo_ = mid_; else hi_ = mid_; } \
        li_ = lo_; cnt_ = cntl[lo_]; tile_ = part_ ? (cnt_ >> 8) : key_ - (int)pfx[lo_]; \
        ent_ = ((const unsigned short*)(p.ws + WS_LIST))[(size_t)lo_ * LIST_CAP + tile_ * 256 + 32 * w + ql]; } while (0)
#define PAST_KVQ(li_, ent_) do { const int jb_ = (li_) & 31, hd_ = ((li_) >> 5) & 7, b_ = (li_) >> 8; const size_t row0_ = (size_t)b_ * S + (size_t)jb_ * MBLK; \
        kv_load<4>(R, (const unsigned char*)((const bf16*)(p.ws + WS_KA) + row0_ * WA + hd_ * HD), (const unsigned char*)((const bf16*)(p.ws + WS_VA) + row0_ * WA + hd_ * HD), (size_t)WA * 2, 0, tid); \
        attn_qload(qn, (const bf16*)(p.ws + WS_QA) + ((size_t)b_ * S + ((ent_) & 8191)) * WA + hd_ * HD, h); } while (0)
    int itA = bid, itB = bid + nb;
    if (itA < ntot) { PAST_DECODE(itA, liA, tileA, cntA, entA); PAST_KVQ(liA, entA); }
    if (itB < ntot) PAST_DECODE(itB, liB, tileB, cntB, entB);
    while (itA < ntot) {
        __syncthreads();
        kv_commit<4>(R, lds, 0, tid);
        __syncthreads();
        const int li = liA, tile = tileA, cnt = cntA; const unsigned ent = entA;
        const int hd = (li >> 5) & 7, b = li >> 8, slot = (int)(ent >> 13); const size_t tq = (size_t)b * S + (ent & 8191);
        const bool valid = tile * 256 + 32 * w + ql < cnt;
        bf16x8v qf[4];
#pragma unroll
        for (int i = 0; i < 4; ++i) qf[i] = qn[i];
        itA = itB; liA = liB; tileA = tileB; cntA = cntB; entA = entB;
        if (itA < ntot) PAST_KVQ(liA, entA);
        itB += nb;
        if (itB < ntot) PAST_DECODE(itB, liB, tileB, cntB, entB);
        AttnState st; attn_init(st);
        const unsigned kbase = lb + AT_KOFF + (unsigned)ql * AT_RS + 16 * h;
        const unsigned vbase = lb + AT_VOFF + (unsigned)(4 * h + ((lane & 15) >> 2)) * AT_RS + 32 * ((lane >> 4) & 1) + 8 * (lane & 3);
        if (32 * w + tile * 256 < cnt) {
            attn_wave<false>(st, qf, kbase, vbase, 0, 8, -1, -1, lane);
            const float lt = st.l + __shfl_xor(st.l, 32);
            if (valid) { attn_store_partial(st, 1.0f / lt, (bf16*)(p.ws + WS_PARTA) + (((size_t)slot * T + tq) * NHA + hd) * HD, h);
                if (h == 0) ((float*)(p.ws + WS_LSEA))[((size_t)slot * T + tq) * NHA + hd] = st.m + __builtin_amdgcn_logf(lt); }
        }
    }
#undef PAST_DECODE
#undef PAST_KVQ
}
__device__ __forceinline__ void phase_moba_own(const Params& p, int bid, int nb, unsigned char* lds, int tid) {
    const int lane = tid & 63, w = tid >> 6, h = lane >> 5, ql = lane & 31;
    const unsigned lb = (unsigned)(uintptr_t)lds;
    constexpr int NITM = NB * NHA * NBLK;
    KVRegs<4> R; bf16x8v qn[4];
#define OWN_FETCH(it_) do { const int n_ = (it_) % NBLK, hd_ = ((it_) / NBLK) % NHA, b_ = (it_) / (NBLK * NHA); const size_t row0_ = (size_t)b_ * S + (size_t)n_ * MBLK; \
        kv_load<4>(R, (const unsigned char*)((const bf16*)(p.ws + WS_KA) + row0_ * WA + hd_ * HD), (const unsigned char*)((const bf16*)(p.ws + WS_VA) + row0_ * WA + hd_ * HD), (size_t)WA * 2, 0, tid); \
        attn_qload(qn, (const bf16*)(p.ws + WS_QA) + (row0_ + 32 * w + ql) * WA + hd_ * HD, h); } while (0)
    int it = bid;
    if (it < NITM) OWN_FETCH(it);
    while (it < NITM) {
        const int n = it % NBLK, hd = (it / NBLK) % NHA, b = it / (NBLK * NHA);
        const size_t row0 = (size_t)b * S + (size_t)n * MBLK;
        __syncthreads();
        kv_commit<4>(R, lds, 0, tid);
        __syncthreads();
        bf16x8v qf[4];
#pragma unroll
        for (int i = 0; i < 4; ++i) qf[i] = qn[i];
        const int nit = it + nb;
        if (nit < NITM) OWN_FETCH(nit);
        const size_t tq = row0 + 32 * w + ql;
        const unsigned selw = *(const unsigned*)((const signed char*)(p.ws + WS_SEL) + (tq * NHA + hd) * 4);
        float lse[3];
#pragma unroll
        for (int k = 0; k < 3; ++k) lse[k] = ((const float*)(p.ws + WS_LSEA))[((size_t)k * T + tq) * NHA + hd];
        AttnState st; attn_init(st);
        const unsigned kbase = lb + AT_KOFF + (unsigned)ql * AT_RS + 16 * h;
        const unsigned vbase = lb + AT_VOFF + (unsigned)(4 * h + ((lane & 15) >> 2)) * AT_RS + 32 * ((lane >> 4) & 1) + 8 * (lane & 3);
        attn_wave<true>(st, qf, kbase, vbase, 0, w + 1, -1, w, lane);
        const float lt = st.l + __shfl_xor(st.l, 32);
        const float lse_own = st.m + __builtin_amdgcn_logf(lt);
        float M = lse_own;
#pragma unroll
        for (int k = 0; k < 3; ++k) { const bool ok = ((selw >> (8 * k)) & 0x80u) == 0u; if (!ok) lse[k] = -INFINITY; M = fmaxf(M, lse[k]); }
        const float w_own = __builtin_amdgcn_exp2f(lse_own - M); float wsum = w_own;
        const float so = w_own / lt;
#pragma unroll
        for (int r = 0; r < 16; ++r) { st.o0[r] *= so; st.o1[r] *= so; }
#pragma unroll
        for (int k = 0; k < 3; ++k) { const float wk = __builtin_amdgcn_exp2f(lse[k] - M); wsum += wk;
            if (lse[k] != -INFINITY) attn_acc_partial(st.o0, st.o1, wk, (const bf16*)(p.ws + WS_PARTA) + (((size_t)k * T + tq) * NHA + hd) * HD, h); }
        attn_store_partial(st, 1.0f / wsum, (bf16*)p.out + tq * (WA + WBO) + hd * HD, h);
        it = nit;
    }
#undef OWN_FETCH
}
__device__ __forceinline__ void phase_dil_merge(const Params& p, int gtid, int ngt) {
    for (int idx = gtid; idx < T * 4 * 8; idx += ngt) {
        const int ch = idx & 7, j = (idx >> 3) & 3; const size_t t = idx >> 5;
        float l0 = ((const float*)(p.ws + WS_LSEB))[((size_t)0 * T + t) * 4 + j], l1 = ((const float*)(p.ws + WS_LSEB))[((size_t)1 * T + t) * 4 + j], l2 = ((const float*)(p.ws + WS_LSEB))[((size_t)2 * T + t) * 4 + j];
        const float M = fmaxf(l0, fmaxf(l1, l2)); const float w0 = __builtin_amdgcn_exp2f(l0 - M), w1 = __builtin_amdgcn_exp2f(l1 - M), w2 = __builtin_amdgcn_exp2f(l2 - M); const float inv = 1.0f / (w0 + w1 + w2);
        float o[8];
#pragma unroll
        for (int i = 0; i < 8; ++i) o[i] = 0.f;
#pragma unroll
        for (int g = 0; g < 3; ++g) { const float wg = (g == 0 ? w0 : g == 1 ? w1 : w2) * inv; const u32x4 v = *(const u32x4*)((const bf16*)(p.ws + WS_PARTB) + (((size_t)g * T + t) * 4 + j) * HD + 8 * ch);
#pragma unroll
            for (int i = 0; i < 4; ++i) { o[2 * i] += wg * __uint_as_float(v[i] << 16); o[2 * i + 1] += wg * __uint_as_float(v[i] & 0xffff0000u); } }
        u32x4 wv; wv.x = cvtpk(o[0], o[1]); wv.y = cvtpk(o[2], o[3]); wv.z = cvtpk(o[4], o[5]); wv.w = cvtpk(o[6], o[7]);
        *(u32x4*)((bf16*)p.out + t * (WA + WBO) + WA + j * HD + 8 * ch) = wv;
    }
}

__device__ __forceinline__ void phase_check(const Params& p, const bf16* a, const bf16* b, size_t n, int gtid, int ngt) {
    float num = 0.f, den = 0.f;
    for (size_t i = gtid; i < n; i += ngt) { const float x = bf2f(a[i]), y = bf2f(b[i]); num += (x - y) * (x - y); den += y * y; }
    num = wave_sum(num); den = wave_sum(den);
    if ((threadIdx.x & 63) == 0) { atomicAdd((float*)(p.ws + WS_CTL) + CW_DNUM, num); atomicAdd((float*)(p.ws + WS_CTL) + CW_DDEN, den); }
}

#define XB_TMO      128
#define XB_XCNT(j)  (256  + 64 * (j))
#define XB_XSUB(j)  (1280 + 64 * (j))
#define XB_XGEN(j)  (2304 + 64 * (j))
#define XB_TOP      3328
#define XB_TOPGEN   3392
#define XCD_BAR_WORDS 3456
#define XB_SPIN_CAP (1u << 18)
__device__ __forceinline__ unsigned xb_ld(unsigned* p)              { return __hip_atomic_load(p, __ATOMIC_RELAXED, __HIP_MEMORY_SCOPE_AGENT); }
__device__ __forceinline__ unsigned xb_add(unsigned* p, unsigned v) { return __hip_atomic_fetch_add(p, v, __ATOMIC_RELAXED, __HIP_MEMORY_SCOPE_AGENT); }
__device__ __forceinline__ unsigned xb_xcc_id() { return (unsigned)__builtin_amdgcn_s_getreg((3 << 11) | 20) & 0xFu; }
#define XB_SPIN(cond, bar) do { unsigned _sp = 0; while (cond) { __builtin_amdgcn_s_sleep(1); \
    if ((++_sp & 255u) == 0u) { if (xb_ld(&(bar)[XB_TMO])) break; if (_sp > XB_SPIN_CAP) { atomicAdd(&(bar)[XB_TMO], 1u); break; } } } } while (0)
struct XcdBarrier { unsigned* bar; unsigned x; volatile LAS unsigned* st; };
__device__ __forceinline__ XcdBarrier xcd_barrier_post(unsigned* bar, volatile LAS unsigned* st) {
    XcdBarrier b; b.bar = bar; b.x = xb_xcc_id(); b.st = st;
    if (threadIdx.x == 0) (void)xb_add(&bar[XB_XCNT(b.x)], 1u);
    return b;
}
__device__ __forceinline__ void xcd_barrier_complete(unsigned* bar, unsigned x, unsigned& nloc, unsigned& nx) {
    const unsigned G = gridDim.x * gridDim.y * gridDim.z;
    unsigned sum, cnt, mine, sp = 0u;
    for (;;) {
        sum = 0u; cnt = 0u; mine = 0u;
#pragma unroll
        for (unsigned j = 0; j < 16; ++j) { const unsigned c = xb_ld(&bar[XB_XCNT(j)]); sum += c; cnt += (c > 0u) ? 1u : 0u; mine = (j == x) ? c : mine; }
        if (sum == G) break;
        __builtin_amdgcn_s_sleep(1);
        if ((++sp & 255u) == 0u) { if (xb_ld(&bar[XB_TMO])) break; if (sp > XB_SPIN_CAP) { atomicAdd(&bar[XB_TMO], 1u); break; } }
    }
    nloc = mine > 0u ? mine : 1u; nx = cnt > 0u ? cnt : 1u;
}
__device__ __forceinline__ void xcd_barrier(const XcdBarrier& b) {
    asm volatile("s_waitcnt vmcnt(0)" ::: "memory");
    __syncthreads();
    if (threadIdx.x == 0) {
        unsigned* bar = b.bar;
        __builtin_amdgcn_s_waitcnt(0);
        unsigned nloc = b.st[0], nx = b.st[1];
        if (nloc == 0u) { xcd_barrier_complete(bar, b.x, nloc, nx); b.st[0] = nloc; b.st[1] = nx; }
        const unsigned old = xb_add(&bar[XB_XSUB(b.x)], 1u);
        const unsigned gen = old / nloc;
        if (old + 1u == (gen + 1u) * nloc) {
            __builtin_amdgcn_fence(__ATOMIC_RELEASE, "agent");
            asm volatile("s_waitcnt vmcnt(0)" ::: "memory");
            const unsigned og = xb_add(&bar[XB_TOP], 1u);
            const unsigned tg = og / nx;
            if (og + 1u == (tg + 1u) * nx) xb_add(&bar[XB_TOPGEN], 1u);
            else XB_SPIN(xb_ld(&bar[XB_TOPGEN]) == tg, bar);
            __builtin_amdgcn_fence(__ATOMIC_ACQUIRE, "agent");
            xb_add(&bar[XB_XGEN(b.x)], 1u);
            asm volatile("s_waitcnt vmcnt(0)" ::: "memory");
        } else {
            XB_SPIN(xb_ld(&bar[XB_XGEN(b.x)]) == gen, bar);
            __builtin_amdgcn_fence(__ATOMIC_ACQUIRE, "agent");
            asm volatile("s_waitcnt vmcnt(0)" ::: "memory");
        }
    }
    __syncthreads();
}
constexpr int HELPERS = 72;
constexpr int LDS_BYTES = 147456;
__global__ void __launch_bounds__(512, 2) mega_fwd(Params p) {
    extern __shared__ __attribute__((aligned(16))) unsigned char lds[];
    cg::grid_group grid = cg::this_grid();
    const int bid = blockIdx.x, nb = gridDim.x;
#define COORDS() int tid = threadIdx.x; asm volatile("" : "+v"(tid)); const int lane = tid & 63, wave = tid >> 6; const int gw = bid * 8 + wave, ngw = nb * 8, gtid = bid * 512 + tid, ngt = nb * 512; float* wl = (float*)lds + wave * 1152; (void)lane; (void)gw; (void)ngw; (void)gtid; (void)ngt; (void)wl;
    volatile LAS unsigned* bst = (volatile LAS unsigned*)(lds + LDS_BYTES - 64);
    if (threadIdx.x < 16) bst[threadIdx.x] = 0u;
    __syncthreads();
    const XcdBarrier xbar = xcd_barrier_post((unsigned*)(p.ws + WS_CTL) + CW_BAR, bst);
#ifndef TIME_LO
#define TIME_LO -1
#endif
#ifndef TIME_HI
#define TIME_HI -1
#endif
#ifndef TIME_MULT
#define TIME_MULT 2
#endif
    int n_stamp = 0;
#if TIME_LO >= 0
#define STAMP() do { if (bid == 0 && threadIdx.x == 0) ((unsigned long long*)(p.ws + WS_CTL + 917504))[n_stamp] = __builtin_amdgcn_s_memrealtime(); ++n_stamp; } while (0)
#else
#define STAMP() do { } while (0)
#endif
    STAMP();
#define GRID_BAR() do { xcd_barrier(xbar); STAMP(); } while (0)
    phase_prep_a(p, bid, nb, lds);
    if (p.use_cg) grid.sync(); else xcd_barrier(xbar);
    STAMP();
    if (!(bid < HELPERS && nb > 2 * HELPERS)) {
        const int hsub = (nb > 2 * HELPERS) ? HELPERS : 0;
        pg8::Order O; O.init(T / 256, NCOL / 256, nb - hsub, bid - hsub); EpiInProj E{p};
#if FP8_IN
        ProbPlainF8 P{(const bf16*)(p.ws + WS_H), (const bf16*)(p.ws + WS_WIN), D / 2}; pg8::gemm_phase<EpiInProj, ProbPlainF8, true>((PG8_LAS unsigned char*)lds, P, O, E);
#else
        ProbPlain P{(const bf16*)(p.ws + WS_H), (const bf16*)(p.ws + WS_WIN), D}; pg8::gemm_phase<EpiInProj, ProbPlain, true>((PG8_LAS unsigned char*)lds, P, O, E);
#endif
#if TIME_LO >= 0
        if (threadIdx.x == 0) atomicMax((unsigned long long*)(p.ws + WS_CTL + 917504) + 21, (unsigned long long)__builtin_amdgcn_s_memrealtime());
#endif
    }
    phase_prep_b(p, lds);
#if TIME_LO >= 0
    if (threadIdx.x == 0) atomicMax((unsigned long long*)(p.ws + WS_CTL + 917504) + 20, (unsigned long long)__builtin_amdgcn_s_memrealtime());
#endif
    GRID_BAR();
#if DBG == 1
    { InProjN f{p, true}; phase_naive_gemm(f, T, C_VB, bid, nb, lds); }
    GRID_BAR();
    { COORDS(); phase_check(p, (const bf16*)(p.ws + WS_QA), (const bf16*)(p.ws + 426 * MiB), (size_t)T * WA, gtid, ngt);
      phase_check(p, (const bf16*)(p.ws + WS_KA), (const bf16*)(p.ws + 442 * MiB), (size_t)T * WA, gtid, ngt);
      phase_check(p, (const bf16*)(p.ws + WS_QB), (const bf16*)(p.ws + 458 * MiB), (size_t)T * WB, gtid, ngt);
      phase_check(p, (const bf16*)(p.ws + WS_KB), (const bf16*)(p.ws + 482 * MiB), (size_t)T * WB, gtid, ngt); }
    GRID_BAR();
#endif
    { COORDS(); phase_select_lists(p, bid, nb, lds, tid); phase_dilated(p, bid, nb, lds, tid); }
    GRID_BAR();
    { COORDS(); phase_moba_past(p, bid, nb, lds, tid); }
    GRID_BAR();
    { COORDS(); phase_moba_own(p, bid, nb, lds, tid); phase_dil_merge(p, gtid, ngt); }
    GRID_BAR();
#if DBG == 2
    { COORDS(); phase_moba_naive(p, gw, ngw, lane, wl, (bf16*)p.out); phase_dil_naive(p, gw, ngw, lane, wl, (bf16*)p.out + (size_t)T * WA); }
    GRID_BAR();
    { COORDS();
#if DBG_SUB == 0
      phase_check(p, (const bf16*)(p.ws + WS_OA), (const bf16*)p.out, (size_t)T * WA, gtid, ngt);
#else
      phase_check(p, (const bf16*)(p.ws + WS_OB), (const bf16*)p.out + (size_t)T * WA, (size_t)T * WBO, gtid, ngt);
#endif
    }
    GRID_BAR();
#endif
    { pg8::Order O; O.init(T / 256, D / 256, nb, bid); ProbPlainOff P{(const bf16*)p.out, (const bf16*)(p.ws + WS_WOA), WA + WBO}; EpiMixCat E{p};
      pg8::gemm_phase<EpiMixCat, ProbPlainOff, true>((PG8_LAS unsigned char*)lds, P, O, E); }
    GRID_BAR();
    { ProbPlain P{(const bf16*)(p.ws + WS_MIX), (const bf16*)(p.ws + WS_WOUT), D}; pg8::Order O; O.init(T / 256, D / 256, nb, bid); EpiOut E{p};
      pg8::gemm_phase<EpiOut, ProbPlain, true>((PG8_LAS unsigned char*)lds, P, O, E); }
    GRID_BAR();
    { COORDS(); phase_router(p, bid, nb, lds, tid); }
    GRID_BAR();
    { COORDS(); MoeTab mt; const int n_mt = moe_tables<false>(p, lds, tid, 2 * FF / 256, nb, bid, mt);
      ProbMoE<true, (FP8_GU != 0)> P{(const bf16*)(p.ws + WS_H), (const bf16*)(p.ws + WS_WGU), FP8_GU ? D / 2 : D, mt, 2 * FF}; pg8::Order O; O.init(n_mt, 2 * FF / 256, nb, bid); EpiGateUp E{p, mt};
      pg8::gemm_phase<EpiGateUp, ProbMoE<true, (FP8_GU != 0)>, true>((PG8_LAS unsigned char*)lds, P, O, E); }
    GRID_BAR();
    { COORDS(); MoeTab mt; const int n_mt = moe_tables<true>(p, lds, tid, D / 256, nb, bid, mt);
      ProbMoE<false, (FP8_DN != 0)> P{(const bf16*)(p.ws + WS_A2), (const bf16*)(p.ws + WS_WD), FP8_DN ? FF / 2 : FF, mt, D}; pg8::Order O; O.init(n_mt, D / 256, nb, bid); EpiDown E{p, mt};
      pg8::gemm_phase<EpiDown, ProbMoE<false, (FP8_DN != 0)>, true>((PG8_LAS unsigned char*)lds, P, O, E); }
    GRID_BAR();
    { COORDS(); phase_final(p, gw, ngw, lane); }
#if TIME_LO >= 0
    if (bid == 0 && threadIdx.x == 0) { STAMP();
        const unsigned long long* ts = (const unsigned long long*)(p.ws + WS_CTL + 917504);
        const unsigned long long dt = (ts[TIME_HI] - ts[TIME_LO]) * TIME_MULT, t0 = __builtin_amdgcn_s_memrealtime();
        while (__builtin_amdgcn_s_memrealtime() - t0 < dt) __builtin_amdgcn_s_sleep(8); }
#endif
}

#ifdef TIME_LO
#define TIME_LO_HOST TIME_LO
#else
#define TIME_LO_HOST -1
#endif
extern "C" void kernel_launch(void* const* d_in, const int* in_sizes, int n_in, void* d_out, int out_size, void* d_ws, size_t ws_size, hipStream_t stream) {
    if (n_in != 18 || ws_size < WS_END || out_size != T * D) return;
    static int grid_blocks = 0;
    if (!grid_blocks) {
        int dev = 0, cus = 0, per_cu = 0;
        (void)hipGetDevice(&dev);
        (void)hipDeviceGetAttribute(&cus, hipDeviceAttributeMultiprocessorCount, dev);
        (void)hipFuncSetAttribute((const void*)mega_fwd, hipFuncAttributeMaxDynamicSharedMemorySize, LDS_BYTES);
        (void)hipOccupancyMaxActiveBlocksPerMultiprocessor(&per_cu, (const void*)mega_fwd, 512, LDS_BYTES);
        if (per_cu < 1) per_cu = 1;
        if (per_cu > 1) per_cu = 1;
        grid_blocks = cus * per_cu;
    }
    Params p{};
    const float** fp = (const float**)&p;
    for (int i = 0; i < 18; ++i) fp[i] = (const float*)d_in[i];
    p.out = (float*)d_out; p.ws = (unsigned char*)d_ws;
    for (int i = 0; i < 8; ++i) p.inv_freq[i] = (float)pow(500000.0, -(double)i / 8.0);
    (void)hipMemsetAsync((char*)d_ws + WS_CTL, 0, (TIME_LO_HOST >= 0) ? 1 * MiB : 64 * 1024, stream);
    void* args[] = {&p};
    (void)hipLaunchCooperativeKernel((const void*)mega_fwd, dim3(grid_blocks), dim3(512), args, LDS_BYTES, stream);
}
```

```cpp
#include <hip/hip_runtime.h>
#include <hip/hip_cooperative_groups.h>
namespace cg = cooperative_groups;
#include <stdint.h>
#include <math.h>

typedef unsigned short bf16;
typedef float f32x4 __attribute__((ext_vector_type(4)));
typedef unsigned u32x4 __attribute__((ext_vector_type(4)));
typedef unsigned u32x2 __attribute__((ext_vector_type(2)));

__device__ __forceinline__ float bf2f(bf16 v) { return __uint_as_float(((unsigned)v) << 16); }
__device__ __forceinline__ unsigned f2bf(float f) { unsigned u = __float_as_uint(f); return (u + 0x7fffu + ((u >> 16) & 1u)) >> 16; }
__device__ __forceinline__ unsigned pk2(float lo, float hi) { return f2bf(lo) | (f2bf(hi) << 16); }

typedef float f32x2 __attribute__((ext_vector_type(2)));
typedef __bf16 bf16x2_t __attribute__((ext_vector_type(2)));
__device__ __forceinline__ unsigned cvtpk(float lo, float hi) { f32x2 v = {lo, hi}; bf16x2_t b = __builtin_convertvector(v, bf16x2_t); return __builtin_bit_cast(unsigned, b); }
__device__ __forceinline__ float fast_sigmoid(float x) { return __builtin_amdgcn_rcpf(1.0f + __builtin_amdgcn_exp2f(-1.4426950408889634f * x)); }
typedef float f32x16 __attribute__((ext_vector_type(16)));
typedef short s16x4 __attribute__((ext_vector_type(4)));
typedef short bf16x8v __attribute__((ext_vector_type(8)));
__device__ __forceinline__ int crow(int r, int h) { return (r & 3) + 8 * (r >> 2) + 4 * h; }
#define GAS __attribute__((address_space(1)))
#define LAS __attribute__((address_space(3)))
typedef bf16 act;
__device__ __forceinline__ float ldact(const act* p) { return bf2f(*p); }
__device__ __forceinline__ void stact(act* p, float v) { *p = (bf16)f2bf(v); }
__device__ __forceinline__ void ldact8(const act* p, float (&o)[8]) { const u32x4 a = *(const u32x4*)p;
#pragma unroll
    for (int i = 0; i < 4; ++i) { o[2 * i] = __uint_as_float(a[i] << 16); o[2 * i + 1] = __uint_as_float(a[i] & 0xffff0000u); } }
#ifndef FP8_GU
#define FP8_GU 1
#endif
#ifndef FP8_DN
#define FP8_DN 1
#endif
#ifndef FP8_IN
#define FP8_IN 1
#endif
#ifndef FP8_Y
#define FP8_Y 1
#endif
#ifndef FP8_MOE
#define FP8_MOE 1
#endif
constexpr int NB = 2, S = 8192, T = NB * S, D = 1024, HD = 64;
constexpr int NHA = 8, NHB = 12, WA = 512, WB = 768, WBO = 256, NCOL = 5888;
constexpr int MBLK = 256, NBLK = S / MBLK;
constexpr int NE = 32, TOPK = 4, FF = 1024;
constexpr int A2ROWS = 73728;
constexpr int C_QA = 0, C_KA = 512, C_VA = 1024, C_QB = 1536, C_KB = 2304, C_VB = 3072, C_GA = 3840, C_GB = 4864;
constexpr float NORM_EPS = 1e-5f;

constexpr size_t MiB = 1u << 20;
constexpr size_t WS_CTL = 0;
constexpr size_t WS_WIN = 1 * MiB;
constexpr size_t WS_WOA = 13 * MiB;
constexpr size_t WS_WOB = 14 * MiB;
constexpr size_t WS_WOUT = 15 * MiB;
constexpr size_t WS_WGU = 17 * MiB;
constexpr size_t WS_WD = 145 * MiB;
constexpr size_t WS_ROPE = 209 * MiB;
constexpr size_t WS_KMEAN = WS_ROPE + 512 * 1024;
constexpr size_t WS_H = 210 * MiB;
constexpr size_t WS_QA = 242 * MiB, WS_KA = 258 * MiB, WS_VA = 274 * MiB;
constexpr size_t WS_QB = 290 * MiB, WS_KB = 314 * MiB, WS_VB = 338 * MiB;
constexpr size_t WS_SA = 362 * MiB, WS_SB = 394 * MiB;
constexpr size_t WS_PARTB = 210 * MiB;
constexpr size_t WS_LSEB = 234 * MiB;
constexpr size_t WS_LSEA = 235 * MiB;
constexpr size_t WS_SEL = 236 * MiB + 512 * 1024;
constexpr size_t WS_LIST = 426 * MiB;
constexpr size_t WS_PARTA = 442 * MiB;
constexpr int LIST_CAP = 8192;
constexpr size_t WS_OB = 434 * MiB;
constexpr size_t WS_OA = 490 * MiB;
constexpr size_t WS_MIX = 242 * MiB;
constexpr size_t WS_A2 = 242 * MiB;
constexpr size_t WS_ELIST = 386 * MiB;
constexpr size_t WS_EP = 388 * MiB;
constexpr size_t WS_ROWTOK = 390 * MiB;
constexpr size_t WS_ROWP = 391 * MiB;
constexpr size_t WS_TILEE = 392 * MiB;
constexpr size_t WS_Y = 17 * MiB;
constexpr size_t WS_END = 512 * MiB;
#ifndef TIMEB_LO
#define TIMEB_LO -1
#endif
#ifndef TIMEB_HI
#define TIMEB_HI -1
#endif
#ifndef TIMEB_GAIN
#define TIMEB_GAIN 1.0f
#endif
#ifndef DBG
#define DBG 0
#endif
#ifndef DBG_SUB
#define DBG_SUB 0
#endif
#ifndef DBG_GAIN
#define DBG_GAIN 100.0f
#endif
constexpr int CW_DNUM = 192, CW_DDEN = 193;
constexpr int CW_ECNT = 8192;
constexpr int CW_BAR = 4096;
constexpr int CW_LCNT = 12288;
constexpr int CW_HQ = 224;
constexpr int CW_NMT = 160;

struct Params {
    const float *x, *ln_mix_g, *w_in, *b_gate_a, *b_gate_b, *w_o_a, *w_o_b, *w_out, *ln_ffn_g, *w_router, *b_router,
        *w_gate, *b_gate, *w_up, *b_up, *w_down, *b_down, *ln_final_g;
    float* out; unsigned char* ws;
    float inv_freq[8];
    int use_cg, pad0;
};

template <int MAP> __device__ __forceinline__ int rowmap(int n) { return MAP == 0 ? n : (32 * (n >> 4) + (n & 15) + (MAP == 2 ? 16 : 0)); }
template <int MAP> __device__ __forceinline__ void transpose_item(const float* W, int K, int N, bf16* WT, float* scr, int item, int lane) {
    const int nblk = N / 64, kb = item / nblk, nb = item % nblk, k0 = 64 * kb, n0 = 64 * nb;
    f32x4 v[16];
#pragma unroll
    for (int i = 0; i < 16; ++i) v[i] = *(const f32x4*)(W + (size_t)(k0 + (lane >> 4) + 4 * i) * N + n0 + 4 * (lane & 15));
#pragma unroll
    for (int i = 0; i < 16; ++i) { float* d = scr + ((lane >> 4) + 4 * i) * 65 + 4 * (lane & 15); d[0] = v[i].x; d[1] = v[i].y; d[2] = v[i].z; d[3] = v[i].w; }
    asm volatile("s_waitcnt lgkmcnt(0)" ::: "memory");
    const int c = lane & 7;
#pragma unroll
    for (int j = 0; j < 8; ++j) { const int n = (lane >> 3) + 8 * j; const float* q = scr + (8 * c) * 65 + n;
        u32x4 o; o.x = cvtpk(q[0 * 65], q[1 * 65]); o.y = cvtpk(q[2 * 65], q[3 * 65]); o.z = cvtpk(q[4 * 65], q[5 * 65]); o.w = cvtpk(q[6 * 65], q[7 * 65]);
        *(u32x4*)(WT + (size_t)rowmap<MAP>(n0 + n) * K + k0 + 8 * c) = o; }
    asm volatile("s_waitcnt lgkmcnt(0)" ::: "memory");
}
__device__ __forceinline__ float wave_sum(float v) {
#pragma unroll
    for (int o = 1; o < 64; o <<= 1) v += __shfl_xor(v, o);
    return v;
}
__device__ __forceinline__ void sincos_acc(float ang, float& c, float& s) {
    const double a = (double)ang; const double k = rint(a * 0.63661977236758134308); const double y = a - k * 1.57079632679489661923; const double y2 = y * y;
    const double sn = y * (1.0 + y2 * (-1.0 / 6 + y2 * (1.0 / 120 + y2 * (-1.0 / 5040 + y2 * (1.0 / 362880 + y2 * (-1.0 / 39916800))))));
    const double cs = 1.0 + y2 * (-0.5 + y2 * (1.0 / 24 + y2 * (-1.0 / 720 + y2 * (1.0 / 40320 + y2 * (-1.0 / 3628800 + y2 * (1.0 / 479001600))))));
    const int q = ((int)k) & 3;
    const double ss = (q == 0) ? sn : (q == 1) ? cs : (q == 2) ? -sn : -cs;
    const double cc = (q == 0) ? cs : (q == 1) ? -sn : (q == 2) ? -cs : sn;
    c = (float)cc; s = (float)ss;
}
struct TItem { const float* W; bf16* WT; int K, N, map, k0, n0, f8, kd; };
__device__ __forceinline__ TItem titem_decode(const Params& p, int it) {
    constexpr int I_OA = (WA / 64) * (D / 32), I_OB = (WBO / 64) * (D / 32), I_OUT = (D / 64) * (D / 32), I_E = (D / 64) * (FF / 32);
    static_assert(I_E == 512 && D == 1024 && FF == 1024, "the expert-matrix decode below uses shifts");
    unsigned char* ws = p.ws; TItem t; int r = it; t.f8 = 0; t.kd = 0; t.N = D; t.map = 0;
    if (r >= I_OA + I_OB + I_OUT) {
        r -= I_OA + I_OB + I_OUT; const int which = r >> 14  , e = (r >> 9) & 31; r &= 511; t.K = D;
        t.f8 = (which == 2) ? (FP8_DN ? 1 : 0) : (FP8_GU ? 1 : 0); const size_t esz = t.f8 ? 1 : 2;
        if (which == 0) { t.W = p.w_gate + (size_t)e * D * FF; t.WT = (bf16*)(ws + WS_WGU + (size_t)e * 2 * FF * D * esz); t.map = 1; }
        else if (which == 1) { t.W = p.w_up + (size_t)e * D * FF; t.WT = (bf16*)(ws + WS_WGU + (size_t)e * 2 * FF * D * esz); t.map = 2; }
        else { t.W = p.w_down + (size_t)e * FF * D; t.WT = (bf16*)(ws + WS_WD + (size_t)e * D * FF * esz); }
    }
    else if (r < I_OA) { t.W = p.w_o_a; t.WT = (bf16*)(ws + WS_WOA); t.K = WA + WBO; }
    else if ((r -= I_OA) < I_OB) { t.W = p.w_o_b; t.WT = (bf16*)(ws + WS_WOA); t.K = WA + WBO; t.kd = WA; }
    else { r -= I_OB; t.W = p.w_out; t.WT = (bf16*)(ws + WS_WOUT); t.K = D; }
    const int pr_ = r >> 1; t.k0 = 64 * (2 * (pr_ >> 5) + (r & 1)); t.n0 = 32 * (pr_ & 31);
    return t;
}
__device__ __forceinline__ void titem_load(const TItem& t, f32x4 (&v)[8], int lane) {
#pragma unroll
    for (int i = 0; i < 8; ++i) v[i] = __builtin_nontemporal_load((const f32x4*)(t.W + (size_t)(t.k0 + (lane >> 3) + 8 * i) * t.N + t.n0 + 4 * (lane & 7)));
}
__device__ __forceinline__ void titem_store(const TItem& t, const f32x4 (&v)[8], float* scr, int lane) {
#pragma unroll
    for (int i = 0; i < 8; ++i) { float* d = scr + ((lane >> 3) + 8 * i) * 33 + 4 * (lane & 7); d[0] = v[i].x; d[1] = v[i].y; d[2] = v[i].z; d[3] = v[i].w; }
    asm volatile("s_waitcnt lgkmcnt(0)" ::: "memory");
    const int c = (lane & 3) + 4 * (lane >> 5);
#pragma unroll
    for (int j = 0; j < 4; ++j) { const int n = ((lane >> 2) & 7) + 8 * j; const float* q = scr + (8 * c) * 33 + n; const int nn = t.n0 + n;
        const int row = t.map == 0 ? nn : (32 * (nn >> 4) + (nn & 15) + (t.map == 2 ? 16 : 0));
        if (t.f8) { int w0 = __builtin_amdgcn_cvt_pk_fp8_f32(q[0 * 33] * 64.f, q[1 * 33] * 64.f, 0, false); w0 = __builtin_amdgcn_cvt_pk_fp8_f32(q[2 * 33] * 64.f, q[3 * 33] * 64.f, w0, true);
            int w1 = __builtin_amdgcn_cvt_pk_fp8_f32(q[4 * 33] * 64.f, q[5 * 33] * 64.f, 0, false); w1 = __builtin_amdgcn_cvt_pk_fp8_f32(q[6 * 33] * 64.f, q[7 * 33] * 64.f, w1, true);
            u32x2 o; o.x = (unsigned)w0; o.y = (unsigned)w1; *(u32x2*)((unsigned char*)t.WT + (size_t)row * t.K + t.kd + t.k0 + 8 * c) = o; }
        else { u32x4 o; o.x = cvtpk(q[0 * 33], q[1 * 33]); o.y = cvtpk(q[2 * 33], q[3 * 33]); o.z = cvtpk(q[4 * 33], q[5 * 33]); o.w = cvtpk(q[6 * 33], q[7 * 33]);
            *(u32x4*)(t.WT + (size_t)row * t.K + t.kd + t.k0 + 8 * c) = o; } }
    asm volatile("s_waitcnt lgkmcnt(0)" ::: "memory");
}
__device__ __forceinline__ void phase_prep_a(const Params& p, int bid, int nb, unsigned char* lds) {
    int tid = threadIdx.x; asm volatile("" : "+v"(tid)); const int lane = tid & 63, wave = tid >> 6;
    const int gw = bid * 8 + wave, NGW = nb * 8;
    unsigned char* ws = p.ws;
    float* scr = (float*)lds + wave * (64 * 33);
    constexpr int I_IN = (D / 64) * (NCOL / 32);
    for (int it = gw; it < I_IN; it += NGW) {
        TItem t; t.W = p.w_in; t.WT = (bf16*)(ws + WS_WIN); t.K = D; t.N = NCOL; t.map = 0; t.f8 = FP8_IN; t.kd = 0; t.k0 = 64 * (it / (NCOL / 32)); t.n0 = 32 * (it % (NCOL / 32));
        f32x4 v[8]; titem_load(t, v, lane); titem_store(t, v, scr, lane);
    }
    for (int m = gw; m < T; m += NGW) {
        const f32x4* xr = (const f32x4*)(p.x + (size_t)m * D) + lane; const f32x4* gr = (const f32x4*)p.ln_mix_g + lane;
        f32x4 v[4]; float s = 0.f;
#pragma unroll
        for (int j = 0; j < 4; ++j) { v[j] = xr[64 * j]; s += (v[j].x * v[j].x + v[j].y * v[j].y) + (v[j].z * v[j].z + v[j].w * v[j].w); }
        const float rstd = 1.0f / sqrtf(wave_sum(s) * (1.0f / D) + NORM_EPS);
#pragma unroll
        for (int j = 0; j < 4; ++j) { const f32x4 g = gr[64 * j];
#if FP8_IN
            int o = __builtin_amdgcn_cvt_pk_fp8_f32(v[j].x * rstd * g.x, v[j].y * rstd * g.y, 0, false); o = __builtin_amdgcn_cvt_pk_fp8_f32(v[j].z * rstd * g.z, v[j].w * rstd * g.w, o, true);
            ((int*)((unsigned char*)(ws + WS_H) + (size_t)m * D))[lane + 64 * j] = o;
#else
            u32x2 o; o.x = cvtpk(v[j].x * rstd * g.x, v[j].y * rstd * g.y); o.y = cvtpk(v[j].z * rstd * g.z, v[j].w * rstd * g.w); ((u32x2*)((bf16*)(ws + WS_H) + (size_t)m * D))[lane + 64 * j] = o;
#endif
        }
    }
    float2* rope = (float2*)(ws + WS_ROPE);
    for (int i = bid * 512 + tid; i < S * 8; i += nb * 512) { const int s = i >> 3, f = i & 7; const float ang = (float)s * p.inv_freq[f]; float c, sn; sincos_acc(ang, c, sn); rope[i] = make_float2(c, sn); }
    for (int i = bid * 512 + tid; i < NB * NHA * NBLK * HD; i += nb * 512) ((float*)(ws + WS_KMEAN))[i] = 0.f;
}
__device__ __forceinline__ void phase_prep_b(const Params& p, unsigned char* lds) {
    int tid = threadIdx.x; asm volatile("" : "+v"(tid)); const int lane = tid & 63, wave = tid >> 6;
    float* scr = (float*)lds + wave * (64 * 33);
    constexpr int NITEMS = (WA / 64) * (D / 32) + (WBO / 64) * (D / 32) + (D / 64) * (D / 32) + 3 * NE * (D / 64) * (FF / 32);
    int* ctr = (int*)(p.ws + WS_CTL) + CW_HQ;
    int qcur = 0, qend = 0; bool qdone = false;
#define TQ_NEXT(dst) do { if (qcur == qend && !qdone) { int b_ = 0; if (lane == 0) b_ = atomicAdd(ctr, 8); b_ = __builtin_amdgcn_readfirstlane(b_); \
        if (b_ >= NITEMS) qdone = true; else { qcur = b_; qend = (b_ + 8 < NITEMS) ? b_ + 8 : NITEMS; } } \
        if (qcur < qend) dst = qcur++; else dst = -1; } while (0)
    TItem ta, tb, tc; f32x4 va[8], vb[8], vc[8];
    int ia, ib, ic;
    TQ_NEXT(ia); if (ia >= 0) { ta = titem_decode(p, ia); titem_load(ta, va, lane); }
    TQ_NEXT(ib); if (ib >= 0) { tb = titem_decode(p, ib); titem_load(tb, vb, lane); }
    while (ia >= 0) {
        TQ_NEXT(ic); if (ic >= 0) { tc = titem_decode(p, ic); titem_load(tc, vc, lane); }
        titem_store(ta, va, scr, lane);
        if (ib < 0) break;
        TQ_NEXT(ia); if (ia >= 0) { ta = titem_decode(p, ia); titem_load(ta, va, lane); }
        titem_store(tb, vb, scr, lane);
        if (ic < 0) break;
        TQ_NEXT(ib); if (ib >= 0) { tb = titem_decode(p, ib); titem_load(tb, vb, lane); }
        titem_store(tc, vc, scr, lane);
    }
#undef TQ_NEXT
}

__device__ __forceinline__ int cl(int tx, int j) { return (tx & 7) + 8 * j + 32 * (tx >> 3); }
template <class F> __device__ __forceinline__ void phase_naive_gemm(const F& f, int M, int N, int bid, int nb, unsigned char* lds) {
    const int half = threadIdx.x >> 8, tid = threadIdx.x & 255, tx = tid & 15, ty = tid >> 4;
    float (*As)[33] = (float (*)[33])(lds + half * (2 * 64 * 33 * 4)); float (*Bs)[33] = As + 64;
    const int nN = N / 64, ntiles = (M / 64) * nN, stride = nb * 2;
    const int nround = (ntiles + stride - 1) / stride;
    const int lr = tid >> 2, lk = (tid & 3) * 8;
    for (int r = 0; r < nround; ++r) {
        const int it = r * stride + bid * 2 + half;
        const bool valid = it < ntiles;
        const int m0 = valid ? (it / nN) * 64 : 0, n0 = valid ? (it % nN) * 64 : 0;
        const bool act_ = valid && f.active(m0);
        float acc[F::NPASS][4][4];
#pragma unroll
        for (int ps = 0; ps < F::NPASS; ++ps)
#pragma unroll
            for (int i = 0; i < 4; ++i)
#pragma unroll
                for (int j = 0; j < 4; ++j) acc[ps][i][j] = 0.f;
#pragma unroll
        for (int ps = 0; ps < F::NPASS; ++ps) {
            const int K = f.K(ps);
            const bf16* ap = act_ ? f.arow(ps, m0 + lr) : nullptr; const bf16* bp = act_ ? f.brow(ps, m0, n0 + lr) : nullptr;
            for (int k0 = 0; k0 < K; k0 += 32) {
                float av[8], bv[8];
                if (act_) { ldact8(ap + k0 + lk, av); ldact8(bp + k0 + lk, bv); }
                else {
#pragma unroll
                    for (int i = 0; i < 8; ++i) { av[i] = 0.f; bv[i] = 0.f; } }
                __syncthreads();
#pragma unroll
                for (int i = 0; i < 8; ++i) { As[lr][lk + i] = av[i]; Bs[lr][lk + i] = bv[i]; }
                __syncthreads();
#pragma unroll 8
                for (int kk = 0; kk < 32; ++kk) {
                    float a[4], b[4];
#pragma unroll
                    for (int i = 0; i < 4; ++i) { a[i] = As[ty * 4 + i][kk]; b[i] = Bs[cl(tx, i)][kk]; }
#pragma unroll
                    for (int i = 0; i < 4; ++i)
#pragma unroll
                        for (int j = 0; j < 4; ++j) acc[ps][i][j] += a[i] * b[j];
                }
            }
        }
        if (act_) {
#pragma unroll
            for (int i = 0; i < 4; ++i) f.epi(m0 + ty * 4 + i, n0, tx, acc[0][i], acc[F::NPASS - 1][i]);
        }
    }
}

struct InProjN {
    static constexpr int NPASS = 1; Params p; bool alt;
    __device__ __forceinline__ bool active(int) const { return true; }
    __device__ __forceinline__ int K(int) const { return D; }
    __device__ __forceinline__ int ldb(int) const { return NCOL; }
    __device__ __forceinline__ const act* arow(int, int m) const { return (const act*)(p.ws + WS_H) + (size_t)m * D; }
    __device__ __forceinline__ const bf16* brow(int, int, int n) const { return (const bf16*)(p.ws + WS_WIN) + (size_t)n * D; }
    __device__ __forceinline__ void epi(int m, int n0, int tx, float (&v)[4], float (&)[4]) const {
        unsigned char* ws = p.ws;
        act* dst; int ld, cb; bool rope = false; const float* gbias = nullptr;
        if (n0 < C_KA) { dst = (act*)(ws + (alt ? 426 * MiB : WS_QA)); ld = WA; cb = n0 - C_QA; rope = true; }
        else if (n0 < C_VA) { dst = (act*)(ws + (alt ? 442 * MiB : WS_KA)); ld = WA; cb = n0 - C_KA; rope = true; }
        else if (n0 < C_QB) { if (alt) return; dst = (act*)(ws + WS_VA); ld = WA; cb = n0 - C_VA; }
        else if (n0 < C_KB) { dst = (act*)(ws + (alt ? 458 * MiB : WS_QB)); ld = WB; cb = n0 - C_QB; rope = true; }
        else if (n0 < C_VB) { dst = (act*)(ws + (alt ? 482 * MiB : WS_KB)); ld = WB; cb = n0 - C_KB; rope = true; }
        else if (alt) { return; }
        else if (n0 < C_GA) { dst = (act*)(ws + WS_VB); ld = WB; cb = n0 - C_VB; }
        else if (n0 < C_GB) { dst = (act*)(ws + WS_SA); ld = D; cb = n0 - C_GA; gbias = p.b_gate_a; }
        else { dst = (act*)(ws + WS_SB); ld = D; cb = n0 - C_GB; gbias = p.b_gate_b; }
        if (rope && (tx >> 3) == 0) {
            const float2 cs = ((const float2*)(ws + WS_ROPE))[(m % S) * 8 + (tx & 7)];
            const float x1 = v[0], x2 = v[1]; v[0] = x1 * cs.x - x2 * cs.y; v[1] = x2 * cs.x + x1 * cs.y;
        }
#pragma unroll
        for (int j = 0; j < 4; ++j) { const int c = cb + cl(tx, j); float o = v[j];
            if (gbias) { o = 1.0f / (1.0f + expf(-(o + gbias[c]))); }
            stact(dst + (size_t)m * ld + c, o); }
    }
};
struct MixN {
    static constexpr int NPASS = 2; Params p;
    __device__ __forceinline__ bool active(int) const { return true; }
    __device__ __forceinline__ int K(int ps) const { return ps == 0 ? WA : WBO; }
    __device__ __forceinline__ int ldb(int) const { return D; }
    __device__ __forceinline__ const act* arow(int ps, int m) const { return ps == 0 ? (const act*)(p.ws + WS_OA) + (size_t)m * WA : (const act*)(p.ws + WS_OB) + (size_t)m * WBO; }
    __device__ __forceinline__ const bf16* brow(int ps, int, int n) const { return ps == 0 ? (const bf16*)(p.ws + WS_WOA) + (size_t)n * WA : (const bf16*)(p.ws + WS_WOB) + (size_t)n * WBO; }
    __device__ __forceinline__ void epi(int m, int n0, int tx, float (&a)[4], float (&b)[4]) const {
#pragma unroll
        for (int j = 0; j < 4; ++j) { const int c = n0 + cl(tx, j); const size_t o = (size_t)m * D + c;
            const float sa = ldact((const act*)(p.ws + WS_SA) + o), sb = ldact((const act*)(p.ws + WS_SB) + o);
            stact((act*)(p.ws + WS_MIX) + o, sa * a[j] + sb * b[j]); }
    }
};
struct OutN {
    static constexpr int NPASS = 1; Params p;
    __device__ __forceinline__ bool active(int) const { return true; }
    __device__ __forceinline__ int K(int) const { return D; }
    __device__ __forceinline__ int ldb(int) const { return D; }
    __device__ __forceinline__ const act* arow(int, int m) const { return (const act*)(p.ws + WS_MIX) + (size_t)m * D; }
    __device__ __forceinline__ const bf16* brow(int, int, int n) const { return (const bf16*)(p.ws + WS_WOUT) + (size_t)n * D; }
    __device__ __forceinline__ void epi(int m, int n0, int tx, float (&a)[4], float (&)[4]) const {
#pragma unroll
        for (int j = 0; j < 4; ++j) { const size_t o = (size_t)m * D + n0 + cl(tx, j); p.out[o] = p.x[o] + a[j]; }
    }
};


namespace pg8 {
#define PG8_LAS __attribute__((address_space(3)))
typedef short bf16x8 __attribute__((ext_vector_type(8)));
typedef int v4i_t __attribute__((ext_vector_type(4)));
typedef int v8i_t __attribute__((ext_vector_type(8)));
constexpr int BM = 256, BK = 64, HALF = 128, HTB = HALF * BK * 2  , STAGE_BYTES = 8 * HTB, NXCD = 8, WGM = 8;
__device__ __forceinline__ int lds_byte(int r, int c) { const int st = (r >> 4) * 2 + (c >> 5), rr = r & 15, cc = c & 31, ob = rr * 64 + cc * 2; return st * 1024 + (ob ^ (((ob >> 9) & 1) << 5)); }
__device__ __forceinline__ void stage_rc(int b, int& R, int& C) { const int st = b / 1024, sb = b % 1024, swz = sb ^ (((sb >> 9) & 1) << 5); R = (st >> 1) * 16 + swz / 64; C = (st & 1) * 32 + (swz % 64) / 2; }
__device__ __forceinline__ int perm32(int rho) { const int n = rho >> 4, i = rho & 15; return 8 * (i >> 2) + 4 * n + (i & 3); }
struct Unit { int pm, pn, slot; };
struct Order {
    int nM, nN, nwg, G, c;
    __device__ __forceinline__ void init(int nM_, int nN_, int G_, int c_) { nM = nM_; nN = nN_; nwg = nM * nN; G = G_; c = c_; }
    __device__ __forceinline__ bool next(int i, Unit& u) const {
        const long L = (long)i * G + c; if (L >= nwg) return false;
        int wgid = (int)L; { const int q = nwg / NXCD, r = nwg % NXCD, xcd = wgid % NXCD, off = wgid / NXCD; wgid = (xcd < r ? xcd * (q + 1) : r * (q + 1) + (xcd - r) * q) + off; }
        const int nig = WGM * nN, gid = wgid / nig, fm = gid * WGM, gsz = (nM - fm) < WGM ? (nM - fm) : WGM;
        u.pm = fm + ((wgid % nig) % gsz); u.pn = (wgid % nig) / gsz; u.slot = i; return true;
    }
};
template <class Epi, class Prob, bool ALIGN_EPI>
__device__ __forceinline__ void gemm_phase(PG8_LAS unsigned char* lds, const Prob& P, const Order& S, const Epi& E) {
    int tid = threadIdx.x; asm volatile("" : "+v"(tid)); const int wid = __builtin_amdgcn_readfirstlane(tid >> 6), lane = tid & 63, wr = wid >> 2, wc = wid & 3, fr = lane & 15, fq = lane >> 4;
    constexpr bool GATHER = Prob::GATHER; constexpr bool FP8 = Prob::FP8;
    const int K = P.K, nt = K / BK;
    unsigned voffA[2], voffB[2];
#pragma unroll
    for (int i = 0; i < 2; ++i) { int R, C; stage_rc(tid * 16 + i * 8192, R, C); const int Rb = Epi::PERM ? ((R & ~31) + perm32(R & 31)) : R; voffA[i] = (unsigned)(R * K + C) * 2u; voffB[i] = (unsigned)(Rb * K + C) * 2u; }
    const size_t kstep = (size_t)(BK * 2);
    const size_t hstep = (size_t)HALF * K * 2;
    const unsigned ldsw = (unsigned)wid * 1024u;
    const int aoff = lds_byte(wr * 64 + fr, fq * 8), boff = lds_byte(wc * 32 + fr, fq * 8);
    const char* const Ab = (const char*)P.abase();
#define PG8_SA(b, h) (((b) * 2 + (h)) * HTB)
#define PG8_SB(b, h) ((4 + (b) * 2 + (h)) * HTB)
#define PG8_GLDS(src, bufoff, i) __builtin_amdgcn_global_load_lds((const unsigned*)(src), (PG8_LAS unsigned*)(lds + (bufoff) + ldsw + (i) * 8192), 16, 0, 0)
#define PG8_STAGE_B(bufoff, gbase) do { PG8_GLDS((const char*)(gbase) + voffB[0], bufoff, 0); PG8_GLDS((const char*)(gbase) + voffB[1], bufoff, 1); } while (0)
#define PG8_STAGE_A(bufoff, h, kb) do { if constexpr (GATHER) { PG8_GLDS(Ab + (size_t)g[h][0] + (kb), bufoff, 0); PG8_GLDS(Ab + (size_t)g[h][1] + (kb), bufoff, 1); } \
        else { PG8_GLDS(cA + (h) * hstep + (kb) + voffA[0], bufoff, 0); PG8_GLDS(cA + (h) * hstep + (kb) + voffA[1], bufoff, 1); } } while (0)
#define PG8_CAT(x0, x1) __builtin_shufflevector(x0, x1, 0, 1, 2, 3, 4, 5, 6, 7)
#define PG8_LO(x) __builtin_bit_cast(bf16x8, __builtin_shufflevector(x, x, 0, 1, 2, 3))
#define PG8_HI(x) __builtin_bit_cast(bf16x8, __builtin_shufflevector(x, x, 4, 5, 6, 7))
#define PG8_LDA(dst, b, h) do { _Pragma("unroll") for (int m = 0; m < 4; ++m) dst[m] = PG8_CAT(*(const PG8_LAS v4i_t*)(lds + PG8_SA(b, h) + aoff + m * 2048), *(const PG8_LAS v4i_t*)(lds + PG8_SA(b, h) + aoff + m * 2048 + 1024)); } while (0)
#define PG8_LDB(dst, b, h) do { _Pragma("unroll") for (int n = 0; n < 2; ++n) dst[n] = PG8_CAT(*(const PG8_LAS v4i_t*)(lds + PG8_SB(b, h) + boff + n * 2048), *(const PG8_LAS v4i_t*)(lds + PG8_SB(b, h) + boff + n * 2048 + 1024)); } while (0)
#define PG8_MMA(ai, bj, At, Bt) do { __builtin_amdgcn_s_setprio(1); _Pragma("unroll") for (int m = 0; m < 4; ++m) _Pragma("unroll") for (int n = 0; n < 2; ++n) { \
        if constexpr (FP8) acc[ai][bj][m][n] = __builtin_amdgcn_mfma_scale_f32_16x16x128_f8f6f4(Bt[n], At[m], acc[ai][bj][m][n], 0, 0, 0, 0x79797979, 0, 0x7f7f7f7f); \
        else { acc[ai][bj][m][n] = __builtin_amdgcn_mfma_f32_16x16x32_bf16(PG8_LO(Bt[n]), PG8_LO(At[m]), acc[ai][bj][m][n], 0, 0, 0); \
               acc[ai][bj][m][n] = __builtin_amdgcn_mfma_f32_16x16x32_bf16(PG8_HI(Bt[n]), PG8_HI(At[m]), acc[ai][bj][m][n], 0, 0, 0); } } \
        __builtin_amdgcn_s_setprio(0); } while (0)
#define PG8_WAIT_V(n) asm volatile("s_waitcnt vmcnt(" #n ")" ::: "memory")
#define PG8_WAIT_L(n) asm volatile("s_waitcnt lgkmcnt(" #n ")" ::: "memory")
#define PG8_BAR __builtin_amdgcn_s_barrier()
#define PG8_SCHED __builtin_amdgcn_sched_barrier(0)
    Unit cur, nxt; int ui = 0;
    if (!S.next(0, cur)) return;
    f32x4 acc[2][2][4][2];
#pragma unroll
    for (int a = 0; a < 2; ++a)
#pragma unroll
        for (int b = 0; b < 2; ++b)
#pragma unroll
            for (int m = 0; m < 4; ++m)
#pragma unroll
                for (int n = 0; n < 2; ++n) acc[a][b][m][n] = (f32x4){0.f, 0.f, 0.f, 0.f};
    v8i_t At[4], B0[2], B1[2];
    unsigned g[2][2], gn[2][2];
    const char* cA = Ab; const char* nA = Ab;
    if constexpr (GATHER) {
#pragma unroll
        for (int h = 0; h < 2; ++h)
#pragma unroll
            for (int i = 0; i < 2; ++i) { g[h][i] = P.goff(cur, h, voffA[i]); gn[h][i] = g[h][i]; }
    } else { cA = Ab + P.aoff(cur); nA = cA; }
    const char* cB = (const char*)P.bbase(cur);
    PG8_STAGE_B(PG8_SB(0, 0), cB); PG8_STAGE_B(PG8_SB(0, 1), cB + hstep); PG8_STAGE_A(PG8_SA(0, 0), 0, 0); PG8_STAGE_A(PG8_SA(0, 1), 1, 0);
    if (wr == 1) PG8_BAR;
    PG8_WAIT_V(2); PG8_BAR;
    PG8_STAGE_B(PG8_SB(1, 0), cB + kstep); PG8_STAGE_A(PG8_SA(1, 0), 0, kstep); PG8_STAGE_B(PG8_SB(1, 1), cB + hstep + kstep);
    PG8_WAIT_V(6); PG8_BAR;
    for (;;) {
        const bool has_next = S.next(ui + 1, nxt);
        const char* nB = cB;
        if (has_next) { nB = (const char*)P.bbase(nxt);
            if constexpr (GATHER) {
#pragma unroll
                for (int h = 0; h < 2; ++h)
#pragma unroll
                    for (int i = 0; i < 2; ++i) gn[h][i] = P.goff(nxt, h, voffA[i]);
            } else nA = Ab + P.aoff(nxt); }
        for (int t = 0; t < nt; t += 2) {
            const bool last = (t == nt - 2);
            const size_t k1 = (size_t)(t + 1) * kstep;
            const size_t k2 = last ? 0 : (size_t)(t + 2) * kstep, k3 = k2 + kstep;
            if constexpr (Epi::MID_T > 0) { if (t == Epi::MID_T) E.mid(acc, cur, wr, wc, fr, fq); }
            PG8_LDB(B0, 0, 0); PG8_LDB(B1, 0, 1); PG8_SCHED; PG8_LDA(At, 0, 0); PG8_STAGE_A(PG8_SA(1, 1), 1, k1);
            if (last) { cB = nB; if constexpr (GATHER) { g[0][0] = gn[0][0]; g[0][1] = gn[0][1]; g[1][0] = gn[1][0]; g[1][1] = gn[1][1]; } else cA = nA; }
            PG8_WAIT_V(8); PG8_WAIT_L(0); PG8_BAR; PG8_MMA(0, 0, At, B0); PG8_MMA(0, 1, At, B1); PG8_BAR; PG8_SCHED;
            PG8_LDA(At, 0, 1); PG8_STAGE_B(PG8_SB(0, 0), cB + k2); PG8_STAGE_B(PG8_SB(0, 1), cB + k2 + hstep); PG8_STAGE_A(PG8_SA(0, 0), 0, k2);
            PG8_WAIT_V(8); PG8_WAIT_L(0); PG8_BAR; PG8_MMA(1, 0, At, B0); PG8_MMA(1, 1, At, B1); PG8_BAR; PG8_SCHED;
            PG8_LDB(B0, 1, 0); PG8_LDB(B1, 1, 1); PG8_SCHED; PG8_LDA(At, 1, 0); PG8_STAGE_A(PG8_SA(0, 1), 1, k2);
            PG8_WAIT_V(8); PG8_WAIT_L(0); PG8_BAR; PG8_MMA(0, 0, At, B0); PG8_MMA(0, 1, At, B1); PG8_BAR; PG8_SCHED;
            PG8_LDA(At, 1, 1); PG8_STAGE_B(PG8_SB(1, 0), cB + k3); PG8_STAGE_B(PG8_SB(1, 1), cB + k3 + hstep); PG8_STAGE_A(PG8_SA(1, 0), 0, k3);
            PG8_WAIT_V(8); PG8_WAIT_L(0); PG8_BAR; PG8_MMA(1, 0, At, B0); PG8_MMA(1, 1, At, B1); PG8_BAR; PG8_SCHED;
        }
        if constexpr (ALIGN_EPI) { if (wr == 0) PG8_BAR; }
        E(acc, cur, wr, wc, fr, fq);
        if (!has_next) break;
#pragma unroll
        for (int a = 0; a < 2; ++a)
#pragma unroll
            for (int b = 0; b < 2; ++b)
#pragma unroll
                for (int m = 0; m < 4; ++m)
#pragma unroll
                    for (int n = 0; n < 2; ++n) acc[a][b][m][n] = (f32x4){0.f, 0.f, 0.f, 0.f};
        cur = nxt; ++ui;
        if constexpr (ALIGN_EPI) { if (wr == 1) PG8_BAR; }
    }
    PG8_WAIT_V(0);
    if constexpr (!ALIGN_EPI) { if (wr == 0) PG8_BAR; }
    PG8_BAR;
#undef PG8_SA
#undef PG8_SB
#undef PG8_GLDS
#undef PG8_STAGE_A
#undef PG8_STAGE_B
#undef PG8_LDA
#undef PG8_LDB
#undef PG8_MMA
#undef PG8_CAT
#undef PG8_LO
#undef PG8_HI
#undef PG8_WAIT_V
#undef PG8_WAIT_L
#undef PG8_BAR
#undef PG8_SCHED
}
}


constexpr int MT_OFF = 131072;
struct MoeTab { const LAS int* e_of; const LAS int* rt; const LAS float* rp; };
template <bool WITH_P> __device__ __forceinline__ int moe_tables(const Params& p, unsigned char* lds, int tid, int nN, int nb, int bid, MoeTab& mt) {
    LAS int* cnt = (LAS int*)(lds + MT_OFF); LAS int* pstart = cnt + 32; LAS int* e_of = cnt + 72; constexpr int MAXU = WITH_P ? 5 : 9;
    LAS int* rt = cnt + 112; LAS float* rp = (LAS float*)(rt + MAXU * 256);
    __syncthreads();
    if (tid < NE) cnt[tid] = __hip_atomic_load((const int*)(p.ws + WS_CTL) + CW_ECNT + 64 * tid, __ATOMIC_RELAXED, __HIP_MEMORY_SCOPE_AGENT);
    __syncthreads();
    if (tid == 0) { int st = 0; for (int e = 0; e < NE; ++e) { pstart[e] = st; st += (cnt[e] + 255) & ~255; } pstart[32] = st; }
    __syncthreads();
    const int n_mt = __builtin_amdgcn_readfirstlane(pstart[32] >> 8);
    pg8::Order O; O.init(n_mt, nN, nb, bid);
    LAS int* pm_of = cnt + 88;
    if (tid < MAXU) { pg8::Unit u; int e = 0, pm = -1;
        if (O.next(tid, u)) { pm = u.pm; for (int q = 1; q < NE; ++q) if (pm * 256 >= pstart[q]) e = q; }
        e_of[tid] = e; pm_of[tid] = pm; }
    __syncthreads();
    for (int idx = tid; idx < MAXU * 256; idx += 512) { const int i = idx >> 8, r = idx & 255, pm = pm_of[i];
        if (pm >= 0) { const int e = e_of[i]; const int pos = pm * 256 + r - pstart[e]; const bool ok = pos < cnt[e];
            rt[idx] = ok ? ((const int*)(p.ws + WS_ELIST))[e * T + pos] : -1;
            if (WITH_P) rp[idx] = ok ? ((const float*)(p.ws + WS_EP))[e * T + pos] : 0.f; } }
    __syncthreads();
    mt.e_of = e_of; mt.rt = rt; mt.rp = rp;
    return n_mt;
}
struct ProbPlain {
    static constexpr bool GATHER = false, FP8 = false;
    const bf16* A; const bf16* Bt; int K;
    __device__ __forceinline__ const bf16* abase() const { return A; }
    __device__ __forceinline__ size_t aoff(const pg8::Unit& u) const { return (size_t)u.pm * 256 * K * 2; }
    __device__ __forceinline__ unsigned goff(const pg8::Unit&, int, unsigned) const { return 0u; }
    __device__ __forceinline__ const bf16* bbase(const pg8::Unit& u) const { return Bt + (size_t)u.pn * 256 * K; }
};
struct ProbPlainOff {
    static constexpr bool GATHER = true, FP8 = false;
    const bf16* A; const bf16* Bt; int K;
    __device__ __forceinline__ const bf16* abase() const { return A; }
    __device__ __forceinline__ size_t aoff(const pg8::Unit& u) const { return (size_t)u.pm * 256 * K * 2; }
    __device__ __forceinline__ unsigned goff(const pg8::Unit& u, int h, unsigned voff) const { return (unsigned)(u.pm * 256 + h * 128) * ((unsigned)K * 2u) + voff; }
    __device__ __forceinline__ const bf16* bbase(const pg8::Unit& u) const { return Bt + (size_t)u.pn * 256 * K; }
};
struct ProbPlainF8 {
    static constexpr bool GATHER = true, FP8 = true;
    const bf16* A; const bf16* Bt; int K;
    __device__ __forceinline__ const bf16* abase() const { return A; }
    __device__ __forceinline__ size_t aoff(const pg8::Unit& u) const { return (size_t)u.pm * 256 * K * 2; }
    __device__ __forceinline__ unsigned goff(const pg8::Unit& u, int h, unsigned voff) const { return (unsigned)(u.pm * 256 + h * 128) * ((unsigned)K * 2u) + voff; }
    __device__ __forceinline__ const bf16* bbase(const pg8::Unit& u) const { return Bt + (size_t)u.pn * 256 * K; }
};
template <bool G, bool F8> struct ProbMoE {
    static constexpr bool GATHER = true, FP8 = F8;
    const bf16* A; const bf16* Bt; int K; MoeTab mt; int rows_e;
    __device__ __forceinline__ const bf16* abase() const { return A; }
    __device__ __forceinline__ size_t aoff(const pg8::Unit& u) const { return (size_t)u.pm * 256 * K * 2; }
    __device__ __forceinline__ unsigned goff(const pg8::Unit& u, int h, unsigned voff) const {
        const unsigned pitch = (unsigned)K * 2u;
        if constexpr (!G) return (unsigned)(u.pm * 256 + h * 128) * pitch + voff;
        const unsigned R = voff / pitch, inrow = voff - R * pitch;
        const int a = mt.rt[u.slot * 256 + h * 128 + (int)R]; const int row = a < 0 ? 0 : (a >> 2);
        return (unsigned)row * pitch + inrow; }
    __device__ __forceinline__ const bf16* bbase(const pg8::Unit& u) const { const int e = __builtin_amdgcn_readfirstlane(mt.e_of[u.slot]); return Bt + ((size_t)e * rows_e + (size_t)u.pn * 256) * K; }
};
struct EpiInProj {
    static constexpr int MID_T = 0; static constexpr bool PERM = true; Params p;
    __device__ __forceinline__ void operator()(const f32x4 (&acc)[2][2][4][2], const pg8::Unit& u, int wr, int wc, int fr, int fq) const {
        unsigned char* ws = p.ws; const int pn = u.pn;
        bf16* dst; int ld, ct; int kind = 0; const float* gb = nullptr;
        if (pn < 2) { dst = (bf16*)(ws + WS_QA); ld = WA; ct = pn * 256; kind = 1; }
        else if (pn < 4) { dst = (bf16*)(ws + WS_KA); ld = WA; ct = (pn - 2) * 256; kind = 1; }
        else if (pn < 6) { dst = (bf16*)(ws + WS_VA); ld = WA; ct = (pn - 4) * 256; }
        else if (pn < 9) { dst = (bf16*)(ws + WS_QB); ld = WB; ct = (pn - 6) * 256; kind = 1; }
        else if (pn < 12) { dst = (bf16*)(ws + WS_KB); ld = WB; ct = (pn - 9) * 256; kind = 1; }
        else if (pn < 15) { dst = (bf16*)(ws + WS_VB); ld = WB; ct = (pn - 12) * 256; }
        else if (pn < 19) { dst = (bf16*)(ws + WS_SA); ld = D; ct = (pn - 15) * 256; kind = 2; gb = p.b_gate_a; }
        else { dst = (bf16*)(ws + WS_SB); ld = D; ct = (pn - 19) * 256; kind = 2; gb = p.b_gate_b; }
        const int row0 = u.pm * 256 + wr * 64 + fr, col0 = ct + wc * 32 + 8 * fq;
        f32x4 bv[2][2];
#pragma unroll
        for (int bj = 0; bj < 2; ++bj)
#pragma unroll
            for (int n = 0; n < 2; ++n) bv[bj][n] = (kind == 2) ? *(const f32x4*)(gb + col0 + bj * 128 + 4 * n) : (f32x4){0.f, 0.f, 0.f, 0.f};
        const bool dorope = (kind == 1) && ((wc & 1) == 0);
        const bool dokm = (pn == 2) || (pn == 3);
        f32x4 ks[2][2];
#pragma unroll
        for (int bj = 0; bj < 2; ++bj) { ks[bj][0] = (f32x4){0.f, 0.f, 0.f, 0.f}; ks[bj][1] = (f32x4){0.f, 0.f, 0.f, 0.f}; }
        const float sgn = (fq == 0) ? -1.0f : 1.0f; const bool rl = fq < 2;
#pragma unroll
        for (int ai = 0; ai < 2; ++ai)
#pragma unroll
            for (int m = 0; m < 4; ++m) {
                const int row = row0 + ai * 128 + m * 16;
                f32x4 cs[4];
                if (dorope) { const f32x4* rp = (const f32x4*)(ws + WS_ROPE) + (size_t)(row % S) * 4;
#pragma unroll
                    for (int i = 0; i < 4; ++i) cs[i] = rp[i]; }
                bf16* rowp = dst + (size_t)row * ld + col0;
#pragma unroll
                for (int bj = 0; bj < 2; ++bj) {
                    f32x4 v0 = acc[ai][bj][m][0], v1 = acc[ai][bj][m][1];
                    if (dorope) {
                        f32x4 q0, q1;
#pragma unroll
                        for (int j = 0; j < 4; ++j) { q0[j] = __shfl_xor(v0[j], 16); q1[j] = __shfl_xor(v1[j], 16); }
                        if (rl) {
                            v0[0] = v0[0] * cs[0][0] + sgn * q0[0] * cs[0][1]; v0[1] = v0[1] * cs[0][2] + sgn * q0[1] * cs[0][3];
                            v0[2] = v0[2] * cs[1][0] + sgn * q0[2] * cs[1][1]; v0[3] = v0[3] * cs[1][2] + sgn * q0[3] * cs[1][3];
                            v1[0] = v1[0] * cs[2][0] + sgn * q1[0] * cs[2][1]; v1[1] = v1[1] * cs[2][2] + sgn * q1[1] * cs[2][3];
                            v1[2] = v1[2] * cs[3][0] + sgn * q1[2] * cs[3][1]; v1[3] = v1[3] * cs[3][2] + sgn * q1[3] * cs[3][3]; }
                    }
                    if (dokm) { ks[bj][0] += v0; ks[bj][1] += v1; }
                    if (kind == 2) {
                        v0 = v0 + bv[bj][0]; v1 = v1 + bv[bj][1];
#pragma unroll
                        for (int j = 0; j < 4; ++j) { v0[j] = fast_sigmoid(v0[j]); v1[j] = fast_sigmoid(v1[j]); } }
                    u32x4 w; w.x = cvtpk(v0[0], v0[1]); w.y = cvtpk(v0[2], v0[3]); w.z = cvtpk(v1[0], v1[1]); w.w = cvtpk(v1[2], v1[3]);
                    *(u32x4*)(rowp + bj * 128) = w;
                }
            }
        if (dokm) {
            float* km = (float*)(ws + WS_KMEAN) + (size_t)((u.pm >> 5) * NHA * NBLK + (u.pm & 31)) * HD;
#pragma unroll
            for (int bj = 0; bj < 2; ++bj)
#pragma unroll
                for (int n = 0; n < 2; ++n)
#pragma unroll
                    for (int j = 0; j < 4; ++j) { float v = ks[bj][n][j]; v += __shfl_xor(v, 1); v += __shfl_xor(v, 2); v += __shfl_xor(v, 4); v += __shfl_xor(v, 8);
                        if (fr == 0) { const int c = col0 + bj * 128 + 4 * n + j; atomicAdd(km + (size_t)(c >> 6) * NBLK * HD + (c & 63), v * (1.0f / MBLK)); } }
        }
    }
};
template <int PASS> struct EpiMix {
    static constexpr int MID_T = 0; static constexpr bool PERM = true; Params p;
    __device__ __forceinline__ void operator()(const f32x4 (&acc)[2][2][4][2], const pg8::Unit& u, int wr, int wc, int fr, int fq) const {
        const int row0 = u.pm * 256 + wr * 64 + fr, col0 = u.pn * 256 + wc * 32 + 8 * fq;
        const bf16* G = (const bf16*)(p.ws + (PASS == 0 ? WS_SA : WS_SB)); bf16* M = (bf16*)(p.ws + WS_MIX);
#pragma unroll
        for (int ai = 0; ai < 2; ++ai)
#pragma unroll
            for (int m = 0; m < 4; ++m) {
                const size_t ro = (size_t)(row0 + ai * 128 + m * 16) * D + col0;
#pragma unroll
                for (int bj = 0; bj < 2; ++bj) {
                    const u32x4 g = *(const u32x4*)(G + ro + bj * 128);
                    f32x4 v0 = acc[ai][bj][m][0], v1 = acc[ai][bj][m][1];
                    v0[0] *= __uint_as_float(g.x << 16); v0[1] *= __uint_as_float(g.x & 0xffff0000u); v0[2] *= __uint_as_float(g.y << 16); v0[3] *= __uint_as_float(g.y & 0xffff0000u);
                    v1[0] *= __uint_as_float(g.z << 16); v1[1] *= __uint_as_float(g.z & 0xffff0000u); v1[2] *= __uint_as_float(g.w << 16); v1[3] *= __uint_as_float(g.w & 0xffff0000u);
                    if (PASS == 1) { const u32x4 t = *(const u32x4*)(M + ro + bj * 128);
                        v0[0] += __uint_as_float(t.x << 16); v0[1] += __uint_as_float(t.x & 0xffff0000u); v0[2] += __uint_as_float(t.y << 16); v0[3] += __uint_as_float(t.y & 0xffff0000u);
                        v1[0] += __uint_as_float(t.z << 16); v1[1] += __uint_as_float(t.z & 0xffff0000u); v1[2] += __uint_as_float(t.w << 16); v1[3] += __uint_as_float(t.w & 0xffff0000u); }
                    u32x4 w; w.x = cvtpk(v0[0], v0[1]); w.y = cvtpk(v0[2], v0[3]); w.z = cvtpk(v1[0], v1[1]); w.w = cvtpk(v1[2], v1[3]);
                    *(u32x4*)(M + ro + bj * 128) = w;
                }
            }
    }
};
struct EpiMixCat {
    static constexpr int MID_T = 8; static constexpr bool PERM = true; Params p;
    __device__ __forceinline__ void mid(f32x4 (&acc)[2][2][4][2], const pg8::Unit& u, int wr, int wc, int fr, int fq) const {
        int row0 = u.pm * 256 + wr * 64 + fr, col0 = u.pn * 256 + wc * 32 + 8 * fq;
        asm volatile("" : "+v"(row0), "+v"(col0));
        const bf16* GA = (const bf16*)(p.ws + WS_SA); const bf16* GB = (const bf16*)(p.ws + WS_SB);
#pragma unroll
        for (int ai = 0; ai < 2; ++ai)
#pragma unroll
            for (int m = 0; m < 4; ++m) {
                const size_t ro = (size_t)(row0 + ai * 128 + m * 16) * D + col0;
#pragma unroll
                for (int bj = 0; bj < 2; ++bj) {
                    const u32x4 a = *(const u32x4*)(GA + ro + bj * 128), b = *(const u32x4*)(GB + ro + bj * 128);
#pragma unroll
                    for (int j = 0; j < 4; ++j) { const float r0 = __uint_as_float(a[j] << 16) * __builtin_amdgcn_rcpf(__uint_as_float(b[j] << 16)), r1 = __uint_as_float(a[j] & 0xffff0000u) * __builtin_amdgcn_rcpf(__uint_as_float(b[j] & 0xffff0000u));
                        if (j < 2) { acc[ai][bj][m][0][2 * j] *= r0; acc[ai][bj][m][0][2 * j + 1] *= r1; } else { acc[ai][bj][m][1][2 * j - 4] *= r0; acc[ai][bj][m][1][2 * j - 3] *= r1; } }
                }
                asm volatile("" ::: "memory");
            }
    }
    __device__ __forceinline__ void operator()(const f32x4 (&acc)[2][2][4][2], const pg8::Unit& u, int wr, int wc, int fr, int fq) const {
        const int row0 = u.pm * 256 + wr * 64 + fr, col0 = u.pn * 256 + wc * 32 + 8 * fq;
        const bf16* GB = (const bf16*)(p.ws + WS_SB); bf16* M = (bf16*)(p.ws + WS_MIX);
#pragma unroll
        for (int ai = 0; ai < 2; ++ai)
#pragma unroll
            for (int m = 0; m < 4; ++m) {
                const size_t ro = (size_t)(row0 + ai * 128 + m * 16) * D + col0;
#pragma unroll
                for (int bj = 0; bj < 2; ++bj) {
                    const u32x4 g = *(const u32x4*)(GB + ro + bj * 128);
                    f32x4 v0 = acc[ai][bj][m][0], v1 = acc[ai][bj][m][1];
                    v0[0] *= __uint_as_float(g.x << 16); v0[1] *= __uint_as_float(g.x & 0xffff0000u); v0[2] *= __uint_as_float(g.y << 16); v0[3] *= __uint_as_float(g.y & 0xffff0000u);
                    v1[0] *= __uint_as_float(g.z << 16); v1[1] *= __uint_as_float(g.z & 0xffff0000u); v1[2] *= __uint_as_float(g.w << 16); v1[3] *= __uint_as_float(g.w & 0xffff0000u);
                    u32x4 w; w.x = cvtpk(v0[0], v0[1]); w.y = cvtpk(v0[2], v0[3]); w.z = cvtpk(v1[0], v1[1]); w.w = cvtpk(v1[2], v1[3]);
                    *(u32x4*)(M + ro + bj * 128) = w;
                }
            }
    }
};
struct EpiOut {
    static constexpr int MID_T = 0; static constexpr bool PERM = false; Params p;
    __device__ __forceinline__ void operator()(const f32x4 (&acc)[2][2][4][2], const pg8::Unit& u, int wr, int wc, int fr, int fq) const {
        const int row0 = u.pm * 256 + wr * 64 + fr, col0 = u.pn * 256 + wc * 32 + 4 * fq;
#pragma unroll
        for (int ai = 0; ai < 2; ++ai)
#pragma unroll
            for (int m = 0; m < 4; ++m) { const size_t ro = (size_t)(row0 + ai * 128 + m * 16) * D + col0;
#pragma unroll
                for (int bj = 0; bj < 2; ++bj)
#pragma unroll
                    for (int n = 0; n < 2; ++n) { const size_t o = ro + bj * 128 + n * 16; *(f32x4*)(p.out + o) = *(const f32x4*)(p.x + o) + acc[ai][bj][m][n]; } }
    }
};
struct EpiGateUp {
    static constexpr int MID_T = 0; static constexpr bool PERM = false; Params p; MoeTab mt;
    __device__ __forceinline__ void operator()(const f32x4 (&acc)[2][2][4][2], const pg8::Unit& u, int wr, int wc, int fr, int fq) const {
        const int e = __builtin_amdgcn_readfirstlane(mt.e_of[u.slot]);
        const int row0 = u.pm * 256 + wr * 64 + fr;
        f32x4 bg[2], bu[2]; int cc[2];
#pragma unroll
        for (int bj = 0; bj < 2; ++bj) { cc[bj] = 16 * (8 * u.pn + 4 * bj + wc) + 4 * fq; bg[bj] = *(const f32x4*)(p.b_gate + e * FF + cc[bj]); bu[bj] = *(const f32x4*)(p.b_up + e * FF + cc[bj]); }
#pragma unroll
        for (int ai = 0; ai < 2; ++ai)
#pragma unroll
            for (int m = 0; m < 4; ++m) { bf16* rowp = (bf16*)(p.ws + WS_A2) + (size_t)(row0 + ai * 128 + m * 16) * FF;
#pragma unroll
                for (int bj = 0; bj < 2; ++bj) { f32x4 g = acc[ai][bj][m][0] + bg[bj], uu = acc[ai][bj][m][1] + bu[bj], a;
#pragma unroll
                    for (int j = 0; j < 4; ++j) { const float gg = fminf(g[j], 7.0f), uc = fminf(fmaxf(uu[j], -7.0f), 7.0f); a[j] = gg * fast_sigmoid(1.702f * gg) * (uc + 1.0f); }
#if FP8_DN
                    int w = __builtin_amdgcn_cvt_pk_fp8_f32(a[0], a[1], 0, false); w = __builtin_amdgcn_cvt_pk_fp8_f32(a[2], a[3], w, true);
                    *(int*)((unsigned char*)(p.ws + WS_A2) + (size_t)(row0 + ai * 128 + m * 16) * FF + cc[bj]) = w; (void)rowp;
#else
                    u32x2 w; w.x = cvtpk(a[0], a[1]); w.y = cvtpk(a[2], a[3]); *(u32x2*)(rowp + cc[bj]) = w;
#endif
                } }
    }
};
struct EpiDown {
    static constexpr int MID_T = 0; static constexpr bool PERM = true; Params p; MoeTab mt;
    __device__ __forceinline__ void operator()(const f32x4 (&acc)[2][2][4][2], const pg8::Unit& u, int wr, int wc, int fr, int fq) const {
        const int e = __builtin_amdgcn_readfirstlane(mt.e_of[u.slot]);
        const int row0 = u.pm * 256 + wr * 64 + fr, col0 = u.pn * 256 + wc * 32 + 8 * fq;
        const float* bd = p.b_down + e * D + col0;
        int asg[2][4]; float pw[2][4];
#pragma unroll
        for (int ai = 0; ai < 2; ++ai)
#pragma unroll
            for (int m = 0; m < 4; ++m) { const int rl = u.slot * 256 + wr * 64 + fr + ai * 128 + m * 16; asg[ai][m] = mt.rt[rl]; pw[ai][m] = mt.rp[rl]; }
        f32x4 bv[2][2];
#pragma unroll
        for (int bj = 0; bj < 2; ++bj) { bv[bj][0] = *(const f32x4*)(bd + bj * 128); bv[bj][1] = *(const f32x4*)(bd + bj * 128 + 4); }
#pragma unroll
        for (int ai = 0; ai < 2; ++ai)
#pragma unroll
            for (int m = 0; m < 4; ++m) {
                if (asg[ai][m] >= 0) { bf16* rowp = (bf16*)(p.ws + WS_Y) + (size_t)asg[ai][m] * D + col0; const float pp = pw[ai][m] * (FP8_Y ? 16.0f : 1.0f);
#pragma unroll
                    for (int bj = 0; bj < 2; ++bj) { const f32x4 v0 = (acc[ai][bj][m][0] + bv[bj][0]) * pp, v1 = (acc[ai][bj][m][1] + bv[bj][1]) * pp;
#if FP8_Y
                        int w0 = __builtin_amdgcn_cvt_pk_fp8_f32(v0[0], v0[1], 0, false); w0 = __builtin_amdgcn_cvt_pk_fp8_f32(v0[2], v0[3], w0, true);
                        int w1 = __builtin_amdgcn_cvt_pk_fp8_f32(v1[0], v1[1], 0, false); w1 = __builtin_amdgcn_cvt_pk_fp8_f32(v1[2], v1[3], w1, true);
                        u32x2 w; w.x = (unsigned)w0; w.y = (unsigned)w1; *(u32x2*)((unsigned char*)(p.ws + WS_Y) + (size_t)asg[ai][m] * D + col0 + bj * 128) = w; (void)rowp;
#else
                        u32x4 w; w.x = cvtpk(v0[0], v0[1]); w.y = cvtpk(v0[2], v0[3]); w.z = cvtpk(v1[0], v1[1]); w.w = cvtpk(v1[2], v1[3]);
                        *(u32x4*)(rowp + bj * 128) = w;
#endif
                    } } }
    }
};

__device__ __forceinline__ void phase_kmean(const Params& p, int gw, int ngw, int lane) {
    for (int it = gw; it < NB * NHA * NBLK; it += ngw) {
        const int n = it % NBLK, h = (it / NBLK) % NHA, b = it / (NBLK * NHA), d = lane;
        const bf16* k = (const bf16*)(p.ws + WS_KA) + ((size_t)b * S + (size_t)n * MBLK) * WA + h * HD + d;
        float s = 0.f; for (int r = 0; r < MBLK; ++r) s += bf2f(k[(size_t)r * WA]);
        ((float*)(p.ws + WS_KMEAN))[(size_t)it * HD + d] = s * (1.0f / MBLK);
    }
}
__device__ __forceinline__ void phase_select(const Params& p, int gtid, int ngt) {
    for (int idx = gtid; idx < T * NHA; idx += ngt) {
        const int h = idx % NHA, t = idx / NHA, b = t / S, s = t % S, blk = s / MBLK;
        const bf16* q = (const bf16*)(p.ws + WS_QA) + (size_t)t * WA + h * HD;
        const float* km = (const float*)(p.ws + WS_KMEAN) + (size_t)(b * NHA + h) * NBLK * HD;
        float best0 = -INFINITY, best1 = -INFINITY, best2 = -INFINITY; int b0 = -1, b1 = -1, b2 = -1;
        for (int n = 0; n < blk; ++n) {
            float g = 0.f; for (int d = 0; d < HD; ++d) g += bf2f(q[d]) * km[n * HD + d];
            if (g > best0) { best2 = best1; b2 = b1; best1 = best0; b1 = b0; best0 = g; b0 = n; }
            else if (g > best1) { best2 = best1; b2 = b1; best1 = g; b1 = n; }
            else if (g > best2) { best2 = g; b2 = n; }
        }
        signed char* sel = (signed char*)(p.ws + WS_SEL) + (size_t)idx * 4;
        sel[0] = (signed char)b0; sel[1] = (signed char)b1; sel[2] = (signed char)b2; sel[3] = -1;
    }
}
__device__ __forceinline__ float dot64(const float* qs, const bf16* kr) {
    float a = 0.f;
    for (int d8 = 0; d8 < 8; ++d8) { float kv[8]; ldact8(kr + d8 * 8, kv);
#pragma unroll
        for (int i = 0; i < 8; ++i) a += qs[d8 * 8 + i] * kv[i]; }
    return a;
}
#define WAVE_LDS_FENCE() asm volatile("s_waitcnt lgkmcnt(0)" ::: "memory")
__device__ __forceinline__ void phase_moba_naive(const Params& p, int gw, int ngw, int lane, float* wl, bf16* oa_dst) {
    float* qs = wl; float* sc = wl + 64;
    for (int it = gw; it < T * NHA; it += ngw) {
        const int h = it % NHA, t = it / NHA, b = t / S, s = t % S, blk = s / MBLK;
        WAVE_LDS_FENCE();
        qs[lane] = bf2f(((const bf16*)(p.ws + WS_QA))[(size_t)t * WA + h * HD + lane]);
        WAVE_LDS_FENCE();
        const signed char* sel = (const signed char*)(p.ws + WS_SEL) + ((size_t)t * NHA + h) * 4;
        const int kb0 = blk, kb1 = sel[0], kb2 = sel[1], kb3 = sel[2];
        const bf16* K = (const bf16*)(p.ws + WS_KA) + (size_t)b * S * WA + h * HD; const bf16* V = (const bf16*)(p.ws + WS_VA) + (size_t)b * S * WA + h * HD;
        float mx = -INFINITY;
        for (int g = 0; g < 4; ++g) { const int kbg = g == 0 ? kb0 : g == 1 ? kb1 : g == 2 ? kb2 : kb3;
            for (int c = 0; c < 4; ++c) {
                const int kk = c * 64 + lane; float v = -INFINITY;
                if (kbg >= 0) { const int key = kbg * MBLK + kk; if (g > 0 || key <= s) v = dot64(qs, K + (size_t)key * WA) * 0.125f; }
                sc[g * 256 + kk] = v; mx = fmaxf(mx, v);
            } }
#pragma unroll
        for (int o = 1; o < 64; o <<= 1) mx = fmaxf(mx, __shfl_xor(mx, o));
        WAVE_LDS_FENCE();
        float l = 0.f;
        for (int i = lane; i < 1024; i += 64) { const float e = (sc[i] == -INFINITY) ? 0.f : expf(sc[i] - mx); sc[i] = e; l += e; }
        l = wave_sum(l);
        WAVE_LDS_FENCE();
        float o = 0.f;
        for (int g = 0; g < 4; ++g) { const int kbg = g == 0 ? kb0 : g == 1 ? kb1 : g == 2 ? kb2 : kb3; if (kbg < 0) continue;
            for (int kk = 0; kk < 256; ++kk) { const float pr = sc[g * 256 + kk]; if (pr != 0.f) o += pr * bf2f(V[(size_t)(kbg * MBLK + kk) * WA + lane]); } }
        oa_dst[(size_t)t * WA + h * HD + lane] = (bf16)f2bf(o / l);
    }
}
__device__ __forceinline__ void phase_dil_naive(const Params& p, int gw, int ngw, int lane, float* wl, bf16* ob_dst) {
    float* qs = wl; float* sc = wl + 192;
    for (int it = gw; it < T * 4; it += ngw) {
        const int j = it % 4, t = it / 4, b = t / S, s = t % S;
        WAVE_LDS_FENCE();
        for (int g = 0; g < 3; ++g) qs[g * 64 + lane] = bf2f(((const bf16*)(p.ws + WS_QB))[(size_t)t * WB + (4 * g + j) * HD + lane]);
        WAVE_LDS_FENCE();
        float mx = -INFINITY;
        for (int g = 0; g < 3; ++g) { const int dl = g == 0 ? 1 : g == 1 ? 4 : 16; const bf16* K = (const bf16*)(p.ws + WS_KB) + (size_t)b * S * WB + (4 * g + j) * HD;
            for (int i = lane; i <= 128; i += 64) { const int key = s - i * dl; float v = -INFINITY;
                if (key >= 0) v = dot64(qs + g * 64, K + (size_t)key * WB) * 0.125f;
                sc[g * 129 + i] = v; mx = fmaxf(mx, v); } }
#pragma unroll
        for (int o = 1; o < 64; o <<= 1) mx = fmaxf(mx, __shfl_xor(mx, o));
        WAVE_LDS_FENCE();
        float l = 0.f;
        for (int i = lane; i < 3 * 129; i += 64) { const float e = (sc[i] == -INFINITY) ? 0.f : expf(sc[i] - mx); sc[i] = e; l += e; }
        l = wave_sum(l);
        WAVE_LDS_FENCE();
        float o = 0.f;
        for (int g = 0; g < 3; ++g) { const int dl = g == 0 ? 1 : g == 1 ? 4 : 16; const bf16* V = (const bf16*)(p.ws + WS_VB) + (size_t)b * S * WB + (4 * g + j) * HD;
            for (int i = 0; i <= 128; ++i) { const float pr = sc[g * 129 + i]; const int key = s - i * dl; if (key >= 0 && pr != 0.f) o += pr * bf2f(V[(size_t)key * WB + lane]); } }
        ob_dst[(size_t)t * WBO + j * HD + lane] = (bf16)f2bf(o / l);
    }
}

__device__ __forceinline__ void phase_router(const Params& p, int bid, int nb, unsigned char* lds, int tid) {
    const int lane = tid & 63, w = tid >> 6, h = lane >> 5, r32 = lane & 31;
    float* part = (float*)lds;
    float* ssqp = (float*)(lds + 65536);
    float* rstd_s = (float*)(lds + 65536 + 2048);
    int4* rec = (int4*)(lds + 65536 + 4096);
    int* lc = (int*)(lds + 65536 + 8192); int* gbase = lc + 32;
    bf16x8v whi[8], wlo[8];
#pragma unroll
    for (int sidx = 0; sidx < 8; ++sidx) { const int k0 = 128 * w + 16 * sidx + 8 * h; float wv[8];
        const f32x4 g0 = *(const f32x4*)(p.ln_ffn_g + k0), g1 = *(const f32x4*)(p.ln_ffn_g + k0 + 4);
#pragma unroll
        for (int j = 0; j < 8; ++j) wv[j] = p.w_router[(size_t)(k0 + j) * NE + r32] * (j < 4 ? g0[j] : g1[j - 4]);
        u32x4 hi, lo;
#pragma unroll
        for (int j = 0; j < 4; ++j) { const unsigned hp = cvtpk(wv[2 * j], wv[2 * j + 1]); hi[j] = hp;
            lo[j] = cvtpk(wv[2 * j] - __uint_as_float(hp << 16), wv[2 * j + 1] - __uint_as_float(hp & 0xffff0000u)); }
        whi[sidx] = __builtin_bit_cast(bf16x8v, hi); wlo[sidx] = __builtin_bit_cast(bf16x8v, lo); }
    for (int tg = bid; tg < T / 64; tg += nb) {
        __syncthreads();
        if (tid < 256) rec[tid] = make_int4(-1, 0, 0, 0);
        if (tid < 32) lc[tid] = 0;
#pragma unroll
        for (int tt = 0; tt < 2; ++tt) {
            const float* xr = p.out + (size_t)(tg * 64 + 32 * tt + r32) * D + 128 * w + 8 * h;
            f32x16 acc = {0.f, 0.f, 0.f, 0.f, 0.f, 0.f, 0.f, 0.f, 0.f, 0.f, 0.f, 0.f, 0.f, 0.f, 0.f, 0.f}; float ssq = 0.f;
#pragma unroll
            for (int sidx = 0; sidx < 8; ++sidx) { const f32x4 x0 = *(const f32x4*)(xr + 16 * sidx), x1 = *(const f32x4*)(xr + 16 * sidx + 4);
                ssq += (x0.x * x0.x + x0.y * x0.y) + (x0.z * x0.z + x0.w * x0.w) + (x1.x * x1.x + x1.y * x1.y) + (x1.z * x1.z + x1.w * x1.w);
                u32x4 hi, lo;
                hi.x = cvtpk(x0.x, x0.y); hi.y = cvtpk(x0.z, x0.w); hi.z = cvtpk(x1.x, x1.y); hi.w = cvtpk(x1.z, x1.w);
                lo.x = cvtpk(x0.x - __uint_as_float(hi.x << 16), x0.y - __uint_as_float(hi.x & 0xffff0000u)); lo.y = cvtpk(x0.z - __uint_as_float(hi.y << 16), x0.w - __uint_as_float(hi.y & 0xffff0000u));
                lo.z = cvtpk(x1.x - __uint_as_float(hi.z << 16), x1.y - __uint_as_float(hi.z & 0xffff0000u)); lo.w = cvtpk(x1.z - __uint_as_float(hi.w << 16), x1.w - __uint_as_float(hi.w & 0xffff0000u));
                const bf16x8v xh = __builtin_bit_cast(bf16x8v, hi), xl = __builtin_bit_cast(bf16x8v, lo);
                acc = __builtin_amdgcn_mfma_f32_32x32x16_bf16(xh, whi[sidx], acc, 0, 0, 0);
                acc = __builtin_amdgcn_mfma_f32_32x32x16_bf16(xh, wlo[sidx], acc, 0, 0, 0);
                acc = __builtin_amdgcn_mfma_f32_32x32x16_bf16(xl, whi[sidx], acc, 0, 0, 0); }
#pragma unroll
            for (int r = 0; r < 16; ++r) part[(w * 64 + 32 * tt + crow(r, h)) * 32 + r32] = acc[r];
            ssq += __shfl_xor(ssq, 32);
            if (h == 0) ssqp[w * 64 + 32 * tt + r32] = ssq;
        }
        __syncthreads();
        if (tid < 64) {
            const int t = tg * 64 + tid;
            float sq = 0.f;
#pragma unroll
            for (int i = 0; i < 8; ++i) sq += ssqp[i * 64 + tid];
            const float rstd = 1.0f / sqrtf(sq * (1.0f / D) + NORM_EPS); rstd_s[tid] = rstd;
            float v0 = -INFINITY, v1 = -INFINITY, v2 = -INFINITY, v3 = -INFINITY; int e0 = 0, e1 = 0, e2 = 0, e3 = 0;
            for (int e = 0; e < NE; ++e) { float a = 0.f;
#pragma unroll
                for (int i = 0; i < 8; ++i) a += part[(i * 64 + tid) * 32 + ((e + tid) & 31)];
                const int ee = (e + tid) & 31; const float lg = a * rstd + p.b_router[ee];
                if (lg > v0 || (lg == v0 && ee < e0)) { v3 = v2; e3 = e2; v2 = v1; e2 = e1; v1 = v0; e1 = e0; v0 = lg; e0 = ee; }
                else if (lg > v1 || (lg == v1 && ee < e1)) { v3 = v2; e3 = e2; v2 = v1; e2 = e1; v1 = lg; e1 = ee; }
                else if (lg > v2 || (lg == v2 && ee < e2)) { v3 = v2; e3 = e2; v2 = lg; e2 = ee; }
                else if (lg > v3 || (lg == v3 && ee < e3)) { v3 = lg; e3 = ee; } }
            const float x1 = expf(v1 - v0), x2 = expf(v2 - v0), x3 = expf(v3 - v0); const float inv = 1.0f / (1.0f + x1 + x2 + x3);
            { const int lp = atomicAdd(&lc[e0], 1); rec[tid * 4 + 0] = make_int4(e0, lp, t * 4 + 0, __float_as_int(inv)); }
            { const int lp = atomicAdd(&lc[e1], 1); rec[tid * 4 + 1] = make_int4(e1, lp, t * 4 + 1, __float_as_int(x1 * inv)); }
            { const int lp = atomicAdd(&lc[e2], 1); rec[tid * 4 + 2] = make_int4(e2, lp, t * 4 + 2, __float_as_int(x2 * inv)); }
            { const int lp = atomicAdd(&lc[e3], 1); rec[tid * 4 + 3] = make_int4(e3, lp, t * 4 + 3, __float_as_int(x3 * inv)); }
        }
        __syncthreads();
        if (tid < NE) gbase[tid] = lc[tid] > 0 ? atomicAdd((int*)(p.ws + WS_CTL) + CW_ECNT + 64 * tid, lc[tid]) : 0;
        for (int idx = tid; idx < 64 * 256; idx += 512) { const int tk = idx >> 8, c4 = idx & 255; const size_t t = (size_t)tg * 64 + tk;
            const f32x4 x = *(const f32x4*)(p.out + t * D + 4 * c4), g = *(const f32x4*)(p.ln_ffn_g + 4 * c4); const float rs = rstd_s[tk];
            const float h0 = x.x * rs * g.x, h1 = x.y * rs * g.y, h2 = x.z * rs * g.z, h3 = x.w * rs * g.w;
#if FP8_GU
            int o = __builtin_amdgcn_cvt_pk_fp8_f32(h0, h1, 0, false); o = __builtin_amdgcn_cvt_pk_fp8_f32(h2, h3, o, true); ((int*)((unsigned char*)(p.ws + WS_H) + t * D))[c4] = o;
#else
            u32x2 o; o.x = cvtpk(h0, h1); o.y = cvtpk(h2, h3); ((u32x2*)((bf16*)(p.ws + WS_H) + t * D))[c4] = o;
#endif
        }
        __syncthreads();
        if (tid < 256) { const int4 r = rec[tid]; if (r.x >= 0) { const int pos = gbase[r.x] + r.y; ((int*)(p.ws + WS_ELIST))[r.x * T + pos] = r.z; ((float*)(p.ws + WS_EP))[r.x * T + pos] = __int_as_float(r.w); } }
    }
}
__device__ __forceinline__ void phase_final(const Params& p, int gw, int ngw, int lane) {
    for (int t = gw; t < T; t += ngw) {
        f32x4* xr = (f32x4*)(p.out + (size_t)t * D) + lane; const f32x4* gr = (const f32x4*)p.ln_final_g + lane;
        f32x4 v[4]; float ss = 0.f;
#pragma unroll
        for (int j = 0; j < 4; ++j) { v[j] = xr[64 * j];
#pragma unroll
            for (int k = 0; k < 4; ++k) {
#if FP8_Y
                const int y = ((const int*)((const unsigned char*)(p.ws + WS_Y) + ((size_t)t * 4 + k) * D))[lane + 64 * j];
                const f32x2 y01 = __builtin_amdgcn_cvt_pk_f32_fp8(y, false), y23 = __builtin_amdgcn_cvt_pk_f32_fp8(y, true);
                v[j].x += y01.x * 0.0625f; v[j].y += y01.y * 0.0625f; v[j].z += y23.x * 0.0625f; v[j].w += y23.y * 0.0625f;
#else
                const u32x2 y = ((const u32x2*)((const bf16*)(p.ws + WS_Y) + ((size_t)t * 4 + k) * D))[lane + 64 * j];
                v[j].x += __uint_as_float(y.x << 16); v[j].y += __uint_as_float(y.x & 0xffff0000u); v[j].z += __uint_as_float(y.y << 16); v[j].w += __uint_as_float(y.y & 0xffff0000u);
#endif
            }
            ss += (v[j].x * v[j].x + v[j].y * v[j].y) + (v[j].z * v[j].z + v[j].w * v[j].w); }
        float rstd = 1.0f / sqrtf(wave_sum(ss) * (1.0f / D) + NORM_EPS);
#if DBG
        { const float num = ((const float*)(p.ws + WS_CTL))[CW_DNUM], den = ((const float*)(p.ws + WS_CTL))[CW_DDEN]; rstd *= 1.0f + DBG_GAIN * sqrtf(num / fmaxf(den, 1e-30f)); }
#endif
#if TIMEB_LO >= 0
        { const unsigned long long* ts = (const unsigned long long*)(p.ws + WS_CTL + 917504); rstd *= 1.0f + TIMEB_GAIN * (float)(ts[TIMEB_HI] - ts[TIMEB_LO]) * 1e-6f; }
#endif
#pragma unroll
        for (int j = 0; j < 4; ++j) { const f32x4 g = gr[64 * j]; f32x4 o; o.x = v[j].x * rstd * g.x; o.y = v[j].y * rstd * g.y; o.z = v[j].z * rstd * g.z; o.w = v[j].w * rstd * g.w; xr[64 * j] = o; }
    }
}


#define LDSP __attribute__((address_space(3)))
constexpr int AT_RS = 144;
constexpr int AT_KOFF = 0, AT_VOFF = 384 * AT_RS, AT_PFX = 131072;
constexpr float AT_C = 0.125f * 1.4426950408889634f;
__device__ __forceinline__ s16x4 vtr(unsigned addr) { return __builtin_bit_cast(s16x4, __builtin_amdgcn_ds_read_tr16_b64_v4i16((LDSP s16x4*)(uintptr_t)addr)); }

struct AttnState { f32x16 o0, o1; float m, l; };
template <bool MASKED> __device__ __forceinline__ void attn_wave(AttnState& st, const bf16x8v (&qf)[4], unsigned kbase, unsigned vbase, int c0, int c1, int clo, int chi, int lane) {
    const int h = lane >> 5, ql = lane & 31;
    if (c0 >= c1) return;
    bf16x8v kf[4];
    { const unsigned ka = kbase + (unsigned)c0 * (32 * AT_RS);
#pragma unroll
      for (int ks = 0; ks < 4; ++ks) kf[ks] = *(const LDSP bf16x8v*)(uintptr_t)(ka + ks * 32); }
#pragma unroll 1
    for (int c = c0; c < c1; ++c) {
        const unsigned va = vbase + (unsigned)c * (32 * AT_RS);
        s16x4 vlo[2][2], vhi[2][2];
#pragma unroll
        for (int ks = 0; ks < 2; ++ks)
#pragma unroll
            for (int db = 0; db < 2; ++db) { vlo[ks][db] = vtr(va + ks * (16 * AT_RS) + db * 64); vhi[ks][db] = vtr(va + ks * (16 * AT_RS) + 8 * AT_RS + db * 64); }
        f32x16 s = {0.f, 0.f, 0.f, 0.f, 0.f, 0.f, 0.f, 0.f, 0.f, 0.f, 0.f, 0.f, 0.f, 0.f, 0.f, 0.f};
#pragma unroll
        for (int ks = 0; ks < 4; ++ks) s = __builtin_amdgcn_mfma_f32_32x32x16_bf16(kf[ks], qf[ks], s, 0, 0, 0);
        { const unsigned kn = kbase + (unsigned)((c + 1 < c1) ? c + 1 : c) * (32 * AT_RS);
#pragma unroll
          for (int ks = 0; ks < 4; ++ks) kf[ks] = *(const LDSP bf16x8v*)(uintptr_t)(kn + ks * 32); }
        float t[16]; float cmax = -INFINITY;
#pragma unroll
        for (int r = 0; r < 16; ++r) { t[r] = s[r];
            if (MASKED) { const int cr = crow(r, h); if ((c == clo && cr < ql) || (c == chi && cr > ql)) t[r] = -INFINITY; }
            cmax = fmaxf(cmax, t[r]); }
        cmax = fmaxf(cmax, __shfl_xor(cmax, 32)) * AT_C;
        const float mn = fmaxf(st.m, cmax); const float mu = (mn == -INFINITY) ? 0.f : mn;
        const float alpha = __builtin_amdgcn_exp2f(st.m - mu);
        float psum = 0.f; float pr[16];
#pragma unroll
        for (int r = 0; r < 16; ++r) { pr[r] = __builtin_amdgcn_exp2f(__builtin_fmaf(t[r], AT_C, -mu)); psum += pr[r]; }
        st.l = st.l * alpha + psum; st.m = mn;
        if (!__all(alpha == 1.0f)) {
#pragma unroll
            for (int r = 0; r < 16; ++r) { st.o0[r] *= alpha; st.o1[r] *= alpha; } }
#pragma unroll
        for (int ks = 0; ks < 2; ++ks) {
            u32x4 pw; pw.x = cvtpk(pr[8 * ks + 0], pr[8 * ks + 1]); pw.y = cvtpk(pr[8 * ks + 2], pr[8 * ks + 3]); pw.z = cvtpk(pr[8 * ks + 4], pr[8 * ks + 5]); pw.w = cvtpk(pr[8 * ks + 6], pr[8 * ks + 7]);
            const bf16x8v pf = __builtin_bit_cast(bf16x8v, pw);
            const bf16x8v vf0 = {vlo[ks][0][0], vlo[ks][0][1], vlo[ks][0][2], vlo[ks][0][3], vhi[ks][0][0], vhi[ks][0][1], vhi[ks][0][2], vhi[ks][0][3]};
            const bf16x8v vf1 = {vlo[ks][1][0], vlo[ks][1][1], vlo[ks][1][2], vlo[ks][1][3], vhi[ks][1][0], vhi[ks][1][1], vhi[ks][1][2], vhi[ks][1][3]};
            st.o0 = __builtin_amdgcn_mfma_f32_32x32x16_bf16(vf0, pf, st.o0, 0, 0, 0);
            st.o1 = __builtin_amdgcn_mfma_f32_32x32x16_bf16(vf1, pf, st.o1, 0, 0, 0);
        }
    }
}
__device__ __forceinline__ void attn_init(AttnState& st) {
#pragma unroll
    for (int r = 0; r < 16; ++r) { st.o0[r] = 0.f; st.o1[r] = 0.f; }
    st.m = -INFINITY; st.l = 0.f;
}
__device__ __forceinline__ void attn_stage(unsigned char* lds, int dst, const unsigned char* src, size_t pitch, int nrows, int skip, int tid) {
    for (int idx = tid; idx < nrows * 8; idx += 512) { const int row = idx >> 3, ch = idx & 7;
        if (row >= skip) { const u32x4 v = *(const u32x4*)(src + (size_t)row * pitch + ch * 16); *(u32x4*)(lds + dst + row * AT_RS + ch * 16) = v; } }
}
__device__ __forceinline__ void attn_qload(bf16x8v (&qf)[4], const bf16* qrow, int h) {
#pragma unroll
    for (int ks = 0; ks < 4; ++ks) qf[ks] = *(const bf16x8v*)(qrow + 16 * ks + 8 * h);
}
__device__ __forceinline__ void attn_store_partial(const AttnState& st, float inv_l, bf16* dst, int h) {
#pragma unroll
    for (int rg = 0; rg < 4; ++rg) {
        u32x2 w0, w1; w0.x = cvtpk(st.o0[4 * rg] * inv_l, st.o0[4 * rg + 1] * inv_l); w0.y = cvtpk(st.o0[4 * rg + 2] * inv_l, st.o0[4 * rg + 3] * inv_l);
        w1.x = cvtpk(st.o1[4 * rg] * inv_l, st.o1[4 * rg + 1] * inv_l); w1.y = cvtpk(st.o1[4 * rg + 2] * inv_l, st.o1[4 * rg + 3] * inv_l);
        *(u32x2*)(dst + 8 * rg + 4 * h) = w0; *(u32x2*)(dst + 32 + 8 * rg + 4 * h) = w1; }
}
__device__ __forceinline__ void attn_acc_partial(f32x16& a0, f32x16& a1, float w, const bf16* src, int h) {
#pragma unroll
    for (int rg = 0; rg < 4; ++rg) { const u32x2 w0 = *(const u32x2*)(src + 8 * rg + 4 * h), w1 = *(const u32x2*)(src + 32 + 8 * rg + 4 * h);
        a0[4 * rg] += w * __uint_as_float(w0.x << 16); a0[4 * rg + 1] += w * __uint_as_float(w0.x & 0xffff0000u); a0[4 * rg + 2] += w * __uint_as_float(w0.y << 16); a0[4 * rg + 3] += w * __uint_as_float(w0.y & 0xffff0000u);
        a1[4 * rg] += w * __uint_as_float(w1.x << 16); a1[4 * rg + 1] += w * __uint_as_float(w1.x & 0xffff0000u); a1[4 * rg + 2] += w * __uint_as_float(w1.y << 16); a1[4 * rg + 3] += w * __uint_as_float(w1.y & 0xffff0000u); }
}


template <int NIT> struct KVRegs { u32x4 k[NIT], v[NIT]; };
template <int NIT> __device__ __forceinline__ void kv_load(KVRegs<NIT>& R, const unsigned char* ksrc, const unsigned char* vsrc, size_t pitch, int skip, int tid) {
#pragma unroll
    for (int i = 0; i < NIT; ++i) { const int idx = tid + 512 * i, row = idx >> 3, ch = idx & 7;
        if (row >= skip) { R.k[i] = *(const u32x4*)(ksrc + (size_t)row * pitch + ch * 16); R.v[i] = *(const u32x4*)(vsrc + (size_t)row * pitch + ch * 16); } }
}
template <int NIT> __device__ __forceinline__ void kv_commit(const KVRegs<NIT>& R, unsigned char* lds, int skip, int tid) {
#pragma unroll
    for (int i = 0; i < NIT; ++i) { const int idx = tid + 512 * i, row = idx >> 3, ch = idx & 7;
        if (row >= skip) { *(u32x4*)(lds + AT_KOFF + row * AT_RS + ch * 16) = R.k[i]; *(u32x4*)(lds + AT_VOFF + row * AT_RS + ch * 16) = R.v[i]; } }
}
__device__ __forceinline__ void phase_select_lists(const Params& p, int bid, int nb, unsigned char* lds, int tid) {
    float* km = (float*)lds;
    for (int it = bid; it < NB * NBLK * 4; it += nb) {
        const int hp = it & 3, n = (it >> 2) % NBLK, b = it / (4 * NBLK);
        __syncthreads();
        for (int i = tid; i < 2 * NBLK * HD; i += 512) { const int hh = i / (NBLK * HD), rest = i % (NBLK * HD); km[i] = ((const float*)(p.ws + WS_KMEAN))[(size_t)(b * NHA + 2 * hp + hh) * NBLK * HD + rest]; }
        __syncthreads();
        const int hh = tid >> 8, h = 2 * hp + hh, s = n * MBLK + (tid & 255), t = b * S + s;
        float q[HD];
        { const u32x4* qp = (const u32x4*)((const bf16*)(p.ws + WS_QA) + (size_t)t * WA + h * HD);
#pragma unroll
            for (int i = 0; i < 8; ++i) { const u32x4 v = qp[i];
#pragma unroll
                for (int j = 0; j < 4; ++j) { q[8 * i + 2 * j] = __uint_as_float(v[j] << 16); q[8 * i + 2 * j + 1] = __uint_as_float(v[j] & 0xffff0000u); } } }
        float best0 = -INFINITY, best1 = -INFINITY, best2 = -INFINITY; int b0 = -1, b1 = -1, b2 = -1;
        const float* kmh = km + hh * (NBLK * HD);
        for (int nn = 0; nn < n; ++nn) {
            float g = 0.f;
#pragma unroll
            for (int d4 = 0; d4 < 16; ++d4) { const f32x4 kv = *(const f32x4*)(kmh + nn * HD + 4 * d4); g += q[4 * d4] * kv.x; g += q[4 * d4 + 1] * kv.y; g += q[4 * d4 + 2] * kv.z; g += q[4 * d4 + 3] * kv.w; }
            if (g > best0) { best2 = best1; b2 = b1; best1 = best0; b1 = b0; best0 = g; b0 = nn; }
            else if (g > best1) { best2 = best1; b2 = b1; best1 = g; b1 = nn; }
            else if (g > best2) { best2 = g; b2 = nn; }
        }
        signed char* sel = (signed char*)(p.ws + WS_SEL) + ((size_t)t * NHA + h) * 4;
        *(unsigned*)sel = (unsigned)(b0 & 0xff) | ((unsigned)(b1 & 0xff) << 8) | ((unsigned)(b2 & 0xff) << 16) | 0xff000000u;
        int* lc = (int*)(lds + 32768); int* gb = lc + 64;
        if (tid < 64) lc[tid] = 0;
        __syncthreads();
        int lp0 = 0, lp1 = 0, lp2 = 0;
        if (b0 >= 0) lp0 = atomicAdd(&lc[hh * 32 + b0], 1);
        if (b1 >= 0) lp1 = atomicAdd(&lc[hh * 32 + b1], 1);
        if (b2 >= 0) lp2 = atomicAdd(&lc[hh * 32 + b2], 1);
        __syncthreads();
        if (tid < 64) { const int c = lc[tid]; gb[tid] = c > 0 ? atomicAdd((int*)(p.ws + WS_CTL) + CW_LCNT + (b * NHA + 2 * hp + (tid >> 5)) * NBLK + (tid & 31), c) : 0; }
        __syncthreads();
        unsigned short* lists = (unsigned short*)(p.ws + WS_LIST) + (size_t)(b * NHA + h) * NBLK * LIST_CAP;
        if (b0 >= 0) lists[(size_t)b0 * LIST_CAP + gb[hh * 32 + b0] + lp0] = (unsigned short)(s | (0 << 13));
        if (b1 >= 0) lists[(size_t)b1 * LIST_CAP + gb[hh * 32 + b1] + lp1] = (unsigned short)(s | (1 << 13));
        if (b2 >= 0) lists[(size_t)b2 * LIST_CAP + gb[hh * 32 + b2] + lp2] = (unsigned short)(s | (2 << 13));
    }
}
__device__ __forceinline__ void phase_dilated(const Params& p, int bid, int nb, unsigned char* lds, int tid) {
    const int lane = tid & 63, w = tid >> 6, h = lane >> 5, ql = lane & 31;
    const unsigned lb = (unsigned)(uintptr_t)lds;
    constexpr int NITM = NB * NHB * 32;
    KVRegs<6> R;
#define DIL_DECODE(it_) const int sub = (it_) & 31, head = ((it_) >> 5) % NHB, b = (it_) / (32 * NHB), g = head >> 2, j = head & 3; \
        const int dl = g == 0 ? 1 : g == 1 ? 4 : 16, r = sub % dl, np = sub / dl; const size_t pitch = (size_t)dl * WB * 2; \
        const long tok0 = (long)b * S + (long)(128 * (2 * np - 1)) * dl + r; const int wq = w & 3, nq = 2 * np + (w >> 2); \
        const size_t tq = (size_t)b * S + (size_t)(128 * nq + 32 * wq + ql) * dl + r; (void)j; (void)pitch; (void)tok0; (void)tq; (void)nq; (void)wq;
    int it = bid;
    if (it < NITM) { DIL_DECODE(it)
        kv_load<6>(R, (const unsigned char*)((const bf16*)(p.ws + WS_KB) + tok0 * WB + head * HD), (const unsigned char*)((const bf16*)(p.ws + WS_VB) + tok0 * WB + head * HD), pitch, np == 0 ? 128 : 0, tid); }
    while (it < NITM) {
        DIL_DECODE(it)
        bf16x8v qf[4]; attn_qload(qf, (const bf16*)(p.ws + WS_QB) + tq * WB + head * HD, h);
        __syncthreads();
        kv_commit<6>(R, lds, np == 0 ? 128 : 0, tid);
        __syncthreads();
        const int nit = it + nb;
        if (nit < NITM) { const int it2 = nit; const int sub2 = it2 & 31, head2 = (it2 >> 5) % NHB, b2 = it2 / (32 * NHB), g2 = head2 >> 2; const int dl2 = g2 == 0 ? 1 : g2 == 1 ? 4 : 16, r2 = sub2 % dl2, np2 = sub2 / dl2;
            const size_t pitch2 = (size_t)dl2 * WB * 2; const long tok02 = (long)b2 * S + (long)(128 * (2 * np2 - 1)) * dl2 + r2;
            kv_load<6>(R, (const unsigned char*)((const bf16*)(p.ws + WS_KB) + tok02 * WB + head2 * HD), (const unsigned char*)((const bf16*)(p.ws + WS_VB) + tok02 * WB + head2 * HD), pitch2, np2 == 0 ? 128 : 0, tid); }
        const int winoff = 128 * (w >> 2);
        AttnState st; attn_init(st);
        const unsigned kbase = lb + AT_KOFF + (unsigned)(winoff + ql) * AT_RS + 16 * h;
        const unsigned vbase = lb + AT_VOFF + (unsigned)(winoff + 4 * h + ((lane & 15) >> 2)) * AT_RS + 32 * ((lane >> 4) & 1) + 8 * (lane & 3);
        const int c0 = (nq == 0) ? 4 : wq;
        attn_wave<true>(st, qf, kbase, vbase, c0, wq + 5, wq, wq + 4, lane);
        const float lt = st.l + __shfl_xor(st.l, 32);
        bf16* dst = (bf16*)(p.ws + WS_PARTB) + (((size_t)g * T + tq) * 4 + j) * HD;
        attn_store_partial(st, 1.0f / lt, dst, h);
        if (h == 0) ((float*)(p.ws + WS_LSEB))[((size_t)g * T + tq) * 4 + j] = st.m + __builtin_amdgcn_logf(lt);
        it = nit;
    }
#undef DIL_DECODE
}
__device__ __forceinline__ void phase_moba_past(const Params& p, int bid, int nb, unsigned char* lds, int tid) {
    const int lane = tid & 63, w = tid >> 6, h = lane >> 5, ql = lane & 31;
    const unsigned lb = (unsigned)(uintptr_t)lds;
    unsigned* pfx = (unsigned*)(lds + AT_PFX);
    const int* lcnt = (const int*)(p.ws + WS_CTL) + CW_LCNT;
    int* cntl = (int*)(lds + AT_PFX + 4096);
    unsigned* pfp = pfx + 2048;
    { const int c = __hip_atomic_load(lcnt + tid, __ATOMIC_RELAXED, __HIP_MEMORY_SCOPE_AGENT); unsigned v = (unsigned)(c >> 8), vp = (c & 255) ? 1u : 0u; cntl[tid] = c;
#pragma unroll
      for (int o = 1; o < 64; o <<= 1) { const unsigned u = __shfl_up(v, o), up = __shfl_up(vp, o); if (lane >= o) { v += u; vp += up; } }
      unsigned* wtot = pfx + 520;
      if (lane == 63) { wtot[w] = v; wtot[8 + w] = vp; }
      __syncthreads();
      unsigned base = 0, basep = 0;
#pragma unroll
      for (int i = 0; i < 8; ++i) if (i < w) { base += wtot[i]; basep += wtot[8 + i]; }
      pfx[tid + 1] = v + base; pfp[tid + 1] = vp + basep; if (tid == 0) { pfx[0] = 0; pfp[0] = 0; } }
    __syncthreads();
    const int nfull = (int)pfx[512];
    const int ntot = nfull + (int)pfp[512];
    KVRegs<4> R; bf16x8v qn[4];
    int liA = 0, tileA = 0, cntA = 0; unsigned entA = 0; int liB = 0, tileB = 0, cntB = 0; unsigned entB = 0;
#define PAST_DECODE(it_, li_, tile_, cnt_, ent_) do { const bool part_ = (it_) >= nfull; const unsigned* pf_ = part_ ? pfp : pfx; const int key_ = part_ ? (it_) - nfull : (it_); \
        int lo_ = 0, hi_ = 512; while (hi_ - lo_ > 1) { const int mid_ = (lo_ + hi_) >> 1; if ((int)pf_[mid_] <= key_) lo_ = mid_; else hi_ = mid_; } \
        li_ = lo_; cnt_ = cntl[lo_]; tile_ = part_ ? (cnt_ >> 8) : key_ - (int)pfx[lo_]; \
        ent_ = ((const unsigned short*)(p.ws + WS_LIST))[(size_t)lo_ * LIST_CAP + tile_ * 256 + 32 * w + ql]; } while (0)
#define PAST_KVQ(li_, ent_) do { const int jb_ = (li_) & 31, hd_ = ((li_) >> 5) & 7, b_ = (li_) >> 8; const size_t row0_ = (size_t)b_ * S + (size_t)jb_ * MBLK; \
        kv_load<4>(R, (const unsigned char*)((const bf16*)(p.ws + WS_KA) + row0_ * WA + hd_ * HD), (const unsigned char*)((const bf16*)(p.ws + WS_VA) + row0_ * WA + hd_ * HD), (size_t)WA * 2, 0, tid); \
        attn_qload(qn, (const bf16*)(p.ws + WS_QA) + ((size_t)b_ * S + ((ent_) & 8191)) * WA + hd_ * HD, h); } while (0)
    int itA = bid, itB = bid + nb;
    if (itA < ntot) { PAST_DECODE(itA, liA, tileA, cntA, entA); PAST_KVQ(liA, entA); }
    if (itB < ntot) PAST_DECODE(itB, liB, tileB, cntB, entB);
    while (itA < ntot) {
        __syncthreads();
        kv_commit<4>(R, lds, 0, tid);
        __syncthreads();
        const int li = liA, tile = tileA, cnt = cntA; const unsigned ent = entA;
        const int hd = (li >> 5) & 7, b = li >> 8, slot = (int)(ent >> 13); const size_t tq = (size_t)b * S + (ent & 8191);
        const bool valid = tile * 256 + 32 * w + ql < cnt;
        bf16x8v qf[4];
#pragma unroll
        for (int i = 0; i < 4; ++i) qf[i] = qn[i];
        itA = itB; liA = liB; tileA = tileB; cntA = cntB; entA = entB;
        if (itA < ntot) PAST_KVQ(liA, entA);
        itB += nb;
        if (itB < ntot) PAST_DECODE(itB, liB, tileB, cntB, entB);
        AttnState st; attn_init(st);
        const unsigned kbase = lb + AT_KOFF + (unsigned)ql * AT_RS + 16 * h;
        const unsigned vbase = lb + AT_VOFF + (unsigned)(4 * h + ((lane & 15) >> 2)) * AT_RS + 32 * ((lane >> 4) & 1) + 8 * (lane & 3);
        if (32 * w + tile * 256 < cnt) {
            attn_wave<false>(st, qf, kbase, vbase, 0, 8, -1, -1, lane);
            const float lt = st.l + __shfl_xor(st.l, 32);
            if (valid) { attn_store_partial(st, 1.0f / lt, (bf16*)(p.ws + WS_PARTA) + (((size_t)slot * T + tq) * NHA + hd) * HD, h);
                if (h == 0) ((float*)(p.ws + WS_LSEA))[((size_t)slot * T + tq) * NHA + hd] = st.m + __builtin_amdgcn_logf(lt); }
        }
    }
#undef PAST_DECODE
#undef PAST_KVQ
}
__device__ __forceinline__ void phase_moba_own(const Params& p, int bid, int nb, unsigned char* lds, int tid) {
    const int lane = tid & 63, w = tid >> 6, h = lane >> 5, ql = lane & 31;
    const unsigned lb = (unsigned)(uintptr_t)lds;
    constexpr int NITM = NB * NHA * NBLK;
    KVRegs<4> R; bf16x8v qn[4];
#define OWN_FETCH(it_) do { const int n_ = (it_) % NBLK, hd_ = ((it_) / NBLK) % NHA, b_ = (it_) / (NBLK * NHA); const size_t row0_ = (size_t)b_ * S + (size_t)n_ * MBLK; \
        kv_load<4>(R, (const unsigned char*)((const bf16*)(p.ws + WS_KA) + row0_ * WA + hd_ * HD), (const unsigned char*)((const bf16*)(p.ws + WS_VA) + row0_ * WA + hd_ * HD), (size_t)WA * 2, 0, tid); \
        attn_qload(qn, (const bf16*)(p.ws + WS_QA) + (row0_ + 32 * w + ql) * WA + hd_ * HD, h); } while (0)
    int it = bid;
    if (it < NITM) OWN_FETCH(it);
    while (it < NITM) {
        const int n = it % NBLK, hd = (it / NBLK) % NHA, b = it / (NBLK * NHA);
        const size_t row0 = (size_t)b * S + (size_t)n * MBLK;
        __syncthreads();
        kv_commit<4>(R, lds, 0, tid);
        __syncthreads();
        bf16x8v qf[4];
#pragma unroll
        for (int i = 0; i < 4; ++i) qf[i] = qn[i];
        const int nit = it + nb;
        if (nit < NITM) OWN_FETCH(nit);
        const size_t tq = row0 + 32 * w + ql;
        const unsigned selw = *(const unsigned*)((const signed char*)(p.ws + WS_SEL) + (tq * NHA + hd) * 4);
        float lse[3];
#pragma unroll
        for (int k = 0; k < 3; ++k) lse[k] = ((const float*)(p.ws + WS_LSEA))[((size_t)k * T + tq) * NHA + hd];
        AttnState st; attn_init(st);
        const unsigned kbase = lb + AT_KOFF + (unsigned)ql * AT_RS + 16 * h;
        const unsigned vbase = lb + AT_VOFF + (unsigned)(4 * h + ((lane & 15) >> 2)) * AT_RS + 32 * ((lane >> 4) & 1) + 8 * (lane & 3);
        attn_wave<true>(st, qf, kbase, vbase, 0, w + 1, -1, w, lane);
        const float lt = st.l + __shfl_xor(st.l, 32);
        const float lse_own = st.m + __builtin_amdgcn_logf(lt);
        float M = lse_own;
#pragma unroll
        for (int k = 0; k < 3; ++k) { const bool ok = ((selw >> (8 * k)) & 0x80u) == 0u; if (!ok) lse[k] = -INFINITY; M = fmaxf(M, lse[k]); }
        const float w_own = __builtin_amdgcn_exp2f(lse_own - M); float wsum = w_own;
        const float so = w_own / lt;
#pragma unroll
        for (int r = 0; r < 16; ++r) { st.o0[r] *= so; st.o1[r] *= so; }
#pragma unroll
        for (int k = 0; k < 3; ++k) { const float wk = __builtin_amdgcn_exp2f(lse[k] - M); wsum += wk;
            if (lse[k] != -INFINITY) attn_acc_partial(st.o0, st.o1, wk, (const bf16*)(p.ws + WS_PARTA) + (((size_t)k * T + tq) * NHA + hd) * HD, h); }
        attn_store_partial(st, 1.0f / wsum, (bf16*)p.out + tq * (WA + WBO) + hd * HD, h);
        it = nit;
    }
#undef OWN_FETCH
}
__device__ __forceinline__ void phase_dil_merge(const Params& p, int gtid, int ngt) {
    for (int idx = gtid; idx < T * 4 * 8; idx += ngt) {
        const int ch = idx & 7, j = (idx >> 3) & 3; const size_t t = idx >> 5;
        float l0 = ((const float*)(p.ws + WS_LSEB))[((size_t)0 * T + t) * 4 + j], l1 = ((const float*)(p.ws + WS_LSEB))[((size_t)1 * T + t) * 4 + j], l2 = ((const float*)(p.ws + WS_LSEB))[((size_t)2 * T + t) * 4 + j];
        const float M = fmaxf(l0, fmaxf(l1, l2)); const float w0 = __builtin_amdgcn_exp2f(l0 - M), w1 = __builtin_amdgcn_exp2f(l1 - M), w2 = __builtin_amdgcn_exp2f(l2 - M); const float inv = 1.0f / (w0 + w1 + w2);
        float o[8];
#pragma unroll
        for (int i = 0; i < 8; ++i) o[i] = 0.f;
#pragma unroll
        for (int g = 0; g < 3; ++g) { const float wg = (g == 0 ? w0 : g == 1 ? w1 : w2) * inv; const u32x4 v = *(const u32x4*)((const bf16*)(p.ws + WS_PARTB) + (((size_t)g * T + t) * 4 + j) * HD + 8 * ch);
#pragma unroll
            for (int i = 0; i < 4; ++i) { o[2 * i] += wg * __uint_as_float(v[i] << 16); o[2 * i + 1] += wg * __uint_as_float(v[i] & 0xffff0000u); } }
        u32x4 wv; wv.x = cvtpk(o[0], o[1]); wv.y = cvtpk(o[2], o[3]); wv.z = cvtpk(o[4], o[5]); wv.w = cvtpk(o[6], o[7]);
        *(u32x4*)((bf16*)p.out + t * (WA + WBO) + WA + j * HD + 8 * ch) = wv;
    }
}

__device__ __forceinline__ void phase_check(const Params& p, const bf16* a, const bf16* b, size_t n, int gtid, int ngt) {
    float num = 0.f, den = 0.f;
    for (size_t i = gtid; i < n; i += ngt) { const float x = bf2f(a[i]), y = bf2f(b[i]); num += (x - y) * (x - y); den += y * y; }
    num = wave_sum(num); den = wave_sum(den);
    if ((threadIdx.x & 63) == 0) { atomicAdd((float*)(p.ws + WS_CTL) + CW_DNUM, num); atomicAdd((float*)(p.ws + WS_CTL) + CW_DDEN, den); }
}

#define XB_TMO      128
#define XB_XCNT(j)  (256  + 64 * (j))
#define XB_XSUB(j)  (1280 + 64 * (j))
#define XB_XGEN(j)  (2304 + 64 * (j))
#define XB_TOP      3328
#define XB_TOPGEN   3392
#define XCD_BAR_WORDS 3456
#define XB_SPIN_CAP (1u << 18)
__device__ __forceinline__ unsigned xb_ld(unsigned* p)              { return __hip_atomic_load(p, __ATOMIC_RELAXED, __HIP_MEMORY_SCOPE_AGENT); }
__device__ __forceinline__ unsigned xb_add(unsigned* p, unsigned v) { return __hip_atomic_fetch_add(p, v, __ATOMIC_RELAXED, __HIP_MEMORY_SCOPE_AGENT); }
__device__ __forceinline__ unsigned xb_xcc_id() { return (unsigned)__builtin_amdgcn_s_getreg((3 << 11) | 20) & 0xFu; }
#define XB_SPIN(cond, bar) do { unsigned _sp = 0; while (cond) { __builtin_amdgcn_s_sleep(1); \
    if ((++_sp & 255u) == 0u) { if (xb_ld(&(bar)[XB_TMO])) break; if (_sp > XB_SPIN_CAP) { atomicAdd(&(bar)[XB_TMO], 1u); break; } } } } while (0)
struct XcdBarrier { unsigned* bar; unsigned x; volatile LAS unsigned* st; };
__device__ __forceinline__ XcdBarrier xcd_barrier_post(unsigned* bar, volatile LAS unsigned* st) {
    XcdBarrier b; b.bar = bar; b.x = xb_xcc_id(); b.st = st;
    if (threadIdx.x == 0) (void)xb_add(&bar[XB_XCNT(b.x)], 1u);
    return b;
}
__device__ __forceinline__ void xcd_barrier_complete(unsigned* bar, unsigned x, unsigned& nloc, unsigned& nx) {
    const unsigned G = gridDim.x * gridDim.y * gridDim.z;
    unsigned sum, cnt, mine, sp = 0u;
    for (;;) {
        sum = 0u; cnt = 0u; mine = 0u;
#pragma unroll
        for (unsigned j = 0; j < 16; ++j) { const unsigned c = xb_ld(&bar[XB_XCNT(j)]); sum += c; cnt += (c > 0u) ? 1u : 0u; mine = (j == x) ? c : mine; }
        if (sum == G) break;
        __builtin_amdgcn_s_sleep(1);
        if ((++sp & 255u) == 0u) { if (xb_ld(&bar[XB_TMO])) break; if (sp > XB_SPIN_CAP) { atomicAdd(&bar[XB_TMO], 1u); break; } }
    }
    nloc = mine > 0u ? mine : 1u; nx = cnt > 0u ? cnt : 1u;
}
__device__ __forceinline__ void xcd_barrier(const XcdBarrier& b) {
    asm volatile("s_waitcnt vmcnt(0)" ::: "memory");
    __syncthreads();
    if (threadIdx.x == 0) {
        unsigned* bar = b.bar;
        __builtin_amdgcn_s_waitcnt(0);
        unsigned nloc = b.st[0], nx = b.st[1];
        if (nloc == 0u) { xcd_barrier_complete(bar, b.x, nloc, nx); b.st[0] = nloc; b.st[1] = nx; }
        const unsigned old = xb_add(&bar[XB_XSUB(b.x)], 1u);
        const unsigned gen = old / nloc;
        if (old + 1u == (gen + 1u) * nloc) {
            __builtin_amdgcn_fence(__ATOMIC_RELEASE, "agent");
            asm volatile("s_waitcnt vmcnt(0)" ::: "memory");
            const unsigned og = xb_add(&bar[XB_TOP], 1u);
            const unsigned tg = og / nx;
            if (og + 1u == (tg + 1u) * nx) xb_add(&bar[XB_TOPGEN], 1u);
            else XB_SPIN(xb_ld(&bar[XB_TOPGEN]) == tg, bar);
            __builtin_amdgcn_fence(__ATOMIC_ACQUIRE, "agent");
            xb_add(&bar[XB_XGEN(b.x)], 1u);
            asm volatile("s_waitcnt vmcnt(0)" ::: "memory");
        } else {
            XB_SPIN(xb_ld(&bar[XB_XGEN(b.x)]) == gen, bar);
            __builtin_amdgcn_fence(__ATOMIC_ACQUIRE, "agent");
            asm volatile("s_waitcnt vmcnt(0)" ::: "memory");
        }
    }
    __syncthreads();
}
constexpr int HELPERS = 96;
constexpr int LDS_BYTES = 147456;
__global__ void __launch_bounds__(512, 2) mega_fwd(Params p) {
    extern __shared__ __attribute__((aligned(16))) unsigned char lds[];
    cg::grid_group grid = cg::this_grid();
    const int bid = blockIdx.x, nb = gridDim.x;
#define COORDS() int tid = threadIdx.x; asm volatile("" : "+v"(tid)); const int lane = tid & 63, wave = tid >> 6; const int gw = bid * 8 + wave, ngw = nb * 8, gtid = bid * 512 + tid, ngt = nb * 512; float* wl = (float*)lds + wave * 1152; (void)lane; (void)gw; (void)ngw; (void)gtid; (void)ngt; (void)wl;
    volatile LAS unsigned* bst = (volatile LAS unsigned*)(lds + LDS_BYTES - 64);
    if (threadIdx.x < 16) bst[threadIdx.x] = 0u;
    __syncthreads();
    const XcdBarrier xbar = xcd_barrier_post((unsigned*)(p.ws + WS_CTL) + CW_BAR, bst);
#ifndef TIME_LO
#define TIME_LO -1
#endif
#ifndef TIME_HI
#define TIME_HI -1
#endif
#ifndef TIME_MULT
#define TIME_MULT 2
#endif
    int n_stamp = 0;
#if TIME_LO >= 0
#define STAMP() do { if (bid == 0 && threadIdx.x == 0) ((unsigned long long*)(p.ws + WS_CTL + 917504))[n_stamp] = __builtin_amdgcn_s_memrealtime(); ++n_stamp; } while (0)
#else
#define STAMP() do { } while (0)
#endif
    STAMP();
#define GRID_BAR() do { xcd_barrier(xbar); STAMP(); } while (0)
    phase_prep_a(p, bid, nb, lds);
    if (p.use_cg) grid.sync(); else xcd_barrier(xbar);
    STAMP();
    if (!(bid < HELPERS && nb > 2 * HELPERS)) {
        const int hsub = (nb > 2 * HELPERS) ? HELPERS : 0;
        pg8::Order O; O.init(T / 256, NCOL / 256, nb - hsub, bid - hsub); EpiInProj E{p};
#if FP8_IN
        ProbPlainF8 P{(const bf16*)(p.ws + WS_H), (const bf16*)(p.ws + WS_WIN), D / 2}; pg8::gemm_phase<EpiInProj, ProbPlainF8, true>((PG8_LAS unsigned char*)lds, P, O, E);
#else
        ProbPlain P{(const bf16*)(p.ws + WS_H), (const bf16*)(p.ws + WS_WIN), D}; pg8::gemm_phase<EpiInProj, ProbPlain, true>((PG8_LAS unsigned char*)lds, P, O, E);
#endif
#if TIME_LO >= 0
        if (threadIdx.x == 0) atomicMax((unsigned long long*)(p.ws + WS_CTL + 917504) + 21, (unsigned long long)__builtin_amdgcn_s_memrealtime());
#endif
    }
    phase_prep_b(p, lds);
#if TIME_LO >= 0
    if (threadIdx.x == 0) atomicMax((unsigned long long*)(p.ws + WS_CTL + 917504) + 20, (unsigned long long)__builtin_amdgcn_s_memrealtime());
#endif
    GRID_BAR();
#if DBG == 1
    { InProjN f{p, true}; phase_naive_gemm(f, T, C_VB, bid, nb, lds); }
    GRID_BAR();
    { COORDS(); phase_check(p, (const bf16*)(p.ws + WS_QA), (const bf16*)(p.ws + 426 * MiB), (size_t)T * WA, gtid, ngt);
      phase_check(p, (const bf16*)(p.ws + WS_KA), (const bf16*)(p.ws + 442 * MiB), (size_t)T * WA, gtid, ngt);
      phase_check(p, (const bf16*)(p.ws + WS_QB), (const bf16*)(p.ws + 458 * MiB), (size_t)T * WB, gtid, ngt);
      phase_check(p, (const bf16*)(p.ws + WS_KB), (const bf16*)(p.ws + 482 * MiB), (size_t)T * WB, gtid, ngt); }
    GRID_BAR();
#endif
    { COORDS(); phase_select_lists(p, bid, nb, lds, tid); phase_dilated(p, bid, nb, lds, tid); }
    GRID_BAR();
    { COORDS(); phase_moba_past(p, bid, nb, lds, tid); }
    GRID_BAR();
    { COORDS(); phase_moba_own(p, bid, nb, lds, tid); phase_dil_merge(p, gtid, ngt); }
    GRID_BAR();
#if DBG == 2
    { COORDS(); phase_moba_naive(p, gw, ngw, lane, wl, (bf16*)p.out); phase_dil_naive(p, gw, ngw, lane, wl, (bf16*)p.out + (size_t)T * WA); }
    GRID_BAR();
    { COORDS();
#if DBG_SUB == 0
      phase_check(p, (const bf16*)(p.ws + WS_OA), (const bf16*)p.out, (size_t)T * WA, gtid, ngt);
#else
      phase_check(p, (const bf16*)(p.ws + WS_OB), (const bf16*)p.out + (size_t)T * WA, (size_t)T * WBO, gtid, ngt);
#endif
    }
    GRID_BAR();
#endif
    { pg8::Order O; O.init(T / 256, D / 256, nb, bid); ProbPlainOff P{(const bf16*)p.out, (const bf16*)(p.ws + WS_WOA), WA + WBO}; EpiMixCat E{p};
      pg8::gemm_phase<EpiMixCat, ProbPlainOff, true>((PG8_LAS unsigned char*)lds, P, O, E); }
    GRID_BAR();
    { ProbPlain P{(const bf16*)(p.ws + WS_MIX), (const bf16*)(p.ws + WS_WOUT), D}; pg8::Order O; O.init(T / 256, D / 256, nb, bid); EpiOut E{p};
      pg8::gemm_phase<EpiOut, ProbPlain, true>((PG8_LAS unsigned char*)lds, P, O, E); }
    GRID_BAR();
    { COORDS(); phase_router(p, bid, nb, lds, tid); }
    GRID_BAR();
    { COORDS(); MoeTab mt; const int n_mt = moe_tables<false>(p, lds, tid, 2 * FF / 256, nb, bid, mt);
      ProbMoE<true, (FP8_GU != 0)> P{(const bf16*)(p.ws + WS_H), (const bf16*)(p.ws + WS_WGU), FP8_GU ? D / 2 : D, mt, 2 * FF}; pg8::Order O; O.init(n_mt, 2 * FF / 256, nb, bid); EpiGateUp E{p, mt};
      pg8::gemm_phase<EpiGateUp, ProbMoE<true, (FP8_GU != 0)>, true>((PG8_LAS unsigned char*)lds, P, O, E); }
    GRID_BAR();
    { COORDS(); MoeTab mt; const int n_mt = moe_tables<true>(p, lds, tid, D / 256, nb, bid, mt);
      ProbMoE<false, (FP8_DN != 0)> P{(const bf16*)(p.ws + WS_A2), (const bf16*)(p.ws + WS_WD), FP8_DN ? FF / 2 : FF, mt, D}; pg8::Order O; O.init(n_mt, D / 256, nb, bid); EpiDown E{p, mt};
      pg8::gemm_phase<EpiDown, ProbMoE<false, (FP8_DN != 0)>, true>((PG8_LAS unsigned char*)lds, P, O, E); }
    GRID_BAR();
    { COORDS(); phase_final(p, gw, ngw, lane); }
#if TIME_LO >= 0
    if (bid == 0 && threadIdx.x == 0) { STAMP();
        const unsigned long long* ts = (const unsigned long long*)(p.ws + WS_CTL + 917504);
        const unsigned long long dt = (ts[TIME_HI] - ts[TIME_LO]) * TIME_MULT, t0 = __builtin_amdgcn_s_memrealtime();
        while (__builtin_amdgcn_s_memrealtime() - t0 < dt) __builtin_amdgcn_s_sleep(8); }
#endif
}

#ifdef TIME_LO
#define TIME_LO_HOST TIME_LO
#else
#define TIME_LO_HOST -1
#endif
extern "C" void kernel_launch(void* const* d_in, const int* in_sizes, int n_in, void* d_out, int out_size, void* d_ws, size_t ws_size, hipStream_t stream) {
    if (n_in != 18 || ws_size < WS_END || out_size != T * D) return;
    static int grid_blocks = 0;
    if (!grid_blocks) {
        int dev = 0, cus = 0, per_cu = 0;
        (void)hipGetDevice(&dev);
        (void)hipDeviceGetAttribute(&cus, hipDeviceAttributeMultiprocessorCount, dev);
        (void)hipFuncSetAttribute((const void*)mega_fwd, hipFuncAttributeMaxDynamicSharedMemorySize, LDS_BYTES);
        (void)hipOccupancyMaxActiveBlocksPerMultiprocessor(&per_cu, (const void*)mega_fwd, 512, LDS_BYTES);
        if (per_cu < 1) per_cu = 1;
        if (per_cu > 1) per_cu = 1;
        grid_blocks = cus * per_cu;
    }
    Params p{};
    const float** fp = (const float**)&p;
    for (int i = 0; i < 18; ++i) fp[i] = (const float*)d_in[i];
    p.out = (float*)d_out; p.ws = (unsigned char*)d_ws;
    for (int i = 0; i < 8; ++i) p.inv_freq[i] = (float)pow(500000.0, -(double)i / 8.0);
    (void)hipMemsetAsync((char*)d_ws + WS_CTL, 0, (TIME_LO_HOST >= 0) ? 1 * MiB : 64 * 1024, stream);
    void* args[] = {&p};
    (void)hipLaunchCooperativeKernel((const void*)mega_fwd, dim3(grid_blocks), dim3(512), args, LDS_BYTES, stream);
}
```

```cpp
#include <hip/hip_runtime.h>
#include <hip/hip_cooperative_groups.h>
namespace cg = cooperative_groups;
#include <stdint.h>
#include <math.h>

typedef unsigned short bf16;
typedef float f32x4 __attribute__((ext_vector_type(4)));
typedef unsigned u32x4 __attribute__((ext_vector_type(4)));
typedef unsigned u32x2 __attribute__((ext_vector_type(2)));

__device__ __forceinline__ float bf2f(bf16 v) { return __uint_as_float(((unsigned)v) << 16); }
__device__ __forceinline__ unsigned f2bf(float f) { unsigned u = __float_as_uint(f); return (u + 0x7fffu + ((u >> 16) & 1u)) >> 16; }
__device__ __forceinline__ unsigned pk2(float lo, float hi) { return f2bf(lo) | (f2bf(hi) << 16); }

typedef float f32x2 __attribute__((ext_vector_type(2)));
typedef __bf16 bf16x2_t __attribute__((ext_vector_type(2)));
__device__ __forceinline__ unsigned cvtpk(float lo, float hi) { f32x2 v = {lo, hi}; bf16x2_t b = __builtin_convertvector(v, bf16x2_t); return __builtin_bit_cast(unsigned, b); }
__device__ __forceinline__ float fast_sigmoid(float x) { return __builtin_amdgcn_rcpf(1.0f + __builtin_amdgcn_exp2f(-1.4426950408889634f * x)); }
typedef float f32x16 __attribute__((ext_vector_type(16)));
typedef short s16x4 __attribute__((ext_vector_type(4)));
typedef short bf16x8v __attribute__((ext_vector_type(8)));
__device__ __forceinline__ int crow(int r, int h) { return (r & 3) + 8 * (r >> 2) + 4 * h; }
#define GAS __attribute__((address_space(1)))
#define LAS __attribute__((address_space(3)))
typedef bf16 act;
__device__ __forceinline__ float ldact(const act* p) { return bf2f(*p); }
__device__ __forceinline__ void stact(act* p, float v) { *p = (bf16)f2bf(v); }
__device__ __forceinline__ void ldact8(const act* p, float (&o)[8]) { const u32x4 a = *(const u32x4*)p;
#pragma unroll
    for (int i = 0; i < 4; ++i) { o[2 * i] = __uint_as_float(a[i] << 16); o[2 * i + 1] = __uint_as_float(a[i] & 0xffff0000u); } }
#ifndef FP8_GU
#define FP8_GU 1
#endif
#ifndef FP8_DN
#define FP8_DN 1
#endif
#ifndef FP8_IN
#define FP8_IN 1
#endif
#ifndef FP8_Y
#define FP8_Y 1
#endif
#ifndef FP8_MOE
#define FP8_MOE 1
#endif
constexpr int NB = 2, S = 8192, T = NB * S, D = 1024, HD = 64;
constexpr int NHA = 8, NHB = 12, WA = 512, WB = 768, WBO = 256, NCOL = 5888;
constexpr int MBLK = 256, NBLK = S / MBLK;
constexpr int NE = 32, TOPK = 4, FF = 1024;
constexpr int A2ROWS = 73728;
constexpr int C_QA = 0, C_KA = 512, C_VA = 1024, C_QB = 1536, C_KB = 2304, C_VB = 3072, C_GA = 3840, C_GB = 4864;
constexpr float NORM_EPS = 1e-5f;

constexpr size_t MiB = 1u << 20;
constexpr size_t WS_CTL = 0;
constexpr size_t WS_WIN = 1 * MiB;
constexpr size_t WS_WOA = 13 * MiB;
constexpr size_t WS_WOB = 14 * MiB;
constexpr size_t WS_WOUT = 15 * MiB;
constexpr size_t WS_WGU = 17 * MiB;
constexpr size_t WS_WD = 145 * MiB;
constexpr size_t WS_ROPE = 209 * MiB;
constexpr size_t WS_KMEAN = WS_ROPE + 512 * 1024;
constexpr size_t WS_H = 210 * MiB;
constexpr size_t WS_QA = 242 * MiB, WS_KA = 258 * MiB, WS_VA = 274 * MiB;
constexpr size_t WS_QB = 290 * MiB, WS_KB = 314 * MiB, WS_VB = 338 * MiB;
constexpr size_t WS_SA = 362 * MiB, WS_SB = 394 * MiB;
constexpr size_t WS_PARTB = 210 * MiB;
constexpr size_t WS_LSEB = 234 * MiB;
constexpr size_t WS_LSEA = 235 * MiB;
constexpr size_t WS_SEL = 236 * MiB + 512 * 1024;
constexpr size_t WS_LIST = 426 * MiB;
constexpr size_t WS_PARTA = 442 * MiB;
constexpr int LIST_CAP = 8192;
constexpr size_t WS_OB = 434 * MiB;
constexpr size_t WS_OA = 490 * MiB;
constexpr size_t WS_MIX = 242 * MiB;
constexpr size_t WS_A2 = 242 * MiB;
constexpr size_t WS_ELIST = 386 * MiB;
constexpr size_t WS_EP = 388 * MiB;
constexpr size_t WS_ROWTOK = 390 * MiB;
constexpr size_t WS_ROWP = 391 * MiB;
constexpr size_t WS_TILEE = 392 * MiB;
constexpr size_t WS_Y = 17 * MiB;
constexpr size_t WS_END = 512 * MiB;
#ifndef TIMEB_LO
#define TIMEB_LO -1
#endif
#ifndef TIMEB_HI
#define TIMEB_HI -1
#endif
#ifndef TIMEB_GAIN
#define TIMEB_GAIN 1.0f
#endif
#ifndef DBG
#define DBG 0
#endif
#ifndef DBG_SUB
#define DBG_SUB 0
#endif
#ifndef DBG_GAIN
#define DBG_GAIN 100.0f
#endif
constexpr int CW_DNUM = 192, CW_DDEN = 193;
constexpr int CW_ECNT = 8192;
constexpr int CW_BAR = 4096;
constexpr int CW_LCNT = 12288;
constexpr int CW_HQ = 224;
constexpr int CW_NMT = 160;

struct Params {
    const float *x, *ln_mix_g, *w_in, *b_gate_a, *b_gate_b, *w_o_a, *w_o_b, *w_out, *ln_ffn_g, *w_router, *b_router,
        *w_gate, *b_gate, *w_up, *b_up, *w_down, *b_down, *ln_final_g;
    float* out; unsigned char* ws;
    float inv_freq[8];
    int use_cg, pad0;
};

template <int MAP> __device__ __forceinline__ int rowmap(int n) { return MAP == 0 ? n : (32 * (n >> 4) + (n & 15) + (MAP == 2 ? 16 : 0)); }
template <int MAP> __device__ __forceinline__ void transpose_item(const float* W, int K, int N, bf16* WT, float* scr, int item, int lane) {
    const int nblk = N / 64, kb = item / nblk, nb = item % nblk, k0 = 64 * kb, n0 = 64 * nb;
    f32x4 v[16];
#pragma unroll
    for (int i = 0; i < 16; ++i) v[i] = *(const f32x4*)(W + (size_t)(k0 + (lane >> 4) + 4 * i) * N + n0 + 4 * (lane & 15));
#pragma unroll
    for (int i = 0; i < 16; ++i) { float* d = scr + ((lane >> 4) + 4 * i) * 65 + 4 * (lane & 15); d[0] = v[i].x; d[1] = v[i].y; d[2] = v[i].z; d[3] = v[i].w; }
    asm volatile("s_waitcnt lgkmcnt(0)" ::: "memory");
    const int c = lane & 7;
#pragma unroll
    for (int j = 0; j < 8; ++j) { const int n = (lane >> 3) + 8 * j; const float* q = scr + (8 * c) * 65 + n;
        u32x4 o; o.x = cvtpk(q[0 * 65], q[1 * 65]); o.y = cvtpk(q[2 * 65], q[3 * 65]); o.z = cvtpk(q[4 * 65], q[5 * 65]); o.w = cvtpk(q[6 * 65], q[7 * 65]);
        *(u32x4*)(WT + (size_t)rowmap<MAP>(n0 + n) * K + k0 + 8 * c) = o; }
    asm volatile("s_waitcnt lgkmcnt(0)" ::: "memory");
}
__device__ __forceinline__ float wave_sum(float v) {
#pragma unroll
    for (int o = 1; o < 64; o <<= 1) v += __shfl_xor(v, o);
    return v;
}
__device__ __forceinline__ void sincos_acc(float ang, float& c, float& s) {
    const double a = (double)ang; const double k = rint(a * 0.63661977236758134308); const double y = a - k * 1.57079632679489661923; const double y2 = y * y;
    const double sn = y * (1.0 + y2 * (-1.0 / 6 + y2 * (1.0 / 120 + y2 * (-1.0 / 5040 + y2 * (1.0 / 362880 + y2 * (-1.0 / 39916800))))));
    const double cs = 1.0 + y2 * (-0.5 + y2 * (1.0 / 24 + y2 * (-1.0 / 720 + y2 * (1.0 / 40320 + y2 * (-1.0 / 3628800 + y2 * (1.0 / 479001600))))));
    const int q = ((int)k) & 3;
    const double ss = (q == 0) ? sn : (q == 1) ? cs : (q == 2) ? -sn : -cs;
    const double cc = (q == 0) ? cs : (q == 1) ? -sn : (q == 2) ? -cs : sn;
    c = (float)cc; s = (float)ss;
}
struct TItem { const float* W; bf16* WT; int K, N, map, k0, n0, f8, kd; };
__device__ __forceinline__ TItem titem_decode(const Params& p, int it) {
    constexpr int I_OA = (WA / 64) * (D / 32), I_OB = (WBO / 64) * (D / 32), I_OUT = (D / 64) * (D / 32), I_E = (D / 64) * (FF / 32);
    static_assert(I_E == 512 && D == 1024 && FF == 1024, "the expert-matrix decode below uses shifts");
    unsigned char* ws = p.ws; TItem t; int r = it; t.f8 = 0; t.kd = 0; t.N = D; t.map = 0;
    if (r >= I_OA + I_OB + I_OUT) {
        r -= I_OA + I_OB + I_OUT; const int which = r >> 14  , e = (r >> 9) & 31; r &= 511; t.K = D;
        t.f8 = (which == 2) ? (FP8_DN ? 1 : 0) : (FP8_GU ? 1 : 0); const size_t esz = t.f8 ? 1 : 2;
        if (which == 0) { t.W = p.w_gate + (size_t)e * D * FF; t.WT = (bf16*)(ws + WS_WGU + (size_t)e * 2 * FF * D * esz); t.map = 1; }
        else if (which == 1) { t.W = p.w_up + (size_t)e * D * FF; t.WT = (bf16*)(ws + WS_WGU + (size_t)e * 2 * FF * D * esz); t.map = 2; }
        else { t.W = p.w_down + (size_t)e * FF * D; t.WT = (bf16*)(ws + WS_WD + (size_t)e * D * FF * esz); }
    }
    else if (r < I_OA) { t.W = p.w_o_a; t.WT = (bf16*)(ws + WS_WOA); t.K = WA + WBO; }
    else if ((r -= I_OA) < I_OB) { t.W = p.w_o_b; t.WT = (bf16*)(ws + WS_WOA); t.K = WA + WBO; t.kd = WA; }
    else { r -= I_OB; t.W = p.w_out; t.WT = (bf16*)(ws + WS_WOUT); t.K = D; }
    const int pr_ = r >> 1; t.k0 = 64 * (2 * (pr_ >> 5) + (r & 1)); t.n0 = 32 * (pr_ & 31);
    return t;
}
__device__ __forceinline__ void titem_load(const TItem& t, f32x4 (&v)[8], int lane) {
#pragma unroll
    for (int i = 0; i < 8; ++i) v[i] = __builtin_nontemporal_load((const f32x4*)(t.W + (size_t)(t.k0 + (lane >> 3) + 8 * i) * t.N + t.n0 + 4 * (lane & 7)));
}
__device__ __forceinline__ void titem_store(const TItem& t, const f32x4 (&v)[8], float* scr, int lane) {
#pragma unroll
    for (int i = 0; i < 8; ++i) { float* d = scr + ((lane >> 3) + 8 * i) * 33 + 4 * (lane & 7); d[0] = v[i].x; d[1] = v[i].y; d[2] = v[i].z; d[3] = v[i].w; }
    asm volatile("s_waitcnt lgkmcnt(0)" ::: "memory");
    const int c = (lane & 3) + 4 * (lane >> 5);
#pragma unroll
    for (int j = 0; j < 4; ++j) { const int n = ((lane >> 2) & 7) + 8 * j; const float* q = scr + (8 * c) * 33 + n; const int nn = t.n0 + n;
        const int row = t.map == 0 ? nn : (32 * (nn >> 4) + (nn & 15) + (t.map == 2 ? 16 : 0));
        if (t.f8) { int w0 = __builtin_amdgcn_cvt_pk_fp8_f32(q[0 * 33] * 64.f, q[1 * 33] * 64.f, 0, false); w0 = __builtin_amdgcn_cvt_pk_fp8_f32(q[2 * 33] * 64.f, q[3 * 33] * 64.f, w0, true);
            int w1 = __builtin_amdgcn_cvt_pk_fp8_f32(q[4 * 33] * 64.f, q[5 * 33] * 64.f, 0, false); w1 = __builtin_amdgcn_cvt_pk_fp8_f32(q[6 * 33] * 64.f, q[7 * 33] * 64.f, w1, true);
            u32x2 o; o.x = (unsigned)w0; o.y = (unsigned)w1; *(u32x2*)((unsigned char*)t.WT + (size_t)row * t.K + t.kd + t.k0 + 8 * c) = o; }
        else { u32x4 o; o.x = cvtpk(q[0 * 33], q[1 * 33]); o.y = cvtpk(q[2 * 33], q[3 * 33]); o.z = cvtpk(q[4 * 33], q[5 * 33]); o.w = cvtpk(q[6 * 33], q[7 * 33]);
            *(u32x4*)(t.WT + (size_t)row * t.K + t.kd + t.k0 + 8 * c) = o; } }
    asm volatile("s_waitcnt lgkmcnt(0)" ::: "memory");
}
__device__ __forceinline__ void phase_prep_a(const Params& p, int bid, int nb, unsigned char* lds) {
    int tid = threadIdx.x; asm volatile("" : "+v"(tid)); const int lane = tid & 63, wave = tid >> 6;
    const int gw = bid * 8 + wave, NGW = nb * 8;
    unsigned char* ws = p.ws;
    float* scr = (float*)lds + wave * (64 * 33);
    constexpr int I_IN = (D / 64) * (NCOL / 32);
    for (int it = gw; it < I_IN; it += NGW) {
        TItem t; t.W = p.w_in; t.WT = (bf16*)(ws + WS_WIN); t.K = D; t.N = NCOL; t.map = 0; t.f8 = FP8_IN; t.kd = 0; t.k0 = 64 * (it / (NCOL / 32)); t.n0 = 32 * (it % (NCOL / 32));
        f32x4 v[8]; titem_load(t, v, lane); titem_store(t, v, scr, lane);
    }
    for (int m = gw; m < T; m += NGW) {
        const f32x4* xr = (const f32x4*)(p.x + (size_t)m * D) + lane; const f32x4* gr = (const f32x4*)p.ln_mix_g + lane;
        f32x4 v[4]; float s = 0.f;
#pragma unroll
        for (int j = 0; j < 4; ++j) { v[j] = xr[64 * j]; s += (v[j].x * v[j].x + v[j].y * v[j].y) + (v[j].z * v[j].z + v[j].w * v[j].w); }
        const float rstd = 1.0f / sqrtf(wave_sum(s) * (1.0f / D) + NORM_EPS);
#pragma unroll
        for (int j = 0; j < 4; ++j) { const f32x4 g = gr[64 * j];
#if FP8_IN
            int o = __builtin_amdgcn_cvt_pk_fp8_f32(v[j].x * rstd * g.x, v[j].y * rstd * g.y, 0, false); o = __builtin_amdgcn_cvt_pk_fp8_f32(v[j].z * rstd * g.z, v[j].w * rstd * g.w, o, true);
            ((int*)((unsigned char*)(ws + WS_H) + (size_t)m * D))[lane + 64 * j] = o;
#else
            u32x2 o; o.x = cvtpk(v[j].x * rstd * g.x, v[j].y * rstd * g.y); o.y = cvtpk(v[j].z * rstd * g.z, v[j].w * rstd * g.w); ((u32x2*)((bf16*)(ws + WS_H) + (size_t)m * D))[lane + 64 * j] = o;
#endif
        }
    }
    float2* rope = (float2*)(ws + WS_ROPE);
    for (int i = bid * 512 + tid; i < S * 8; i += nb * 512) { const int s = i >> 3, f = i & 7; const float ang = (float)s * p.inv_freq[f]; float c, sn; sincos_acc(ang, c, sn); rope[i] = make_float2(c, sn); }
    for (int i = bid * 512 + tid; i < NB * NHA * NBLK * HD; i += nb * 512) ((float*)(ws + WS_KMEAN))[i] = 0.f;
}
__device__ __forceinline__ void phase_prep_b(const Params& p, unsigned char* lds) {
    int tid = threadIdx.x; asm volatile("" : "+v"(tid)); const int lane = tid & 63, wave = tid >> 6;
    float* scr = (float*)lds + wave * (64 * 33);
    constexpr int NITEMS = (WA / 64) * (D / 32) + (WBO / 64) * (D / 32) + (D / 64) * (D / 32) + 3 * NE * (D / 64) * (FF / 32);
    int* ctr = (int*)(p.ws + WS_CTL) + CW_HQ;
    int qcur = 0, qend = 0; bool qdone = false;
#define TQ_NEXT(dst) do { if (qcur == qend && !qdone) { int b_ = 0; if (lane == 0) b_ = atomicAdd(ctr, 8); b_ = __builtin_amdgcn_readfirstlane(b_); \
        if (b_ >= NITEMS) qdone = true; else { qcur = b_; qend = (b_ + 8 < NITEMS) ? b_ + 8 : NITEMS; } } \
        if (qcur < qend) dst = qcur++; else dst = -1; } while (0)
    TItem ta, tb, tc; f32x4 va[8], vb[8], vc[8];
    int ia, ib, ic;
    TQ_NEXT(ia); if (ia >= 0) { ta = titem_decode(p, ia); titem_load(ta, va, lane); }
    TQ_NEXT(ib); if (ib >= 0) { tb = titem_decode(p, ib); titem_load(tb, vb, lane); }
    while (ia >= 0) {
        TQ_NEXT(ic); if (ic >= 0) { tc = titem_decode(p, ic); titem_load(tc, vc, lane); }
        titem_store(ta, va, scr, lane);
        if (ib < 0) break;
        TQ_NEXT(ia); if (ia >= 0) { ta = titem_decode(p, ia); titem_load(ta, va, lane); }
        titem_store(tb, vb, scr, lane);
        if (ic < 0) break;
        TQ_NEXT(ib); if (ib >= 0) { tb = titem_decode(p, ib); titem_load(tb, vb, lane); }
        titem_store(tc, vc, scr, lane);
    }
#undef TQ_NEXT
}

__device__ __forceinline__ int cl(int tx, int j) { return (tx & 7) + 8 * j + 32 * (tx >> 3); }
template <class F> __device__ __forceinline__ void phase_naive_gemm(const F& f, int M, int N, int bid, int nb, unsigned char* lds) {
    const int half = threadIdx.x >> 8, tid = threadIdx.x & 255, tx = tid & 15, ty = tid >> 4;
    float (*As)[33] = (float (*)[33])(lds + half * (2 * 64 * 33 * 4)); float (*Bs)[33] = As + 64;
    const int nN = N / 64, ntiles = (M / 64) * nN, stride = nb * 2;
    const int nround = (ntiles + stride - 1) / stride;
    const int lr = tid >> 2, lk = (tid & 3) * 8;
    for (int r = 0; r < nround; ++r) {
        const int it = r * stride + bid * 2 + half;
        const bool valid = it < ntiles;
        const int m0 = valid ? (it / nN) * 64 : 0, n0 = valid ? (it % nN) * 64 : 0;
        const bool act_ = valid && f.active(m0);
        float acc[F::NPASS][4][4];
#pragma unroll
        for (int ps = 0; ps < F::NPASS; ++ps)
#pragma unroll
            for (int i = 0; i < 4; ++i)
#pragma unroll
                for (int j = 0; j < 4; ++j) acc[ps][i][j] = 0.f;
#pragma unroll
        for (int ps = 0; ps < F::NPASS; ++ps) {
            const int K = f.K(ps);
            const bf16* ap = act_ ? f.arow(ps, m0 + lr) : nullptr; const bf16* bp = act_ ? f.brow(ps, m0, n0 + lr) : nullptr;
            for (int k0 = 0; k0 < K; k0 += 32) {
                float av[8], bv[8];
                if (act_) { ldact8(ap + k0 + lk, av); ldact8(bp + k0 + lk, bv); }
                else {
#pragma unroll
                    for (int i = 0; i < 8; ++i) { av[i] = 0.f; bv[i] = 0.f; } }
                __syncthreads();
#pragma unroll
                for (int i = 0; i < 8; ++i) { As[lr][lk + i] = av[i]; Bs[lr][lk + i] = bv[i]; }
                __syncthreads();
#pragma unroll 8
                for (int kk = 0; kk < 32; ++kk) {
                    float a[4], b[4];
#pragma unroll
                    for (int i = 0; i < 4; ++i) { a[i] = As[ty * 4 + i][kk]; b[i] = Bs[cl(tx, i)][kk]; }
#pragma unroll
                    for (int i = 0; i < 4; ++i)
#pragma unroll
                        for (int j = 0; j < 4; ++j) acc[ps][i][j] += a[i] * b[j];
                }
            }
        }
        if (act_) {
#pragma unroll
            for (int i = 0; i < 4; ++i) f.epi(m0 + ty * 4 + i, n0, tx, acc[0][i], acc[F::NPASS - 1][i]);
        }
    }
}

struct InProjN {
    static constexpr int NPASS = 1; Params p; bool alt;
    __device__ __forceinline__ bool active(int) const { return true; }
    __device__ __forceinline__ int K(int) const { return D; }
    __device__ __forceinline__ int ldb(int) const { return NCOL; }
    __device__ __forceinline__ const act* arow(int, int m) const { return (const act*)(p.ws + WS_H) + (size_t)m * D; }
    __device__ __forceinline__ const bf16* brow(int, int, int n) const { return (const bf16*)(p.ws + WS_WIN) + (size_t)n * D; }
    __device__ __forceinline__ void epi(int m, int n0, int tx, float (&v)[4], float (&)[4]) const {
        unsigned char* ws = p.ws;
        act* dst; int ld, cb; bool rope = false; const float* gbias = nullptr;
        if (n0 < C_KA) { dst = (act*)(ws + (alt ? 426 * MiB : WS_QA)); ld = WA; cb = n0 - C_QA; rope = true; }
        else if (n0 < C_VA) { dst = (act*)(ws + (alt ? 442 * MiB : WS_KA)); ld = WA; cb = n0 - C_KA; rope = true; }
        else if (n0 < C_QB) { if (alt) return; dst = (act*)(ws + WS_VA); ld = WA; cb = n0 - C_VA; }
        else if (n0 < C_KB) { dst = (act*)(ws + (alt ? 458 * MiB : WS_QB)); ld = WB; cb = n0 - C_QB; rope = true; }
        else if (n0 < C_VB) { dst = (act*)(ws + (alt ? 482 * MiB : WS_KB)); ld = WB; cb = n0 - C_KB; rope = true; }
        else if (alt) { return; }
        else if (n0 < C_GA) { dst = (act*)(ws + WS_VB); ld = WB; cb = n0 - C_VB; }
        else if (n0 < C_GB) { dst = (act*)(ws + WS_SA); ld = D; cb = n0 - C_GA; gbias = p.b_gate_a; }
        else { dst = (act*)(ws + WS_SB); ld = D; cb = n0 - C_GB; gbias = p.b_gate_b; }
        if (rope && (tx >> 3) == 0) {
            const float2 cs = ((const float2*)(ws + WS_ROPE))[(m % S) * 8 + (tx & 7)];
            const float x1 = v[0], x2 = v[1]; v[0] = x1 * cs.x - x2 * cs.y; v[1] = x2 * cs.x + x1 * cs.y;
        }
#pragma unroll
        for (int j = 0; j < 4; ++j) { const int c = cb + cl(tx, j); float o = v[j];
            if (gbias) { o = 1.0f / (1.0f + expf(-(o + gbias[c]))); }
            stact(dst + (size_t)m * ld + c, o); }
    }
};
struct MixN {
    static constexpr int NPASS = 2; Params p;
    __device__ __forceinline__ bool active(int) const { return true; }
    __device__ __forceinline__ int K(int ps) const { return ps == 0 ? WA : WBO; }
    __device__ __forceinline__ int ldb(int) const { return D; }
    __device__ __forceinline__ const act* arow(int ps, int m) const { return ps == 0 ? (const act*)(p.ws + WS_OA) + (size_t)m * WA : (const act*)(p.ws + WS_OB) + (size_t)m * WBO; }
    __device__ __forceinline__ const bf16* brow(int ps, int, int n) const { return ps == 0 ? (const bf16*)(p.ws + WS_WOA) + (size_t)n * WA : (const bf16*)(p.ws + WS_WOB) + (size_t)n * WBO; }
    __device__ __forceinline__ void epi(int m, int n0, int tx, float (&a)[4], float (&b)[4]) const {
#pragma unroll
        for (int j = 0; j < 4; ++j) { const int c = n0 + cl(tx, j); const size_t o = (size_t)m * D + c;
            const float sa = ldact((const act*)(p.ws + WS_SA) + o), sb = ldact((const act*)(p.ws + WS_SB) + o);
            stact((act*)(p.ws + WS_MIX) + o, sa * a[j] + sb * b[j]); }
    }
};
struct OutN {
    static constexpr int NPASS = 1; Params p;
    __device__ __forceinline__ bool active(int) const { return true; }
    __device__ __forceinline__ int K(int) const { return D; }
    __device__ __forceinline__ int ldb(int) const { return D; }
    __device__ __forceinline__ const act* arow(int, int m) const { return (const act*)(p.ws + WS_MIX) + (size_t)m * D; }
    __device__ __forceinline__ const bf16* brow(int, int, int n) const { return (const bf16*)(p.ws + WS_WOUT) + (size_t)n * D; }
    __device__ __forceinline__ void epi(int m, int n0, int tx, float (&a)[4], float (&)[4]) const {
#pragma unroll
        for (int j = 0; j < 4; ++j) { const size_t o = (size_t)m * D + n0 + cl(tx, j); p.out[o] = p.x[o] + a[j]; }
    }
};


namespace pg8 {
#define PG8_LAS __attribute__((address_space(3)))
typedef short bf16x8 __attribute__((ext_vector_type(8)));
typedef int v4i_t __attribute__((ext_vector_type(4)));
typedef int v8i_t __attribute__((ext_vector_type(8)));
constexpr int BM = 256, BK = 64, HALF = 128, HTB = HALF * BK * 2  , STAGE_BYTES = 8 * HTB, NXCD = 8, WGM = 8;
__device__ __forceinline__ int lds_byte(int r, int c) { const int st = (r >> 4) * 2 + (c >> 5), rr = r & 15, cc = c & 31, ob = rr * 64 + cc * 2; return st * 1024 + (ob ^ (((ob >> 9) & 1) << 5)); }
__device__ __forceinline__ void stage_rc(int b, int& R, int& C) { const int st = b / 1024, sb = b % 1024, swz = sb ^ (((sb >> 9) & 1) << 5); R = (st >> 1) * 16 + swz / 64; C = (st & 1) * 32 + (swz % 64) / 2; }
__device__ __forceinline__ int perm32(int rho) { const int n = rho >> 4, i = rho & 15; return 8 * (i >> 2) + 4 * n + (i & 3); }
struct Unit { int pm, pn, slot; };
struct Order {
    int nM, nN, nwg, G, c;
    __device__ __forceinline__ void init(int nM_, int nN_, int G_, int c_) { nM = nM_; nN = nN_; nwg = nM * nN; G = G_; c = c_; }
    __device__ __forceinline__ bool next(int i, Unit& u) const {
        const long L = (long)i * G + c; if (L >= nwg) return false;
        int wgid = (int)L; { const int q = nwg / NXCD, r = nwg % NXCD, xcd = wgid % NXCD, off = wgid / NXCD; wgid = (xcd < r ? xcd * (q + 1) : r * (q + 1) + (xcd - r) * q) + off; }
        const int nig = WGM * nN, gid = wgid / nig, fm = gid * WGM, gsz = (nM - fm) < WGM ? (nM - fm) : WGM;
        u.pm = fm + ((wgid % nig) % gsz); u.pn = (wgid % nig) / gsz; u.slot = i; return true;
    }
};
template <class Epi, class Prob, bool ALIGN_EPI>
__device__ __forceinline__ void gemm_phase(PG8_LAS unsigned char* lds, const Prob& P, const Order& S, const Epi& E) {
    int tid = threadIdx.x; asm volatile("" : "+v"(tid)); const int wid = __builtin_amdgcn_readfirstlane(tid >> 6), lane = tid & 63, wr = wid >> 2, wc = wid & 3, fr = lane & 15, fq = lane >> 4;
    constexpr bool GATHER = Prob::GATHER; constexpr bool FP8 = Prob::FP8;
    const int K = P.K, nt = K / BK;
    unsigned voffA[2], voffB[2];
#pragma unroll
    for (int i = 0; i < 2; ++i) { int R, C; stage_rc(tid * 16 + i * 8192, R, C); const int Rb = Epi::PERM ? ((R & ~31) + perm32(R & 31)) : R; voffA[i] = (unsigned)(R * K + C) * 2u; voffB[i] = (unsigned)(Rb * K + C) * 2u; }
    const size_t kstep = (size_t)(BK * 2);
    const size_t hstep = (size_t)HALF * K * 2;
    const unsigned ldsw = (unsigned)wid * 1024u;
    const int aoff = lds_byte(wr * 64 + fr, fq * 8), boff = lds_byte(wc * 32 + fr, fq * 8);
    const char* const Ab = (const char*)P.abase();
#define PG8_SA(b, h) (((b) * 2 + (h)) * HTB)
#define PG8_SB(b, h) ((4 + (b) * 2 + (h)) * HTB)
#define PG8_GLDS(src, bufoff, i) __builtin_amdgcn_global_load_lds((const unsigned*)(src), (PG8_LAS unsigned*)(lds + (bufoff) + ldsw + (i) * 8192), 16, 0, 0)
#define PG8_STAGE_B(bufoff, gbase) do { PG8_GLDS((const char*)(gbase) + voffB[0], bufoff, 0); PG8_GLDS((const char*)(gbase) + voffB[1], bufoff, 1); } while (0)
#define PG8_STAGE_A(bufoff, h, kb) do { if constexpr (GATHER) { PG8_GLDS(Ab + (size_t)g[h][0] + (kb), bufoff, 0); PG8_GLDS(Ab + (size_t)g[h][1] + (kb), bufoff, 1); } \
        else { PG8_GLDS(cA + (h) * hstep + (kb) + voffA[0], bufoff, 0); PG8_GLDS(cA + (h) * hstep + (kb) + voffA[1], bufoff, 1); } } while (0)
#define PG8_CAT(x0, x1) __builtin_shufflevector(x0, x1, 0, 1, 2, 3, 4, 5, 6, 7)
#define PG8_LO(x) __builtin_bit_cast(bf16x8, __builtin_shufflevector(x, x, 0, 1, 2, 3))
#define PG8_HI(x) __builtin_bit_cast(bf16x8, __builtin_shufflevector(x, x, 4, 5, 6, 7))
#define PG8_LDA(dst, b, h) do { _Pragma("unroll") for (int m = 0; m < 4; ++m) dst[m] = PG8_CAT(*(const PG8_LAS v4i_t*)(lds + PG8_SA(b, h) + aoff + m * 2048), *(const PG8_LAS v4i_t*)(lds + PG8_SA(b, h) + aoff + m * 2048 + 1024)); } while (0)
#define PG8_LDB(dst, b, h) do { _Pragma("unroll") for (int n = 0; n < 2; ++n) dst[n] = PG8_CAT(*(const PG8_LAS v4i_t*)(lds + PG8_SB(b, h) + boff + n * 2048), *(const PG8_LAS v4i_t*)(lds + PG8_SB(b, h) + boff + n * 2048 + 1024)); } while (0)
#define PG8_MMA(ai, bj, At, Bt) do { __builtin_amdgcn_s_setprio(1); _Pragma("unroll") for (int m = 0; m < 4; ++m) _Pragma("unroll") for (int n = 0; n < 2; ++n) { \
        if constexpr (FP8) acc[ai][bj][m][n] = __builtin_amdgcn_mfma_scale_f32_16x16x128_f8f6f4(Bt[n], At[m], acc[ai][bj][m][n], 0, 0, 0, 0x79797979, 0, 0x7f7f7f7f); \
        else { acc[ai][bj][m][n] = __builtin_amdgcn_mfma_f32_16x16x32_bf16(PG8_LO(Bt[n]), PG8_LO(At[m]), acc[ai][bj][m][n], 0, 0, 0); \
               acc[ai][bj][m][n] = __builtin_amdgcn_mfma_f32_16x16x32_bf16(PG8_HI(Bt[n]), PG8_HI(At[m]), acc[ai][bj][m][n], 0, 0, 0); } } \
        __builtin_amdgcn_s_setprio(0); } while (0)
#define PG8_WAIT_V(n) asm volatile("s_waitcnt vmcnt(" #n ")" ::: "memory")
#define PG8_WAIT_L(n) asm volatile("s_waitcnt lgkmcnt(" #n ")" ::: "memory")
#define PG8_BAR __builtin_amdgcn_s_barrier()
#define PG8_SCHED __builtin_amdgcn_sched_barrier(0)
    Unit cur, nxt; int ui = 0;
    if (!S.next(0, cur)) return;
    f32x4 acc[2][2][4][2];
#pragma unroll
    for (int a = 0; a < 2; ++a)
#pragma unroll
        for (int b = 0; b < 2; ++b)
#pragma unroll
            for (int m = 0; m < 4; ++m)
#pragma unroll
                for (int n = 0; n < 2; ++n) acc[a][b][m][n] = (f32x4){0.f, 0.f, 0.f, 0.f};
    if constexpr (Epi::HAS_INIT) { f32x4 iv[2][2]; E.init_load(iv, cur, wc, fq); E.init_apply(acc, iv); }
    v8i_t At[4], B0[2], B1[2];
    unsigned g[2][2], gn[2][2];
    const char* cA = Ab; const char* nA = Ab;
    if constexpr (GATHER) {
#pragma unroll
        for (int h = 0; h < 2; ++h)
#pragma unroll
            for (int i = 0; i < 2; ++i) { g[h][i] = P.goff(cur, h, voffA[i]); gn[h][i] = g[h][i]; }
    } else { cA = Ab + P.aoff(cur); nA = cA; }
    const char* cB = (const char*)P.bbase(cur);
    PG8_STAGE_B(PG8_SB(0, 0), cB); PG8_STAGE_B(PG8_SB(0, 1), cB + hstep); PG8_STAGE_A(PG8_SA(0, 0), 0, 0); PG8_STAGE_A(PG8_SA(0, 1), 1, 0);
    if (wr == 1) PG8_BAR;
    PG8_WAIT_V(2); PG8_BAR;
    PG8_STAGE_B(PG8_SB(1, 0), cB + kstep); PG8_STAGE_A(PG8_SA(1, 0), 0, kstep); PG8_STAGE_B(PG8_SB(1, 1), cB + hstep + kstep);
    PG8_WAIT_V(6); PG8_BAR;
    for (;;) {
        const bool has_next = S.next(ui + 1, nxt);
        const char* nB = cB;
        if (has_next) { nB = (const char*)P.bbase(nxt);
            if constexpr (GATHER) {
#pragma unroll
                for (int h = 0; h < 2; ++h)
#pragma unroll
                    for (int i = 0; i < 2; ++i) gn[h][i] = P.goff(nxt, h, voffA[i]);
            } else nA = Ab + P.aoff(nxt); }
        for (int t = 0; t < nt; t += 2) {
            const bool last = (t == nt - 2);
            const size_t k1 = (size_t)(t + 1) * kstep;
            const size_t k2 = last ? 0 : (size_t)(t + 2) * kstep, k3 = k2 + kstep;
            if constexpr (Epi::MID_T > 0) { if (t == Epi::MID_T) E.mid(acc, cur, wr, wc, fr, fq); }
            PG8_LDB(B0, 0, 0); PG8_LDB(B1, 0, 1); PG8_SCHED; PG8_LDA(At, 0, 0); PG8_STAGE_A(PG8_SA(1, 1), 1, k1);
            if (last) { cB = nB; if constexpr (GATHER) { g[0][0] = gn[0][0]; g[0][1] = gn[0][1]; g[1][0] = gn[1][0]; g[1][1] = gn[1][1]; } else cA = nA; }
            PG8_WAIT_V(8); PG8_WAIT_L(0); PG8_BAR; PG8_MMA(0, 0, At, B0); PG8_MMA(0, 1, At, B1); PG8_BAR; PG8_SCHED;
            PG8_LDA(At, 0, 1); PG8_STAGE_B(PG8_SB(0, 0), cB + k2); PG8_STAGE_B(PG8_SB(0, 1), cB + k2 + hstep); PG8_STAGE_A(PG8_SA(0, 0), 0, k2);
            PG8_WAIT_V(8); PG8_WAIT_L(0); PG8_BAR; PG8_MMA(1, 0, At, B0); PG8_MMA(1, 1, At, B1); PG8_BAR; PG8_SCHED;
            PG8_LDB(B0, 1, 0); PG8_LDB(B1, 1, 1); PG8_SCHED; PG8_LDA(At, 1, 0); PG8_STAGE_A(PG8_SA(0, 1), 1, k2);
            PG8_WAIT_V(8); PG8_WAIT_L(0); PG8_BAR; PG8_MMA(0, 0, At, B0); PG8_MMA(0, 1, At, B1); PG8_BAR; PG8_SCHED;
            PG8_LDA(At, 1, 1); PG8_STAGE_B(PG8_SB(1, 0), cB + k3); PG8_STAGE_B(PG8_SB(1, 1), cB + k3 + hstep); PG8_STAGE_A(PG8_SA(1, 0), 0, k3);
            PG8_WAIT_V(8); PG8_WAIT_L(0); PG8_BAR; PG8_MMA(1, 0, At, B0); PG8_MMA(1, 1, At, B1); PG8_BAR; PG8_SCHED;
        }
        if constexpr (ALIGN_EPI) { if (wr == 0) PG8_BAR; }
        f32x4 iv[2][2];
        if constexpr (Epi::HAS_INIT) { if (has_next) E.init_load(iv, nxt, wc, fq); }
        E(acc, cur, wr, wc, fr, fq);
        if (!has_next) break;
#pragma unroll
        for (int a = 0; a < 2; ++a)
#pragma unroll
            for (int b = 0; b < 2; ++b)
#pragma unroll
                for (int m = 0; m < 4; ++m)
#pragma unroll
                    for (int n = 0; n < 2; ++n) acc[a][b][m][n] = (f32x4){0.f, 0.f, 0.f, 0.f};
        if constexpr (Epi::HAS_INIT) E.init_apply(acc, iv);
        cur = nxt; ++ui;
        if constexpr (ALIGN_EPI) { if (wr == 1) PG8_BAR; }
    }
    PG8_WAIT_V(0);
    if constexpr (!ALIGN_EPI) { if (wr == 0) PG8_BAR; }
    PG8_BAR;
#undef PG8_SA
#undef PG8_SB
#undef PG8_GLDS
#undef PG8_STAGE_A
#undef PG8_STAGE_B
#undef PG8_LDA
#undef PG8_LDB
#undef PG8_MMA
#undef PG8_CAT
#undef PG8_LO
#undef PG8_HI
#undef PG8_WAIT_V
#undef PG8_WAIT_L
#undef PG8_BAR
#undef PG8_SCHED
}
}


constexpr int MT_OFF = 131072;
struct MoeTab { const LAS int* e_of; const LAS int* rt; const LAS float* rp; };
template <bool WITH_P> __device__ __forceinline__ int moe_tables(const Params& p, unsigned char* lds, int tid, int nN, int nb, int bid, MoeTab& mt) {
    LAS int* cnt = (LAS int*)(lds + MT_OFF); LAS int* pstart = cnt + 32; LAS int* e_of = cnt + 72; constexpr int MAXU = WITH_P ? 5 : 9;
    LAS int* rt = cnt + 112; LAS float* rp = (LAS float*)(rt + MAXU * 256);
    __syncthreads();
    if (tid < NE) cnt[tid] = __hip_atomic_load((const int*)(p.ws + WS_CTL) + CW_ECNT + 64 * tid, __ATOMIC_RELAXED, __HIP_MEMORY_SCOPE_AGENT);
    __syncthreads();
    if (tid == 0) { int st = 0; for (int e = 0; e < NE; ++e) { pstart[e] = st; st += (cnt[e] + 255) & ~255; } pstart[32] = st; }
    __syncthreads();
    const int n_mt = __builtin_amdgcn_readfirstlane(pstart[32] >> 8);
    pg8::Order O; O.init(n_mt, nN, nb, bid);
    LAS int* pm_of = cnt + 88;
    if (tid < MAXU) { pg8::Unit u; int e = 0, pm = -1;
        if (O.next(tid, u)) { pm = u.pm; for (int q = 1; q < NE; ++q) if (pm * 256 >= pstart[q]) e = q; }
        e_of[tid] = e; pm_of[tid] = pm; }
    __syncthreads();
    for (int idx = tid; idx < MAXU * 256; idx += 512) { const int i = idx >> 8, r = idx & 255, pm = pm_of[i];
        if (pm >= 0) { const int e = e_of[i]; const int pos = pm * 256 + r - pstart[e]; const bool ok = pos < cnt[e];
            rt[idx] = ok ? ((const int*)(p.ws + WS_ELIST))[e * T + pos] : -1;
            if (WITH_P) rp[idx] = ok ? ((const float*)(p.ws + WS_EP))[e * T + pos] : 0.f; } }
    __syncthreads();
    mt.e_of = e_of; mt.rt = rt; mt.rp = rp;
    return n_mt;
}
struct ProbPlain {
    static constexpr bool GATHER = false, FP8 = false;
    const bf16* A; const bf16* Bt; int K;
    __device__ __forceinline__ const bf16* abase() const { return A; }
    __device__ __forceinline__ size_t aoff(const pg8::Unit& u) const { return (size_t)u.pm * 256 * K * 2; }
    __device__ __forceinline__ unsigned goff(const pg8::Unit&, int, unsigned) const { return 0u; }
    __device__ __forceinline__ const bf16* bbase(const pg8::Unit& u) const { return Bt + (size_t)u.pn * 256 * K; }
};
struct ProbPlainOff {
    static constexpr bool GATHER = true, FP8 = false;
    const bf16* A; const bf16* Bt; int K;
    __device__ __forceinline__ const bf16* abase() const { return A; }
    __device__ __forceinline__ size_t aoff(const pg8::Unit& u) const { return (size_t)u.pm * 256 * K * 2; }
    __device__ __forceinline__ unsigned goff(const pg8::Unit& u, int h, unsigned voff) const { return (unsigned)(u.pm * 256 + h * 128) * ((unsigned)K * 2u) + voff; }
    __device__ __forceinline__ const bf16* bbase(const pg8::Unit& u) const { return Bt + (size_t)u.pn * 256 * K; }
};
struct ProbPlainF8 {
    static constexpr bool GATHER = true, FP8 = true;
    const bf16* A; const bf16* Bt; int K;
    __device__ __forceinline__ const bf16* abase() const { return A; }
    __device__ __forceinline__ size_t aoff(const pg8::Unit& u) const { return (size_t)u.pm * 256 * K * 2; }
    __device__ __forceinline__ unsigned goff(const pg8::Unit& u, int h, unsigned voff) const { return (unsigned)(u.pm * 256 + h * 128) * ((unsigned)K * 2u) + voff; }
    __device__ __forceinline__ const bf16* bbase(const pg8::Unit& u) const { return Bt + (size_t)u.pn * 256 * K; }
};
template <bool G, bool F8> struct ProbMoE {
    static constexpr bool GATHER = true, FP8 = F8;
    const bf16* A; const bf16* Bt; int K; MoeTab mt; int rows_e;
    __device__ __forceinline__ const bf16* abase() const { return A; }
    __device__ __forceinline__ size_t aoff(const pg8::Unit& u) const { return (size_t)u.pm * 256 * K * 2; }
    __device__ __forceinline__ unsigned goff(const pg8::Unit& u, int h, unsigned voff) const {
        const unsigned pitch = (unsigned)K * 2u;
        if constexpr (!G) return (unsigned)(u.pm * 256 + h * 128) * pitch + voff;
        const unsigned R = voff / pitch, inrow = voff - R * pitch;
        const int a = mt.rt[u.slot * 256 + h * 128 + (int)R]; const int row = a < 0 ? 0 : (a >> 2);
        return (unsigned)row * pitch + inrow; }
    __device__ __forceinline__ const bf16* bbase(const pg8::Unit& u) const { const int e = __builtin_amdgcn_readfirstlane(mt.e_of[u.slot]); return Bt + ((size_t)e * rows_e + (size_t)u.pn * 256) * K; }
};
struct EpiInProj {
    static constexpr bool HAS_INIT = false; static constexpr int MID_T = 0; static constexpr bool PERM = true; Params p;
    __device__ __forceinline__ void operator()(const f32x4 (&acc)[2][2][4][2], const pg8::Unit& u, int wr, int wc, int fr, int fq) const {
        unsigned char* ws = p.ws; const int pn = u.pn;
        bf16* dst; int ld, ct; int kind = 0; const float* gb = nullptr;
        if (pn < 2) { dst = (bf16*)(ws + WS_QA); ld = WA; ct = pn * 256; kind = 1; }
        else if (pn < 4) { dst = (bf16*)(ws + WS_KA); ld = WA; ct = (pn - 2) * 256; kind = 1; }
        else if (pn < 6) { dst = (bf16*)(ws + WS_VA); ld = WA; ct = (pn - 4) * 256; }
        else if (pn < 9) { dst = (bf16*)(ws + WS_QB); ld = WB; ct = (pn - 6) * 256; kind = 1; }
        else if (pn < 12) { dst = (bf16*)(ws + WS_KB); ld = WB; ct = (pn - 9) * 256; kind = 1; }
        else if (pn < 15) { dst = (bf16*)(ws + WS_VB); ld = WB; ct = (pn - 12) * 256; }
        else if (pn < 19) { dst = (bf16*)(ws + WS_SA); ld = D; ct = (pn - 15) * 256; kind = 2; gb = p.b_gate_a; }
        else { dst = (bf16*)(ws + WS_SB); ld = D; ct = (pn - 19) * 256; kind = 2; gb = p.b_gate_b; }
        const int row0 = u.pm * 256 + wr * 64 + fr, col0 = ct + wc * 32 + 8 * fq;
        f32x4 bv[2][2];
#pragma unroll
        for (int bj = 0; bj < 2; ++bj)
#pragma unroll
            for (int n = 0; n < 2; ++n) bv[bj][n] = (kind == 2) ? *(const f32x4*)(gb + col0 + bj * 128 + 4 * n) : (f32x4){0.f, 0.f, 0.f, 0.f};
        const bool dorope = (kind == 1) && ((wc & 1) == 0);
        const bool dokm = (pn == 2) || (pn == 3);
        f32x4 ks[2][2];
#pragma unroll
        for (int bj = 0; bj < 2; ++bj) { ks[bj][0] = (f32x4){0.f, 0.f, 0.f, 0.f}; ks[bj][1] = (f32x4){0.f, 0.f, 0.f, 0.f}; }
        const float sgn = (fq == 0) ? -1.0f : 1.0f; const bool rl = fq < 2;
#pragma unroll
        for (int ai = 0; ai < 2; ++ai)
#pragma unroll
            for (int m = 0; m < 4; ++m) {
                const int row = row0 + ai * 128 + m * 16;
                f32x4 cs[4];
                if (dorope) { const f32x4* rp = (const f32x4*)(ws + WS_ROPE) + (size_t)(row % S) * 4;
#pragma unroll
                    for (int i = 0; i < 4; ++i) cs[i] = rp[i]; }
                bf16* rowp = dst + (size_t)row * ld + col0;
#pragma unroll
                for (int bj = 0; bj < 2; ++bj) {
                    f32x4 v0 = acc[ai][bj][m][0], v1 = acc[ai][bj][m][1];
                    if (dorope) {
                        f32x4 q0, q1;
#pragma unroll
                        for (int j = 0; j < 4; ++j) { q0[j] = __shfl_xor(v0[j], 16); q1[j] = __shfl_xor(v1[j], 16); }
                        if (rl) {
                            v0[0] = v0[0] * cs[0][0] + sgn * q0[0] * cs[0][1]; v0[1] = v0[1] * cs[0][2] + sgn * q0[1] * cs[0][3];
                            v0[2] = v0[2] * cs[1][0] + sgn * q0[2] * cs[1][1]; v0[3] = v0[3] * cs[1][2] + sgn * q0[3] * cs[1][3];
                            v1[0] = v1[0] * cs[2][0] + sgn * q1[0] * cs[2][1]; v1[1] = v1[1] * cs[2][2] + sgn * q1[1] * cs[2][3];
                            v1[2] = v1[2] * cs[3][0] + sgn * q1[2] * cs[3][1]; v1[3] = v1[3] * cs[3][2] + sgn * q1[3] * cs[3][3]; }
                    }
                    if (dokm) { ks[bj][0] += v0; ks[bj][1] += v1; }
                    if (kind == 2) {
                        v0 = v0 + bv[bj][0]; v1 = v1 + bv[bj][1];
#pragma unroll
                        for (int j = 0; j < 4; ++j) { v0[j] = fast_sigmoid(v0[j]); v1[j] = fast_sigmoid(v1[j]); } }
                    u32x4 w; w.x = cvtpk(v0[0], v0[1]); w.y = cvtpk(v0[2], v0[3]); w.z = cvtpk(v1[0], v1[1]); w.w = cvtpk(v1[2], v1[3]);
                    *(u32x4*)(rowp + bj * 128) = w;
                }
            }
        if (dokm) {
            float* km = (float*)(ws + WS_KMEAN) + (size_t)((u.pm >> 5) * NHA * NBLK + (u.pm & 31)) * HD;
#pragma unroll
            for (int bj = 0; bj < 2; ++bj)
#pragma unroll
                for (int n = 0; n < 2; ++n)
#pragma unroll
                    for (int j = 0; j < 4; ++j) { float v = ks[bj][n][j]; v += __shfl_xor(v, 1); v += __shfl_xor(v, 2); v += __shfl_xor(v, 4); v += __shfl_xor(v, 8);
                        if (fr == 0) { const int c = col0 + bj * 128 + 4 * n + j; atomicAdd(km + (size_t)(c >> 6) * NBLK * HD + (c & 63), v * (1.0f / MBLK)); } }
        }
    }
};
template <int PASS> struct EpiMix {
    static constexpr bool HAS_INIT = false; static constexpr int MID_T = 0; static constexpr bool PERM = true; Params p;
    __device__ __forceinline__ void operator()(const f32x4 (&acc)[2][2][4][2], const pg8::Unit& u, int wr, int wc, int fr, int fq) const {
        const int row0 = u.pm * 256 + wr * 64 + fr, col0 = u.pn * 256 + wc * 32 + 8 * fq;
        const bf16* G = (const bf16*)(p.ws + (PASS == 0 ? WS_SA : WS_SB)); bf16* M = (bf16*)(p.ws + WS_MIX);
#pragma unroll
        for (int ai = 0; ai < 2; ++ai)
#pragma unroll
            for (int m = 0; m < 4; ++m) {
                const size_t ro = (size_t)(row0 + ai * 128 + m * 16) * D + col0;
#pragma unroll
                for (int bj = 0; bj < 2; ++bj) {
                    const u32x4 g = *(const u32x4*)(G + ro + bj * 128);
                    f32x4 v0 = acc[ai][bj][m][0], v1 = acc[ai][bj][m][1];
                    v0[0] *= __uint_as_float(g.x << 16); v0[1] *= __uint_as_float(g.x & 0xffff0000u); v0[2] *= __uint_as_float(g.y << 16); v0[3] *= __uint_as_float(g.y & 0xffff0000u);
                    v1[0] *= __uint_as_float(g.z << 16); v1[1] *= __uint_as_float(g.z & 0xffff0000u); v1[2] *= __uint_as_float(g.w << 16); v1[3] *= __uint_as_float(g.w & 0xffff0000u);
                    if (PASS == 1) { const u32x4 t = *(const u32x4*)(M + ro + bj * 128);
                        v0[0] += __uint_as_float(t.x << 16); v0[1] += __uint_as_float(t.x & 0xffff0000u); v0[2] += __uint_as_float(t.y << 16); v0[3] += __uint_as_float(t.y & 0xffff0000u);
                        v1[0] += __uint_as_float(t.z << 16); v1[1] += __uint_as_float(t.z & 0xffff0000u); v1[2] += __uint_as_float(t.w << 16); v1[3] += __uint_as_float(t.w & 0xffff0000u); }
                    u32x4 w; w.x = cvtpk(v0[0], v0[1]); w.y = cvtpk(v0[2], v0[3]); w.z = cvtpk(v1[0], v1[1]); w.w = cvtpk(v1[2], v1[3]);
                    *(u32x4*)(M + ro + bj * 128) = w;
                }
            }
    }
};
struct EpiMixCat {
    static constexpr bool HAS_INIT = false; static constexpr int MID_T = 8; static constexpr bool PERM = true; Params p;
    __device__ __forceinline__ void mid(f32x4 (&acc)[2][2][4][2], const pg8::Unit& u, int wr, int wc, int fr, int fq) const {
        int row0 = u.pm * 256 + wr * 64 + fr, col0 = u.pn * 256 + wc * 32 + 8 * fq;
        asm volatile("" : "+v"(row0), "+v"(col0));
        const bf16* GA = (const bf16*)(p.ws + WS_SA); const bf16* GB = (const bf16*)(p.ws + WS_SB);
#pragma unroll
        for (int ai = 0; ai < 2; ++ai)
#pragma unroll
            for (int m = 0; m < 4; ++m) {
                const size_t ro = (size_t)(row0 + ai * 128 + m * 16) * D + col0;
#pragma unroll
                for (int bj = 0; bj < 2; ++bj) {
                    const u32x4 a = *(const u32x4*)(GA + ro + bj * 128), b = *(const u32x4*)(GB + ro + bj * 128);
#pragma unroll
                    for (int j = 0; j < 4; ++j) { const float r0 = __uint_as_float(a[j] << 16) * __builtin_amdgcn_rcpf(__uint_as_float(b[j] << 16)), r1 = __uint_as_float(a[j] & 0xffff0000u) * __builtin_amdgcn_rcpf(__uint_as_float(b[j] & 0xffff0000u));
                        if (j < 2) { acc[ai][bj][m][0][2 * j] *= r0; acc[ai][bj][m][0][2 * j + 1] *= r1; } else { acc[ai][bj][m][1][2 * j - 4] *= r0; acc[ai][bj][m][1][2 * j - 3] *= r1; } }
                }
                asm volatile("" ::: "memory");
            }
    }
    __device__ __forceinline__ void operator()(const f32x4 (&acc)[2][2][4][2], const pg8::Unit& u, int wr, int wc, int fr, int fq) const {
        const int row0 = u.pm * 256 + wr * 64 + fr, col0 = u.pn * 256 + wc * 32 + 8 * fq;
        const bf16* GB = (const bf16*)(p.ws + WS_SB); bf16* M = (bf16*)(p.ws + WS_MIX);
#pragma unroll
        for (int ai = 0; ai < 2; ++ai)
#pragma unroll
            for (int m = 0; m < 4; ++m) {
                const size_t ro = (size_t)(row0 + ai * 128 + m * 16) * D + col0;
#pragma unroll
                for (int bj = 0; bj < 2; ++bj) {
                    const u32x4 g = *(const u32x4*)(GB + ro + bj * 128);
                    f32x4 v0 = acc[ai][bj][m][0], v1 = acc[ai][bj][m][1];
                    v0[0] *= __uint_as_float(g.x << 16); v0[1] *= __uint_as_float(g.x & 0xffff0000u); v0[2] *= __uint_as_float(g.y << 16); v0[3] *= __uint_as_float(g.y & 0xffff0000u);
                    v1[0] *= __uint_as_float(g.z << 16); v1[1] *= __uint_as_float(g.z & 0xffff0000u); v1[2] *= __uint_as_float(g.w << 16); v1[3] *= __uint_as_float(g.w & 0xffff0000u);
                    u32x4 w; w.x = cvtpk(v0[0], v0[1]); w.y = cvtpk(v0[2], v0[3]); w.z = cvtpk(v1[0], v1[1]); w.w = cvtpk(v1[2], v1[3]);
                    *(u32x4*)(M + ro + bj * 128) = w;
                }
            }
    }
};
struct EpiOut {
    static constexpr bool HAS_INIT = false; static constexpr int MID_T = 0; static constexpr bool PERM = false; Params p;
    __device__ __forceinline__ void operator()(const f32x4 (&acc)[2][2][4][2], const pg8::Unit& u, int wr, int wc, int fr, int fq) const {
        const int row0 = u.pm * 256 + wr * 64 + fr, col0 = u.pn * 256 + wc * 32 + 4 * fq;
#pragma unroll
        for (int ai = 0; ai < 2; ++ai)
#pragma unroll
            for (int m = 0; m < 4; ++m) { const size_t ro = (size_t)(row0 + ai * 128 + m * 16) * D + col0;
#pragma unroll
                for (int bj = 0; bj < 2; ++bj)
#pragma unroll
                    for (int n = 0; n < 2; ++n) { const size_t o = ro + bj * 128 + n * 16; *(f32x4*)(p.out + o) = *(const f32x4*)(p.x + o) + acc[ai][bj][m][n]; } }
    }
};
struct EpiGateUp {
    static constexpr bool HAS_INIT = true; static constexpr int MID_T = 0; static constexpr bool PERM = false; Params p; MoeTab mt;
    __device__ __forceinline__ void init_load(f32x4 (&iv)[2][2], const pg8::Unit& u, int wc, int fq) const {
        const int e = __builtin_amdgcn_readfirstlane(mt.e_of[u.slot]);
#pragma unroll
        for (int bj = 0; bj < 2; ++bj) { const int cc = 16 * (8 * u.pn + 4 * bj + wc) + 4 * fq; iv[bj][0] = *(const f32x4*)(p.b_gate + e * FF + cc); iv[bj][1] = *(const f32x4*)(p.b_up + e * FF + cc); }
    }
    __device__ __forceinline__ void init_apply(f32x4 (&acc)[2][2][4][2], const f32x4 (&iv)[2][2]) const {
#pragma unroll
        for (int ai = 0; ai < 2; ++ai)
#pragma unroll
            for (int bj = 0; bj < 2; ++bj)
#pragma unroll
                for (int m = 0; m < 4; ++m) { acc[ai][bj][m][0] = iv[bj][0]; acc[ai][bj][m][1] = iv[bj][1] + 1.0f; }
    }
    __device__ __forceinline__ void operator()(const f32x4 (&acc)[2][2][4][2], const pg8::Unit& u, int wr, int wc, int fr, int fq) const {
        const int row0 = u.pm * 256 + wr * 64 + fr;
#pragma unroll
        for (int ai = 0; ai < 2; ++ai)
#pragma unroll
            for (int m = 0; m < 4; ++m) {
#pragma unroll
                for (int bj = 0; bj < 2; ++bj) { const int cc = 16 * (8 * u.pn + 4 * bj + wc) + 4 * fq; const f32x4 g = acc[ai][bj][m][0], uu = acc[ai][bj][m][1]; f32x4 a;
#pragma unroll
                    for (int j = 0; j < 4; ++j) { const float gg = fminf(g[j], 7.0f), u1 = fminf(fmaxf(uu[j], -6.0f), 8.0f);
                        a[j] = gg * __builtin_amdgcn_rcpf(1.0f + __builtin_amdgcn_exp2f(-2.4554669595930156f * gg)) * u1; }
#if FP8_DN
                    int w = __builtin_amdgcn_cvt_pk_fp8_f32(a[0], a[1], 0, false); w = __builtin_amdgcn_cvt_pk_fp8_f32(a[2], a[3], w, true);
                    *(int*)((unsigned char*)(p.ws + WS_A2) + (size_t)(row0 + ai * 128 + m * 16) * FF + cc) = w;
#else
                    u32x2 w; w.x = cvtpk(a[0], a[1]); w.y = cvtpk(a[2], a[3]); *(u32x2*)((bf16*)(p.ws + WS_A2) + (size_t)(row0 + ai * 128 + m * 16) * FF + cc) = w;
#endif
                } }
    }
};
struct EpiDown {
    static constexpr bool HAS_INIT = false; static constexpr int MID_T = 0; static constexpr bool PERM = true; Params p; MoeTab mt;
    __device__ __forceinline__ void operator()(const f32x4 (&acc)[2][2][4][2], const pg8::Unit& u, int wr, int wc, int fr, int fq) const {
        const int e = __builtin_amdgcn_readfirstlane(mt.e_of[u.slot]);
        const int row0 = u.pm * 256 + wr * 64 + fr, col0 = u.pn * 256 + wc * 32 + 8 * fq;
        const float* bd = p.b_down + e * D + col0;
        int asg[2][4]; float pw[2][4];
#pragma unroll
        for (int ai = 0; ai < 2; ++ai)
#pragma unroll
            for (int m = 0; m < 4; ++m) { const int rl = u.slot * 256 + wr * 64 + fr + ai * 128 + m * 16; asg[ai][m] = mt.rt[rl]; pw[ai][m] = mt.rp[rl]; }
        f32x4 bv[2][2];
#pragma unroll
        for (int bj = 0; bj < 2; ++bj) { bv[bj][0] = *(const f32x4*)(bd + bj * 128); bv[bj][1] = *(const f32x4*)(bd + bj * 128 + 4); }
#pragma unroll
        for (int ai = 0; ai < 2; ++ai)
#pragma unroll
            for (int m = 0; m < 4; ++m) {
                if (asg[ai][m] >= 0) { bf16* rowp = (bf16*)(p.ws + WS_Y) + (size_t)asg[ai][m] * D + col0; const float pp = pw[ai][m] * (FP8_Y ? 16.0f : 1.0f);
#pragma unroll
                    for (int bj = 0; bj < 2; ++bj) { const f32x4 v0 = (acc[ai][bj][m][0] + bv[bj][0]) * pp, v1 = (acc[ai][bj][m][1] + bv[bj][1]) * pp;
#if FP8_Y
                        int w0 = __builtin_amdgcn_cvt_pk_fp8_f32(v0[0], v0[1], 0, false); w0 = __builtin_amdgcn_cvt_pk_fp8_f32(v0[2], v0[3], w0, true);
                        int w1 = __builtin_amdgcn_cvt_pk_fp8_f32(v1[0], v1[1], 0, false); w1 = __builtin_amdgcn_cvt_pk_fp8_f32(v1[2], v1[3], w1, true);
                        u32x2 w; w.x = (unsigned)w0; w.y = (unsigned)w1; *(u32x2*)((unsigned char*)(p.ws + WS_Y) + (size_t)asg[ai][m] * D + col0 + bj * 128) = w; (void)rowp;
#else
                        u32x4 w; w.x = cvtpk(v0[0], v0[1]); w.y = cvtpk(v0[2], v0[3]); w.z = cvtpk(v1[0], v1[1]); w.w = cvtpk(v1[2], v1[3]);
                        *(u32x4*)(rowp + bj * 128) = w;
#endif
                    } } }
    }
};

__device__ __forceinline__ void phase_kmean(const Params& p, int gw, int ngw, int lane) {
    for (int it = gw; it < NB * NHA * NBLK; it += ngw) {
        const int n = it % NBLK, h = (it / NBLK) % NHA, b = it / (NBLK * NHA), d = lane;
        const bf16* k = (const bf16*)(p.ws + WS_KA) + ((size_t)b * S + (size_t)n * MBLK) * WA + h * HD + d;
        float s = 0.f; for (int r = 0; r < MBLK; ++r) s += bf2f(k[(size_t)r * WA]);
        ((float*)(p.ws + WS_KMEAN))[(size_t)it * HD + d] = s * (1.0f / MBLK);
    }
}
__device__ __forceinline__ void phase_select(const Params& p, int gtid, int ngt) {
    for (int idx = gtid; idx < T * NHA; idx += ngt) {
        const int h = idx % NHA, t = idx / NHA, b = t / S, s = t % S, blk = s / MBLK;
        const bf16* q = (const bf16*)(p.ws + WS_QA) + (size_t)t * WA + h * HD;
        const float* km = (const float*)(p.ws + WS_KMEAN) + (size_t)(b * NHA + h) * NBLK * HD;
        float best0 = -INFINITY, best1 = -INFINITY, best2 = -INFINITY; int b0 = -1, b1 = -1, b2 = -1;
        for (int n = 0; n < blk; ++n) {
            float g = 0.f; for (int d = 0; d < HD; ++d) g += bf2f(q[d]) * km[n * HD + d];
            if (g > best0) { best2 = best1; b2 = b1; best1 = best0; b1 = b0; best0 = g; b0 = n; }
            else if (g > best1) { best2 = best1; b2 = b1; best1 = g; b1 = n; }
            else if (g > best2) { best2 = g; b2 = n; }
        }
        signed char* sel = (signed char*)(p.ws + WS_SEL) + (size_t)idx * 4;
        sel[0] = (signed char)b0; sel[1] = (signed char)b1; sel[2] = (signed char)b2; sel[3] = -1;
    }
}
__device__ __forceinline__ float dot64(const float* qs, const bf16* kr) {
    float a = 0.f;
    for (int d8 = 0; d8 < 8; ++d8) { float kv[8]; ldact8(kr + d8 * 8, kv);
#pragma unroll
        for (int i = 0; i < 8; ++i) a += qs[d8 * 8 + i] * kv[i]; }
    return a;
}
#define WAVE_LDS_FENCE() asm volatile("s_waitcnt lgkmcnt(0)" ::: "memory")
__device__ __forceinline__ void phase_moba_naive(const Params& p, int gw, int ngw, int lane, float* wl, bf16* oa_dst) {
    float* qs = wl; float* sc = wl + 64;
    for (int it = gw; it < T * NHA; it += ngw) {
        const int h = it % NHA, t = it / NHA, b = t / S, s = t % S, blk = s / MBLK;
        WAVE_LDS_FENCE();
        qs[lane] = bf2f(((const bf16*)(p.ws + WS_QA))[(size_t)t * WA + h * HD + lane]);
        WAVE_LDS_FENCE();
        const signed char* sel = (const signed char*)(p.ws + WS_SEL) + ((size_t)t * NHA + h) * 4;
        const int kb0 = blk, kb1 = sel[0], kb2 = sel[1], kb3 = sel[2];
        const bf16* K = (const bf16*)(p.ws + WS_KA) + (size_t)b * S * WA + h * HD; const bf16* V = (const bf16*)(p.ws + WS_VA) + (size_t)b * S * WA + h * HD;
        float mx = -INFINITY;
        for (int g = 0; g < 4; ++g) { const int kbg = g == 0 ? kb0 : g == 1 ? kb1 : g == 2 ? kb2 : kb3;
            for (int c = 0; c < 4; ++c) {
                const int kk = c * 64 + lane; float v = -INFINITY;
                if (kbg >= 0) { const int key = kbg * MBLK + kk; if (g > 0 || key <= s) v = dot64(qs, K + (size_t)key * WA) * 0.125f; }
                sc[g * 256 + kk] = v; mx = fmaxf(mx, v);
            } }
#pragma unroll
        for (int o = 1; o < 64; o <<= 1) mx = fmaxf(mx, __shfl_xor(mx, o));
        WAVE_LDS_FENCE();
        float l = 0.f;
        for (int i = lane; i < 1024; i += 64) { const float e = (sc[i] == -INFINITY) ? 0.f : expf(sc[i] - mx); sc[i] = e; l += e; }
        l = wave_sum(l);
        WAVE_LDS_FENCE();
        float o = 0.f;
        for (int g = 0; g < 4; ++g) { const int kbg = g == 0 ? kb0 : g == 1 ? kb1 : g == 2 ? kb2 : kb3; if (kbg < 0) continue;
            for (int kk = 0; kk < 256; ++kk) { const float pr = sc[g * 256 + kk]; if (pr != 0.f) o += pr * bf2f(V[(size_t)(kbg * MBLK + kk) * WA + lane]); } }
        oa_dst[(size_t)t * WA + h * HD + lane] = (bf16)f2bf(o / l);
    }
}
__device__ __forceinline__ void phase_dil_naive(const Params& p, int gw, int ngw, int lane, float* wl, bf16* ob_dst) {
    float* qs = wl; float* sc = wl + 192;
    for (int it = gw; it < T * 4; it += ngw) {
        const int j = it % 4, t = it / 4, b = t / S, s = t % S;
        WAVE_LDS_FENCE();
        for (int g = 0; g < 3; ++g) qs[g * 64 + lane] = bf2f(((const bf16*)(p.ws + WS_QB))[(size_t)t * WB + (4 * g + j) * HD + lane]);
        WAVE_LDS_FENCE();
        float mx = -INFINITY;
        for (int g = 0; g < 3; ++g) { const int dl = g == 0 ? 1 : g == 1 ? 4 : 16; const bf16* K = (const bf16*)(p.ws + WS_KB) + (size_t)b * S * WB + (4 * g + j) * HD;
            for (int i = lane; i <= 128; i += 64) { const int key = s - i * dl; float v = -INFINITY;
                if (key >= 0) v = dot64(qs + g * 64, K + (size_t)key * WB) * 0.125f;
                sc[g * 129 + i] = v; mx = fmaxf(mx, v); } }
#pragma unroll
        for (int o = 1; o < 64; o <<= 1) mx = fmaxf(mx, __shfl_xor(mx, o));
        WAVE_LDS_FENCE();
        float l = 0.f;
        for (int i = lane; i < 3 * 129; i += 64) { const float e = (sc[i] == -INFINITY) ? 0.f : expf(sc[i] - mx); sc[i] = e; l += e; }
        l = wave_sum(l);
        WAVE_LDS_FENCE();
        float o = 0.f;
        for (int g = 0; g < 3; ++g) { const int dl = g == 0 ? 1 : g == 1 ? 4 : 16; const bf16* V = (const bf16*)(p.ws + WS_VB) + (size_t)b * S * WB + (4 * g + j) * HD;
            for (int i = 0; i <= 128; ++i) { const float pr = sc[g * 129 + i]; const int key = s - i * dl; if (key >= 0 && pr != 0.f) o += pr * bf2f(V[(size_t)key * WB + lane]); } }
        ob_dst[(size_t)t * WBO + j * HD + lane] = (bf16)f2bf(o / l);
    }
}

__device__ __forceinline__ void phase_router(const Params& p, int bid, int nb, unsigned char* lds, int tid) {
    const int lane = tid & 63, w = tid >> 6, h = lane >> 5, r32 = lane & 31;
    float* part = (float*)lds;
    float* ssqp = (float*)(lds + 65536);
    float* rstd_s = (float*)(lds + 65536 + 2048);
    int4* rec = (int4*)(lds + 65536 + 4096);
    int* lc = (int*)(lds + 65536 + 8192); int* gbase = lc + 32;
    bf16x8v whi[8], wlo[8];
#pragma unroll
    for (int sidx = 0; sidx < 8; ++sidx) { const int k0 = 128 * w + 16 * sidx + 8 * h; float wv[8];
        const f32x4 g0 = *(const f32x4*)(p.ln_ffn_g + k0), g1 = *(const f32x4*)(p.ln_ffn_g + k0 + 4);
#pragma unroll
        for (int j = 0; j < 8; ++j) wv[j] = p.w_router[(size_t)(k0 + j) * NE + r32] * (j < 4 ? g0[j] : g1[j - 4]);
        u32x4 hi, lo;
#pragma unroll
        for (int j = 0; j < 4; ++j) { const unsigned hp = cvtpk(wv[2 * j], wv[2 * j + 1]); hi[j] = hp;
            lo[j] = cvtpk(wv[2 * j] - __uint_as_float(hp << 16), wv[2 * j + 1] - __uint_as_float(hp & 0xffff0000u)); }
        whi[sidx] = __builtin_bit_cast(bf16x8v, hi); wlo[sidx] = __builtin_bit_cast(bf16x8v, lo); }
    for (int tg = bid; tg < T / 64; tg += nb) {
        __syncthreads();
        if (tid < 256) rec[tid] = make_int4(-1, 0, 0, 0);
        if (tid < 32) lc[tid] = 0;
#pragma unroll
        for (int tt = 0; tt < 2; ++tt) {
            const float* xr = p.out + (size_t)(tg * 64 + 32 * tt + r32) * D + 128 * w + 8 * h;
            f32x16 acc = {0.f, 0.f, 0.f, 0.f, 0.f, 0.f, 0.f, 0.f, 0.f, 0.f, 0.f, 0.f, 0.f, 0.f, 0.f, 0.f}; float ssq = 0.f;
#pragma unroll
            for (int sidx = 0; sidx < 8; ++sidx) { const f32x4 x0 = *(const f32x4*)(xr + 16 * sidx), x1 = *(const f32x4*)(xr + 16 * sidx + 4);
                ssq += (x0.x * x0.x + x0.y * x0.y) + (x0.z * x0.z + x0.w * x0.w) + (x1.x * x1.x + x1.y * x1.y) + (x1.z * x1.z + x1.w * x1.w);
                u32x4 hi, lo;
                hi.x = cvtpk(x0.x, x0.y); hi.y = cvtpk(x0.z, x0.w); hi.z = cvtpk(x1.x, x1.y); hi.w = cvtpk(x1.z, x1.w);
                lo.x = cvtpk(x0.x - __uint_as_float(hi.x << 16), x0.y - __uint_as_float(hi.x & 0xffff0000u)); lo.y = cvtpk(x0.z - __uint_as_float(hi.y << 16), x0.w - __uint_as_float(hi.y & 0xffff0000u));
                lo.z = cvtpk(x1.x - __uint_as_float(hi.z << 16), x1.y - __uint_as_float(hi.z & 0xffff0000u)); lo.w = cvtpk(x1.z - __uint_as_float(hi.w << 16), x1.w - __uint_as_float(hi.w & 0xffff0000u));
                const bf16x8v xh = __builtin_bit_cast(bf16x8v, hi), xl = __builtin_bit_cast(bf16x8v, lo);
                acc = __builtin_amdgcn_mfma_f32_32x32x16_bf16(xh, whi[sidx], acc, 0, 0, 0);
                acc = __builtin_amdgcn_mfma_f32_32x32x16_bf16(xh, wlo[sidx], acc, 0, 0, 0);
                acc = __builtin_amdgcn_mfma_f32_32x32x16_bf16(xl, whi[sidx], acc, 0, 0, 0); }
#pragma unroll
            for (int r = 0; r < 16; ++r) part[(w * 64 + 32 * tt + crow(r, h)) * 32 + r32] = acc[r];
            ssq += __shfl_xor(ssq, 32);
            if (h == 0) ssqp[w * 64 + 32 * tt + r32] = ssq;
        }
        __syncthreads();
        if (tid < 64) {
            const int t = tg * 64 + tid;
            float sq = 0.f;
#pragma unroll
            for (int i = 0; i < 8; ++i) sq += ssqp[i * 64 + tid];
            const float rstd = 1.0f / sqrtf(sq * (1.0f / D) + NORM_EPS); rstd_s[tid] = rstd;
            float v0 = -INFINITY, v1 = -INFINITY, v2 = -INFINITY, v3 = -INFINITY; int e0 = 0, e1 = 0, e2 = 0, e3 = 0;
            for (int e = 0; e < NE; ++e) { float a = 0.f;
#pragma unroll
                for (int i = 0; i < 8; ++i) a += part[(i * 64 + tid) * 32 + ((e + tid) & 31)];
                const int ee = (e + tid) & 31; const float lg = a * rstd + p.b_router[ee];
                if (lg > v0 || (lg == v0 && ee < e0)) { v3 = v2; e3 = e2; v2 = v1; e2 = e1; v1 = v0; e1 = e0; v0 = lg; e0 = ee; }
                else if (lg > v1 || (lg == v1 && ee < e1)) { v3 = v2; e3 = e2; v2 = v1; e2 = e1; v1 = lg; e1 = ee; }
                else if (lg > v2 || (lg == v2 && ee < e2)) { v3 = v2; e3 = e2; v2 = lg; e2 = ee; }
                else if (lg > v3 || (lg == v3 && ee < e3)) { v3 = lg; e3 = ee; } }
            const float x1 = expf(v1 - v0), x2 = expf(v2 - v0), x3 = expf(v3 - v0); const float inv = 1.0f / (1.0f + x1 + x2 + x3);
            { const int lp = atomicAdd(&lc[e0], 1); rec[tid * 4 + 0] = make_int4(e0, lp, t * 4 + 0, __float_as_int(inv)); }
            { const int lp = atomicAdd(&lc[e1], 1); rec[tid * 4 + 1] = make_int4(e1, lp, t * 4 + 1, __float_as_int(x1 * inv)); }
            { const int lp = atomicAdd(&lc[e2], 1); rec[tid * 4 + 2] = make_int4(e2, lp, t * 4 + 2, __float_as_int(x2 * inv)); }
            { const int lp = atomicAdd(&lc[e3], 1); rec[tid * 4 + 3] = make_int4(e3, lp, t * 4 + 3, __float_as_int(x3 * inv)); }
        }
        __syncthreads();
        if (tid < NE) gbase[tid] = lc[tid] > 0 ? atomicAdd((int*)(p.ws + WS_CTL) + CW_ECNT + 64 * tid, lc[tid]) : 0;
        for (int idx = tid; idx < 64 * 256; idx += 512) { const int tk = idx >> 8, c4 = idx & 255; const size_t t = (size_t)tg * 64 + tk;
            const f32x4 x = *(const f32x4*)(p.out + t * D + 4 * c4), g = *(const f32x4*)(p.ln_ffn_g + 4 * c4); const float rs = rstd_s[tk];
            const float h0 = x.x * rs * g.x, h1 = x.y * rs * g.y, h2 = x.z * rs * g.z, h3 = x.w * rs * g.w;
#if FP8_GU
            int o = __builtin_amdgcn_cvt_pk_fp8_f32(h0, h1, 0, false); o = __builtin_amdgcn_cvt_pk_fp8_f32(h2, h3, o, true); ((int*)((unsigned char*)(p.ws + WS_H) + t * D))[c4] = o;
#else
            u32x2 o; o.x = cvtpk(h0, h1); o.y = cvtpk(h2, h3); ((u32x2*)((bf16*)(p.ws + WS_H) + t * D))[c4] = o;
#endif
        }
        __syncthreads();
        if (tid < 256) { const int4 r = rec[tid]; if (r.x >= 0) { const int pos = gbase[r.x] + r.y; ((int*)(p.ws + WS_ELIST))[r.x * T + pos] = r.z; ((float*)(p.ws + WS_EP))[r.x * T + pos] = __int_as_float(r.w); } }
    }
}
__device__ __forceinline__ void phase_final(const Params& p, int gw, int ngw, int lane) {
    for (int t = gw; t < T; t += ngw) {
        f32x4* xr = (f32x4*)(p.out + (size_t)t * D) + lane; const f32x4* gr = (const f32x4*)p.ln_final_g + lane;
        f32x4 v[4]; float ss = 0.f;
#pragma unroll
        for (int j = 0; j < 4; ++j) { v[j] = xr[64 * j];
#pragma unroll
            for (int k = 0; k < 4; ++k) {
#if FP8_Y
                const int y = ((const int*)((const unsigned char*)(p.ws + WS_Y) + ((size_t)t * 4 + k) * D))[lane + 64 * j];
                const f32x2 y01 = __builtin_amdgcn_cvt_pk_f32_fp8(y, false), y23 = __builtin_amdgcn_cvt_pk_f32_fp8(y, true);
                v[j].x += y01.x * 0.0625f; v[j].y += y01.y * 0.0625f; v[j].z += y23.x * 0.0625f; v[j].w += y23.y * 0.0625f;
#else
                const u32x2 y = ((const u32x2*)((const bf16*)(p.ws + WS_Y) + ((size_t)t * 4 + k) * D))[lane + 64 * j];
                v[j].x += __uint_as_float(y.x << 16); v[j].y += __uint_as_float(y.x & 0xffff0000u); v[j].z += __uint_as_float(y.y << 16); v[j].w += __uint_as_float(y.y & 0xffff0000u);
#endif
            }
            ss += (v[j].x * v[j].x + v[j].y * v[j].y) + (v[j].z * v[j].z + v[j].w * v[j].w); }
        float rstd = 1.0f / sqrtf(wave_sum(ss) * (1.0f / D) + NORM_EPS);
#if DBG
        { const float num = ((const float*)(p.ws + WS_CTL))[CW_DNUM], den = ((const float*)(p.ws + WS_CTL))[CW_DDEN]; rstd *= 1.0f + DBG_GAIN * sqrtf(num / fmaxf(den, 1e-30f)); }
#endif
#if TIMEB_LO >= 0
        { const unsigned long long* ts = (const unsigned long long*)(p.ws + WS_CTL + 917504); rstd *= 1.0f + TIMEB_GAIN * (float)(ts[TIMEB_HI] - ts[TIMEB_LO]) * 1e-6f; }
#endif
#pragma unroll
        for (int j = 0; j < 4; ++j) { const f32x4 g = gr[64 * j]; f32x4 o; o.x = v[j].x * rstd * g.x; o.y = v[j].y * rstd * g.y; o.z = v[j].z * rstd * g.z; o.w = v[j].w * rstd * g.w; xr[64 * j] = o; }
    }
}


#define LDSP __attribute__((address_space(3)))
constexpr int AT_RS = 144;
constexpr int AT_KOFF = 0, AT_VOFF = 384 * AT_RS, AT_PFX = 131072;
constexpr float AT_C = 0.125f * 1.4426950408889634f;
__device__ __forceinline__ s16x4 vtr(unsigned addr) { return __builtin_bit_cast(s16x4, __builtin_amdgcn_ds_read_tr16_b64_v4i16((LDSP s16x4*)(uintptr_t)addr)); }

struct AttnState { f32x16 o0, o1; float m, l; };
template <bool MASKED> __device__ __forceinline__ void attn_wave(AttnState& st, const bf16x8v (&qf)[4], unsigned kbase, unsigned vbase, int c0, int c1, int clo, int chi, int lane) {
    const int h = lane >> 5, ql = lane & 31;
    if (c0 >= c1) return;
    bf16x8v kf[4];
    { const unsigned ka = kbase + (unsigned)c0 * (32 * AT_RS);
#pragma unroll
      for (int ks = 0; ks < 4; ++ks) kf[ks] = *(const LDSP bf16x8v*)(uintptr_t)(ka + ks * 32); }
#pragma unroll 1
    for (int c = c0; c < c1; ++c) {
        const unsigned va = vbase + (unsigned)c * (32 * AT_RS);
        s16x4 vlo[2][2], vhi[2][2];
#pragma unroll
        for (int ks = 0; ks < 2; ++ks)
#pragma unroll
            for (int db = 0; db < 2; ++db) { vlo[ks][db] = vtr(va + ks * (16 * AT_RS) + db * 64); vhi[ks][db] = vtr(va + ks * (16 * AT_RS) + 8 * AT_RS + db * 64); }
        f32x16 s = {0.f, 0.f, 0.f, 0.f, 0.f, 0.f, 0.f, 0.f, 0.f, 0.f, 0.f, 0.f, 0.f, 0.f, 0.f, 0.f};
#pragma unroll
        for (int ks = 0; ks < 4; ++ks) s = __builtin_amdgcn_mfma_f32_32x32x16_bf16(kf[ks], qf[ks], s, 0, 0, 0);
        { const unsigned kn = kbase + (unsigned)((c + 1 < c1) ? c + 1 : c) * (32 * AT_RS);
#pragma unroll
          for (int ks = 0; ks < 4; ++ks) kf[ks] = *(const LDSP bf16x8v*)(uintptr_t)(kn + ks * 32); }
        float t[16]; float cmax = -INFINITY;
#pragma unroll
        for (int r = 0; r < 16; ++r) { t[r] = s[r];
            if (MASKED) { const int cr = crow(r, h); if ((c == clo && cr < ql) || (c == chi && cr > ql)) t[r] = -INFINITY; }
            cmax = fmaxf(cmax, t[r]); }
        cmax = fmaxf(cmax, __shfl_xor(cmax, 32)) * AT_C;
        const float mn = fmaxf(st.m, cmax); const float mu = (mn == -INFINITY) ? 0.f : mn;
        const float alpha = __builtin_amdgcn_exp2f(st.m - mu);
        float psum = 0.f; float pr[16];
#pragma unroll
        for (int r = 0; r < 16; ++r) { pr[r] = __builtin_amdgcn_exp2f(__builtin_fmaf(t[r], AT_C, -mu)); psum += pr[r]; }
        st.l = st.l * alpha + psum; st.m = mn;
        if (!__all(alpha == 1.0f)) {
#pragma unroll
            for (int r = 0; r < 16; ++r) { st.o0[r] *= alpha; st.o1[r] *= alpha; } }
#pragma unroll
        for (int ks = 0; ks < 2; ++ks) {
            u32x4 pw; pw.x = cvtpk(pr[8 * ks + 0], pr[8 * ks + 1]); pw.y = cvtpk(pr[8 * ks + 2], pr[8 * ks + 3]); pw.z = cvtpk(pr[8 * ks + 4], pr[8 * ks + 5]); pw.w = cvtpk(pr[8 * ks + 6], pr[8 * ks + 7]);
            const bf16x8v pf = __builtin_bit_cast(bf16x8v, pw);
            const bf16x8v vf0 = {vlo[ks][0][0], vlo[ks][0][1], vlo[ks][0][2], vlo[ks][0][3], vhi[ks][0][0], vhi[ks][0][1], vhi[ks][0][2], vhi[ks][0][3]};
            const bf16x8v vf1 = {vlo[ks][1][0], vlo[ks][1][1], vlo[ks][1][2], vlo[ks][1][3], vhi[ks][1][0], vhi[ks][1][1], vhi[ks][1][2], vhi[ks][1][3]};
            st.o0 = __builtin_amdgcn_mfma_f32_32x32x16_bf16(vf0, pf, st.o0, 0, 0, 0);
            st.o1 = __builtin_amdgcn_mfma_f32_32x32x16_bf16(vf1, pf, st.o1, 0, 0, 0);
        }
    }
}
__device__ __forceinline__ void attn_init(AttnState& st) {
#pragma unroll
    for (int r = 0; r < 16; ++r) { st.o0[r] = 0.f; st.o1[r] = 0.f; }
    st.m = -INFINITY; st.l = 0.f;
}
__device__ __forceinline__ void attn_stage(unsigned char* lds, int dst, const unsigned char* src, size_t pitch, int nrows, int skip, int tid) {
    for (int idx = tid; idx < nrows * 8; idx += 512) { const int row = idx >> 3, ch = idx & 7;
        if (row >= skip) { const u32x4 v = *(const u32x4*)(src + (size_t)row * pitch + ch * 16); *(u32x4*)(lds + dst + row * AT_RS + ch * 16) = v; } }
}
__device__ __forceinline__ void attn_qload(bf16x8v (&qf)[4], const bf16* qrow, int h) {
#pragma unroll
    for (int ks = 0; ks < 4; ++ks) qf[ks] = *(const bf16x8v*)(qrow + 16 * ks + 8 * h);
}
__device__ __forceinline__ void attn_store_partial(const AttnState& st, float inv_l, bf16* dst, int h) {
#pragma unroll
    for (int rg = 0; rg < 4; ++rg) {
        u32x2 w0, w1; w0.x = cvtpk(st.o0[4 * rg] * inv_l, st.o0[4 * rg + 1] * inv_l); w0.y = cvtpk(st.o0[4 * rg + 2] * inv_l, st.o0[4 * rg + 3] * inv_l);
        w1.x = cvtpk(st.o1[4 * rg] * inv_l, st.o1[4 * rg + 1] * inv_l); w1.y = cvtpk(st.o1[4 * rg + 2] * inv_l, st.o1[4 * rg + 3] * inv_l);
        *(u32x2*)(dst + 8 * rg + 4 * h) = w0; *(u32x2*)(dst + 32 + 8 * rg + 4 * h) = w1; }
}
__device__ __forceinline__ void attn_acc_partial(f32x16& a0, f32x16& a1, float w, const bf16* src, int h) {
#pragma unroll
    for (int rg = 0; rg < 4; ++rg) { const u32x2 w0 = *(const u32x2*)(src + 8 * rg + 4 * h), w1 = *(const u32x2*)(src + 32 + 8 * rg + 4 * h);
        a0[4 * rg] += w * __uint_as_float(w0.x << 16); a0[4 * rg + 1] += w * __uint_as_float(w0.x & 0xffff0000u); a0[4 * rg + 2] += w * __uint_as_float(w0.y << 16); a0[4 * rg + 3] += w * __uint_as_float(w0.y & 0xffff0000u);
        a1[4 * rg] += w * __uint_as_float(w1.x << 16); a1[4 * rg + 1] += w * __uint_as_float(w1.x & 0xffff0000u); a1[4 * rg + 2] += w * __uint_as_float(w1.y << 16); a1[4 * rg + 3] += w * __uint_as_float(w1.y & 0xffff0000u); }
}


template <int NIT> struct KVRegs { u32x4 k[NIT], v[NIT]; };
template <int NIT> __device__ __forceinline__ void kv_load(KVRegs<NIT>& R, const unsigned char* ksrc, const unsigned char* vsrc, size_t pitch, int skip, int tid) {
#pragma unroll
    for (int i = 0; i < NIT; ++i) { const int idx = tid + 512 * i, row = idx >> 3, ch = idx & 7;
        if (row >= skip) { R.k[i] = *(const u32x4*)(ksrc + (size_t)row * pitch + ch * 16); R.v[i] = *(const u32x4*)(vsrc + (size_t)row * pitch + ch * 16); } }
}
template <int NIT> __device__ __forceinline__ void kv_commit(const KVRegs<NIT>& R, unsigned char* lds, int skip, int tid) {
#pragma unroll
    for (int i = 0; i < NIT; ++i) { const int idx = tid + 512 * i, row = idx >> 3, ch = idx & 7;
        if (row >= skip) { *(u32x4*)(lds + AT_KOFF + row * AT_RS + ch * 16) = R.k[i]; *(u32x4*)(lds + AT_VOFF + row * AT_RS + ch * 16) = R.v[i]; } }
}
__device__ __forceinline__ void phase_select_lists(const Params& p, int bid, int nb, unsigned char* lds, int tid) {
    float* km = (float*)lds;
    for (int it = bid; it < NB * NBLK * 4; it += nb) {
        const int hp = it & 3, n = (it >> 2) % NBLK, b = it / (4 * NBLK);
        __syncthreads();
        for (int i = tid; i < 2 * NBLK * HD; i += 512) { const int hh = i / (NBLK * HD), rest = i % (NBLK * HD); km[i] = ((const float*)(p.ws + WS_KMEAN))[(size_t)(b * NHA + 2 * hp + hh) * NBLK * HD + rest]; }
        __syncthreads();
        const int hh = tid >> 8, h = 2 * hp + hh, s = n * MBLK + (tid & 255), t = b * S + s;
        float q[HD];
        { const u32x4* qp = (const u32x4*)((const bf16*)(p.ws + WS_QA) + (size_t)t * WA + h * HD);
#pragma unroll
            for (int i = 0; i < 8; ++i) { const u32x4 v = qp[i];
#pragma unroll
                for (int j = 0; j < 4; ++j) { q[8 * i + 2 * j] = __uint_as_float(v[j] << 16); q[8 * i + 2 * j + 1] = __uint_as_float(v[j] & 0xffff0000u); } } }
        float best0 = -INFINITY, best1 = -INFINITY, best2 = -INFINITY; int b0 = -1, b1 = -1, b2 = -1;
        const float* kmh = km + hh * (NBLK * HD);
        for (int nn = 0; nn < n; ++nn) {
            float g = 0.f;
#pragma unroll
            for (int d4 = 0; d4 < 16; ++d4) { const f32x4 kv = *(const f32x4*)(kmh + nn * HD + 4 * d4); g += q[4 * d4] * kv.x; g += q[4 * d4 + 1] * kv.y; g += q[4 * d4 + 2] * kv.z; g += q[4 * d4 + 3] * kv.w; }
            if (g > best0) { best2 = best1; b2 = b1; best1 = best0; b1 = b0; best0 = g; b0 = nn; }
            else if (g > best1) { best2 = best1; b2 = b1; best1 = g; b1 = nn; }
            else if (g > best2) { best2 = g; b2 = nn; }
        }
        signed char* sel = (signed char*)(p.ws + WS_SEL) + ((size_t)t * NHA + h) * 4;
        *(unsigned*)sel = (unsigned)(b0 & 0xff) | ((unsigned)(b1 & 0xff) << 8) | ((unsigned)(b2 & 0xff) << 16) | 0xff000000u;
        int* lc = (int*)(lds + 32768); int* gb = lc + 64;
        if (tid < 64) lc[tid] = 0;
        __syncthreads();
        int lp0 = 0, lp1 = 0, lp2 = 0;
        if (b0 >= 0) lp0 = atomicAdd(&lc[hh * 32 + b0], 1);
        if (b1 >= 0) lp1 = atomicAdd(&lc[hh * 32 + b1], 1);
        if (b2 >= 0) lp2 = atomicAdd(&lc[hh * 32 + b2], 1);
        __syncthreads();
        if (tid < 64) { const int c = lc[tid]; gb[tid] = c > 0 ? atomicAdd((int*)(p.ws + WS_CTL) + CW_LCNT + (b * NHA + 2 * hp + (tid >> 5)) * NBLK + (tid & 31), c) : 0; }
        __syncthreads();
        unsigned short* lists = (unsigned short*)(p.ws + WS_LIST) + (size_t)(b * NHA + h) * NBLK * LIST_CAP;
        if (b0 >= 0) lists[(size_t)b0 * LIST_CAP + gb[hh * 32 + b0] + lp0] = (unsigned short)(s | (0 << 13));
        if (b1 >= 0) lists[(size_t)b1 * LIST_CAP + gb[hh * 32 + b1] + lp1] = (unsigned short)(s | (1 << 13));
        if (b2 >= 0) lists[(size_t)b2 * LIST_CAP + gb[hh * 32 + b2] + lp2] = (unsigned short)(s | (2 << 13));
    }
}
__device__ __forceinline__ void phase_dilated(const Params& p, int bid, int nb, unsigned char* lds, int tid) {
    const int lane = tid & 63, w = tid >> 6, h = lane >> 5, ql = lane & 31;
    const unsigned lb = (unsigned)(uintptr_t)lds;
    constexpr int NITM = NB * NHB * 32;
    KVRegs<6> R;
#define DIL_DECODE(it_) const int sub = (it_) & 31, head = ((it_) >> 5) % NHB, b = (it_) / (32 * NHB), g = head >> 2, j = head & 3; \
        const int dl = g == 0 ? 1 : g == 1 ? 4 : 16, r = sub % dl, np = sub / dl; const size_t pitch = (size_t)dl * WB * 2; \
        const long tok0 = (long)b * S + (long)(128 * (2 * np - 1)) * dl + r; const int wq = w & 3, nq = 2 * np + (w >> 2); \
        const size_t tq = (size_t)b * S + (size_t)(128 * nq + 32 * wq + ql) * dl + r; (void)j; (void)pitch; (void)tok0; (void)tq; (void)nq; (void)wq;
    int it = bid;
    if (it < NITM) { DIL_DECODE(it)
        kv_load<6>(R, (const unsigned char*)((const bf16*)(p.ws + WS_KB) + tok0 * WB + head * HD), (const unsigned char*)((const bf16*)(p.ws + WS_VB) + tok0 * WB + head * HD), pitch, np == 0 ? 128 : 0, tid); }
    while (it < NITM) {
        DIL_DECODE(it)
        bf16x8v qf[4]; attn_qload(qf, (const bf16*)(p.ws + WS_QB) + tq * WB + head * HD, h);
        __syncthreads();
        kv_commit<6>(R, lds, np == 0 ? 128 : 0, tid);
        __syncthreads();
        const int nit = it + nb;
        if (nit < NITM) { const int it2 = nit; const int sub2 = it2 & 31, head2 = (it2 >> 5) % NHB, b2 = it2 / (32 * NHB), g2 = head2 >> 2; const int dl2 = g2 == 0 ? 1 : g2 == 1 ? 4 : 16, r2 = sub2 % dl2, np2 = sub2 / dl2;
            const size_t pitch2 = (size_t)dl2 * WB * 2; const long tok02 = (long)b2 * S + (long)(128 * (2 * np2 - 1)) * dl2 + r2;
            kv_load<6>(R, (const unsigned char*)((const bf16*)(p.ws + WS_KB) + tok02 * WB + head2 * HD), (const unsigned char*)((const bf16*)(p.ws + WS_VB) + tok02 * WB + head2 * HD), pitch2, np2 == 0 ? 128 : 0, tid); }
        const int winoff = 128 * (w >> 2);
        AttnState st; attn_init(st);
        const unsigned kbase = lb + AT_KOFF + (unsigned)(winoff + ql) * AT_RS + 16 * h;
        const unsigned vbase = lb + AT_VOFF + (unsigned)(winoff + 4 * h + ((lane & 15) >> 2)) * AT_RS + 32 * ((lane >> 4) & 1) + 8 * (lane & 3);
        const int c0 = (nq == 0) ? 4 : wq;
        attn_wave<true>(st, qf, kbase, vbase, c0, wq + 5, wq, wq + 4, lane);
        const float lt = st.l + __shfl_xor(st.l, 32);
        bf16* dst = (bf16*)(p.ws + WS_PARTB) + (((size_t)g * T + tq) * 4 + j) * HD;
        attn_store_partial(st, 1.0f / lt, dst, h);
        if (h == 0) ((float*)(p.ws + WS_LSEB))[((size_t)g * T + tq) * 4 + j] = st.m + __builtin_amdgcn_logf(lt);
        it = nit;
    }
#undef DIL_DECODE
}
__device__ __forceinline__ void phase_moba_past(const Params& p, int bid, int nb, unsigned char* lds, int tid) {
    const int lane = tid & 63, w = tid >> 6, h = lane >> 5, ql = lane & 31;
    const unsigned lb = (unsigned)(uintptr_t)lds;
    unsigned* pfx = (unsigned*)(lds + AT_PFX);
    const int* lcnt = (const int*)(p.ws + WS_CTL) + CW_LCNT;
    int* cntl = (int*)(lds + AT_PFX + 4096);
    unsigned* pfp = pfx + 2048;
    { const int c = __hip_atomic_load(lcnt + tid, __ATOMIC_RELAXED, __HIP_MEMORY_SCOPE_AGENT); unsigned v = (unsigned)(c >> 8), vp = (c & 255) ? 1u : 0u; cntl[tid] = c;
#pragma unroll
      for (int o = 1; o < 64; o <<= 1) { const unsigned u = __shfl_up(v, o), up = __shfl_up(vp, o); if (lane >= o) { v += u; vp += up; } }
      unsigned* wtot = pfx + 520;
      if (lane == 63) { wtot[w] = v; wtot[8 + w] = vp; }
      __syncthreads();
      unsigned base = 0, basep = 0;
#pragma unroll
      for (int i = 0; i < 8; ++i) if (i < w) { base += wtot[i]; basep += wtot[8 + i]; }
      pfx[tid + 1] = v + base; pfp[tid + 1] = vp + basep; if (tid == 0) { pfx[0] = 0; pfp[0] = 0; } }
    __syncthreads();
    const int nfull = (int)pfx[512];
    const int ntot = nfull + (int)pfp[512];
    KVRegs<4> R; bf16x8v qn[4];
    int liA = 0, tileA = 0, cntA = 0; unsigned entA = 0; int liB = 0, tileB = 0, cntB = 0; unsigned entB = 0;
#define PAST_DECODE(it_, li_, tile_, cnt_, ent_) do { const bool part_ = (it_) >= nfull; const unsigned* pf_ = part_ ? pfp : pfx; const int key_ = part_ ? (it_) - nfull : (it_); \
        int lo_ = 0, hi_ = 512; while (hi_ - lo_ > 1) { const int mid_ = (lo_ + hi_) >> 1; if ((int)pf_[mid_] <= key_) lo_ = mid_; else hi_ = mid_; } \
        li_ = lo_; cnt_ = cntl[lo_]; tile_ = part_ ? (cnt_ >> 8) : key_ - (int)pfx[lo_]; \
        ent_ = ((const unsigned short*)(p.ws + WS_LIST))[(size_t)lo_ * LIST_CAP + tile_ * 256 + 32 * w + ql]; } while (0)
#define PAST_KVQ(li_, ent_) do { const int jb_ = (li_) & 31, hd_ = ((li_) >> 5) & 7, b_ = (li_) >> 8; const size_t row0_ = (size_t)b_ * S + (size_t)jb_ * MBLK; \
        kv_load<4>(R, (const unsigned char*)((const bf16*)(p.ws + WS_KA) + row0_ * WA + hd_ * HD), (const unsigned char*)((const bf16*)(p.ws + WS_VA) + row0_ * WA + hd_ * HD), (size_t)WA * 2, 0, tid); \
        attn_qload(qn, (const bf16*)(p.ws + WS_QA) + ((size_t)b_ * S + ((ent_) & 8191)) * WA + hd_ * HD, h); } while (0)
    int itA = bid, itB = bid + nb;
    if (itA < ntot) { PAST_DECODE(itA, liA, tileA, cntA, entA); PAST_KVQ(liA, entA); }
    if (itB < ntot) PAST_DECODE(itB, liB, tileB, cntB, entB);
    while (itA < ntot) {
        __syncthreads();
        kv_commit<4>(R, lds, 0, tid);
        __syncthreads();
        const int li = liA, tile = tileA, cnt = cntA; const unsigned ent = entA;
        const int hd = (li >> 5) & 7, b = li >> 8, slot = (int)(ent >> 13); const size_t tq = (size_t)b * S + (ent & 8191);
        const bool valid = tile * 256 + 32 * w + ql < cnt;
        bf16x8v qf[4];
#pragma unroll
        for (int i = 0; i < 4; ++i) qf[i] = qn[i];
        itA = itB; liA = liB; tileA = tileB; cntA = cntB; entA = entB;
        if (itA < ntot) PAST_KVQ(liA, entA);
        itB += nb;
        if (itB < ntot) PAST_DECODE(itB, liB, tileB, cntB, entB);
        AttnState st; attn_init(st);
        const unsigned kbase = lb + AT_KOFF + (unsigned)ql * AT_RS + 16 * h;
        const unsigned vbase = lb + AT_VOFF + (unsigned)(4 * h + ((lane & 15) >> 2)) * AT_RS + 32 * ((lane >> 4) & 1) + 8 * (lane & 3);
        if (32 * w + tile * 256 < cnt) {
            attn_wave<false>(st, qf, kbase, vbase, 0, 8, -1, -1, lane);
            const float lt = st.l + __shfl_xor(st.l, 32);
            if (valid) { attn_store_partial(st, 1.0f / lt, (bf16*)(p.ws + WS_PARTA) + (((size_t)slot * T + tq) * NHA + hd) * HD, h);
                if (h == 0) ((float*)(p.ws + WS_LSEA))[((size_t)slot * T + tq) * NHA + hd] = st.m + __builtin_amdgcn_logf(lt); }
        }
    }
#undef PAST_DECODE
#undef PAST_KVQ
}
__device__ __forceinline__ void phase_moba_own(const Params& p, int bid, int nb, unsigned char* lds, int tid) {
    const int lane = tid & 63, w = tid >> 6, h = lane >> 5, ql = lane & 31;
    const unsigned lb = (unsigned)(uintptr_t)lds;
    constexpr int NITM = NB * NHA * NBLK;
    KVRegs<4> R; bf16x8v qn[4];
#define OWN_FETCH(it_) do { const int n_ = (it_) % NBLK, hd_ = ((it_) / NBLK) % NHA, b_ = (it_) / (NBLK * NHA); const size_t row0_ = (size_t)b_ * S + (size_t)n_ * MBLK; \
        kv_load<4>(R, (const unsigned char*)((const bf16*)(p.ws + WS_KA) + row0_ * WA + hd_ * HD), (const unsigned char*)((const bf16*)(p.ws + WS_VA) + row0_ * WA + hd_ * HD), (size_t)WA * 2, 0, tid); \
        attn_qload(qn, (const bf16*)(p.ws + WS_QA) + (row0_ + 32 * w + ql) * WA + hd_ * HD, h); } while (0)
    int it = bid;
    if (it < NITM) OWN_FETCH(it);
    while (it < NITM) {
        const int n = it % NBLK, hd = (it / NBLK) % NHA, b = it / (NBLK * NHA);
        const size_t row0 = (size_t)b * S + (size_t)n * MBLK;
        __syncthreads();
        kv_commit<4>(R, lds, 0, tid);
        __syncthreads();
        bf16x8v qf[4];
#pragma unroll
        for (int i = 0; i < 4; ++i) qf[i] = qn[i];
        const int nit = it + nb;
        if (nit < NITM) OWN_FETCH(nit);
        const size_t tq = row0 + 32 * w + ql;
        const unsigned selw = *(const unsigned*)((const signed char*)(p.ws + WS_SEL) + (tq * NHA + hd) * 4);
        float lse[3];
#pragma unroll
        for (int k = 0; k < 3; ++k) lse[k] = ((const float*)(p.ws + WS_LSEA))[((size_t)k * T + tq) * NHA + hd];
        AttnState st; attn_init(st);
        const unsigned kbase = lb + AT_KOFF + (unsigned)ql * AT_RS + 16 * h;
        const unsigned vbase = lb + AT_VOFF + (unsigned)(4 * h + ((lane & 15) >> 2)) * AT_RS + 32 * ((lane >> 4) & 1) + 8 * (lane & 3);
        attn_wave<true>(st, qf, kbase, vbase, 0, w + 1, -1, w, lane);
        const float lt = st.l + __shfl_xor(st.l, 32);
        const float lse_own = st.m + __builtin_amdgcn_logf(lt);
        float M = lse_own;
#pragma unroll
        for (int k = 0; k < 3; ++k) { const bool ok = ((selw >> (8 * k)) & 0x80u) == 0u; if (!ok) lse[k] = -INFINITY; M = fmaxf(M, lse[k]); }
        const float w_own = __builtin_amdgcn_exp2f(lse_own - M); float wsum = w_own;
        const float so = w_own / lt;
#pragma unroll
        for (int r = 0; r < 16; ++r) { st.o0[r] *= so; st.o1[r] *= so; }
#pragma unroll
        for (int k = 0; k < 3; ++k) { const float wk = __builtin_amdgcn_exp2f(lse[k] - M); wsum += wk;
            if (lse[k] != -INFINITY) attn_acc_partial(st.o0, st.o1, wk, (const bf16*)(p.ws + WS_PARTA) + (((size_t)k * T + tq) * NHA + hd) * HD, h); }
        attn_store_partial(st, 1.0f / wsum, (bf16*)p.out + tq * (WA + WBO) + hd * HD, h);
        it = nit;
    }
#undef OWN_FETCH
}
__device__ __forceinline__ void phase_dil_merge(const Params& p, int gtid, int ngt) {
    for (int idx = gtid; idx < T * 4 * 8; idx += ngt) {
        const int ch = idx & 7, j = (idx >> 3) & 3; const size_t t = idx >> 5;
        float l0 = ((const float*)(p.ws + WS_LSEB))[((size_t)0 * T + t) * 4 + j], l1 = ((const float*)(p.ws + WS_LSEB))[((size_t)1 * T + t) * 4 + j], l2 = ((const float*)(p.ws + WS_LSEB))[((size_t)2 * T + t) * 4 + j];
        const float M = fmaxf(l0, fmaxf(l1, l2)); const float w0 = __builtin_amdgcn_exp2f(l0 - M), w1 = __builtin_amdgcn_exp2f(l1 - M), w2 = __builtin_amdgcn_exp2f(l2 - M); const float inv = 1.0f / (w0 + w1 + w2);
        float o[8];
#pragma unroll
        for (int i = 0; i < 8; ++i) o[i] = 0.f;
#pragma unroll
        for (int g = 0; g < 3; ++g) { const float wg = (g == 0 ? w0 : g == 1 ? w1 : w2) * inv; const u32x4 v = *(const u32x4*)((const bf16*)(p.ws + WS_PARTB) + (((size_t)g * T + t) * 4 + j) * HD + 8 * ch);
#pragma unroll
            for (int i = 0; i < 4; ++i) { o[2 * i] += wg * __uint_as_float(v[i] << 16); o[2 * i + 1] += wg * __uint_as_float(v[i] & 0xffff0000u); } }
        u32x4 wv; wv.x = cvtpk(o[0], o[1]); wv.y = cvtpk(o[2], o[3]); wv.z = cvtpk(o[4], o[5]); wv.w = cvtpk(o[6], o[7]);
        *(u32x4*)((bf16*)p.out + t * (WA + WBO) + WA + j * HD + 8 * ch) = wv;
    }
}

__device__ __forceinline__ void phase_check(const Params& p, const bf16* a, const bf16* b, size_t n, int gtid, int ngt) {
    float num = 0.f, den = 0.f;
    for (size_t i = gtid; i < n; i += ngt) { const float x = bf2f(a[i]), y = bf2f(b[i]); num += (x - y) * (x - y); den += y * y; }
    num = wave_sum(num); den = wave_sum(den);
    if ((threadIdx.x & 63) == 0) { atomicAdd((float*)(p.ws + WS_CTL) + CW_DNUM, num); atomicAdd((float*)(p.ws + WS_CTL) + CW_DDEN, den); }
}

#define XB_TMO      128
#define XB_XCNT(j)  (256  + 64 * (j))
#define XB_XSUB(j)  (1280 + 64 * (j))
#define XB_XGEN(j)  (2304 + 64 * (j))
#define XB_TOP      3328
#define XB_TOPGEN   3392
#define XCD_BAR_WORDS 3456
#define XB_SPIN_CAP (1u << 18)
__device__ __forceinline__ unsigned xb_ld(unsigned* p)              { return __hip_atomic_load(p, __ATOMIC_RELAXED, __HIP_MEMORY_SCOPE_AGENT); }
__device__ __forceinline__ unsigned xb_add(unsigned* p, unsigned v) { return __hip_atomic_fetch_add(p, v, __ATOMIC_RELAXED, __HIP_MEMORY_SCOPE_AGENT); }
__device__ __forceinline__ unsigned xb_xcc_id() { return (unsigned)__builtin_amdgcn_s_getreg((3 << 11) | 20) & 0xFu; }
#define XB_SPIN(cond, bar) do { unsigned _sp = 0; while (cond) { __builtin_amdgcn_s_sleep(1); \
    if ((++_sp & 255u) == 0u) { if (xb_ld(&(bar)[XB_TMO])) break; if (_sp > XB_SPIN_CAP) { atomicAdd(&(bar)[XB_TMO], 1u); break; } } } } while (0)
struct XcdBarrier { unsigned* bar; unsigned x; volatile LAS unsigned* st; };
__device__ __forceinline__ XcdBarrier xcd_barrier_post(unsigned* bar, volatile LAS unsigned* st) {
    XcdBarrier b; b.bar = bar; b.x = xb_xcc_id(); b.st = st;
    if (threadIdx.x == 0) (void)xb_add(&bar[XB_XCNT(b.x)], 1u);
    return b;
}
__device__ __forceinline__ void xcd_barrier_complete(unsigned* bar, unsigned x, unsigned& nloc, unsigned& nx) {
    const unsigned G = gridDim.x * gridDim.y * gridDim.z;
    unsigned sum, cnt, mine, sp = 0u;
    for (;;) {
        sum = 0u; cnt = 0u; mine = 0u;
#pragma unroll
        for (unsigned j = 0; j < 16; ++j) { const unsigned c = xb_ld(&bar[XB_XCNT(j)]); sum += c; cnt += (c > 0u) ? 1u : 0u; mine = (j == x) ? c : mine; }
        if (sum == G) break;
        __builtin_amdgcn_s_sleep(1);
        if ((++sp & 255u) == 0u) { if (xb_ld(&bar[XB_TMO])) break; if (sp > XB_SPIN_CAP) { atomicAdd(&bar[XB_TMO], 1u); break; } }
    }
    nloc = mine > 0u ? mine : 1u; nx = cnt > 0u ? cnt : 1u;
}
__device__ __forceinline__ void xcd_barrier(const XcdBarrier& b) {
    asm volatile("s_waitcnt vmcnt(0)" ::: "memory");
    __syncthreads();
    if (threadIdx.x == 0) {
        unsigned* bar = b.bar;
        __builtin_amdgcn_s_waitcnt(0);
        unsigned nloc = b.st[0], nx = b.st[1];
        if (nloc == 0u) { xcd_barrier_complete(bar, b.x, nloc, nx); b.st[0] = nloc; b.st[1] = nx; }
        const unsigned old = xb_add(&bar[XB_XSUB(b.x)], 1u);
        const unsigned gen = old / nloc;
        if (old + 1u == (gen + 1u) * nloc) {
            __builtin_amdgcn_fence(__ATOMIC_RELEASE, "agent");
            asm volatile("s_waitcnt vmcnt(0)" ::: "memory");
            const unsigned og = xb_add(&bar[XB_TOP], 1u);
            const unsigned tg = og / nx;
            if (og + 1u == (tg + 1u) * nx) xb_add(&bar[XB_TOPGEN], 1u);
            else XB_SPIN(xb_ld(&bar[XB_TOPGEN]) == tg, bar);
            __builtin_amdgcn_fence(__ATOMIC_ACQUIRE, "agent");
            xb_add(&bar[XB_XGEN(b.x)], 1u);
            asm volatile("s_waitcnt vmcnt(0)" ::: "memory");
        } else {
            XB_SPIN(xb_ld(&bar[XB_XGEN(b.x)]) == gen, bar);
            __builtin_amdgcn_fence(__ATOMIC_ACQUIRE, "agent");
            asm volatile("s_waitcnt vmcnt(0)" ::: "memory");
        }
    }
    __syncthreads();
}
constexpr int HELPERS = 96;
constexpr int LDS_BYTES = 147456;
__global__ void __launch_bounds__(512, 2) mega_fwd(Params p) {
    extern __shared__ __attribute__((aligned(16))) unsigned char lds[];
    cg::grid_group grid = cg::this_grid();
    const int bid = blockIdx.x, nb = gridDim.x;
#define COORDS() int tid = threadIdx.x; asm volatile("" : "+v"(tid)); const int lane = tid & 63, wave = tid >> 6; const int gw = bid * 8 + wave, ngw = nb * 8, gtid = bid * 512 + tid, ngt = nb * 512; float* wl = (float*)lds + wave * 1152; (void)lane; (void)gw; (void)ngw; (void)gtid; (void)ngt; (void)wl;
    volatile LAS unsigned* bst = (volatile LAS unsigned*)(lds + LDS_BYTES - 64);
    if (threadIdx.x < 16) bst[threadIdx.x] = 0u;
    __syncthreads();
    const XcdBarrier xbar = xcd_barrier_post((unsigned*)(p.ws + WS_CTL) + CW_BAR, bst);
#ifndef TIME_LO
#define TIME_LO -1
#endif
#ifndef TIME_HI
#define TIME_HI -1
#endif
#ifndef TIME_MULT
#define TIME_MULT 2
#endif
    int n_stamp = 0;
#if TIME_LO >= 0
#define STAMP() do { if (bid == 0 && threadIdx.x == 0) ((unsigned long long*)(p.ws + WS_CTL + 917504))[n_stamp] = __builtin_amdgcn_s_memrealtime(); ++n_stamp; } while (0)
#else
#define STAMP() do { } while (0)
#endif
    STAMP();
#define GRID_BAR() do { xcd_barrier(xbar); STAMP(); } while (0)
    phase_prep_a(p, bid, nb, lds);
    if (p.use_cg) grid.sync(); else xcd_barrier(xbar);
    STAMP();
    if (!(bid < HELPERS && nb > 2 * HELPERS)) {
        const int hsub = (nb > 2 * HELPERS) ? HELPERS : 0;
        pg8::Order O; O.init(T / 256, NCOL / 256, nb - hsub, bid - hsub); EpiInProj E{p};
#if FP8_IN
        ProbPlainF8 P{(const bf16*)(p.ws + WS_H), (const bf16*)(p.ws + WS_WIN), D / 2}; pg8::gemm_phase<EpiInProj, ProbPlainF8, true>((PG8_LAS unsigned char*)lds, P, O, E);
#else
        ProbPlain P{(const bf16*)(p.ws + WS_H), (const bf16*)(p.ws + WS_WIN), D}; pg8::gemm_phase<EpiInProj, ProbPlain, true>((PG8_LAS unsigned char*)lds, P, O, E);
#endif
#if TIME_LO >= 0
        if (threadIdx.x == 0) atomicMax((unsigned long long*)(p.ws + WS_CTL + 917504) + 21, (unsigned long long)__builtin_amdgcn_s_memrealtime());
#endif
    }
    phase_prep_b(p, lds);
#if TIME_LO >= 0
    if (threadIdx.x == 0) atomicMax((unsigned long long*)(p.ws + WS_CTL + 917504) + 20, (unsigned long long)__builtin_amdgcn_s_memrealtime());
#endif
    GRID_BAR();
#if DBG == 1
    { InProjN f{p, true}; phase_naive_gemm(f, T, C_VB, bid, nb, lds); }
    GRID_BAR();
    { COORDS(); phase_check(p, (const bf16*)(p.ws + WS_QA), (const bf16*)(p.ws + 426 * MiB), (size_t)T * WA, gtid, ngt);
      phase_check(p, (const bf16*)(p.ws + WS_KA), (const bf16*)(p.ws + 442 * MiB), (size_t)T * WA, gtid, ngt);
      phase_check(p, (const bf16*)(p.ws + WS_QB), (const bf16*)(p.ws + 458 * MiB), (size_t)T * WB, gtid, ngt);
      phase_check(p, (const bf16*)(p.ws + WS_KB), (const bf16*)(p.ws + 482 * MiB), (size_t)T * WB, gtid, ngt); }
    GRID_BAR();
#endif
    { COORDS(); phase_select_lists(p, bid, nb, lds, tid); phase_dilated(p, bid, nb, lds, tid); }
    GRID_BAR();
    { COORDS(); phase_moba_past(p, bid, nb, lds, tid); }
    GRID_BAR();
    { COORDS(); phase_moba_own(p, bid, nb, lds, tid); phase_dil_merge(p, gtid, ngt); }
    GRID_BAR();
#if DBG == 2
    { COORDS(); phase_moba_naive(p, gw, ngw, lane, wl, (bf16*)p.out); phase_dil_naive(p, gw, ngw, lane, wl, (bf16*)p.out + (size_t)T * WA); }
    GRID_BAR();
    { COORDS();
#if DBG_SUB == 0
      phase_check(p, (const bf16*)(p.ws + WS_OA), (const bf16*)p.out, (size_t)T * WA, gtid, ngt);
#else
      phase_check(p, (const bf16*)(p.ws + WS_OB), (const bf16*)p.out + (size_t)T * WA, (size_t)T * WBO, gtid, ngt);
#endif
    }
    GRID_BAR();
#endif
    { pg8::Order O; O.init(T / 256, D / 256, nb, bid); ProbPlainOff P{(const bf16*)p.out, (const bf16*)(p.ws + WS_WOA), WA + WBO}; EpiMixCat E{p};
      pg8::gemm_phase<EpiMixCat, ProbPlainOff, true>((PG8_LAS unsigned char*)lds, P, O, E); }
    GRID_BAR();
    { ProbPlain P{(const bf16*)(p.ws + WS_MIX), (const bf16*)(p.ws + WS_WOUT), D}; pg8::Order O; O.init(T / 256, D / 256, nb, bid); EpiOut E{p};
      pg8::gemm_phase<EpiOut, ProbPlain, true>((PG8_LAS unsigned char*)lds, P, O, E); }
    GRID_BAR();
    { COORDS(); phase_router(p, bid, nb, lds, tid); }
    GRID_BAR();
    { COORDS(); MoeTab mt; const int n_mt = moe_tables<false>(p, lds, tid, 2 * FF / 256, nb, bid, mt);
      ProbMoE<true, (FP8_GU != 0)> P{(const bf16*)(p.ws + WS_H), (const bf16*)(p.ws + WS_WGU), FP8_GU ? D / 2 : D, mt, 2 * FF}; pg8::Order O; O.init(n_mt, 2 * FF / 256, nb, bid); EpiGateUp E{p, mt};
      pg8::gemm_phase<EpiGateUp, ProbMoE<true, (FP8_GU != 0)>, true>((PG8_LAS unsigned char*)lds, P, O, E); }
    GRID_BAR();
    { COORDS(); MoeTab mt; const int n_mt = moe_tables<true>(p, lds, tid, D / 256, nb, bid, mt);
      ProbMoE<false, (FP8_DN != 0)> P{(const bf16*)(p.ws + WS_A2), (const bf16*)(p.ws + WS_WD), FP8_DN ? FF / 2 : FF, mt, D}; pg8::Order O; O.init(n_mt, D / 256, nb, bid); EpiDown E{p, mt};
      pg8::gemm_phase<EpiDown, ProbMoE<false, (FP8_DN != 0)>, true>((PG8_LAS unsigned char*)lds, P, O, E); }
    GRID_BAR();
    { COORDS(); phase_final(p, gw, ngw, lane); }
#if TIME_LO >= 0
    if (bid == 0 && threadIdx.x == 0) { STAMP();
        const unsigned long long* ts = (const unsigned long long*)(p.ws + WS_CTL + 917504);
        const unsigned long long dt = (ts[TIME_HI] - ts[TIME_LO]) * TIME_MULT, t0 = __builtin_amdgcn_s_memrealtime();
        while (__builtin_amdgcn_s_memrealtime() - t0 < dt) __builtin_amdgcn_s_sleep(8); }
#endif
}

#ifdef TIME_LO
#define TIME_LO_HOST TIME_LO
#else
#define TIME_LO_HOST -1
#endif
extern "C" void kernel_launch(void* const* d_in, const int* in_sizes, int n_in, void* d_out, int out_size, void* d_ws, size_t ws_size, hipStream_t stream) {
    if (n_in != 18 || ws_size < WS_END || out_size != T * D) return;
    static int grid_blocks = 0;
    if (!grid_blocks) {
        int dev = 0, cus = 0, per_cu = 0;
        (void)hipGetDevice(&dev);
        (void)hipDeviceGetAttribute(&cus, hipDeviceAttributeMultiprocessorCount, dev);
        (void)hipFuncSetAttribute((const void*)mega_fwd, hipFuncAttributeMaxDynamicSharedMemorySize, LDS_BYTES);
        (void)hipOccupancyMaxActiveBlocksPerMultiprocessor(&per_cu, (const void*)mega_fwd, 512, LDS_BYTES);
        if (per_cu < 1) per_cu = 1;
        if (per_cu > 1) per_cu = 1;
        grid_blocks = cus * per_cu;
    }
    Params p{};
    const float** fp = (const float**)&p;
    for (int i = 0; i < 18; ++i) fp[i] = (const float*)d_in[i];
    p.out = (float*)d_out; p.ws = (unsigned char*)d_ws;
    for (int i = 0; i < 8; ++i) p.inv_freq[i] = (float)pow(500000.0, -(double)i / 8.0);
    (void)hipMemsetAsync((char*)d_ws + WS_CTL, 0, (TIME_LO_HOST >= 0) ? 1 * MiB : 64 * 1024, stream);
    void* args[] = {&p};
    (void)hipLaunchCooperativeKernel((const void*)mega_fwd, dim3(grid_blocks), dim3(512), args, LDS_BYTES, stream);
}
```

```cpp
#include <hip/hip_runtime.h>
#include <hip/hip_cooperative_groups.h>
namespace cg = cooperative_groups;
#include <stdint.h>
#include <math.h>

typedef unsigned short bf16;
typedef float f32x4 __attribute__((ext_vector_type(4)));
typedef unsigned u32x4 __attribute__((ext_vector_type(4)));
typedef unsigned u32x2 __attribute__((ext_vector_type(2)));

__device__ __forceinline__ float bf2f(bf16 v) { return __uint_as_float(((unsigned)v) << 16); }
__device__ __forceinline__ unsigned f2bf(float f) { unsigned u = __float_as_uint(f); return (u + 0x7fffu + ((u >> 16) & 1u)) >> 16; }
__device__ __forceinline__ unsigned pk2(float lo, float hi) { return f2bf(lo) | (f2bf(hi) << 16); }

typedef float f32x2 __attribute__((ext_vector_type(2)));
typedef __bf16 bf16x2_t __attribute__((ext_vector_type(2)));
__device__ __forceinline__ unsigned cvtpk(float lo, float hi) { f32x2 v = {lo, hi}; bf16x2_t b = __builtin_convertvector(v, bf16x2_t); return __builtin_bit_cast(unsigned, b); }
__device__ __forceinline__ float fast_sigmoid(float x) { return __builtin_amdgcn_rcpf(1.0f + __builtin_amdgcn_exp2f(-1.4426950408889634f * x)); }
typedef float f32x16 __attribute__((ext_vector_type(16)));
typedef short s16x4 __attribute__((ext_vector_type(4)));
typedef short bf16x8v __attribute__((ext_vector_type(8)));
__device__ __forceinline__ int crow(int r, int h) { return (r & 3) + 8 * (r >> 2) + 4 * h; }
#define GAS __attribute__((address_space(1)))
#define LAS __attribute__((address_space(3)))
typedef bf16 act;
__device__ __forceinline__ float ldact(const act* p) { return bf2f(*p); }
__device__ __forceinline__ void stact(act* p, float v) { *p = (bf16)f2bf(v); }
__device__ __forceinline__ void ldact8(const act* p, float (&o)[8]) { const u32x4 a = *(const u32x4*)p;
#pragma unroll
    for (int i = 0; i < 4; ++i) { o[2 * i] = __uint_as_float(a[i] << 16); o[2 * i + 1] = __uint_as_float(a[i] & 0xffff0000u); } }
#ifndef FP8_GU
#define FP8_GU 1
#endif
#ifndef FP8_DN
#define FP8_DN 1
#endif
#ifndef FP8_IN
#define FP8_IN 1
#endif
#ifndef FP8_Y
#define FP8_Y 1
#endif
#ifndef FP8_MOE
#define FP8_MOE 1
#endif
constexpr int NB = 2, S = 8192, T = NB * S, D = 1024, HD = 64;
constexpr int NHA = 8, NHB = 12, WA = 512, WB = 768, WBO = 256, NCOL = 5888;
constexpr int MBLK = 256, NBLK = S / MBLK;
constexpr int NE = 32, TOPK = 4, FF = 1024;
constexpr int A2ROWS = 73728;
constexpr int C_QA = 0, C_KA = 512, C_VA = 1024, C_QB = 1536, C_KB = 2304, C_VB = 3072, C_GA = 3840, C_GB = 4864;
constexpr float NORM_EPS = 1e-5f;

constexpr size_t MiB = 1u << 20;
constexpr size_t WS_CTL = 0;
constexpr size_t WS_WIN = 1 * MiB;
constexpr size_t WS_WOA = 13 * MiB;
constexpr size_t WS_WOB = 14 * MiB;
constexpr size_t WS_WOUT = 15 * MiB;
constexpr size_t WS_WGU = 17 * MiB;
constexpr size_t WS_WD = 145 * MiB;
constexpr size_t WS_ROPE = 209 * MiB;
constexpr size_t WS_KMEAN = WS_ROPE + 512 * 1024;
constexpr size_t WS_H = 210 * MiB;
constexpr size_t WS_QA = 242 * MiB, WS_KA = 258 * MiB, WS_VA = 274 * MiB;
constexpr size_t WS_QB = 290 * MiB, WS_KB = 314 * MiB, WS_VB = 338 * MiB;
constexpr size_t WS_SA = 362 * MiB, WS_SB = 394 * MiB;
constexpr size_t WS_PARTB = 210 * MiB;
constexpr size_t WS_LSEB = 234 * MiB;
constexpr size_t WS_LSEA = 235 * MiB;
constexpr size_t WS_SEL = 236 * MiB + 512 * 1024;
constexpr size_t WS_LIST = 426 * MiB;
constexpr size_t WS_PARTA = 442 * MiB;
constexpr int LIST_CAP = 8192;
constexpr size_t WS_OB = 434 * MiB;
constexpr size_t WS_OA = 490 * MiB;
constexpr size_t WS_MIX = 242 * MiB;
constexpr size_t WS_A2 = 242 * MiB;
constexpr size_t WS_ELIST = 386 * MiB;
constexpr size_t WS_EP = 388 * MiB;
constexpr size_t WS_ROWTOK = 390 * MiB;
constexpr size_t WS_ROWP = 391 * MiB;
constexpr size_t WS_TILEE = 392 * MiB;
constexpr size_t WS_Y = 17 * MiB;
constexpr size_t WS_END = 512 * MiB;
#ifndef TIMEB_LO
#define TIMEB_LO -1
#endif
#ifndef TIMEB_HI
#define TIMEB_HI -1
#endif
#ifndef TIMEB_GAIN
#define TIMEB_GAIN 1.0f
#endif
#ifndef DBG
#define DBG 0
#endif
#ifndef DBG_SUB
#define DBG_SUB 0
#endif
#ifndef DBG_GAIN
#define DBG_GAIN 100.0f
#endif
constexpr int CW_DNUM = 192, CW_DDEN = 193;
constexpr int CW_ECNT = 8192;
constexpr int CW_BAR = 4096;
constexpr int CW_LCNT = 12288;
constexpr int CW_HQ = 224;
constexpr int CW_NMT = 160;

struct Params {
    const float *x, *ln_mix_g, *w_in, *b_gate_a, *b_gate_b, *w_o_a, *w_o_b, *w_out, *ln_ffn_g, *w_router, *b_router,
        *w_gate, *b_gate, *w_up, *b_up, *w_down, *b_down, *ln_final_g;
    float* out; unsigned char* ws;
    float inv_freq[8];
    int use_cg, pad0;
};

template <int MAP> __device__ __forceinline__ int rowmap(int n) { return MAP == 0 ? n : (32 * (n >> 4) + (n & 15) + (MAP == 2 ? 16 : 0)); }
template <int MAP> __device__ __forceinline__ void transpose_item(const float* W, int K, int N, bf16* WT, float* scr, int item, int lane) {
    const int nblk = N / 64, kb = item / nblk, nb = item % nblk, k0 = 64 * kb, n0 = 64 * nb;
    f32x4 v[16];
#pragma unroll
    for (int i = 0; i < 16; ++i) v[i] = *(const f32x4*)(W + (size_t)(k0 + (lane >> 4) + 4 * i) * N + n0 + 4 * (lane & 15));
#pragma unroll
    for (int i = 0; i < 16; ++i) { float* d = scr + ((lane >> 4) + 4 * i) * 65 + 4 * (lane & 15); d[0] = v[i].x; d[1] = v[i].y; d[2] = v[i].z; d[3] = v[i].w; }
    asm volatile("s_waitcnt lgkmcnt(0)" ::: "memory");
    const int c = lane & 7;
#pragma unroll
    for (int j = 0; j < 8; ++j) { const int n = (lane >> 3) + 8 * j; const float* q = scr + (8 * c) * 65 + n;
        u32x4 o; o.x = cvtpk(q[0 * 65], q[1 * 65]); o.y = cvtpk(q[2 * 65], q[3 * 65]); o.z = cvtpk(q[4 * 65], q[5 * 65]); o.w = cvtpk(q[6 * 65], q[7 * 65]);
        *(u32x4*)(WT + (size_t)rowmap<MAP>(n0 + n) * K + k0 + 8 * c) = o; }
    asm volatile("s_waitcnt lgkmcnt(0)" ::: "memory");
}
__device__ __forceinline__ float wave_sum(float v) {
#pragma unroll
    for (int o = 1; o < 64; o <<= 1) v += __shfl_xor(v, o);
    return v;
}
__device__ __forceinline__ void sincos_acc(float ang, float& c, float& s) {
    const double a = (double)ang; const double k = rint(a * 0.63661977236758134308); const double y = a - k * 1.57079632679489661923; const double y2 = y * y;
    const double sn = y * (1.0 + y2 * (-1.0 / 6 + y2 * (1.0 / 120 + y2 * (-1.0 / 5040 + y2 * (1.0 / 362880 + y2 * (-1.0 / 39916800))))));
    const double cs = 1.0 + y2 * (-0.5 + y2 * (1.0 / 24 + y2 * (-1.0 / 720 + y2 * (1.0 / 40320 + y2 * (-1.0 / 3628800 + y2 * (1.0 / 479001600))))));
    const int q = ((int)k) & 3;
    const double ss = (q == 0) ? sn : (q == 1) ? cs : (q == 2) ? -sn : -cs;
    const double cc = (q == 0) ? cs : (q == 1) ? -sn : (q == 2) ? -cs : sn;
    c = (float)cc; s = (float)ss;
}
struct TItem { const float* W; bf16* WT; int K, N, map, k0, n0, f8, kd; };
__device__ __forceinline__ TItem titem_decode(const Params& p, int it) {
    constexpr int I_OA = (WA / 64) * (D / 32), I_OB = (WBO / 64) * (D / 32), I_OUT = (D / 64) * (D / 32), I_E = (D / 64) * (FF / 32);
    static_assert(I_E == 512 && D == 1024 && FF == 1024, "the expert-matrix decode below uses shifts");
    unsigned char* ws = p.ws; TItem t; int r = it; t.f8 = 0; t.kd = 0; t.N = D; t.map = 0;
    if (r >= I_OA + I_OB + I_OUT) {
        r -= I_OA + I_OB + I_OUT; const int which = r >> 14  , e = (r >> 9) & 31; r &= 511; t.K = D;
        t.f8 = (which == 2) ? (FP8_DN ? 1 : 0) : (FP8_GU ? 1 : 0); const size_t esz = t.f8 ? 1 : 2;
        if (which == 0) { t.W = p.w_gate + (size_t)e * D * FF; t.WT = (bf16*)(ws + WS_WGU + (size_t)e * 2 * FF * D * esz); t.map = 1; }
        else if (which == 1) { t.W = p.w_up + (size_t)e * D * FF; t.WT = (bf16*)(ws + WS_WGU + (size_t)e * 2 * FF * D * esz); t.map = 2; }
        else { t.W = p.w_down + (size_t)e * FF * D; t.WT = (bf16*)(ws + WS_WD + (size_t)e * D * FF * esz); }
    }
    else if (r < I_OA) { t.W = p.w_o_a; t.WT = (bf16*)(ws + WS_WOA); t.K = WA + WBO; }
    else if ((r -= I_OA) < I_OB) { t.W = p.w_o_b; t.WT = (bf16*)(ws + WS_WOA); t.K = WA + WBO; t.kd = WA; }
    else { r -= I_OB; t.W = p.w_out; t.WT = (bf16*)(ws + WS_WOUT); t.K = D; }
    const int pr_ = r >> 1; t.k0 = 64 * (2 * (pr_ >> 5) + (r & 1)); t.n0 = 32 * (pr_ & 31);
    return t;
}
__device__ __forceinline__ void titem_load(const TItem& t, f32x4 (&v)[8], int lane) {
#pragma unroll
    for (int i = 0; i < 8; ++i) v[i] = __builtin_nontemporal_load((const f32x4*)(t.W + (size_t)(t.k0 + (lane >> 3) + 8 * i) * t.N + t.n0 + 4 * (lane & 7)));
}
__device__ __forceinline__ void titem_store(const TItem& t, const f32x4 (&v)[8], float* scr, int lane) {
#pragma unroll
    for (int i = 0; i < 8; ++i) { float* d = scr + ((lane >> 3) + 8 * i) * 33 + 4 * (lane & 7); d[0] = v[i].x; d[1] = v[i].y; d[2] = v[i].z; d[3] = v[i].w; }
    asm volatile("s_waitcnt lgkmcnt(0)" ::: "memory");
    const int c = (lane & 3) + 4 * (lane >> 5);
#pragma unroll
    for (int j = 0; j < 4; ++j) { const int n = ((lane >> 2) & 7) + 8 * j; const float* q = scr + (8 * c) * 33 + n; const int nn = t.n0 + n;
        const int row = t.map == 0 ? nn : (32 * (nn >> 4) + (nn & 15) + (t.map == 2 ? 16 : 0));
        if (t.f8) { int w0 = __builtin_amdgcn_cvt_pk_fp8_f32(q[0 * 33] * 64.f, q[1 * 33] * 64.f, 0, false); w0 = __builtin_amdgcn_cvt_pk_fp8_f32(q[2 * 33] * 64.f, q[3 * 33] * 64.f, w0, true);
            int w1 = __builtin_amdgcn_cvt_pk_fp8_f32(q[4 * 33] * 64.f, q[5 * 33] * 64.f, 0, false); w1 = __builtin_amdgcn_cvt_pk_fp8_f32(q[6 * 33] * 64.f, q[7 * 33] * 64.f, w1, true);
            u32x2 o; o.x = (unsigned)w0; o.y = (unsigned)w1; *(u32x2*)((unsigned char*)t.WT + (size_t)row * t.K + t.kd + t.k0 + 8 * c) = o; }
        else { u32x4 o; o.x = cvtpk(q[0 * 33], q[1 * 33]); o.y = cvtpk(q[2 * 33], q[3 * 33]); o.z = cvtpk(q[4 * 33], q[5 * 33]); o.w = cvtpk(q[6 * 33], q[7 * 33]);
            *(u32x4*)(t.WT + (size_t)row * t.K + t.kd + t.k0 + 8 * c) = o; } }
    asm volatile("s_waitcnt lgkmcnt(0)" ::: "memory");
}
__device__ __forceinline__ void phase_prep_a(const Params& p, int bid, int nb, unsigned char* lds) {
    int tid = threadIdx.x; asm volatile("" : "+v"(tid)); const int lane = tid & 63, wave = tid >> 6;
    const int gw = bid * 8 + wave, NGW = nb * 8;
    unsigned char* ws = p.ws;
    float* scr = (float*)lds + wave * (64 * 33);
    constexpr int I_IN = (D / 64) * (NCOL / 32);
    for (int it = gw; it < I_IN; it += NGW) {
        TItem t; t.W = p.w_in; t.WT = (bf16*)(ws + WS_WIN); t.K = D; t.N = NCOL; t.map = 0; t.f8 = FP8_IN; t.kd = 0; t.k0 = 64 * (it / (NCOL / 32)); t.n0 = 32 * (it % (NCOL / 32));
        f32x4 v[8]; titem_load(t, v, lane); titem_store(t, v, scr, lane);
    }
    for (int m = gw; m < T; m += NGW) {
        const f32x4* xr = (const f32x4*)(p.x + (size_t)m * D) + lane; const f32x4* gr = (const f32x4*)p.ln_mix_g + lane;
        f32x4 v[4]; float s = 0.f;
#pragma unroll
        for (int j = 0; j < 4; ++j) { v[j] = xr[64 * j]; s += (v[j].x * v[j].x + v[j].y * v[j].y) + (v[j].z * v[j].z + v[j].w * v[j].w); }
        const float rstd = 1.0f / sqrtf(wave_sum(s) * (1.0f / D) + NORM_EPS);
#pragma unroll
        for (int j = 0; j < 4; ++j) { const f32x4 g = gr[64 * j];
#if FP8_IN
            int o = __builtin_amdgcn_cvt_pk_fp8_f32(v[j].x * rstd * g.x, v[j].y * rstd * g.y, 0, false); o = __builtin_amdgcn_cvt_pk_fp8_f32(v[j].z * rstd * g.z, v[j].w * rstd * g.w, o, true);
            ((int*)((unsigned char*)(ws + WS_H) + (size_t)m * D))[lane + 64 * j] = o;
#else
            u32x2 o; o.x = cvtpk(v[j].x * rstd * g.x, v[j].y * rstd * g.y); o.y = cvtpk(v[j].z * rstd * g.z, v[j].w * rstd * g.w); ((u32x2*)((bf16*)(ws + WS_H) + (size_t)m * D))[lane + 64 * j] = o;
#endif
        }
    }
    float2* rope = (float2*)(ws + WS_ROPE);
    for (int i = bid * 512 + tid; i < S * 8; i += nb * 512) { const int s = i >> 3, f = i & 7; const float ang = (float)s * p.inv_freq[f]; float c, sn; sincos_acc(ang, c, sn); rope[i] = make_float2(c, sn); }
    for (int i = bid * 512 + tid; i < NB * NHA * NBLK * HD; i += nb * 512) ((float*)(ws + WS_KMEAN))[i] = 0.f;
}
__device__ __forceinline__ void phase_prep_b(const Params& p, unsigned char* lds) {
    int tid = threadIdx.x; asm volatile("" : "+v"(tid)); const int lane = tid & 63, wave = tid >> 6;
    float* scr = (float*)lds + wave * (64 * 33);
    constexpr int NITEMS = (WA / 64) * (D / 32) + (WBO / 64) * (D / 32) + (D / 64) * (D / 32) + 3 * NE * (D / 64) * (FF / 32);
    int* ctr = (int*)(p.ws + WS_CTL) + CW_HQ;
    int qcur = 0, qend = 0; bool qdone = false;
#define TQ_NEXT(dst) do { if (qcur == qend && !qdone) { int b_ = 0; if (lane == 0) b_ = atomicAdd(ctr, 8); b_ = __builtin_amdgcn_readfirstlane(b_); \
        if (b_ >= NITEMS) qdone = true; else { qcur = b_; qend = (b_ + 8 < NITEMS) ? b_ + 8 : NITEMS; } } \
        if (qcur < qend) dst = qcur++; else dst = -1; } while (0)
    TItem ta, tb, tc; f32x4 va[8], vb[8], vc[8];
    int ia, ib, ic;
    TQ_NEXT(ia); if (ia >= 0) { ta = titem_decode(p, ia); titem_load(ta, va, lane); }
    TQ_NEXT(ib); if (ib >= 0) { tb = titem_decode(p, ib); titem_load(tb, vb, lane); }
    while (ia >= 0) {
        TQ_NEXT(ic); if (ic >= 0) { tc = titem_decode(p, ic); titem_load(tc, vc, lane); }
        titem_store(ta, va, scr, lane);
        if (ib < 0) break;
        TQ_NEXT(ia); if (ia >= 0) { ta = titem_decode(p, ia); titem_load(ta, va, lane); }
        titem_store(tb, vb, scr, lane);
        if (ic < 0) break;
        TQ_NEXT(ib); if (ib >= 0) { tb = titem_decode(p, ib); titem_load(tb, vb, lane); }
        titem_store(tc, vc, scr, lane);
    }
#undef TQ_NEXT
}

__device__ __forceinline__ int cl(int tx, int j) { return (tx & 7) + 8 * j + 32 * (tx >> 3); }
template <class F> __device__ __forceinline__ void phase_naive_gemm(const F& f, int M, int N, int bid, int nb, unsigned char* lds) {
    const int half = threadIdx.x >> 8, tid = threadIdx.x & 255, tx = tid & 15, ty = tid >> 4;
    float (*As)[33] = (float (*)[33])(lds + half * (2 * 64 * 33 * 4)); float (*Bs)[33] = As + 64;
    const int nN = N / 64, ntiles = (M / 64) * nN, stride = nb * 2;
    const int nround = (ntiles + stride - 1) / stride;
    const int lr = tid >> 2, lk = (tid & 3) * 8;
    for (int r = 0; r < nround; ++r) {
        const int it = r * stride + bid * 2 + half;
        const bool valid = it < ntiles;
        const int m0 = valid ? (it / nN) * 64 : 0, n0 = valid ? (it % nN) * 64 : 0;
        const bool act_ = valid && f.active(m0);
        float acc[F::NPASS][4][4];
#pragma unroll
        for (int ps = 0; ps < F::NPASS; ++ps)
#pragma unroll
            for (int i = 0; i < 4; ++i)
#pragma unroll
                for (int j = 0; j < 4; ++j) acc[ps][i][j] = 0.f;
#pragma unroll
        for (int ps = 0; ps < F::NPASS; ++ps) {
            const int K = f.K(ps);
            const bf16* ap = act_ ? f.arow(ps, m0 + lr) : nullptr; const bf16* bp = act_ ? f.brow(ps, m0, n0 + lr) : nullptr;
            for (int k0 = 0; k0 < K; k0 += 32) {
                float av[8], bv[8];
                if (act_) { ldact8(ap + k0 + lk, av); ldact8(bp + k0 + lk, bv); }
                else {
#pragma unroll
                    for (int i = 0; i < 8; ++i) { av[i] = 0.f; bv[i] = 0.f; } }
                __syncthreads();
#pragma unroll
                for (int i = 0; i < 8; ++i) { As[lr][lk + i] = av[i]; Bs[lr][lk + i] = bv[i]; }
                __syncthreads();
#pragma unroll 8
                for (int kk = 0; kk < 32; ++kk) {
                    float a[4], b[4];
#pragma unroll
                    for (int i = 0; i < 4; ++i) { a[i] = As[ty * 4 + i][kk]; b[i] = Bs[cl(tx, i)][kk]; }
#pragma unroll
                    for (int i = 0; i < 4; ++i)
#pragma unroll
                        for (int j = 0; j < 4; ++j) acc[ps][i][j] += a[i] * b[j];
                }
            }
        }
        if (act_) {
#pragma unroll
            for (int i = 0; i < 4; ++i) f.epi(m0 + ty * 4 + i, n0, tx, acc[0][i], acc[F::NPASS - 1][i]);
        }
    }
}

struct InProjN {
    static constexpr int NPASS = 1; Params p; bool alt;
    __device__ __forceinline__ bool active(int) const { return true; }
    __device__ __forceinline__ int K(int) const { return D; }
    __device__ __forceinline__ int ldb(int) const { return NCOL; }
    __device__ __forceinline__ const act* arow(int, int m) const { return (const act*)(p.ws + WS_H) + (size_t)m * D; }
    __device__ __forceinline__ const bf16* brow(int, int, int n) const { return (const bf16*)(p.ws + WS_WIN) + (size_t)n * D; }
    __device__ __forceinline__ void epi(int m, int n0, int tx, float (&v)[4], float (&)[4]) const {
        unsigned char* ws = p.ws;
        act* dst; int ld, cb; bool rope = false; const float* gbias = nullptr;
        if (n0 < C_KA) { dst = (act*)(ws + (alt ? 426 * MiB : WS_QA)); ld = WA; cb = n0 - C_QA; rope = true; }
        else if (n0 < C_VA) { dst = (act*)(ws + (alt ? 442 * MiB : WS_KA)); ld = WA; cb = n0 - C_KA; rope = true; }
        else if (n0 < C_QB) { if (alt) return; dst = (act*)(ws + WS_VA); ld = WA; cb = n0 - C_VA; }
        else if (n0 < C_KB) { dst = (act*)(ws + (alt ? 458 * MiB : WS_QB)); ld = WB; cb = n0 - C_QB; rope = true; }
        else if (n0 < C_VB) { dst = (act*)(ws + (alt ? 482 * MiB : WS_KB)); ld = WB; cb = n0 - C_KB; rope = true; }
        else if (alt) { return; }
        else if (n0 < C_GA) { dst = (act*)(ws + WS_VB); ld = WB; cb = n0 - C_VB; }
        else if (n0 < C_GB) { dst = (act*)(ws + WS_SA); ld = D; cb = n0 - C_GA; gbias = p.b_gate_a; }
        else { dst = (act*)(ws + WS_SB); ld = D; cb = n0 - C_GB; gbias = p.b_gate_b; }
        if (rope && (tx >> 3) == 0) {
            const float2 cs = ((const float2*)(ws + WS_ROPE))[(m % S) * 8 + (tx & 7)];
            const float x1 = v[0], x2 = v[1]; v[0] = x1 * cs.x - x2 * cs.y; v[1] = x2 * cs.x + x1 * cs.y;
        }
#pragma unroll
        for (int j = 0; j < 4; ++j) { const int c = cb + cl(tx, j); float o = v[j];
            if (gbias) { o = 1.0f / (1.0f + expf(-(o + gbias[c]))); }
            stact(dst + (size_t)m * ld + c, o); }
    }
};
struct MixN {
    static constexpr int NPASS = 2; Params p;
    __device__ __forceinline__ bool active(int) const { return true; }
    __device__ __forceinline__ int K(int ps) const { return ps == 0 ? WA : WBO; }
    __device__ __forceinline__ int ldb(int) const { return D; }
    __device__ __forceinline__ const act* arow(int ps, int m) const { return ps == 0 ? (const act*)(p.ws + WS_OA) + (size_t)m * WA : (const act*)(p.ws + WS_OB) + (size_t)m * WBO; }
    __device__ __forceinline__ const bf16* brow(int ps, int, int n) const { return ps == 0 ? (const bf16*)(p.ws + WS_WOA) + (size_t)n * WA : (const bf16*)(p.ws + WS_WOB) + (size_t)n * WBO; }
    __device__ __forceinline__ void epi(int m, int n0, int tx, float (&a)[4], float (&b)[4]) const {
#pragma unroll
        for (int j = 0; j < 4; ++j) { const int c = n0 + cl(tx, j); const size_t o = (size_t)m * D + c;
            const float sa = ldact((const act*)(p.ws + WS_SA) + o), sb = ldact((const act*)(p.ws + WS_SB) + o);
            stact((act*)(p.ws + WS_MIX) + o, sa * a[j] + sb * b[j]); }
    }
};
struct OutN {
    static constexpr int NPASS = 1; Params p;
    __device__ __forceinline__ bool active(int) const { return true; }
    __device__ __forceinline__ int K(int) const { return D; }
    __device__ __forceinline__ int ldb(int) const { return D; }
    __device__ __forceinline__ const act* arow(int, int m) const { return (const act*)(p.ws + WS_MIX) + (size_t)m * D; }
    __device__ __forceinline__ const bf16* brow(int, int, int n) const { return (const bf16*)(p.ws + WS_WOUT) + (size_t)n * D; }
    __device__ __forceinline__ void epi(int m, int n0, int tx, float (&a)[4], float (&)[4]) const {
#pragma unroll
        for (int j = 0; j < 4; ++j) { const size_t o = (size_t)m * D + n0 + cl(tx, j); p.out[o] = p.x[o] + a[j]; }
    }
};


namespace pg8 {
#define PG8_LAS __attribute__((address_space(3)))
typedef short bf16x8 __attribute__((ext_vector_type(8)));
typedef int v4i_t __attribute__((ext_vector_type(4)));
typedef int v8i_t __attribute__((ext_vector_type(8)));
constexpr int BM = 256, BK = 64, HALF = 128, HTB = HALF * BK * 2  , STAGE_BYTES = 8 * HTB, NXCD = 8, WGM = 8;
__device__ __forceinline__ int lds_byte(int r, int c) { const int st = (r >> 4) * 2 + (c >> 5), rr = r & 15, cc = c & 31, ob = rr * 64 + cc * 2; return st * 1024 + (ob ^ (((ob >> 9) & 1) << 5)); }
__device__ __forceinline__ void stage_rc(int b, int& R, int& C) { const int st = b / 1024, sb = b % 1024, swz = sb ^ (((sb >> 9) & 1) << 5); R = (st >> 1) * 16 + swz / 64; C = (st & 1) * 32 + (swz % 64) / 2; }
__device__ __forceinline__ int perm32(int rho) { const int n = rho >> 4, i = rho & 15; return 8 * (i >> 2) + 4 * n + (i & 3); }
struct Unit { int pm, pn, slot; };
struct Order {
    int nM, nN, nwg, G, c;
    __device__ __forceinline__ void init(int nM_, int nN_, int G_, int c_) { nM = nM_; nN = nN_; nwg = nM * nN; G = G_; c = c_; }
    __device__ __forceinline__ bool next(int i, Unit& u) const {
        const long L = (long)i * G + c; if (L >= nwg) return false;
        int wgid = (int)L; { const int q = nwg / NXCD, r = nwg % NXCD, xcd = wgid % NXCD, off = wgid / NXCD; wgid = (xcd < r ? xcd * (q + 1) : r * (q + 1) + (xcd - r) * q) + off; }
        const int nig = WGM * nN, gid = wgid / nig, fm = gid * WGM, gsz = (nM - fm) < WGM ? (nM - fm) : WGM;
        u.pm = fm + ((wgid % nig) % gsz); u.pn = (wgid % nig) / gsz; u.slot = i; return true;
    }
};
template <class Epi, class Prob, bool ALIGN_EPI>
__device__ __forceinline__ void gemm_phase(PG8_LAS unsigned char* lds, const Prob& P, const Order& S, const Epi& E) {
    int tid = threadIdx.x; asm volatile("" : "+v"(tid)); const int wid = __builtin_amdgcn_readfirstlane(tid >> 6), lane = tid & 63, wr = wid >> 2, wc = wid & 3, fr = lane & 15, fq = lane >> 4;
    constexpr bool GATHER = Prob::GATHER; constexpr bool FP8 = Prob::FP8;
    const int K = P.K, nt = K / BK;
    unsigned voffA[2], voffB[2];
#pragma unroll
    for (int i = 0; i < 2; ++i) { int R, C; stage_rc(tid * 16 + i * 8192, R, C); const int Rb = Epi::PERM ? ((R & ~31) + perm32(R & 31)) : R; voffA[i] = (unsigned)(R * K + C) * 2u; voffB[i] = (unsigned)(Rb * K + C) * 2u; }
    const size_t kstep = (size_t)(BK * 2);
    const size_t hstep = (size_t)HALF * K * 2;
    const unsigned ldsw = (unsigned)wid * 1024u;
    const int aoff = lds_byte(wr * 64 + fr, fq * 8), boff = lds_byte(wc * 32 + fr, fq * 8);
    const char* const Ab = (const char*)P.abase();
#define PG8_SA(b, h) (((b) * 2 + (h)) * HTB)
#define PG8_SB(b, h) ((4 + (b) * 2 + (h)) * HTB)
#define PG8_GLDS(src, bufoff, i) __builtin_amdgcn_global_load_lds((const unsigned*)(src), (PG8_LAS unsigned*)(lds + (bufoff) + ldsw + (i) * 8192), 16, 0, 0)
#define PG8_STAGE_B(bufoff, gbase) do { PG8_GLDS((const char*)(gbase) + voffB[0], bufoff, 0); PG8_GLDS((const char*)(gbase) + voffB[1], bufoff, 1); } while (0)
#define PG8_STAGE_A(bufoff, h, kb) do { if constexpr (GATHER) { PG8_GLDS(Ab + (size_t)g[h][0] + (kb), bufoff, 0); PG8_GLDS(Ab + (size_t)g[h][1] + (kb), bufoff, 1); } \
        else { PG8_GLDS(cA + (h) * hstep + (kb) + voffA[0], bufoff, 0); PG8_GLDS(cA + (h) * hstep + (kb) + voffA[1], bufoff, 1); } } while (0)
#define PG8_CAT(x0, x1) __builtin_shufflevector(x0, x1, 0, 1, 2, 3, 4, 5, 6, 7)
#define PG8_LO(x) __builtin_bit_cast(bf16x8, __builtin_shufflevector(x, x, 0, 1, 2, 3))
#define PG8_HI(x) __builtin_bit_cast(bf16x8, __builtin_shufflevector(x, x, 4, 5, 6, 7))
#define PG8_LDA(dst, b, h) do { _Pragma("unroll") for (int m = 0; m < 4; ++m) dst[m] = PG8_CAT(*(const PG8_LAS v4i_t*)(lds + PG8_SA(b, h) + aoff + m * 2048), *(const PG8_LAS v4i_t*)(lds + PG8_SA(b, h) + aoff + m * 2048 + 1024)); } while (0)
#define PG8_LDB(dst, b, h) do { _Pragma("unroll") for (int n = 0; n < 2; ++n) dst[n] = PG8_CAT(*(const PG8_LAS v4i_t*)(lds + PG8_SB(b, h) + boff + n * 2048), *(const PG8_LAS v4i_t*)(lds + PG8_SB(b, h) + boff + n * 2048 + 1024)); } while (0)
#define PG8_MMA(ai, bj, At, Bt) do { __builtin_amdgcn_s_setprio(1); _Pragma("unroll") for (int m = 0; m < 4; ++m) _Pragma("unroll") for (int n = 0; n < 2; ++n) { \
        if constexpr (FP8) acc[ai][bj][m][n] = __builtin_amdgcn_mfma_scale_f32_16x16x128_f8f6f4(Bt[n], At[m], acc[ai][bj][m][n], 0, 0, 0, 0x79797979, 0, 0x7f7f7f7f); \
        else { acc[ai][bj][m][n] = __builtin_amdgcn_mfma_f32_16x16x32_bf16(PG8_LO(Bt[n]), PG8_LO(At[m]), acc[ai][bj][m][n], 0, 0, 0); \
               acc[ai][bj][m][n] = __builtin_amdgcn_mfma_f32_16x16x32_bf16(PG8_HI(Bt[n]), PG8_HI(At[m]), acc[ai][bj][m][n], 0, 0, 0); } } \
        __builtin_amdgcn_s_setprio(0); } while (0)
#define PG8_WAIT_V(n) asm volatile("s_waitcnt vmcnt(" #n ")" ::: "memory")
#define PG8_WAIT_L(n) asm volatile("s_waitcnt lgkmcnt(" #n ")" ::: "memory")
#define PG8_BAR __builtin_amdgcn_s_barrier()
#define PG8_SCHED __builtin_amdgcn_sched_barrier(0)
    Unit cur, nxt; int ui = 0;
    if (!S.next(0, cur)) return;
    f32x4 acc[2][2][4][2];
#pragma unroll
    for (int a = 0; a < 2; ++a)
#pragma unroll
        for (int b = 0; b < 2; ++b)
#pragma unroll
            for (int m = 0; m < 4; ++m)
#pragma unroll
                for (int n = 0; n < 2; ++n) acc[a][b][m][n] = (f32x4){0.f, 0.f, 0.f, 0.f};
    if constexpr (Epi::HAS_INIT) { f32x4 iv[2][2]; E.init_load(iv, cur, wc, fq); E.init_apply(acc, iv); }
    v8i_t At[4], B0[2], B1[2];
    unsigned g[2][2], gn[2][2];
    const char* cA = Ab; const char* nA = Ab;
    if constexpr (GATHER) {
#pragma unroll
        for (int h = 0; h < 2; ++h)
#pragma unroll
            for (int i = 0; i < 2; ++i) { g[h][i] = P.goff(cur, h, voffA[i]); gn[h][i] = g[h][i]; }
    } else { cA = Ab + P.aoff(cur); nA = cA; }
    const char* cB = (const char*)P.bbase(cur);
    PG8_STAGE_B(PG8_SB(0, 0), cB); PG8_STAGE_B(PG8_SB(0, 1), cB + hstep); PG8_STAGE_A(PG8_SA(0, 0), 0, 0); PG8_STAGE_A(PG8_SA(0, 1), 1, 0);
    if (wr == 1) PG8_BAR;
    PG8_WAIT_V(2); PG8_BAR;
    PG8_STAGE_B(PG8_SB(1, 0), cB + kstep); PG8_STAGE_A(PG8_SA(1, 0), 0, kstep); PG8_STAGE_B(PG8_SB(1, 1), cB + hstep + kstep);
    PG8_WAIT_V(6); PG8_BAR;
    for (;;) {
        const bool has_next = S.next(ui + 1, nxt);
        const char* nB = cB;
        if (has_next) { nB = (const char*)P.bbase(nxt);
            if constexpr (GATHER) {
#pragma unroll
                for (int h = 0; h < 2; ++h)
#pragma unroll
                    for (int i = 0; i < 2; ++i) gn[h][i] = P.goff(nxt, h, voffA[i]);
            } else nA = Ab + P.aoff(nxt); }
        for (int t = 0; t < nt; t += 2) {
            const bool last = (t == nt - 2);
            const size_t k1 = (size_t)(t + 1) * kstep;
            const size_t k2 = last ? 0 : (size_t)(t + 2) * kstep, k3 = k2 + kstep;
            if constexpr (Epi::MID_T > 0) { if (t == Epi::MID_T) E.mid(acc, cur, wr, wc, fr, fq); }
            PG8_LDB(B0, 0, 0); PG8_LDB(B1, 0, 1); PG8_SCHED; PG8_LDA(At, 0, 0); PG8_STAGE_A(PG8_SA(1, 1), 1, k1);
            if (last) { cB = nB; if constexpr (GATHER) { g[0][0] = gn[0][0]; g[0][1] = gn[0][1]; g[1][0] = gn[1][0]; g[1][1] = gn[1][1]; } else cA = nA; }
            PG8_WAIT_V(8); PG8_WAIT_L(0); PG8_BAR; PG8_MMA(0, 0, At, B0); PG8_MMA(0, 1, At, B1); PG8_BAR; PG8_SCHED;
            PG8_LDA(At, 0, 1); PG8_STAGE_B(PG8_SB(0, 0), cB + k2); PG8_STAGE_B(PG8_SB(0, 1), cB + k2 + hstep); PG8_STAGE_A(PG8_SA(0, 0), 0, k2);
            PG8_WAIT_V(8); PG8_WAIT_L(0); PG8_BAR; PG8_MMA(1, 0, At, B0); PG8_MMA(1, 1, At, B1); PG8_BAR; PG8_SCHED;
            PG8_LDB(B0, 1, 0); PG8_LDB(B1, 1, 1); PG8_SCHED; PG8_LDA(At, 1, 0); PG8_STAGE_A(PG8_SA(0, 1), 1, k2);
            PG8_WAIT_V(8); PG8_WAIT_L(0); PG8_BAR; PG8_MMA(0, 0, At, B0); PG8_MMA(0, 1, At, B1); PG8_BAR; PG8_SCHED;
            PG8_LDA(At, 1, 1); PG8_STAGE_B(PG8_SB(1, 0), cB + k3); PG8_STAGE_B(PG8_SB(1, 1), cB + k3 + hstep); PG8_STAGE_A(PG8_SA(1, 0), 0, k3);
            PG8_WAIT_V(8); PG8_WAIT_L(0); PG8_BAR; PG8_MMA(1, 0, At, B0); PG8_MMA(1, 1, At, B1); PG8_BAR; PG8_SCHED;
        }
        if constexpr (ALIGN_EPI) { if (wr == 0) PG8_BAR; }
        f32x4 iv[2][2];
        if constexpr (Epi::HAS_INIT) { if (has_next) E.init_load(iv, nxt, wc, fq); }
        E(acc, cur, wr, wc, fr, fq);
        if (!has_next) break;
#pragma unroll
        for (int a = 0; a < 2; ++a)
#pragma unroll
            for (int b = 0; b < 2; ++b)
#pragma unroll
                for (int m = 0; m < 4; ++m)
#pragma unroll
                    for (int n = 0; n < 2; ++n) acc[a][b][m][n] = (f32x4){0.f, 0.f, 0.f, 0.f};
        if constexpr (Epi::HAS_INIT) E.init_apply(acc, iv);
        cur = nxt; ++ui;
        if constexpr (ALIGN_EPI) { if (wr == 1) PG8_BAR; }
    }
    PG8_WAIT_V(0);
    if constexpr (!ALIGN_EPI) { if (wr == 0) PG8_BAR; }
    PG8_BAR;
#undef PG8_SA
#undef PG8_SB
#undef PG8_GLDS
#undef PG8_STAGE_A
#undef PG8_STAGE_B
#undef PG8_LDA
#undef PG8_LDB
#undef PG8_MMA
#undef PG8_CAT
#undef PG8_LO
#undef PG8_HI
#undef PG8_WAIT_V
#undef PG8_WAIT_L
#undef PG8_BAR
#undef PG8_SCHED
}
}


constexpr int MT_OFF = 131072;
struct MoeTab { const LAS int* e_of; const LAS int* rt; const LAS float* rp; };
template <bool WITH_P> __device__ __forceinline__ int moe_tables(const Params& p, unsigned char* lds, int tid, int nN, int nb, int bid, MoeTab& mt) {
    LAS int* cnt = (LAS int*)(lds + MT_OFF); LAS int* pstart = cnt + 32; LAS int* e_of = cnt + 72; constexpr int MAXU = WITH_P ? 5 : 9;
    LAS int* rt = cnt + 112; LAS float* rp = (LAS float*)(rt + MAXU * 256);
    __syncthreads();
    if (tid < NE) cnt[tid] = __hip_atomic_load((const int*)(p.ws + WS_CTL) + CW_ECNT + 64 * tid, __ATOMIC_RELAXED, __HIP_MEMORY_SCOPE_AGENT);
    __syncthreads();
    if (tid == 0) { int st = 0; for (int e = 0; e < NE; ++e) { pstart[e] = st; st += (cnt[e] + 255) & ~255; } pstart[32] = st; }
    __syncthreads();
    const int n_mt = __builtin_amdgcn_readfirstlane(pstart[32] >> 8);
    pg8::Order O; O.init(n_mt, nN, nb, bid);
    LAS int* pm_of = cnt + 88;
    if (tid < MAXU) { pg8::Unit u; int e = 0, pm = -1;
        if (O.next(tid, u)) { pm = u.pm; for (int q = 1; q < NE; ++q) if (pm * 256 >= pstart[q]) e = q; }
        e_of[tid] = e; pm_of[tid] = pm; }
    __syncthreads();
    for (int idx = tid; idx < MAXU * 256; idx += 512) { const int i = idx >> 8, r = idx & 255, pm = pm_of[i];
        if (pm >= 0) { const int e = e_of[i]; const int pos = pm * 256 + r - pstart[e]; const bool ok = pos < cnt[e];
            rt[idx] = ok ? ((const int*)(p.ws + WS_ELIST))[e * T + pos] : -1;
            if (WITH_P) rp[idx] = ok ? ((const float*)(p.ws + WS_EP))[e * T + pos] : 0.f; } }
    __syncthreads();
    mt.e_of = e_of; mt.rt = rt; mt.rp = rp;
    return n_mt;
}
struct ProbPlain {
    static constexpr bool GATHER = false, FP8 = false;
    const bf16* A; const bf16* Bt; int K;
    __device__ __forceinline__ const bf16* abase() const { return A; }
    __device__ __forceinline__ size_t aoff(const pg8::Unit& u) const { return (size_t)u.pm * 256 * K * 2; }
    __device__ __forceinline__ unsigned goff(const pg8::Unit&, int, unsigned) const { return 0u; }
    __device__ __forceinline__ const bf16* bbase(const pg8::Unit& u) const { return Bt + (size_t)u.pn * 256 * K; }
};
struct ProbPlainOff {
    static constexpr bool GATHER = true, FP8 = false;
    const bf16* A; const bf16* Bt; int K;
    __device__ __forceinline__ const bf16* abase() const { return A; }
    __device__ __forceinline__ size_t aoff(const pg8::Unit& u) const { return (size_t)u.pm * 256 * K * 2; }
    __device__ __forceinline__ unsigned goff(const pg8::Unit& u, int h, unsigned voff) const { return (unsigned)(u.pm * 256 + h * 128) * ((unsigned)K * 2u) + voff; }
    __device__ __forceinline__ const bf16* bbase(const pg8::Unit& u) const { return Bt + (size_t)u.pn * 256 * K; }
};
struct ProbPlainF8 {
    static constexpr bool GATHER = true, FP8 = true;
    const bf16* A; const bf16* Bt; int K;
    __device__ __forceinline__ const bf16* abase() const { return A; }
    __device__ __forceinline__ size_t aoff(const pg8::Unit& u) const { return (size_t)u.pm * 256 * K * 2; }
    __device__ __forceinline__ unsigned goff(const pg8::Unit& u, int h, unsigned voff) const { return (unsigned)(u.pm * 256 + h * 128) * ((unsigned)K * 2u) + voff; }
    __device__ __forceinline__ const bf16* bbase(const pg8::Unit& u) const { return Bt + (size_t)u.pn * 256 * K; }
};
template <bool G, bool F8> struct ProbMoE {
    static constexpr bool GATHER = true, FP8 = F8;
    const bf16* A; const bf16* Bt; int K; MoeTab mt; int rows_e;
    __device__ __forceinline__ const bf16* abase() const { return A; }
    __device__ __forceinline__ size_t aoff(const pg8::Unit& u) const { return (size_t)u.pm * 256 * K * 2; }
    __device__ __forceinline__ unsigned goff(const pg8::Unit& u, int h, unsigned voff) const {
        const unsigned pitch = (unsigned)K * 2u;
        if constexpr (!G) return (unsigned)(u.pm * 256 + h * 128) * pitch + voff;
        const unsigned R = voff / pitch, inrow = voff - R * pitch;
        const int a = mt.rt[u.slot * 256 + h * 128 + (int)R]; const int row = a < 0 ? 0 : (a >> 2);
        return (unsigned)row * pitch + inrow; }
    __device__ __forceinline__ const bf16* bbase(const pg8::Unit& u) const { const int e = __builtin_amdgcn_readfirstlane(mt.e_of[u.slot]); return Bt + ((size_t)e * rows_e + (size_t)u.pn * 256) * K; }
};
struct EpiInProj {
    static constexpr bool HAS_INIT = false; static constexpr int MID_T = 0; static constexpr bool PERM = true; Params p;
    __device__ __forceinline__ void operator()(const f32x4 (&acc)[2][2][4][2], const pg8::Unit& u, int wr, int wc, int fr, int fq) const {
        unsigned char* ws = p.ws; const int pn = u.pn;
        bf16* dst; int ld, ct; int kind = 0; const float* gb = nullptr;
        if (pn < 2) { dst = (bf16*)(ws + WS_QA); ld = WA; ct = pn * 256; kind = 1; }
        else if (pn < 4) { dst = (bf16*)(ws + WS_KA); ld = WA; ct = (pn - 2) * 256; kind = 1; }
        else if (pn < 6) { dst = (bf16*)(ws + WS_VA); ld = WA; ct = (pn - 4) * 256; }
        else if (pn < 9) { dst = (bf16*)(ws + WS_QB); ld = WB; ct = (pn - 6) * 256; kind = 1; }
        else if (pn < 12) { dst = (bf16*)(ws + WS_KB); ld = WB; ct = (pn - 9) * 256; kind = 1; }
        else if (pn < 15) { dst = (bf16*)(ws + WS_VB); ld = WB; ct = (pn - 12) * 256; }
        else if (pn < 19) { dst = (bf16*)(ws + WS_SA); ld = D; ct = (pn - 15) * 256; kind = 2; gb = p.b_gate_a; }
        else { dst = (bf16*)(ws + WS_SB); ld = D; ct = (pn - 19) * 256; kind = 2; gb = p.b_gate_b; }
        const int row0 = u.pm * 256 + wr * 64 + fr, col0 = ct + wc * 32 + 8 * fq;
        f32x4 bv[2][2];
#pragma unroll
        for (int bj = 0; bj < 2; ++bj)
#pragma unroll
            for (int n = 0; n < 2; ++n) bv[bj][n] = (kind == 2) ? *(const f32x4*)(gb + col0 + bj * 128 + 4 * n) : (f32x4){0.f, 0.f, 0.f, 0.f};
        const bool dorope = (kind == 1) && ((wc & 1) == 0);
        const bool dokm = (pn == 2) || (pn == 3);
        f32x4 ks[2][2];
#pragma unroll
        for (int bj = 0; bj < 2; ++bj) { ks[bj][0] = (f32x4){0.f, 0.f, 0.f, 0.f}; ks[bj][1] = (f32x4){0.f, 0.f, 0.f, 0.f}; }
        const float sgn = (fq == 0) ? -1.0f : 1.0f; const bool rl = fq < 2;
#pragma unroll
        for (int ai = 0; ai < 2; ++ai)
#pragma unroll
            for (int m = 0; m < 4; ++m) {
                const int row = row0 + ai * 128 + m * 16;
                f32x4 cs[4];
                if (dorope) { const f32x4* rp = (const f32x4*)(ws + WS_ROPE) + (size_t)(row % S) * 4;
#pragma unroll
                    for (int i = 0; i < 4; ++i) cs[i] = rp[i]; }
                bf16* rowp = dst + (size_t)row * ld + col0;
#pragma unroll
                for (int bj = 0; bj < 2; ++bj) {
                    f32x4 v0 = acc[ai][bj][m][0], v1 = acc[ai][bj][m][1];
                    if (dorope) {
                        f32x4 q0, q1;
#pragma unroll
                        for (int j = 0; j < 4; ++j) { q0[j] = __shfl_xor(v0[j], 16); q1[j] = __shfl_xor(v1[j], 16); }
                        if (rl) {
                            v0[0] = v0[0] * cs[0][0] + sgn * q0[0] * cs[0][1]; v0[1] = v0[1] * cs[0][2] + sgn * q0[1] * cs[0][3];
                            v0[2] = v0[2] * cs[1][0] + sgn * q0[2] * cs[1][1]; v0[3] = v0[3] * cs[1][2] + sgn * q0[3] * cs[1][3];
                            v1[0] = v1[0] * cs[2][0] + sgn * q1[0] * cs[2][1]; v1[1] = v1[1] * cs[2][2] + sgn * q1[1] * cs[2][3];
                            v1[2] = v1[2] * cs[3][0] + sgn * q1[2] * cs[3][1]; v1[3] = v1[3] * cs[3][2] + sgn * q1[3] * cs[3][3]; }
                    }
                    if (dokm) { ks[bj][0] += v0; ks[bj][1] += v1; }
                    if (kind == 2) {
                        v0 = v0 + bv[bj][0]; v1 = v1 + bv[bj][1];
#pragma unroll
                        for (int j = 0; j < 4; ++j) { v0[j] = fast_sigmoid(v0[j]); v1[j] = fast_sigmoid(v1[j]); } }
                    u32x4 w; w.x = cvtpk(v0[0], v0[1]); w.y = cvtpk(v0[2], v0[3]); w.z = cvtpk(v1[0], v1[1]); w.w = cvtpk(v1[2], v1[3]);
                    *(u32x4*)(rowp + bj * 128) = w;
                }
            }
        if (dokm) {
            float* km = (float*)(ws + WS_KMEAN) + (size_t)((u.pm >> 5) * NHA * NBLK + (u.pm & 31)) * HD;
#pragma unroll
            for (int bj = 0; bj < 2; ++bj)
#pragma unroll
                for (int n = 0; n < 2; ++n)
#pragma unroll
                    for (int j = 0; j < 4; ++j) { float v = ks[bj][n][j]; v += __shfl_xor(v, 1); v += __shfl_xor(v, 2); v += __shfl_xor(v, 4); v += __shfl_xor(v, 8);
                        if (fr == 0) { const int c = col0 + bj * 128 + 4 * n + j; atomicAdd(km + (size_t)(c >> 6) * NBLK * HD + (c & 63), v * (1.0f / MBLK)); } }
        }
    }
};
template <int PASS> struct EpiMix {
    static constexpr bool HAS_INIT = false; static constexpr int MID_T = 0; static constexpr bool PERM = true; Params p;
    __device__ __forceinline__ void operator()(const f32x4 (&acc)[2][2][4][2], const pg8::Unit& u, int wr, int wc, int fr, int fq) const {
        const int row0 = u.pm * 256 + wr * 64 + fr, col0 = u.pn * 256 + wc * 32 + 8 * fq;
        const bf16* G = (const bf16*)(p.ws + (PASS == 0 ? WS_SA : WS_SB)); bf16* M = (bf16*)(p.ws + WS_MIX);
#pragma unroll
        for (int ai = 0; ai < 2; ++ai)
#pragma unroll
            for (int m = 0; m < 4; ++m) {
                const size_t ro = (size_t)(row0 + ai * 128 + m * 16) * D + col0;
#pragma unroll
                for (int bj = 0; bj < 2; ++bj) {
                    const u32x4 g = *(const u32x4*)(G + ro + bj * 128);
                    f32x4 v0 = acc[ai][bj][m][0], v1 = acc[ai][bj][m][1];
                    v0[0] *= __uint_as_float(g.x << 16); v0[1] *= __uint_as_float(g.x & 0xffff0000u); v0[2] *= __uint_as_float(g.y << 16); v0[3] *= __uint_as_float(g.y & 0xffff0000u);
                    v1[0] *= __uint_as_float(g.z << 16); v1[1] *= __uint_as_float(g.z & 0xffff0000u); v1[2] *= __uint_as_float(g.w << 16); v1[3] *= __uint_as_float(g.w & 0xffff0000u);
                    if (PASS == 1) { const u32x4 t = *(const u32x4*)(M + ro + bj * 128);
                        v0[0] += __uint_as_float(t.x << 16); v0[1] += __uint_as_float(t.x & 0xffff0000u); v0[2] += __uint_as_float(t.y << 16); v0[3] += __uint_as_float(t.y & 0xffff0000u);
                        v1[0] += __uint_as_float(t.z << 16); v1[1] += __uint_as_float(t.z & 0xffff0000u); v1[2] += __uint_as_float(t.w << 16); v1[3] += __uint_as_float(t.w & 0xffff0000u); }
                    u32x4 w; w.x = cvtpk(v0[0], v0[1]); w.y = cvtpk(v0[2], v0[3]); w.z = cvtpk(v1[0], v1[1]); w.w = cvtpk(v1[2], v1[3]);
                    *(u32x4*)(M + ro + bj * 128) = w;
                }
            }
    }
};
struct EpiMixCat {
    static constexpr bool HAS_INIT = false; static constexpr int MID_T = 8; static constexpr bool PERM = true; Params p;
    __device__ __forceinline__ void mid(f32x4 (&acc)[2][2][4][2], const pg8::Unit& u, int wr, int wc, int fr, int fq) const {
        int row0 = u.pm * 256 + wr * 64 + fr, col0 = u.pn * 256 + wc * 32 + 8 * fq;
        asm volatile("" : "+v"(row0), "+v"(col0));
        const bf16* GA = (const bf16*)(p.ws + WS_SA); const bf16* GB = (const bf16*)(p.ws + WS_SB);
#pragma unroll
        for (int ai = 0; ai < 2; ++ai)
#pragma unroll
            for (int m = 0; m < 4; ++m) {
                const size_t ro = (size_t)(row0 + ai * 128 + m * 16) * D + col0;
#pragma unroll
                for (int bj = 0; bj < 2; ++bj) {
                    const u32x4 a = *(const u32x4*)(GA + ro + bj * 128), b = *(const u32x4*)(GB + ro + bj * 128);
#pragma unroll
                    for (int j = 0; j < 4; ++j) { const float r0 = __uint_as_float(a[j] << 16) * __builtin_amdgcn_rcpf(__uint_as_float(b[j] << 16)), r1 = __uint_as_float(a[j] & 0xffff0000u) * __builtin_amdgcn_rcpf(__uint_as_float(b[j] & 0xffff0000u));
                        if (j < 2) { acc[ai][bj][m][0][2 * j] *= r0; acc[ai][bj][m][0][2 * j + 1] *= r1; } else { acc[ai][bj][m][1][2 * j - 4] *= r0; acc[ai][bj][m][1][2 * j - 3] *= r1; } }
                }
                asm volatile("" ::: "memory");
            }
    }
    __device__ __forceinline__ void operator()(const f32x4 (&acc)[2][2][4][2], const pg8::Unit& u, int wr, int wc, int fr, int fq) const {
        const int row0 = u.pm * 256 + wr * 64 + fr, col0 = u.pn * 256 + wc * 32 + 8 * fq;
        const bf16* GB = (const bf16*)(p.ws + WS_SB); bf16* M = (bf16*)(p.ws + WS_MIX);
#pragma unroll
        for (int ai = 0; ai < 2; ++ai)
#pragma unroll
            for (int m = 0; m < 4; ++m) {
                const size_t ro = (size_t)(row0 + ai * 128 + m * 16) * D + col0;
#pragma unroll
                for (int bj = 0; bj < 2; ++bj) {
                    const u32x4 g = *(const u32x4*)(GB + ro + bj * 128);
                    f32x4 v0 = acc[ai][bj][m][0], v1 = acc[ai][bj][m][1];
                    v0[0] *= __uint_as_float(g.x << 16); v0[1] *= __uint_as_float(g.x & 0xffff0000u); v0[2] *= __uint_as_float(g.y << 16); v0[3] *= __uint_as_float(g.y & 0xffff0000u);
                    v1[0] *= __uint_as_float(g.z << 16); v1[1] *= __uint_as_float(g.z & 0xffff0000u); v1[2] *= __uint_as_float(g.w << 16); v1[3] *= __uint_as_float(g.w & 0xffff0000u);
                    u32x4 w; w.x = cvtpk(v0[0], v0[1]); w.y = cvtpk(v0[2], v0[3]); w.z = cvtpk(v1[0], v1[1]); w.w = cvtpk(v1[2], v1[3]);
                    *(u32x4*)(M + ro + bj * 128) = w;
                }
            }
    }
};
struct EpiOut {
    static constexpr bool HAS_INIT = false; static constexpr int MID_T = 0; static constexpr bool PERM = false; Params p;
    __device__ __forceinline__ void operator()(const f32x4 (&acc)[2][2][4][2], const pg8::Unit& u, int wr, int wc, int fr, int fq) const {
        const int row0 = u.pm * 256 + wr * 64 + fr, col0 = u.pn * 256 + wc * 32 + 4 * fq;
#pragma unroll
        for (int ai = 0; ai < 2; ++ai)
#pragma unroll
            for (int m = 0; m < 4; ++m) { const size_t ro = (size_t)(row0 + ai * 128 + m * 16) * D + col0;
#pragma unroll
                for (int bj = 0; bj < 2; ++bj)
#pragma unroll
                    for (int n = 0; n < 2; ++n) { const size_t o = ro + bj * 128 + n * 16; *(f32x4*)(p.out + o) = *(const f32x4*)(p.x + o) + acc[ai][bj][m][n]; } }
    }
};
struct EpiGateUp {
    static constexpr bool HAS_INIT = true; static constexpr int MID_T = 0; static constexpr bool PERM = false; Params p; MoeTab mt;
    __device__ __forceinline__ void init_load(f32x4 (&iv)[2][2], const pg8::Unit& u, int wc, int fq) const {
        const int e = __builtin_amdgcn_readfirstlane(mt.e_of[u.slot]);
#pragma unroll
        for (int bj = 0; bj < 2; ++bj) { const int cc = 16 * (8 * u.pn + 4 * bj + wc) + 4 * fq; iv[bj][0] = *(const f32x4*)(p.b_gate + e * FF + cc); iv[bj][1] = *(const f32x4*)(p.b_up + e * FF + cc); }
    }
    __device__ __forceinline__ void init_apply(f32x4 (&acc)[2][2][4][2], const f32x4 (&iv)[2][2]) const {
#pragma unroll
        for (int ai = 0; ai < 2; ++ai)
#pragma unroll
            for (int bj = 0; bj < 2; ++bj)
#pragma unroll
                for (int m = 0; m < 4; ++m) { acc[ai][bj][m][0] = iv[bj][0]; acc[ai][bj][m][1] = iv[bj][1] + 1.0f; }
    }
    __device__ __forceinline__ void operator()(const f32x4 (&acc)[2][2][4][2], const pg8::Unit& u, int wr, int wc, int fr, int fq) const {
        const int row0 = u.pm * 256 + wr * 64 + fr;
#pragma unroll
        for (int ai = 0; ai < 2; ++ai)
#pragma unroll
            for (int m = 0; m < 4; ++m) {
#pragma unroll
                for (int bj = 0; bj < 2; ++bj) { const int cc = 16 * (8 * u.pn + 4 * bj + wc) + 4 * fq; const f32x4 g = acc[ai][bj][m][0], uu = acc[ai][bj][m][1]; f32x4 a;
#pragma unroll
                    for (int j = 0; j < 4; ++j) { const float gg = fminf(g[j], 7.0f), u1 = fminf(fmaxf(uu[j], -6.0f), 8.0f);
                        a[j] = gg * __builtin_amdgcn_rcpf(1.0f + __builtin_amdgcn_exp2f(-2.4554669595930156f * gg)) * u1; }
#if FP8_DN
                    int w = __builtin_amdgcn_cvt_pk_fp8_f32(a[0], a[1], 0, false); w = __builtin_amdgcn_cvt_pk_fp8_f32(a[2], a[3], w, true);
                    *(int*)((unsigned char*)(p.ws + WS_A2) + (size_t)(row0 + ai * 128 + m * 16) * FF + cc) = w;
#else
                    u32x2 w; w.x = cvtpk(a[0], a[1]); w.y = cvtpk(a[2], a[3]); *(u32x2*)((bf16*)(p.ws + WS_A2) + (size_t)(row0 + ai * 128 + m * 16) * FF + cc) = w;
#endif
                } }
    }
};
struct EpiDown {
    static constexpr bool HAS_INIT = false; static constexpr int MID_T = 0; static constexpr bool PERM = true; Params p; MoeTab mt;
    __device__ __forceinline__ void operator()(const f32x4 (&acc)[2][2][4][2], const pg8::Unit& u, int wr, int wc, int fr, int fq) const {
        const int e = __builtin_amdgcn_readfirstlane(mt.e_of[u.slot]);
        const int row0 = u.pm * 256 + wr * 64 + fr, col0 = u.pn * 256 + wc * 32 + 8 * fq;
        const float* bd = p.b_down + e * D + col0;
        int asg[2][4]; float pw[2][4];
#pragma unroll
        for (int ai = 0; ai < 2; ++ai)
#pragma unroll
            for (int m = 0; m < 4; ++m) { const int rl = u.slot * 256 + wr * 64 + fr + ai * 128 + m * 16; asg[ai][m] = mt.rt[rl]; pw[ai][m] = mt.rp[rl]; }
        f32x4 bv[2][2];
#pragma unroll
        for (int bj = 0; bj < 2; ++bj) { bv[bj][0] = *(const f32x4*)(bd + bj * 128); bv[bj][1] = *(const f32x4*)(bd + bj * 128 + 4); }
#pragma unroll
        for (int ai = 0; ai < 2; ++ai)
#pragma unroll
            for (int m = 0; m < 4; ++m) {
                if (asg[ai][m] >= 0) { bf16* rowp = (bf16*)(p.ws + WS_Y) + (size_t)asg[ai][m] * D + col0; const float pp = pw[ai][m] * (FP8_Y ? 16.0f : 1.0f);
#pragma unroll
                    for (int bj = 0; bj < 2; ++bj) { const f32x4 v0 = (acc[ai][bj][m][0] + bv[bj][0]) * pp, v1 = (acc[ai][bj][m][1] + bv[bj][1]) * pp;
#if FP8_Y
                        int w0 = __builtin_amdgcn_cvt_pk_fp8_f32(v0[0], v0[1], 0, false); w0 = __builtin_amdgcn_cvt_pk_fp8_f32(v0[2], v0[3], w0, true);
                        int w1 = __builtin_amdgcn_cvt_pk_fp8_f32(v1[0], v1[1], 0, false); w1 = __builtin_amdgcn_cvt_pk_fp8_f32(v1[2], v1[3], w1, true);
                        u32x2 w; w.x = (unsigned)w0; w.y = (unsigned)w1; *(u32x2*)((unsigned char*)(p.ws + WS_Y) + (size_t)asg[ai][m] * D + col0 + bj * 128) = w; (void)rowp;
#else
                        u32x4 w; w.x = cvtpk(v0[0], v0[1]); w.y = cvtpk(v0[2], v0[3]); w.z = cvtpk(v1[0], v1[1]); w.w = cvtpk(v1[2], v1[3]);
                        *(u32x4*)(rowp + bj * 128) = w;
#endif
                    } } }
    }
};

__device__ __forceinline__ void phase_kmean(const Params& p, int gw, int ngw, int lane) {
    for (int it = gw; it < NB * NHA * NBLK; it += ngw) {
        const int n = it % NBLK, h = (it / NBLK) % NHA, b = it / (NBLK * NHA), d = lane;
        const bf16* k = (const bf16*)(p.ws + WS_KA) + ((size_t)b * S + (size_t)n * MBLK) * WA + h * HD + d;
        float s = 0.f; for (int r = 0; r < MBLK; ++r) s += bf2f(k[(size_t)r * WA]);
        ((float*)(p.ws + WS_KMEAN))[(size_t)it * HD + d] = s * (1.0f / MBLK);
    }
}
__device__ __forceinline__ void phase_select(const Params& p, int gtid, int ngt) {
    for (int idx = gtid; idx < T * NHA; idx += ngt) {
        const int h = idx % NHA, t = idx / NHA, b = t / S, s = t % S, blk = s / MBLK;
        const bf16* q = (const bf16*)(p.ws + WS_QA) + (size_t)t * WA + h * HD;
        const float* km = (const float*)(p.ws + WS_KMEAN) + (size_t)(b * NHA + h) * NBLK * HD;
        float best0 = -INFINITY, best1 = -INFINITY, best2 = -INFINITY; int b0 = -1, b1 = -1, b2 = -1;
        for (int n = 0; n < blk; ++n) {
            float g = 0.f; for (int d = 0; d < HD; ++d) g += bf2f(q[d]) * km[n * HD + d];
            if (g > best0) { best2 = best1; b2 = b1; best1 = best0; b1 = b0; best0 = g; b0 = n; }
            else if (g > best1) { best2 = best1; b2 = b1; best1 = g; b1 = n; }
            else if (g > best2) { best2 = g; b2 = n; }
        }
        signed char* sel = (signed char*)(p.ws + WS_SEL) + (size_t)idx * 4;
        sel[0] = (signed char)b0; sel[1] = (signed char)b1; sel[2] = (signed char)b2; sel[3] = -1;
    }
}
__device__ __forceinline__ float dot64(const float* qs, const bf16* kr) {
    float a = 0.f;
    for (int d8 = 0; d8 < 8; ++d8) { float kv[8]; ldact8(kr + d8 * 8, kv);
#pragma unroll
        for (int i = 0; i < 8; ++i) a += qs[d8 * 8 + i] * kv[i]; }
    return a;
}
#define WAVE_LDS_FENCE() asm volatile("s_waitcnt lgkmcnt(0)" ::: "memory")
__device__ __forceinline__ void phase_moba_naive(const Params& p, int gw, int ngw, int lane, float* wl, bf16* oa_dst) {
    float* qs = wl; float* sc = wl + 64;
    for (int it = gw; it < T * NHA; it += ngw) {
        const int h = it % NHA, t = it / NHA, b = t / S, s = t % S, blk = s / MBLK;
        WAVE_LDS_FENCE();
        qs[lane] = bf2f(((const bf16*)(p.ws + WS_QA))[(size_t)t * WA + h * HD + lane]);
        WAVE_LDS_FENCE();
        const signed char* sel = (const signed char*)(p.ws + WS_SEL) + ((size_t)t * NHA + h) * 4;
        const int kb0 = blk, kb1 = sel[0], kb2 = sel[1], kb3 = sel[2];
        const bf16* K = (const bf16*)(p.ws + WS_KA) + (size_t)b * S * WA + h * HD; const bf16* V = (const bf16*)(p.ws + WS_VA) + (size_t)b * S * WA + h * HD;
        float mx = -INFINITY;
        for (int g = 0; g < 4; ++g) { const int kbg = g == 0 ? kb0 : g == 1 ? kb1 : g == 2 ? kb2 : kb3;
            for (int c = 0; c < 4; ++c) {
                const int kk = c * 64 + lane; float v = -INFINITY;
                if (kbg >= 0) { const int key = kbg * MBLK + kk; if (g > 0 || key <= s) v = dot64(qs, K + (size_t)key * WA) * 0.125f; }
                sc[g * 256 + kk] = v; mx = fmaxf(mx, v);
            } }
#pragma unroll
        for (int o = 1; o < 64; o <<= 1) mx = fmaxf(mx, __shfl_xor(mx, o));
        WAVE_LDS_FENCE();
        float l = 0.f;
        for (int i = lane; i < 1024; i += 64) { const float e = (sc[i] == -INFINITY) ? 0.f : expf(sc[i] - mx); sc[i] = e; l += e; }
        l = wave_sum(l);
        WAVE_LDS_FENCE();
        float o = 0.f;
        for (int g = 0; g < 4; ++g) { const int kbg = g == 0 ? kb0 : g == 1 ? kb1 : g == 2 ? kb2 : kb3; if (kbg < 0) continue;
            for (int kk = 0; kk < 256; ++kk) { const float pr = sc[g * 256 + kk]; if (pr != 0.f) o += pr * bf2f(V[(size_t)(kbg * MBLK + kk) * WA + lane]); } }
        oa_dst[(size_t)t * WA + h * HD + lane] = (bf16)f2bf(o / l);
    }
}
__device__ __forceinline__ void phase_dil_naive(const Params& p, int gw, int ngw, int lane, float* wl, bf16* ob_dst) {
    float* qs = wl; float* sc = wl + 192;
    for (int it = gw; it < T * 4; it += ngw) {
        const int j = it % 4, t = it / 4, b = t / S, s = t % S;
        WAVE_LDS_FENCE();
        for (int g = 0; g < 3; ++g) qs[g * 64 + lane] = bf2f(((const bf16*)(p.ws + WS_QB))[(size_t)t * WB + (4 * g + j) * HD + lane]);
        WAVE_LDS_FENCE();
        float mx = -INFINITY;
        for (int g = 0; g < 3; ++g) { const int dl = g == 0 ? 1 : g == 1 ? 4 : 16; const bf16* K = (const bf16*)(p.ws + WS_KB) + (size_t)b * S * WB + (4 * g + j) * HD;
            for (int i = lane; i <= 128; i += 64) { const int key = s - i * dl; float v = -INFINITY;
                if (key >= 0) v = dot64(qs + g * 64, K + (size_t)key * WB) * 0.125f;
                sc[g * 129 + i] = v; mx = fmaxf(mx, v); } }
#pragma unroll
        for (int o = 1; o < 64; o <<= 1) mx = fmaxf(mx, __shfl_xor(mx, o));
        WAVE_LDS_FENCE();
        float l = 0.f;
        for (int i = lane; i < 3 * 129; i += 64) { const float e = (sc[i] == -INFINITY) ? 0.f : expf(sc[i] - mx); sc[i] = e; l += e; }
        l = wave_sum(l);
        WAVE_LDS_FENCE();
        float o = 0.f;
        for (int g = 0; g < 3; ++g) { const int dl = g == 0 ? 1 : g == 1 ? 4 : 16; const bf16* V = (const bf16*)(p.ws + WS_VB) + (size_t)b * S * WB + (4 * g + j) * HD;
            for (int i = 0; i <= 128; ++i) { const float pr = sc[g * 129 + i]; const int key = s - i * dl; if (key >= 0 && pr != 0.f) o += pr * bf2f(V[(size_t)key * WB + lane]); } }
        ob_dst[(size_t)t * WBO + j * HD + lane] = (bf16)f2bf(o / l);
    }
}

__device__ __forceinline__ void phase_router(const Params& p, int bid, int nb, unsigned char* lds, int tid) {
    const int lane = tid & 63, w = tid >> 6, h = lane >> 5, r32 = lane & 31;
    float* part = (float*)lds;
    float* ssqp = (float*)(lds + 65536);
    float* rstd_s = (float*)(lds + 65536 + 2048);
    int4* rec = (int4*)(lds + 65536 + 4096);
    int* lc = (int*)(lds + 65536 + 8192); int* gbase = lc + 32;
    bf16x8v whi[8], wlo[8];
#pragma unroll
    for (int sidx = 0; sidx < 8; ++sidx) { const int k0 = 128 * w + 16 * sidx + 8 * h; float wv[8];
        const f32x4 g0 = *(const f32x4*)(p.ln_ffn_g + k0), g1 = *(const f32x4*)(p.ln_ffn_g + k0 + 4);
#pragma unroll
        for (int j = 0; j < 8; ++j) wv[j] = p.w_router[(size_t)(k0 + j) * NE + r32] * (j < 4 ? g0[j] : g1[j - 4]);
        u32x4 hi, lo;
#pragma unroll
        for (int j = 0; j < 4; ++j) { const unsigned hp = cvtpk(wv[2 * j], wv[2 * j + 1]); hi[j] = hp;
            lo[j] = cvtpk(wv[2 * j] - __uint_as_float(hp << 16), wv[2 * j + 1] - __uint_as_float(hp & 0xffff0000u)); }
        whi[sidx] = __builtin_bit_cast(bf16x8v, hi); wlo[sidx] = __builtin_bit_cast(bf16x8v, lo); }
    for (int tg = bid; tg < T / 64; tg += nb) {
        __syncthreads();
        if (tid < 256) rec[tid] = make_int4(-1, 0, 0, 0);
        if (tid < 32) lc[tid] = 0;
#pragma unroll
        for (int tt = 0; tt < 2; ++tt) {
            const float* xr = p.out + (size_t)(tg * 64 + 32 * tt + r32) * D + 128 * w + 8 * h;
            f32x16 acc = {0.f, 0.f, 0.f, 0.f, 0.f, 0.f, 0.f, 0.f, 0.f, 0.f, 0.f, 0.f, 0.f, 0.f, 0.f, 0.f}; float ssq = 0.f;
#pragma unroll
            for (int sidx = 0; sidx < 8; ++sidx) { const f32x4 x0 = *(const f32x4*)(xr + 16 * sidx), x1 = *(const f32x4*)(xr + 16 * sidx + 4);
                ssq += (x0.x * x0.x + x0.y * x0.y) + (x0.z * x0.z + x0.w * x0.w) + (x1.x * x1.x + x1.y * x1.y) + (x1.z * x1.z + x1.w * x1.w);
                u32x4 hi, lo;
                hi.x = cvtpk(x0.x, x0.y); hi.y = cvtpk(x0.z, x0.w); hi.z = cvtpk(x1.x, x1.y); hi.w = cvtpk(x1.z, x1.w);
                lo.x = cvtpk(x0.x - __uint_as_float(hi.x << 16), x0.y - __uint_as_float(hi.x & 0xffff0000u)); lo.y = cvtpk(x0.z - __uint_as_float(hi.y << 16), x0.w - __uint_as_float(hi.y & 0xffff0000u));
                lo.z = cvtpk(x1.x - __uint_as_float(hi.z << 16), x1.y - __uint_as_float(hi.z & 0xffff0000u)); lo.w = cvtpk(x1.z - __uint_as_float(hi.w << 16), x1.w - __uint_as_float(hi.w & 0xffff0000u));
                const bf16x8v xh = __builtin_bit_cast(bf16x8v, hi), xl = __builtin_bit_cast(bf16x8v, lo);
                acc = __builtin_amdgcn_mfma_f32_32x32x16_bf16(xh, whi[sidx], acc, 0, 0, 0);
                acc = __builtin_amdgcn_mfma_f32_32x32x16_bf16(xh, wlo[sidx], acc, 0, 0, 0);
                acc = __builtin_amdgcn_mfma_f32_32x32x16_bf16(xl, whi[sidx], acc, 0, 0, 0); }
#pragma unroll
            for (int r = 0; r < 16; ++r) part[(w * 64 + 32 * tt + crow(r, h)) * 32 + r32] = acc[r];
            ssq += __shfl_xor(ssq, 32);
            if (h == 0) ssqp[w * 64 + 32 * tt + r32] = ssq;
        }
        __syncthreads();
        if (tid < 64) {
            const int t = tg * 64 + tid;
            float sq = 0.f;
#pragma unroll
            for (int i = 0; i < 8; ++i) sq += ssqp[i * 64 + tid];
            const float rstd = 1.0f / sqrtf(sq * (1.0f / D) + NORM_EPS); rstd_s[tid] = rstd;
            float v0 = -INFINITY, v1 = -INFINITY, v2 = -INFINITY, v3 = -INFINITY; int e0 = 0, e1 = 0, e2 = 0, e3 = 0;
            for (int e = 0; e < NE; ++e) { float a = 0.f;
#pragma unroll
                for (int i = 0; i < 8; ++i) a += part[(i * 64 + tid) * 32 + ((e + tid) & 31)];
                const int ee = (e + tid) & 31; const float lg = a * rstd + p.b_router[ee];
                if (lg > v0 || (lg == v0 && ee < e0)) { v3 = v2; e3 = e2; v2 = v1; e2 = e1; v1 = v0; e1 = e0; v0 = lg; e0 = ee; }
                else if (lg > v1 || (lg == v1 && ee < e1)) { v3 = v2; e3 = e2; v2 = v1; e2 = e1; v1 = lg; e1 = ee; }
                else if (lg > v2 || (lg == v2 && ee < e2)) { v3 = v2; e3 = e2; v2 = lg; e2 = ee; }
                else if (lg > v3 || (lg == v3 && ee < e3)) { v3 = lg; e3 = ee; } }
            const float x1 = expf(v1 - v0), x2 = expf(v2 - v0), x3 = expf(v3 - v0); const float inv = 1.0f / (1.0f + x1 + x2 + x3);
            { const int lp = atomicAdd(&lc[e0], 1); rec[tid * 4 + 0] = make_int4(e0, lp, t * 4 + 0, __float_as_int(inv)); }
            { const int lp = atomicAdd(&lc[e1], 1); rec[tid * 4 + 1] = make_int4(e1, lp, t * 4 + 1, __float_as_int(x1 * inv)); }
            { const int lp = atomicAdd(&lc[e2], 1); rec[tid * 4 + 2] = make_int4(e2, lp, t * 4 + 2, __float_as_int(x2 * inv)); }
            { const int lp = atomicAdd(&lc[e3], 1); rec[tid * 4 + 3] = make_int4(e3, lp, t * 4 + 3, __float_as_int(x3 * inv)); }
        }
        __syncthreads();
        if (tid < NE) gbase[tid] = lc[tid] > 0 ? atomicAdd((int*)(p.ws + WS_CTL) + CW_ECNT + 64 * tid, lc[tid]) : 0;
        for (int idx = tid; idx < 64 * 256; idx += 512) { const int tk = idx >> 8, c4 = idx & 255; const size_t t = (size_t)tg * 64 + tk;
            const f32x4 x = *(const f32x4*)(p.out + t * D + 4 * c4), g = *(const f32x4*)(p.ln_ffn_g + 4 * c4); const float rs = rstd_s[tk];
            const float h0 = x.x * rs * g.x, h1 = x.y * rs * g.y, h2 = x.z * rs * g.z, h3 = x.w * rs * g.w;
#if FP8_GU
            int o = __builtin_amdgcn_cvt_pk_fp8_f32(h0, h1, 0, false); o = __builtin_amdgcn_cvt_pk_fp8_f32(h2, h3, o, true); ((int*)((unsigned char*)(p.ws + WS_H) + t * D))[c4] = o;
#else
            u32x2 o; o.x = cvtpk(h0, h1); o.y = cvtpk(h2, h3); ((u32x2*)((bf16*)(p.ws + WS_H) + t * D))[c4] = o;
#endif
        }
        __syncthreads();
        if (tid < 256) { const int4 r = rec[tid]; if (r.x >= 0) { const int pos = gbase[r.x] + r.y; ((int*)(p.ws + WS_ELIST))[r.x * T + pos] = r.z; ((float*)(p.ws + WS_EP))[r.x * T + pos] = __int_as_float(r.w); } }
    }
}
__device__ __forceinline__ void phase_final(const Params& p, int gw, int ngw, int lane) {
    for (int t = gw; t < T; t += ngw) {
        f32x4* xr = (f32x4*)(p.out + (size_t)t * D) + lane; const f32x4* gr = (const f32x4*)p.ln_final_g + lane;
        f32x4 v[4]; float ss = 0.f;
#pragma unroll
        for (int j = 0; j < 4; ++j) { v[j] = xr[64 * j];
#pragma unroll
            for (int k = 0; k < 4; ++k) {
#if FP8_Y
                const int y = ((const int*)((const unsigned char*)(p.ws + WS_Y) + ((size_t)t * 4 + k) * D))[lane + 64 * j];
                const f32x2 y01 = __builtin_amdgcn_cvt_pk_f32_fp8(y, false), y23 = __builtin_amdgcn_cvt_pk_f32_fp8(y, true);
                v[j].x += y01.x * 0.0625f; v[j].y += y01.y * 0.0625f; v[j].z += y23.x * 0.0625f; v[j].w += y23.y * 0.0625f;
#else
                const u32x2 y = ((const u32x2*)((const bf16*)(p.ws + WS_Y) + ((size_t)t * 4 + k) * D))[lane + 64 * j];
                v[j].x += __uint_as_float(y.x << 16); v[j].y += __uint_as_float(y.x & 0xffff0000u); v[j].z += __uint_as_float(y.y << 16); v[j].w += __uint_as_float(y.y & 0xffff0000u);
#endif
            }
            ss += (v[j].x * v[j].x + v[j].y * v[j].y) + (v[j].z * v[j].z + v[j].w * v[j].w); }
        float rstd = 1.0f / sqrtf(wave_sum(ss) * (1.0f / D) + NORM_EPS);
#if DBG
        { const float num = ((const float*)(p.ws + WS_CTL))[CW_DNUM], den = ((const float*)(p.ws + WS_CTL))[CW_DDEN]; rstd *= 1.0f + DBG_GAIN * sqrtf(num / fmaxf(den, 1e-30f)); }
#endif
#if TIMEB_LO >= 0
        { const unsigned long long* ts = (const unsigned long long*)(p.ws + WS_CTL + 917504); rstd *= 1.0f + TIMEB_GAIN * (float)(ts[TIMEB_HI] - ts[TIMEB_LO]) * 1e-6f; }
#endif
#pragma unroll
        for (int j = 0; j < 4; ++j) { const f32x4 g = gr[64 * j]; f32x4 o; o.x = v[j].x * rstd * g.x; o.y = v[j].y * rstd * g.y; o.z = v[j].z * rstd * g.z; o.w = v[j].w * rstd * g.w; xr[64 * j] = o; }
    }
}


#define LDSP __attribute__((address_space(3)))
constexpr int AT_RS = 144;
constexpr int AT_KOFF = 0, AT_VOFF = 384 * AT_RS, AT_PFX = 131072;
constexpr float AT_C = 0.125f * 1.4426950408889634f;
__device__ __forceinline__ s16x4 vtr(unsigned addr) { return __builtin_bit_cast(s16x4, __builtin_amdgcn_ds_read_tr16_b64_v4i16((LDSP s16x4*)(uintptr_t)addr)); }

struct AttnState { f32x16 o0, o1; float m, l; };
template <bool MASKED> __device__ __forceinline__ void attn_wave(AttnState& st, const bf16x8v (&qf)[4], unsigned kbase, unsigned vbase, int c0, int c1, int clo, int chi, int lane) {
    const int h = lane >> 5, ql = lane & 31;
    if (c0 >= c1) return;
    bf16x8v kf[4];
    { const unsigned ka = kbase + (unsigned)c0 * (32 * AT_RS);
#pragma unroll
      for (int ks = 0; ks < 4; ++ks) kf[ks] = *(const LDSP bf16x8v*)(uintptr_t)(ka + ks * 32); }
#pragma unroll 1
    for (int c = c0; c < c1; ++c) {
        const unsigned va = vbase + (unsigned)c * (32 * AT_RS);
        s16x4 vlo[2][2], vhi[2][2];
#pragma unroll
        for (int ks = 0; ks < 2; ++ks)
#pragma unroll
            for (int db = 0; db < 2; ++db) { vlo[ks][db] = vtr(va + ks * (16 * AT_RS) + db * 64); vhi[ks][db] = vtr(va + ks * (16 * AT_RS) + 8 * AT_RS + db * 64); }
        f32x16 s = {0.f, 0.f, 0.f, 0.f, 0.f, 0.f, 0.f, 0.f, 0.f, 0.f, 0.f, 0.f, 0.f, 0.f, 0.f, 0.f};
#pragma unroll
        for (int ks = 0; ks < 4; ++ks) s = __builtin_amdgcn_mfma_f32_32x32x16_bf16(kf[ks], qf[ks], s, 0, 0, 0);
        { const unsigned kn = kbase + (unsigned)((c + 1 < c1) ? c + 1 : c) * (32 * AT_RS);
#pragma unroll
          for (int ks = 0; ks < 4; ++ks) kf[ks] = *(const LDSP bf16x8v*)(uintptr_t)(kn + ks * 32); }
        float t[16]; float cmax = -INFINITY;
#pragma unroll
        for (int r = 0; r < 16; ++r) { t[r] = s[r];
            if (MASKED) { const int cr = crow(r, h); if ((c == clo && cr < ql) || (c == chi && cr > ql)) t[r] = -INFINITY; }
            cmax = fmaxf(cmax, t[r]); }
        cmax = fmaxf(cmax, __shfl_xor(cmax, 32)) * AT_C;
        const float mn = fmaxf(st.m, cmax); const float mu = (mn == -INFINITY) ? 0.f : mn;
        const float alpha = __builtin_amdgcn_exp2f(st.m - mu);
        float psum = 0.f; float pr[16];
#pragma unroll
        for (int r = 0; r < 16; ++r) { pr[r] = __builtin_amdgcn_exp2f(__builtin_fmaf(t[r], AT_C, -mu)); psum += pr[r]; }
        st.l = st.l * alpha + psum; st.m = mn;
        if (!__all(alpha == 1.0f)) {
#pragma unroll
            for (int r = 0; r < 16; ++r) { st.o0[r] *= alpha; st.o1[r] *= alpha; } }
#pragma unroll
        for (int ks = 0; ks < 2; ++ks) {
            u32x4 pw; pw.x = cvtpk(pr[8 * ks + 0], pr[8 * ks + 1]); pw.y = cvtpk(pr[8 * ks + 2], pr[8 * ks + 3]); pw.z = cvtpk(pr[8 * ks + 4], pr[8 * ks + 5]); pw.w = cvtpk(pr[8 * ks + 6], pr[8 * ks + 7]);
            const bf16x8v pf = __builtin_bit_cast(bf16x8v, pw);
            const bf16x8v vf0 = {vlo[ks][0][0], vlo[ks][0][1], vlo[ks][0][2], vlo[ks][0][3], vhi[ks][0][0], vhi[ks][0][1], vhi[ks][0][2], vhi[ks][0][3]};
            const bf16x8v vf1 = {vlo[ks][1][0], vlo[ks][1][1], vlo[ks][1][2], vlo[ks][1][3], vhi[ks][1][0], vhi[ks][1][1], vhi[ks][1][2], vhi[ks][1][3]};
            st.o0 = __builtin_amdgcn_mfma_f32_32x32x16_bf16(vf0, pf, st.o0, 0, 0, 0);
            st.o1 = __builtin_amdgcn_mfma_f32_32x32x16_bf16(vf1, pf, st.o1, 0, 0, 0);
        }
    }
}
__device__ __forceinline__ void attn_init(AttnState& st) {
#pragma unroll
    for (int r = 0; r < 16; ++r) { st.o0[r] = 0.f; st.o1[r] = 0.f; }
    st.m = -INFINITY; st.l = 0.f;
}
__device__ __forceinline__ void attn_stage(unsigned char* lds, int dst, const unsigned char* src, size_t pitch, int nrows, int skip, int tid) {
    for (int idx = tid; idx < nrows * 8; idx += 512) { const int row = idx >> 3, ch = idx & 7;
        if (row >= skip) { const u32x4 v = *(const u32x4*)(src + (size_t)row * pitch + ch * 16); *(u32x4*)(lds + dst + row * AT_RS + ch * 16) = v; } }
}
__device__ __forceinline__ void attn_qload(bf16x8v (&qf)[4], const bf16* qrow, int h) {
#pragma unroll
    for (int ks = 0; ks < 4; ++ks) qf[ks] = *(const bf16x8v*)(qrow + 16 * ks + 8 * h);
}
__device__ __forceinline__ void attn_store_partial(const AttnState& st, float inv_l, bf16* dst, int h) {
#pragma unroll
    for (int rg = 0; rg < 4; ++rg) {
        u32x2 w0, w1; w0.x = cvtpk(st.o0[4 * rg] * inv_l, st.o0[4 * rg + 1] * inv_l); w0.y = cvtpk(st.o0[4 * rg + 2] * inv_l, st.o0[4 * rg + 3] * inv_l);
        w1.x = cvtpk(st.o1[4 * rg] * inv_l, st.o1[4 * rg + 1] * inv_l); w1.y = cvtpk(st.o1[4 * rg + 2] * inv_l, st.o1[4 * rg + 3] * inv_l);
        *(u32x2*)(dst + 8 * rg + 4 * h) = w0; *(u32x2*)(dst + 32 + 8 * rg + 4 * h) = w1; }
}
__device__ __forceinline__ void attn_acc_partial(f32x16& a0, f32x16& a1, float w, const bf16* src, int h) {
#pragma unroll
    for (int rg = 0; rg < 4; ++rg) { const u32x2 w0 = *(const u32x2*)(src + 8 * rg + 4 * h), w1 = *(const u32x2*)(src + 32 + 8 * rg + 4 * h);
        a0[4 * rg] += w * __uint_as_float(w0.x << 16); a0[4 * rg + 1] += w * __uint_as_float(w0.x & 0xffff0000u); a0[4 * rg + 2] += w * __uint_as_float(w0.y << 16); a0[4 * rg + 3] += w * __uint_as_float(w0.y & 0xffff0000u);
        a1[4 * rg] += w * __uint_as_float(w1.x << 16); a1[4 * rg + 1] += w * __uint_as_float(w1.x & 0xffff0000u); a1[4 * rg + 2] += w * __uint_as_float(w1.y << 16); a1[4 * rg + 3] += w * __uint_as_float(w1.y & 0xffff0000u); }
}


template <int NIT> struct KVRegs { u32x4 k[NIT], v[NIT]; };
template <int NIT> __device__ __forceinline__ void kv_load(KVRegs<NIT>& R, const unsigned char* ksrc, const unsigned char* vsrc, size_t pitch, int skip, int tid) {
#pragma unroll
    for (int i = 0; i < NIT; ++i) { const int idx = tid + 512 * i, row = idx >> 3, ch = idx & 7;
        if (row >= skip) { R.k[i] = *(const u32x4*)(ksrc + (size_t)row * pitch + ch * 16); R.v[i] = *(const u32x4*)(vsrc + (size_t)row * pitch + ch * 16); } }
}
template <int NIT> __device__ __forceinline__ void kv_commit(const KVRegs<NIT>& R, unsigned char* lds, int skip, int tid) {
#pragma unroll
    for (int i = 0; i < NIT; ++i) { const int idx = tid + 512 * i, row = idx >> 3, ch = idx & 7;
        if (row >= skip) { *(u32x4*)(lds + AT_KOFF + row * AT_RS + ch * 16) = R.k[i]; *(u32x4*)(lds + AT_VOFF + row * AT_RS + ch * 16) = R.v[i]; } }
}
__device__ __forceinline__ void phase_select_lists(const Params& p, int bid, int nb, unsigned char* lds, int tid) {
    float* km = (float*)lds;
    for (int it = bid; it < NB * NBLK * 4; it += nb) {
        const int hp = it & 3, n = (it >> 2) % NBLK, b = it / (4 * NBLK);
        __syncthreads();
        for (int i = tid; i < 2 * NBLK * HD; i += 512) { const int hh = i / (NBLK * HD), rest = i % (NBLK * HD); km[i] = ((const float*)(p.ws + WS_KMEAN))[(size_t)(b * NHA + 2 * hp + hh) * NBLK * HD + rest]; }
        __syncthreads();
        const int hh = tid >> 8, h = 2 * hp + hh, s = n * MBLK + (tid & 255), t = b * S + s;
        float q[HD];
        { const u32x4* qp = (const u32x4*)((const bf16*)(p.ws + WS_QA) + (size_t)t * WA + h * HD);
#pragma unroll
            for (int i = 0; i < 8; ++i) { const u32x4 v = qp[i];
#pragma unroll
                for (int j = 0; j < 4; ++j) { q[8 * i + 2 * j] = __uint_as_float(v[j] << 16); q[8 * i + 2 * j + 1] = __uint_as_float(v[j] & 0xffff0000u); } } }
        float best0 = -INFINITY, best1 = -INFINITY, best2 = -INFINITY; int b0 = -1, b1 = -1, b2 = -1;
        const float* kmh = km + hh * (NBLK * HD);
        for (int nn = 0; nn < n; ++nn) {
            float g = 0.f;
#pragma unroll
            for (int d4 = 0; d4 < 16; ++d4) { const f32x4 kv = *(const f32x4*)(kmh + nn * HD + 4 * d4); g += q[4 * d4] * kv.x; g += q[4 * d4 + 1] * kv.y; g += q[4 * d4 + 2] * kv.z; g += q[4 * d4 + 3] * kv.w; }
            if (g > best0) { best2 = best1; b2 = b1; best1 = best0; b1 = b0; best0 = g; b0 = nn; }
            else if (g > best1) { best2 = best1; b2 = b1; best1 = g; b1 = nn; }
            else if (g > best2) { best2 = g; b2 = nn; }
        }
        signed char* sel = (signed char*)(p.ws + WS_SEL) + ((size_t)t * NHA + h) * 4;
        *(unsigned*)sel = (unsigned)(b0 & 0xff) | ((unsigned)(b1 & 0xff) << 8) | ((unsigned)(b2 & 0xff) << 16) | 0xff000000u;
        int* lc = (int*)(lds + 32768); int* gb = lc + 64;
        if (tid < 64) lc[tid] = 0;
        __syncthreads();
        int lp0 = 0, lp1 = 0, lp2 = 0;
        if (b0 >= 0) lp0 = atomicAdd(&lc[hh * 32 + b0], 1);
        if (b1 >= 0) lp1 = atomicAdd(&lc[hh * 32 + b1], 1);
        if (b2 >= 0) lp2 = atomicAdd(&lc[hh * 32 + b2], 1);
        __syncthreads();
        if (tid < 64) { const int c = lc[tid]; gb[tid] = c > 0 ? atomicAdd((int*)(p.ws + WS_CTL) + CW_LCNT + (b * NHA + 2 * hp + (tid >> 5)) * NBLK + (tid & 31), c) : 0; }
        __syncthreads();
        unsigned short* lists = (unsigned short*)(p.ws + WS_LIST) + (size_t)(b * NHA + h) * NBLK * LIST_CAP;
        if (b0 >= 0) lists[(size_t)b0 * LIST_CAP + gb[hh * 32 + b0] + lp0] = (unsigned short)(s | (0 << 13));
        if (b1 >= 0) lists[(size_t)b1 * LIST_CAP + gb[hh * 32 + b1] + lp1] = (unsigned short)(s | (1 << 13));
        if (b2 >= 0) lists[(size_t)b2 * LIST_CAP + gb[hh * 32 + b2] + lp2] = (unsigned short)(s | (2 << 13));
    }
}
__device__ __forceinline__ void phase_dilated(const Params& p, int bid, int nb, unsigned char* lds, int tid) {
    const int lane = tid & 63, w = tid >> 6, h = lane >> 5, ql = lane & 31;
    const unsigned lb = (unsigned)(uintptr_t)lds;
    constexpr int NITM = NB * NHB * 32;
    KVRegs<6> R;
#define DIL_DECODE(it_) const int sub = (it_) & 31, head = ((it_) >> 5) % NHB, b = (it_) / (32 * NHB), g = head >> 2, j = head & 3; \
        const int dl = g == 0 ? 1 : g == 1 ? 4 : 16, r = sub % dl, np = sub / dl; const size_t pitch = (size_t)dl * WB * 2; \
        const long tok0 = (long)b * S + (long)(128 * (2 * np - 1)) * dl + r; const int wq = w & 3, nq = 2 * np + (w >> 2); \
        const size_t tq = (size_t)b * S + (size_t)(128 * nq + 32 * wq + ql) * dl + r; (void)j; (void)pitch; (void)tok0; (void)tq; (void)nq; (void)wq;
    int it = bid;
    if (it < NITM) { DIL_DECODE(it)
        kv_load<6>(R, (const unsigned char*)((const bf16*)(p.ws + WS_KB) + tok0 * WB + head * HD), (const unsigned char*)((const bf16*)(p.ws + WS_VB) + tok0 * WB + head * HD), pitch, np == 0 ? 128 : 0, tid); }
    while (it < NITM) {
        DIL_DECODE(it)
        bf16x8v qf[4]; attn_qload(qf, (const bf16*)(p.ws + WS_QB) + tq * WB + head * HD, h);
        __syncthreads();
        kv_commit<6>(R, lds, np == 0 ? 128 : 0, tid);
        __syncthreads();
        const int nit = it + nb;
        if (nit < NITM) { const int it2 = nit; const int sub2 = it2 & 31, head2 = (it2 >> 5) % NHB, b2 = it2 / (32 * NHB), g2 = head2 >> 2; const int dl2 = g2 == 0 ? 1 : g2 == 1 ? 4 : 16, r2 = sub2 % dl2, np2 = sub2 / dl2;
            const size_t pitch2 = (size_t)dl2 * WB * 2; const long tok02 = (long)b2 * S + (long)(128 * (2 * np2 - 1)) * dl2 + r2;
            kv_load<6>(R, (const unsigned char*)((const bf16*)(p.ws + WS_KB) + tok02 * WB + head2 * HD), (const unsigned char*)((const bf16*)(p.ws + WS_VB) + tok02 * WB + head2 * HD), pitch2, np2 == 0 ? 128 : 0, tid); }
        const int winoff = 128 * (w >> 2);
        AttnState st; attn_init(st);
        const unsigned kbase = lb + AT_KOFF + (unsigned)(winoff + ql) * AT_RS + 16 * h;
        const unsigned vbase = lb + AT_VOFF + (unsigned)(winoff + 4 * h + ((lane & 15) >> 2)) * AT_RS + 32 * ((lane >> 4) & 1) + 8 * (lane & 3);
        const int c0 = (nq == 0) ? 4 : wq;
        attn_wave<true>(st, qf, kbase, vbase, c0, wq + 5, wq, wq + 4, lane);
        const float lt = st.l + __shfl_xor(st.l, 32);
        bf16* dst = (bf16*)(p.ws + WS_PARTB) + (((size_t)g * T + tq) * 4 + j) * HD;
        attn_store_partial(st, 1.0f / lt, dst, h);
        if (h == 0) ((float*)(p.ws + WS_LSEB))[((size_t)g * T + tq) * 4 + j] = st.m + __builtin_amdgcn_logf(lt);
        it = nit;
    }
#undef DIL_DECODE
}
__device__ __forceinline__ void phase_moba_past(const Params& p, int bid, int nb, unsigned char* lds, int tid) {
    const int lane = tid & 63, w = tid >> 6, h = lane >> 5, ql = lane & 31;
    const unsigned lb = (unsigned)(uintptr_t)lds;
    unsigned* pfx = (unsigned*)(lds + AT_PFX);
    const int* lcnt = (const int*)(p.ws + WS_CTL) + CW_LCNT;
    int* cntl = (int*)(lds + AT_PFX + 4096);
    unsigned* pfp = pfx + 2048;
    { const int c = __hip_atomic_load(lcnt + tid, __ATOMIC_RELAXED, __HIP_MEMORY_SCOPE_AGENT); unsigned v = (unsigned)(c >> 8), vp = (c & 255) ? 1u : 0u; cntl[tid] = c;
#pragma unroll
      for (int o = 1; o < 64; o <<= 1) { const unsigned u = __shfl_up(v, o), up = __shfl_up(vp, o); if (lane >= o) { v += u; vp += up; } }
      unsigned* wtot = pfx + 520;
      if (lane == 63) { wtot[w] = v; wtot[8 + w] = vp; }
      __syncthreads();
      unsigned base = 0, basep = 0;
#pragma unroll
      for (int i = 0; i < 8; ++i) if (i < w) { base += wtot[i]; basep += wtot[8 + i]; }
      pfx[tid + 1] = v + base; pfp[tid + 1] = vp + basep; if (tid == 0) { pfx[0] = 0; pfp[0] = 0; } }
    __syncthreads();
    const int nfull = (int)pfx[512];
    const int ntot = nfull + (int)pfp[512];
    KVRegs<4> R; bf16x8v qn[4];
    int liA = 0, tileA = 0, cntA = 0; unsigned entA = 0; int liB = 0, tileB = 0, cntB = 0; unsigned entB = 0;
#define PAST_DECODE(it_, li_, tile_, cnt_, ent_) do { const bool part_ = (it_) >= nfull; const unsigned* pf_ = part_ ? pfp : pfx; const int key_ = part_ ? (it_) - nfull : (it_); \
        int lo_ = 0, hi_ = 512; while (hi_ - lo_ > 1) { const int mid_ = (lo_ + hi_) >> 1; if ((int)pf_[mid_] <= key_) lo_ = mid_; else hi_ = mid_; } \
        li_ = lo_; cnt_ = cntl[lo_]; tile_ = part_ ? (cnt_ >> 8) : key_ - (int)pfx[lo_]; \
        ent_ = ((const unsigned short*)(p.ws + WS_LIST))[(size_t)lo_ * LIST_CAP + tile_ * 256 + 32 * w + ql]; } while (0)
#define PAST_KVQ(li_, ent_) do { const int jb_ = (li_) & 31, hd_ = ((li_) >> 5) & 7, b_ = (li_) >> 8; const size_t row0_ = (size_t)b_ * S + (size_t)jb_ * MBLK; \
        kv_load<4>(R, (const unsigned char*)((const bf16*)(p.ws + WS_KA) + row0_ * WA + hd_ * HD), (const unsigned char*)((const bf16*)(p.ws + WS_VA) + row0_ * WA + hd_ * HD), (size_t)WA * 2, 0, tid); \
        attn_qload(qn, (const bf16*)(p.ws + WS_QA) + ((size_t)b_ * S + ((ent_) & 8191)) * WA + hd_ * HD, h); } while (0)
    int itA = bid, itB = bid + nb;
    if (itA < ntot) { PAST_DECODE(itA, liA, tileA, cntA, entA); PAST_KVQ(liA, entA); }
    if (itB < ntot) PAST_DECODE(itB, liB, tileB, cntB, entB);
    while (itA < ntot) {
        __syncthreads();
        kv_commit<4>(R, lds, 0, tid);
        __syncthreads();
        const int li = liA, tile = tileA, cnt = cntA; const unsigned ent = entA;
        const int hd = (li >> 5) & 7, b = li >> 8, slot = (int)(ent >> 13); const size_t tq = (size_t)b * S + (ent & 8191);
        const bool valid = tile * 256 + 32 * w + ql < cnt;
        bf16x8v qf[4];
#pragma unroll
        for (int i = 0; i < 4; ++i) qf[i] = qn[i];
        itA = itB; liA = liB; tileA = tileB; cntA = cntB; entA = entB;
        if (itA < ntot) PAST_KVQ(liA, entA);
        itB += nb;
        if (itB < ntot) PAST_DECODE(itB, liB, tileB, cntB, entB);
        AttnState st; attn_init(st);
        const unsigned kbase = lb + AT_KOFF + (unsigned)ql * AT_RS + 16 * h;
        const unsigned vbase = lb + AT_VOFF + (unsigned)(4 * h + ((lane & 15) >> 2)) * AT_RS + 32 * ((lane >> 4) & 1) + 8 * (lane & 3);
        if (32 * w + tile * 256 < cnt) {
            attn_wave<false>(st, qf, kbase, vbase, 0, 8, -1, -1, lane);
            const float lt = st.l + __shfl_xor(st.l, 32);
            if (valid) { attn_store_partial(st, 1.0f / lt, (bf16*)(p.ws + WS_PARTA) + (((size_t)slot * T + tq) * NHA + hd) * HD, h);
                if (h == 0) ((float*)(p.ws + WS_LSEA))[((size_t)slot * T + tq) * NHA + hd] = st.m + __builtin_amdgcn_logf(lt); }
        }
    }
#undef PAST_DECODE
#undef PAST_KVQ
}
__device__ __forceinline__ void phase_moba_own(const Params& p, int bid, int nb, unsigned char* lds, int tid) {
    const int lane = tid & 63, w = tid >> 6, h = lane >> 5, ql = lane & 31;
    const unsigned lb = (unsigned)(uintptr_t)lds;
    constexpr int NITM = NB * NHA * NBLK;
    KVRegs<4> R; bf16x8v qn[4];
#define OWN_FETCH(it_) do { const int n_ = (it_) % NBLK, hd_ = ((it_) / NBLK) % NHA, b_ = (it_) / (NBLK * NHA); const size_t row0_ = (size_t)b_ * S + (size_t)n_ * MBLK; \
        kv_load<4>(R, (const unsigned char*)((const bf16*)(p.ws + WS_KA) + row0_ * WA + hd_ * HD), (const unsigned char*)((const bf16*)(p.ws + WS_VA) + row0_ * WA + hd_ * HD), (size_t)WA * 2, 0, tid); \
        attn_qload(qn, (const bf16*)(p.ws + WS_QA) + (row0_ + 32 * w + ql) * WA + hd_ * HD, h); } while (0)
    int it = bid;
    if (it < NITM) OWN_FETCH(it);
    while (it < NITM) {
        const int n = it % NBLK, hd = (it / NBLK) % NHA, b = it / (NBLK * NHA);
        const size_t row0 = (size_t)b * S + (size_t)n * MBLK;
        __syncthreads();
        kv_commit<4>(R, lds, 0, tid);
        __syncthreads();
        bf16x8v qf[4];
#pragma unroll
        for (int i = 0; i < 4; ++i) qf[i] = qn[i];
        const int nit = it + nb;
        if (nit < NITM) OWN_FETCH(nit);
        const size_t tq = row0 + 32 * w + ql;
        const unsigned selw = *(const unsigned*)((const signed char*)(p.ws + WS_SEL) + (tq * NHA + hd) * 4);
        float lse[3];
#pragma unroll
        for (int k = 0; k < 3; ++k) lse[k] = ((const float*)(p.ws + WS_LSEA))[((size_t)k * T + tq) * NHA + hd];
        AttnState st; attn_init(st);
        const unsigned kbase = lb + AT_KOFF + (unsigned)ql * AT_RS + 16 * h;
        const unsigned vbase = lb + AT_VOFF + (unsigned)(4 * h + ((lane & 15) >> 2)) * AT_RS + 32 * ((lane >> 4) & 1) + 8 * (lane & 3);
        attn_wave<true>(st, qf, kbase, vbase, 0, w + 1, -1, w, lane);
        const float lt = st.l + __shfl_xor(st.l, 32);
        const float lse_own = st.m + __builtin_amdgcn_logf(lt);
        float M = lse_own;
#pragma unroll
        for (int k = 0; k < 3; ++k) { const bool ok = ((selw >> (8 * k)) & 0x80u) == 0u; if (!ok) lse[k] = -INFINITY; M = fmaxf(M, lse[k]); }
        const float w_own = __builtin_amdgcn_exp2f(lse_own - M); float wsum = w_own;
        const float so = w_own / lt;
#pragma unroll
        for (int r = 0; r < 16; ++r) { st.o0[r] *= so; st.o1[r] *= so; }
#pragma unroll
        for (int k = 0; k < 3; ++k) { const float wk = __builtin_amdgcn_exp2f(lse[k] - M); wsum += wk;
            if (lse[k] != -INFINITY) attn_acc_partial(st.o0, st.o1, wk, (const bf16*)(p.ws + WS_PARTA) + (((size_t)k * T + tq) * NHA + hd) * HD, h); }
        attn_store_partial(st, 1.0f / wsum, (bf16*)p.out + tq * (WA + WBO) + hd * HD, h);
        it = nit;
    }
#undef OWN_FETCH
}
__device__ __forceinline__ void phase_dil_merge(const Params& p, int gtid, int ngt) {
    for (int idx = gtid; idx < T * 4 * 8; idx += ngt) {
        const int ch = idx & 7, j = (idx >> 3) & 3; const size_t t = idx >> 5;
        float l0 = ((const float*)(p.ws + WS_LSEB))[((size_t)0 * T + t) * 4 + j], l1 = ((const float*)(p.ws + WS_LSEB))[((size_t)1 * T + t) * 4 + j], l2 = ((const float*)(p.ws + WS_LSEB))[((size_t)2 * T + t) * 4 + j];
        const float M = fmaxf(l0, fmaxf(l1, l2)); const float w0 = __builtin_amdgcn_exp2f(l0 - M), w1 = __builtin_amdgcn_exp2f(l1 - M), w2 = __builtin_amdgcn_exp2f(l2 - M); const float inv = 1.0f / (w0 + w1 + w2);
        float o[8];
#pragma unroll
        for (int i = 0; i < 8; ++i) o[i] = 0.f;
#pragma unroll
        for (int g = 0; g < 3; ++g) { const float wg = (g == 0 ? w0 : g == 1 ? w1 : w2) * inv; const u32x4 v = *(const u32x4*)((const bf16*)(p.ws + WS_PARTB) + (((size_t)g * T + t) * 4 + j) * HD + 8 * ch);
#pragma unroll
            for (int i = 0; i < 4; ++i) { o[2 * i] += wg * __uint_as_float(v[i] << 16); o[2 * i + 1] += wg * __uint_as_float(v[i] & 0xffff0000u); } }
        u32x4 wv; wv.x = cvtpk(o[0], o[1]); wv.y = cvtpk(o[2], o[3]); wv.z = cvtpk(o[4], o[5]); wv.w = cvtpk(o[6], o[7]);
        *(u32x4*)((bf16*)p.out + t * (WA + WBO) + WA + j * HD + 8 * ch) = wv;
    }
}

__device__ __forceinline__ void phase_check(const Params& p, const bf16* a, const bf16* b, size_t n, int gtid, int ngt) {
    float num = 0.f, den = 0.f;
    for (size_t i = gtid; i < n; i += ngt) { const float x = bf2f(a[i]), y = bf2f(b[i]); num += (x - y) * (x - y); den += y * y; }
    num = wave_sum(num); den = wave_sum(den);
    if ((threadIdx.x & 63) == 0) { atomicAdd((float*)(p.ws + WS_CTL) + CW_DNUM, num); atomicAdd((float*)(p.ws + WS_CTL) + CW_DDEN, den); }
}

#define XB_TMO      128
#define XB_XCNT(j)  (256  + 64 * (j))
#define XB_XSUB(j)  (1280 + 64 * (j))
#define XB_XGEN(j)  (2304 + 64 * (j))
#define XB_TOP      3328
#define XB_TOPGEN   3392
#define XCD_BAR_WORDS 3456
#define XB_SPIN_CAP (1u << 18)
__device__ __forceinline__ unsigned xb_ld(unsigned* p)              { return __hip_atomic_load(p, __ATOMIC_RELAXED, __HIP_MEMORY_SCOPE_AGENT); }
__device__ __forceinline__ unsigned xb_add(unsigned* p, unsigned v) { return __hip_atomic_fetch_add(p, v, __ATOMIC_RELAXED, __HIP_MEMORY_SCOPE_AGENT); }
__device__ __forceinline__ unsigned xb_xcc_id() { return (unsigned)__builtin_amdgcn_s_getreg((3 << 11) | 20) & 0xFu; }
#define XB_SPIN(cond, bar) do { unsigned _sp = 0; while (cond) { __builtin_amdgcn_s_sleep(1); \
    if ((++_sp & 255u) == 0u) { if (xb_ld(&(bar)[XB_TMO])) break; if (_sp > XB_SPIN_CAP) { atomicAdd(&(bar)[XB_TMO], 1u); break; } } } } while (0)
struct XcdBarrier { unsigned* bar; unsigned x; volatile LAS unsigned* st; };
__device__ __forceinline__ XcdBarrier xcd_barrier_post(unsigned* bar, volatile LAS unsigned* st) {
    XcdBarrier b; b.bar = bar; b.x = xb_xcc_id(); b.st = st;
    if (threadIdx.x == 0) (void)xb_add(&bar[XB_XCNT(b.x)], 1u);
    return b;
}
__device__ __forceinline__ void xcd_barrier_complete(unsigned* bar, unsigned x, unsigned& nloc, unsigned& nx) {
    const unsigned G = gridDim.x * gridDim.y * gridDim.z;
    unsigned sum, cnt, mine, sp = 0u;
    for (;;) {
        sum = 0u; cnt = 0u; mine = 0u;
#pragma unroll
        for (unsigned j = 0; j < 16; ++j) { const unsigned c = xb_ld(&bar[XB_XCNT(j)]); sum += c; cnt += (c > 0u) ? 1u : 0u; mine = (j == x) ? c : mine; }
        if (sum == G) break;
        __builtin_amdgcn_s_sleep(1);
        if ((++sp & 255u) == 0u) { if (xb_ld(&bar[XB_TMO])) break; if (sp > XB_SPIN_CAP) { atomicAdd(&bar[XB_TMO], 1u); break; } }
    }
    nloc = mine > 0u ? mine : 1u; nx = cnt > 0u ? cnt : 1u;
}
__device__ __forceinline__ void xcd_barrier(const XcdBarrier& b) {
    asm volatile("s_waitcnt vmcnt(0)" ::: "memory");
    __syncthreads();
    if (threadIdx.x == 0) {
        unsigned* bar = b.bar;
        __builtin_amdgcn_s_waitcnt(0);
        unsigned nloc = b.st[0], nx = b.st[1];
        if (nloc == 0u) { xcd_barrier_complete(bar, b.x, nloc, nx); b.st[0] = nloc; b.st[1] = nx; }
        const unsigned old = xb_add(&bar[XB_XSUB(b.x)], 1u);
        const unsigned gen = old / nloc;
        if (old + 1u == (gen + 1u) * nloc) {
            __builtin_amdgcn_fence(__ATOMIC_RELEASE, "agent");
            asm volatile("s_waitcnt vmcnt(0)" ::: "memory");
            const unsigned og = xb_add(&bar[XB_TOP], 1u);
            const unsigned tg = og / nx;
            if (og + 1u == (tg + 1u) * nx) xb_add(&bar[XB_TOPGEN], 1u);
            else XB_SPIN(xb_ld(&bar[XB_TOPGEN]) == tg, bar);
            __builtin_amdgcn_fence(__ATOMIC_ACQUIRE, "agent");
            xb_add(&bar[XB_XGEN(b.x)], 1u);
            asm volatile("s_waitcnt vmcnt(0)" ::: "memory");
        } else {
            XB_SPIN(xb_ld(&bar[XB_XGEN(b.x)]) == gen, bar);
            __builtin_amdgcn_fence(__ATOMIC_ACQUIRE, "agent");
            asm volatile("s_waitcnt vmcnt(0)" ::: "memory");
        }
    }
    __syncthreads();
}
constexpr int HELPERS = 104;
constexpr int LDS_BYTES = 147456;
__global__ void __launch_bounds__(512, 2) mega_fwd(Params p) {
    extern __shared__ __attribute__((aligned(16))) unsigned char lds[];
    cg::grid_group grid = cg::this_grid();
    const int bid = blockIdx.x, nb = gridDim.x;
#define COORDS() int tid = threadIdx.x; asm volatile("" : "+v"(tid)); const int lane = tid & 63, wave = tid >> 6; const int gw = bid * 8 + wave, ngw = nb * 8, gtid = bid * 512 + tid, ngt = nb * 512; float* wl = (float*)lds + wave * 1152; (void)lane; (void)gw; (void)ngw; (void)gtid; (void)ngt; (void)wl;
    volatile LAS unsigned* bst = (volatile LAS unsigned*)(lds + LDS_BYTES - 64);
    if (threadIdx.x < 16) bst[threadIdx.x] = 0u;
    __syncthreads();
    const XcdBarrier xbar = xcd_barrier_post((unsigned*)(p.ws + WS_CTL) + CW_BAR, bst);
#ifndef TIME_LO
#define TIME_LO -1
#endif
#ifndef TIME_HI
#define TIME_HI -1
#endif
#ifndef TIME_MULT
#define TIME_MULT 2
#endif
    int n_stamp = 0;
#if TIME_LO >= 0
#define STAMP() do { if (bid == 0 && threadIdx.x == 0) ((unsigned long long*)(p.ws + WS_CTL + 917504))[n_stamp] = __builtin_amdgcn_s_memrealtime(); ++n_stamp; } while (0)
#else
#define STAMP() do { } while (0)
#endif
    STAMP();
#define GRID_BAR() do { xcd_barrier(xbar); STAMP(); } while (0)
    phase_prep_a(p, bid, nb, lds);
    if (p.use_cg) grid.sync(); else xcd_barrier(xbar);
    STAMP();
    if (!(bid < HELPERS && nb > 2 * HELPERS)) {
        const int hsub = (nb > 2 * HELPERS) ? HELPERS : 0;
        pg8::Order O; O.init(T / 256, NCOL / 256, nb - hsub, bid - hsub); EpiInProj E{p};
#if FP8_IN
        ProbPlainF8 P{(const bf16*)(p.ws + WS_H), (const bf16*)(p.ws + WS_WIN), D / 2}; pg8::gemm_phase<EpiInProj, ProbPlainF8, true>((PG8_LAS unsigned char*)lds, P, O, E);
#else
        ProbPlain P{(const bf16*)(p.ws + WS_H), (const bf16*)(p.ws + WS_WIN), D}; pg8::gemm_phase<EpiInProj, ProbPlain, true>((PG8_LAS unsigned char*)lds, P, O, E);
#endif
#if TIME_LO >= 0
        if (threadIdx.x == 0) atomicMax((unsigned long long*)(p.ws + WS_CTL + 917504) + 21, (unsigned long long)__builtin_amdgcn_s_memrealtime());
#endif
    }
    phase_prep_b(p, lds);
#if TIME_LO >= 0
    if (threadIdx.x == 0) atomicMax((unsigned long long*)(p.ws + WS_CTL + 917504) + 20, (unsigned long long)__builtin_amdgcn_s_memrealtime());
#endif
    GRID_BAR();
#if DBG == 1
    { InProjN f{p, true}; phase_naive_gemm(f, T, C_VB, bid, nb, lds); }
    GRID_BAR();
    { COORDS(); phase_check(p, (const bf16*)(p.ws + WS_QA), (const bf16*)(p.ws + 426 * MiB), (size_t)T * WA, gtid, ngt);
      phase_check(p, (const bf16*)(p.ws + WS_KA), (const bf16*)(p.ws + 442 * MiB), (size_t)T * WA, gtid, ngt);
      phase_check(p, (const bf16*)(p.ws + WS_QB), (const bf16*)(p.ws + 458 * MiB), (size_t)T * WB, gtid, ngt);
      phase_check(p, (const bf16*)(p.ws + WS_KB), (const bf16*)(p.ws + 482 * MiB), (size_t)T * WB, gtid, ngt); }
    GRID_BAR();
#endif
    { COORDS(); phase_select_lists(p, bid, nb, lds, tid); phase_dilated(p, bid, nb, lds, tid); }
    GRID_BAR();
    { COORDS(); phase_moba_past(p, bid, nb, lds, tid); }
    GRID_BAR();
    { COORDS(); phase_moba_own(p, bid, nb, lds, tid); phase_dil_merge(p, gtid, ngt); }
    GRID_BAR();
#if DBG == 2
    { COORDS(); phase_moba_naive(p, gw, ngw, lane, wl, (bf16*)p.out); phase_dil_naive(p, gw, ngw, lane, wl, (bf16*)p.out + (size_t)T * WA); }
    GRID_BAR();
    { COORDS();
#if DBG_SUB == 0
      phase_check(p, (const bf16*)(p.ws + WS_OA), (const bf16*)p.out, (size_t)T * WA, gtid, ngt);
#else
      phase_check(p, (const bf16*)(p.ws + WS_OB), (const bf16*)p.out + (size_t)T * WA, (size_t)T * WBO, gtid, ngt);
#endif
    }
    GRID_BAR();
#endif
    { pg8::Order O; O.init(T / 256, D / 256, nb, bid); ProbPlainOff P{(const bf16*)p.out, (const bf16*)(p.ws + WS_WOA), WA + WBO}; EpiMixCat E{p};
      pg8::gemm_phase<EpiMixCat, ProbPlainOff, true>((PG8_LAS unsigned char*)lds, P, O, E); }
    GRID_BAR();
    { ProbPlain P{(const bf16*)(p.ws + WS_MIX), (const bf16*)(p.ws + WS_WOUT), D}; pg8::Order O; O.init(T / 256, D / 256, nb, bid); EpiOut E{p};
      pg8::gemm_phase<EpiOut, ProbPlain, true>((PG8_LAS unsigned char*)lds, P, O, E); }
    GRID_BAR();
    { COORDS(); phase_router(p, bid, nb, lds, tid); }
    GRID_BAR();
    { COORDS(); MoeTab mt; const int n_mt = moe_tables<false>(p, lds, tid, 2 * FF / 256, nb, bid, mt);
      ProbMoE<true, (FP8_GU != 0)> P{(const bf16*)(p.ws + WS_H), (const bf16*)(p.ws + WS_WGU), FP8_GU ? D / 2 : D, mt, 2 * FF}; pg8::Order O; O.init(n_mt, 2 * FF / 256, nb, bid); EpiGateUp E{p, mt};
      pg8::gemm_phase<EpiGateUp, ProbMoE<true, (FP8_GU != 0)>, true>((PG8_LAS unsigned char*)lds, P, O, E); }
    GRID_BAR();
    { COORDS(); MoeTab mt; const int n_mt = moe_tables<true>(p, lds, tid, D / 256, nb, bid, mt);
      ProbMoE<false, (FP8_DN != 0)> P{(const bf16*)(p.ws + WS_A2), (const bf16*)(p.ws + WS_WD), FP8_DN ? FF / 2 : FF, mt, D}; pg8::Order O; O.init(n_mt, D / 256, nb, bid); EpiDown E{p, mt};
      pg8::gemm_phase<EpiDown, ProbMoE<false, (FP8_DN != 0)>, true>((PG8_LAS unsigned char*)lds, P, O, E); }
    GRID_BAR();
    { COORDS(); phase_final(p, gw, ngw, lane); }
#if TIME_LO >= 0
    if (bid == 0 && threadIdx.x == 0) { STAMP();
        const unsigned long long* ts = (const unsigned long long*)(p.ws + WS_CTL + 917504);
        const unsigned long long dt = (ts[TIME_HI] - ts[TIME_LO]) * TIME_MULT, t0 = __builtin_amdgcn_s_memrealtime();
        while (__builtin_amdgcn_s_memrealtime() - t0 < dt) __builtin_amdgcn_s_sleep(8); }
#endif
}

#ifdef TIME_LO
#define TIME_LO_HOST TIME_LO
#else
#define TIME_LO_HOST -1
#endif
extern "C" void kernel_launch(void* const* d_in, const int* in_sizes, int n_in, void* d_out, int out_size, void* d_ws, size_t ws_size, hipStream_t stream) {
    if (n_in != 18 || ws_size < WS_END || out_size != T * D) return;
    static int grid_blocks = 0;
    if (!grid_blocks) {
        int dev = 0, cus = 0, per_cu = 0;
        (void)hipGetDevice(&dev);
        (void)hipDeviceGetAttribute(&cus, hipDeviceAttributeMultiprocessorCount, dev);
        (void)hipFuncSetAttribute((const void*)mega_fwd, hipFuncAttributeMaxDynamicSharedMemorySize, LDS_BYTES);
        (void)hipOccupancyMaxActiveBlocksPerMultiprocessor(&per_cu, (const void*)mega_fwd, 512, LDS_BYTES);
        if (per_cu < 1) per_cu = 1;
        if (per_cu > 1) per_cu = 1;
        grid_blocks = cus * per_cu;
    }
    Params p{};
    const float** fp = (const float**)&p;
    for (int i = 0; i < 18; ++i) fp[i] = (const float*)d_in[i];
    p.out = (float*)d_out; p.ws = (unsigned char*)d_ws;
    for (int i = 0; i < 8; ++i) p.inv_freq[i] = (float)pow(500000.0, -(double)i / 8.0);
    (void)hipMemsetAsync((char*)d_ws + WS_CTL, 0, (TIME_LO_HOST >= 0) ? 1 * MiB : 64 * 1024, stream);
    void* args[] = {&p};
    (void)hipLaunchCooperativeKernel((const void*)mega_fwd, dim3(grid_blocks), dim3(512), args, LDS_BYTES, stream);
}
```

```cpp
#include <hip/hip_runtime.h>
#include <hip/hip_cooperative_groups.h>
namespace cg = cooperative_groups;
#include <stdint.h>
#include <math.h>

typedef unsigned short bf16;
typedef float f32x4 __attribute__((ext_vector_type(4)));
typedef unsigned u32x4 __attribute__((ext_vector_type(4)));
typedef unsigned u32x2 __attribute__((ext_vector_type(2)));

__device__ __forceinline__ float bf2f(bf16 v) { return __uint_as_float(((unsigned)v) << 16); }
__device__ __forceinline__ unsigned f2bf(float f) { unsigned u = __float_as_uint(f); return (u + 0x7fffu + ((u >> 16) & 1u)) >> 16; }
__device__ __forceinline__ unsigned pk2(float lo, float hi) { return f2bf(lo) | (f2bf(hi) << 16); }

typedef float f32x2 __attribute__((ext_vector_type(2)));
typedef __bf16 bf16x2_t __attribute__((ext_vector_type(2)));
__device__ __forceinline__ unsigned cvtpk(float lo, float hi) { f32x2 v = {lo, hi}; bf16x2_t b = __builtin_convertvector(v, bf16x2_t); return __builtin_bit_cast(unsigned, b); }
__device__ __forceinline__ float fast_sigmoid(float x) { return __builtin_amdgcn_rcpf(1.0f + __builtin_amdgcn_exp2f(-1.4426950408889634f * x)); }
typedef float f32x16 __attribute__((ext_vector_type(16)));
typedef short s16x4 __attribute__((ext_vector_type(4)));
typedef short bf16x8v __attribute__((ext_vector_type(8)));
__device__ __forceinline__ int crow(int r, int h) { return (r & 3) + 8 * (r >> 2) + 4 * h; }
#define GAS __attribute__((address_space(1)))
#define LAS __attribute__((address_space(3)))
typedef bf16 act;
__device__ __forceinline__ float ldact(const act* p) { return bf2f(*p); }
__device__ __forceinline__ void stact(act* p, float v) { *p = (bf16)f2bf(v); }
__device__ __forceinline__ void ldact8(const act* p, float (&o)[8]) { const u32x4 a = *(const u32x4*)p;
#pragma unroll
    for (int i = 0; i < 4; ++i) { o[2 * i] = __uint_as_float(a[i] << 16); o[2 * i + 1] = __uint_as_float(a[i] & 0xffff0000u); } }
#ifndef FP8_GU
#define FP8_GU 1
#endif
#ifndef FP8_DN
#define FP8_DN 1
#endif
#ifndef FP8_IN
#define FP8_IN 1
#endif
#ifndef FP8_Y
#define FP8_Y 1
#endif
#ifndef FP8_MOE
#define FP8_MOE 1
#endif
constexpr int NB = 2, S = 8192, T = NB * S, D = 1024, HD = 64;
constexpr int NHA = 8, NHB = 12, WA = 512, WB = 768, WBO = 256, NCOL = 5888;
constexpr int MBLK = 256, NBLK = S / MBLK;
constexpr int NE = 32, TOPK = 4, FF = 1024;
constexpr int A2ROWS = 73728;
constexpr int C_QA = 0, C_KA = 512, C_VA = 1024, C_QB = 1536, C_KB = 2304, C_VB = 3072, C_GA = 3840, C_GB = 4864;
constexpr float NORM_EPS = 1e-5f;

constexpr size_t MiB = 1u << 20;
constexpr size_t WS_CTL = 0;
constexpr size_t WS_WIN = 1 * MiB;
constexpr size_t WS_WOA = 13 * MiB;
constexpr size_t WS_WOB = 14 * MiB;
constexpr size_t WS_WOUT = 15 * MiB;
constexpr size_t WS_WGU = 17 * MiB;
constexpr size_t WS_WD = 145 * MiB;
constexpr size_t WS_ROPE = 209 * MiB;
constexpr size_t WS_KMEAN = WS_ROPE + 512 * 1024;
constexpr size_t WS_H = 210 * MiB;
constexpr size_t WS_QA = 242 * MiB, WS_KA = 258 * MiB, WS_VA = 274 * MiB;
constexpr size_t WS_QB = 290 * MiB, WS_KB = 314 * MiB, WS_VB = 338 * MiB;
constexpr size_t WS_SA = 362 * MiB, WS_SB = 394 * MiB;
constexpr size_t WS_PARTB = 210 * MiB;
constexpr size_t WS_LSEB = 234 * MiB;
constexpr size_t WS_LSEA = 235 * MiB;
constexpr size_t WS_SEL = 236 * MiB + 512 * 1024;
constexpr size_t WS_LIST = 426 * MiB;
constexpr size_t WS_PARTA = 442 * MiB;
constexpr int LIST_CAP = 8192;
constexpr size_t WS_OB = 434 * MiB;
constexpr size_t WS_OA = 490 * MiB;
constexpr size_t WS_MIX = 242 * MiB;
constexpr size_t WS_A2 = 242 * MiB;
constexpr size_t WS_ELIST = 386 * MiB;
constexpr size_t WS_EP = 388 * MiB;
constexpr size_t WS_ROWTOK = 390 * MiB;
constexpr size_t WS_ROWP = 391 * MiB;
constexpr size_t WS_TILEE = 392 * MiB;
constexpr size_t WS_Y = 17 * MiB;
constexpr size_t WS_END = 512 * MiB;
#ifndef TIMEB_LO
#define TIMEB_LO -1
#endif
#ifndef TIMEB_HI
#define TIMEB_HI -1
#endif
#ifndef TIMEB_GAIN
#define TIMEB_GAIN 1.0f
#endif
#ifndef DBG
#define DBG 0
#endif
#ifndef DBG_SUB
#define DBG_SUB 0
#endif
#ifndef DBG_GAIN
#define DBG_GAIN 100.0f
#endif
constexpr int CW_DNUM = 192, CW_DDEN = 193;
constexpr int CW_ECNT = 8192;
constexpr int CW_BAR = 4096;
constexpr int CW_LCNT = 12288;
constexpr int CW_HQ = 224;
constexpr int CW_NMT = 160;

struct Params {
    const float *x, *ln_mix_g, *w_in, *b_gate_a, *b_gate_b, *w_o_a, *w_o_b, *w_out, *ln_ffn_g, *w_router, *b_router,
        *w_gate, *b_gate, *w_up, *b_up, *w_down, *b_down, *ln_final_g;
    float* out; unsigned char* ws;
    float inv_freq[8];
    int use_cg, pad0;
};

template <int MAP> __device__ __forceinline__ int rowmap(int n) { return MAP == 0 ? n : (32 * (n >> 4) + (n & 15) + (MAP == 2 ? 16 : 0)); }
template <int MAP> __device__ __forceinline__ void transpose_item(const float* W, int K, int N, bf16* WT, float* scr, int item, int lane) {
    const int nblk = N / 64, kb = item / nblk, nb = item % nblk, k0 = 64 * kb, n0 = 64 * nb;
    f32x4 v[16];
#pragma unroll
    for (int i = 0; i < 16; ++i) v[i] = *(const f32x4*)(W + (size_t)(k0 + (lane >> 4) + 4 * i) * N + n0 + 4 * (lane & 15));
#pragma unroll
    for (int i = 0; i < 16; ++i) { float* d = scr + ((lane >> 4) + 4 * i) * 65 + 4 * (lane & 15); d[0] = v[i].x; d[1] = v[i].y; d[2] = v[i].z; d[3] = v[i].w; }
    asm volatile("s_waitcnt lgkmcnt(0)" ::: "memory");
    const int c = lane & 7;
#pragma unroll
    for (int j = 0; j < 8; ++j) { const int n = (lane >> 3) + 8 * j; const float* q = scr + (8 * c) * 65 + n;
        u32x4 o; o.x = cvtpk(q[0 * 65], q[1 * 65]); o.y = cvtpk(q[2 * 65], q[3 * 65]); o.z = cvtpk(q[4 * 65], q[5 * 65]); o.w = cvtpk(q[6 * 65], q[7 * 65]);
        *(u32x4*)(WT + (size_t)rowmap<MAP>(n0 + n) * K + k0 + 8 * c) = o; }
    asm volatile("s_waitcnt lgkmcnt(0)" ::: "memory");
}
__device__ __forceinline__ float wave_sum(float v) {
#pragma unroll
    for (int o = 1; o < 64; o <<= 1) v += __shfl_xor(v, o);
    return v;
}
__device__ __forceinline__ void sincos_acc(float ang, float& c, float& s) {
    const double a = (double)ang; const double k = rint(a * 0.63661977236758134308); const double y = a - k * 1.57079632679489661923; const double y2 = y * y;
    const double sn = y * (1.0 + y2 * (-1.0 / 6 + y2 * (1.0 / 120 + y2 * (-1.0 / 5040 + y2 * (1.0 / 362880 + y2 * (-1.0 / 39916800))))));
    const double cs = 1.0 + y2 * (-0.5 + y2 * (1.0 / 24 + y2 * (-1.0 / 720 + y2 * (1.0 / 40320 + y2 * (-1.0 / 3628800 + y2 * (1.0 / 479001600))))));
    const int q = ((int)k) & 3;
    const double ss = (q == 0) ? sn : (q == 1) ? cs : (q == 2) ? -sn : -cs;
    const double cc = (q == 0) ? cs : (q == 1) ? -sn : (q == 2) ? -cs : sn;
    c = (float)cc; s = (float)ss;
}
struct TItem { const float* W; bf16* WT; int K, N, map, k0, n0, f8, kd; };
__device__ __forceinline__ TItem titem_decode(const Params& p, int it) {
    constexpr int I_OA = (WA / 64) * (D / 32), I_OB = (WBO / 64) * (D / 32), I_OUT = (D / 64) * (D / 32), I_E = (D / 64) * (FF / 32);
    static_assert(I_E == 512 && D == 1024 && FF == 1024, "the expert-matrix decode below uses shifts");
    unsigned char* ws = p.ws; TItem t; int r = it; t.f8 = 0; t.kd = 0; t.N = D; t.map = 0;
    if (r >= I_OA + I_OB + I_OUT) {
        r -= I_OA + I_OB + I_OUT; const int which = r >> 14  , e = (r >> 9) & 31; r &= 511; t.K = D;
        t.f8 = (which == 2) ? (FP8_DN ? 1 : 0) : (FP8_GU ? 1 : 0); const size_t esz = t.f8 ? 1 : 2;
        if (which == 0) { t.W = p.w_gate + (size_t)e * D * FF; t.WT = (bf16*)(ws + WS_WGU + (size_t)e * 2 * FF * D * esz); t.map = 1; }
        else if (which == 1) { t.W = p.w_up + (size_t)e * D * FF; t.WT = (bf16*)(ws + WS_WGU + (size_t)e * 2 * FF * D * esz); t.map = 2; }
        else { t.W = p.w_down + (size_t)e * FF * D; t.WT = (bf16*)(ws + WS_WD + (size_t)e * D * FF * esz); }
    }
    else if (r < I_OA) { t.W = p.w_o_a; t.WT = (bf16*)(ws + WS_WOA); t.K = WA + WBO; }
    else if ((r -= I_OA) < I_OB) { t.W = p.w_o_b; t.WT = (bf16*)(ws + WS_WOA); t.K = WA + WBO; t.kd = WA; }
    else { r -= I_OB; t.W = p.w_out; t.WT = (bf16*)(ws + WS_WOUT); t.K = D; }
    const int pr_ = r >> 1; t.k0 = 64 * (2 * (pr_ >> 5) + (r & 1)); t.n0 = 32 * (pr_ & 31);
    return t;
}
__device__ __forceinline__ void titem_load(const TItem& t, f32x4 (&v)[8], int lane) {
#pragma unroll
    for (int i = 0; i < 8; ++i) v[i] = __builtin_nontemporal_load((const f32x4*)(t.W + (size_t)(t.k0 + (lane >> 3) + 8 * i) * t.N + t.n0 + 4 * (lane & 7)));
}
__device__ __forceinline__ void titem_store(const TItem& t, const f32x4 (&v)[8], float* scr, int lane) {
#pragma unroll
    for (int i = 0; i < 8; ++i) { float* d = scr + ((lane >> 3) + 8 * i) * 33 + 4 * (lane & 7); d[0] = v[i].x; d[1] = v[i].y; d[2] = v[i].z; d[3] = v[i].w; }
    asm volatile("s_waitcnt lgkmcnt(0)" ::: "memory");
    const int c = (lane & 3) + 4 * (lane >> 5);
#pragma unroll
    for (int j = 0; j < 4; ++j) { const int n = ((lane >> 2) & 7) + 8 * j; const float* q = scr + (8 * c) * 33 + n; const int nn = t.n0 + n;
        const int row = t.map == 0 ? nn : (32 * (nn >> 4) + (nn & 15) + (t.map == 2 ? 16 : 0));
        if (t.f8) { int w0 = __builtin_amdgcn_cvt_pk_fp8_f32(q[0 * 33] * 64.f, q[1 * 33] * 64.f, 0, false); w0 = __builtin_amdgcn_cvt_pk_fp8_f32(q[2 * 33] * 64.f, q[3 * 33] * 64.f, w0, true);
            int w1 = __builtin_amdgcn_cvt_pk_fp8_f32(q[4 * 33] * 64.f, q[5 * 33] * 64.f, 0, false); w1 = __builtin_amdgcn_cvt_pk_fp8_f32(q[6 * 33] * 64.f, q[7 * 33] * 64.f, w1, true);
            u32x2 o; o.x = (unsigned)w0; o.y = (unsigned)w1; *(u32x2*)((unsigned char*)t.WT + (size_t)row * t.K + t.kd + t.k0 + 8 * c) = o; }
        else { u32x4 o; o.x = cvtpk(q[0 * 33], q[1 * 33]); o.y = cvtpk(q[2 * 33], q[3 * 33]); o.z = cvtpk(q[4 * 33], q[5 * 33]); o.w = cvtpk(q[6 * 33], q[7 * 33]);
            *(u32x4*)(t.WT + (size_t)row * t.K + t.kd + t.k0 + 8 * c) = o; } }
    asm volatile("s_waitcnt lgkmcnt(0)" ::: "memory");
}
__device__ __forceinline__ void phase_prep_a(const Params& p, int bid, int nb, unsigned char* lds) {
    int tid = threadIdx.x; asm volatile("" : "+v"(tid)); const int lane = tid & 63, wave = tid >> 6;
    const int gw = bid * 8 + wave, NGW = nb * 8;
    unsigned char* ws = p.ws;
    float* scr = (float*)lds + wave * (64 * 33);
    constexpr int I_IN = (D / 64) * (NCOL / 32);
    for (int it = gw; it < I_IN; it += NGW) {
        TItem t; t.W = p.w_in; t.WT = (bf16*)(ws + WS_WIN); t.K = D; t.N = NCOL; t.map = 0; t.f8 = FP8_IN; t.kd = 0; t.k0 = 64 * (it / (NCOL / 32)); t.n0 = 32 * (it % (NCOL / 32));
        f32x4 v[8]; titem_load(t, v, lane); titem_store(t, v, scr, lane);
    }
    for (int m = gw; m < T; m += NGW) {
        const f32x4* xr = (const f32x4*)(p.x + (size_t)m * D) + lane; const f32x4* gr = (const f32x4*)p.ln_mix_g + lane;
        f32x4 v[4]; float s = 0.f;
#pragma unroll
        for (int j = 0; j < 4; ++j) { v[j] = xr[64 * j]; s += (v[j].x * v[j].x + v[j].y * v[j].y) + (v[j].z * v[j].z + v[j].w * v[j].w); }
        const float rstd = 1.0f / sqrtf(wave_sum(s) * (1.0f / D) + NORM_EPS);
#pragma unroll
        for (int j = 0; j < 4; ++j) { const f32x4 g = gr[64 * j];
#if FP8_IN
            int o = __builtin_amdgcn_cvt_pk_fp8_f32(v[j].x * rstd * g.x, v[j].y * rstd * g.y, 0, false); o = __builtin_amdgcn_cvt_pk_fp8_f32(v[j].z * rstd * g.z, v[j].w * rstd * g.w, o, true);
            ((int*)((unsigned char*)(ws + WS_H) + (size_t)m * D))[lane + 64 * j] = o;
#else
            u32x2 o; o.x = cvtpk(v[j].x * rstd * g.x, v[j].y * rstd * g.y); o.y = cvtpk(v[j].z * rstd * g.z, v[j].w * rstd * g.w); ((u32x2*)((bf16*)(ws + WS_H) + (size_t)m * D))[lane + 64 * j] = o;
#endif
        }
    }
    float2* rope = (float2*)(ws + WS_ROPE);
    for (int i = bid * 512 + tid; i < S * 8; i += nb * 512) { const int s = i >> 3, f = i & 7; const float ang = (float)s * p.inv_freq[f]; float c, sn; sincos_acc(ang, c, sn); rope[i] = make_float2(c, sn); }
    for (int i = bid * 512 + tid; i < NB * NHA * NBLK * HD; i += nb * 512) ((float*)(ws + WS_KMEAN))[i] = 0.f;
}
__device__ __forceinline__ void phase_prep_b(const Params& p, unsigned char* lds) {
    int tid = threadIdx.x; asm volatile("" : "+v"(tid)); const int lane = tid & 63, wave = tid >> 6;
    float* scr = (float*)lds + wave * (64 * 33);
    constexpr int NITEMS = (WA / 64) * (D / 32) + (WBO / 64) * (D / 32) + (D / 64) * (D / 32) + 3 * NE * (D / 64) * (FF / 32);
    int* ctr = (int*)(p.ws + WS_CTL) + CW_HQ;
    int qcur = 0, qend = 0; bool qdone = false;
#define TQ_NEXT(dst) do { if (qcur == qend && !qdone) { int b_ = 0; if (lane == 0) b_ = atomicAdd(ctr, 8); b_ = __builtin_amdgcn_readfirstlane(b_); \
        if (b_ >= NITEMS) qdone = true; else { qcur = b_; qend = (b_ + 8 < NITEMS) ? b_ + 8 : NITEMS; } } \
        if (qcur < qend) dst = qcur++; else dst = -1; } while (0)
    TItem ta, tb, tc; f32x4 va[8], vb[8], vc[8];
    int ia, ib, ic;
    TQ_NEXT(ia); if (ia >= 0) { ta = titem_decode(p, ia); titem_load(ta, va, lane); }
    TQ_NEXT(ib); if (ib >= 0) { tb = titem_decode(p, ib); titem_load(tb, vb, lane); }
    while (ia >= 0) {
        TQ_NEXT(ic); if (ic >= 0) { tc = titem_decode(p, ic); titem_load(tc, vc, lane); }
        titem_store(ta, va, scr, lane);
        if (ib < 0) break;
        TQ_NEXT(ia); if (ia >= 0) { ta = titem_decode(p, ia); titem_load(ta, va, lane); }
        titem_store(tb, vb, scr, lane);
        if (ic < 0) break;
        TQ_NEXT(ib); if (ib >= 0) { tb = titem_decode(p, ib); titem_load(tb, vb, lane); }
        titem_store(tc, vc, scr, lane);
    }
#undef TQ_NEXT
}

__device__ __forceinline__ int cl(int tx, int j) { return (tx & 7) + 8 * j + 32 * (tx >> 3); }
template <class F> __device__ __forceinline__ void phase_naive_gemm(const F& f, int M, int N, int bid, int nb, unsigned char* lds) {
    const int half = threadIdx.x >> 8, tid = threadIdx.x & 255, tx = tid & 15, ty = tid >> 4;
    float (*As)[33] = (float (*)[33])(lds + half * (2 * 64 * 33 * 4)); float (*Bs)[33] = As + 64;
    const int nN = N / 64, ntiles = (M / 64) * nN, stride = nb * 2;
    const int nround = (ntiles + stride - 1) / stride;
    const int lr = tid >> 2, lk = (tid & 3) * 8;
    for (int r = 0; r < nround; ++r) {
        const int it = r * stride + bid * 2 + half;
        const bool valid = it < ntiles;
        const int m0 = valid ? (it / nN) * 64 : 0, n0 = valid ? (it % nN) * 64 : 0;
        const bool act_ = valid && f.active(m0);
        float acc[F::NPASS][4][4];
#pragma unroll
        for (int ps = 0; ps < F::NPASS; ++ps)
#pragma unroll
            for (int i = 0; i < 4; ++i)
#pragma unroll
                for (int j = 0; j < 4; ++j) acc[ps][i][j] = 0.f;
#pragma unroll
        for (int ps = 0; ps < F::NPASS; ++ps) {
            const int K = f.K(ps);
            const bf16* ap = act_ ? f.arow(ps, m0 + lr) : nullptr; const bf16* bp = act_ ? f.brow(ps, m0, n0 + lr) : nullptr;
            for (int k0 = 0; k0 < K; k0 += 32) {
                float av[8], bv[8];
                if (act_) { ldact8(ap + k0 + lk, av); ldact8(bp + k0 + lk, bv); }
                else {
#pragma unroll
                    for (int i = 0; i < 8; ++i) { av[i] = 0.f; bv[i] = 0.f; } }
                __syncthreads();
#pragma unroll
                for (int i = 0; i < 8; ++i) { As[lr][lk + i] = av[i]; Bs[lr][lk + i] = bv[i]; }
                __syncthreads();
#pragma unroll 8
                for (int kk = 0; kk < 32; ++kk) {
                    float a[4], b[4];
#pragma unroll
                    for (int i = 0; i < 4; ++i) { a[i] = As[ty * 4 + i][kk]; b[i] = Bs[cl(tx, i)][kk]; }
#pragma unroll
                    for (int i = 0; i < 4; ++i)
#pragma unroll
                        for (int j = 0; j < 4; ++j) acc[ps][i][j] += a[i] * b[j];
                }
            }
        }
        if (act_) {
#pragma unroll
            for (int i = 0; i < 4; ++i) f.epi(m0 + ty * 4 + i, n0, tx, acc[0][i], acc[F::NPASS - 1][i]);
        }
    }
}

struct InProjN {
    static constexpr int NPASS = 1; Params p; bool alt;
    __device__ __forceinline__ bool active(int) const { return true; }
    __device__ __forceinline__ int K(int) const { return D; }
    __device__ __forceinline__ int ldb(int) const { return NCOL; }
    __device__ __forceinline__ const act* arow(int, int m) const { return (const act*)(p.ws + WS_H) + (size_t)m * D; }
    __device__ __forceinline__ const bf16* brow(int, int, int n) const { return (const bf16*)(p.ws + WS_WIN) + (size_t)n * D; }
    __device__ __forceinline__ void epi(int m, int n0, int tx, float (&v)[4], float (&)[4]) const {
        unsigned char* ws = p.ws;
        act* dst; int ld, cb; bool rope = false; const float* gbias = nullptr;
        if (n0 < C_KA) { dst = (act*)(ws + (alt ? 426 * MiB : WS_QA)); ld = WA; cb = n0 - C_QA; rope = true; }
        else if (n0 < C_VA) { dst = (act*)(ws + (alt ? 442 * MiB : WS_KA)); ld = WA; cb = n0 - C_KA; rope = true; }
        else if (n0 < C_QB) { if (alt) return; dst = (act*)(ws + WS_VA); ld = WA; cb = n0 - C_VA; }
        else if (n0 < C_KB) { dst = (act*)(ws + (alt ? 458 * MiB : WS_QB)); ld = WB; cb = n0 - C_QB; rope = true; }
        else if (n0 < C_VB) { dst = (act*)(ws + (alt ? 482 * MiB : WS_KB)); ld = WB; cb = n0 - C_KB; rope = true; }
        else if (alt) { return; }
        else if (n0 < C_GA) { dst = (act*)(ws + WS_VB); ld = WB; cb = n0 - C_VB; }
        else if (n0 < C_GB) { dst = (act*)(ws + WS_SA); ld = D; cb = n0 - C_GA; gbias = p.b_gate_a; }
        else { dst = (act*)(ws + WS_SB); ld = D; cb = n0 - C_GB; gbias = p.b_gate_b; }
        if (rope && (tx >> 3) == 0) {
            const float2 cs = ((const float2*)(ws + WS_ROPE))[(m % S) * 8 + (tx & 7)];
            const float x1 = v[0], x2 = v[1]; v[0] = x1 * cs.x - x2 * cs.y; v[1] = x2 * cs.x + x1 * cs.y;
        }
#pragma unroll
        for (int j = 0; j < 4; ++j) { const int c = cb + cl(tx, j); float o = v[j];
            if (gbias) { o = 1.0f / (1.0f + expf(-(o + gbias[c]))); }
            stact(dst + (size_t)m * ld + c, o); }
    }
};
struct MixN {
    static constexpr int NPASS = 2; Params p;
    __device__ __forceinline__ bool active(int) const { return true; }
    __device__ __forceinline__ int K(int ps) const { return ps == 0 ? WA : WBO; }
    __device__ __forceinline__ int ldb(int) const { return D; }
    __device__ __forceinline__ const act* arow(int ps, int m) const { return ps == 0 ? (const act*)(p.ws + WS_OA) + (size_t)m * WA : (const act*)(p.ws + WS_OB) + (size_t)m * WBO; }
    __device__ __forceinline__ const bf16* brow(int ps, int, int n) const { return ps == 0 ? (const bf16*)(p.ws + WS_WOA) + (size_t)n * WA : (const bf16*)(p.ws + WS_WOB) + (size_t)n * WBO; }
    __device__ __forceinline__ void epi(int m, int n0, int tx, float (&a)[4], float (&b)[4]) const {
#pragma unroll
        for (int j = 0; j < 4; ++j) { const int c = n0 + cl(tx, j); const size_t o = (size_t)m * D + c;
            const float sa = ldact((const act*)(p.ws + WS_SA) + o), sb = ldact((const act*)(p.ws + WS_SB) + o);
            stact((act*)(p.ws + WS_MIX) + o, sa * a[j] + sb * b[j]); }
    }
};
struct OutN {
    static constexpr int NPASS = 1; Params p;
    __device__ __forceinline__ bool active(int) const { return true; }
    __device__ __forceinline__ int K(int) const { return D; }
    __device__ __forceinline__ int ldb(int) const { return D; }
    __device__ __forceinline__ const act* arow(int, int m) const { return (const act*)(p.ws + WS_MIX) + (size_t)m * D; }
    __device__ __forceinline__ const bf16* brow(int, int, int n) const { return (const bf16*)(p.ws + WS_WOUT) + (size_t)n * D; }
    __device__ __forceinline__ void epi(int m, int n0, int tx, float (&a)[4], float (&)[4]) const {
#pragma unroll
        for (int j = 0; j < 4; ++j) { const size_t o = (size_t)m * D + n0 + cl(tx, j); p.out[o] = p.x[o] + a[j]; }
    }
};


namespace pg8 {
#define PG8_LAS __attribute__((address_space(3)))
typedef short bf16x8 __attribute__((ext_vector_type(8)));
typedef int v4i_t __attribute__((ext_vector_type(4)));
typedef int v8i_t __attribute__((ext_vector_type(8)));
constexpr int BM = 256, BK = 64, HALF = 128, HTB = HALF * BK * 2  , STAGE_BYTES = 8 * HTB, NXCD = 8, WGM = 8;
__device__ __forceinline__ int lds_byte(int r, int c) { const int st = (r >> 4) * 2 + (c >> 5), rr = r & 15, cc = c & 31, ob = rr * 64 + cc * 2; return st * 1024 + (ob ^ (((ob >> 9) & 1) << 5)); }
__device__ __forceinline__ void stage_rc(int b, int& R, int& C) { const int st = b / 1024, sb = b % 1024, swz = sb ^ (((sb >> 9) & 1) << 5); R = (st >> 1) * 16 + swz / 64; C = (st & 1) * 32 + (swz % 64) / 2; }
__device__ __forceinline__ int perm32(int rho) { const int n = rho >> 4, i = rho & 15; return 8 * (i >> 2) + 4 * n + (i & 3); }
struct Unit { int pm, pn, slot; };
struct Order {
    int nM, nN, nwg, G, c;
    __device__ __forceinline__ void init(int nM_, int nN_, int G_, int c_) { nM = nM_; nN = nN_; nwg = nM * nN; G = G_; c = c_; }
    __device__ __forceinline__ bool next(int i, Unit& u) const {
        const long L = (long)i * G + c; if (L >= nwg) return false;
        int wgid = (int)L; { const int q = nwg / NXCD, r = nwg % NXCD, xcd = wgid % NXCD, off = wgid / NXCD; wgid = (xcd < r ? xcd * (q + 1) : r * (q + 1) + (xcd - r) * q) + off; }
        const int nig = WGM * nN, gid = wgid / nig, fm = gid * WGM, gsz = (nM - fm) < WGM ? (nM - fm) : WGM;
        u.pm = fm + ((wgid % nig) % gsz); u.pn = (wgid % nig) / gsz; u.slot = i; return true;
    }
};
template <class Epi, class Prob, bool ALIGN_EPI>
__device__ __forceinline__ void gemm_phase(PG8_LAS unsigned char* lds, const Prob& P, const Order& S, const Epi& E) {
    int tid = threadIdx.x; asm volatile("" : "+v"(tid)); const int wid = __builtin_amdgcn_readfirstlane(tid >> 6), lane = tid & 63, wr = wid >> 2, wc = wid & 3, fr = lane & 15, fq = lane >> 4;
    constexpr bool GATHER = Prob::GATHER; constexpr bool FP8 = Prob::FP8;
    const int K = P.K, nt = K / BK;
    unsigned voffA[2], voffB[2];
#pragma unroll
    for (int i = 0; i < 2; ++i) { int R, C; stage_rc(tid * 16 + i * 8192, R, C); const int Rb = Epi::PERM ? ((R & ~31) + perm32(R & 31)) : R; voffA[i] = (unsigned)(R * K + C) * 2u; voffB[i] = (unsigned)(Rb * K + C) * 2u; }
    const size_t kstep = (size_t)(BK * 2);
    const size_t hstep = (size_t)HALF * K * 2;
    const unsigned ldsw = (unsigned)wid * 1024u;
    const int aoff = lds_byte(wr * 64 + fr, fq * 8), boff = lds_byte(wc * 32 + fr, fq * 8);
    const char* const Ab = (const char*)P.abase();
#define PG8_SA(b, h) (((b) * 2 + (h)) * HTB)
#define PG8_SB(b, h) ((4 + (b) * 2 + (h)) * HTB)
#define PG8_GLDS(src, bufoff, i) __builtin_amdgcn_global_load_lds((const unsigned*)(src), (PG8_LAS unsigned*)(lds + (bufoff) + ldsw + (i) * 8192), 16, 0, 0)
#define PG8_STAGE_B(bufoff, gbase) do { PG8_GLDS((const char*)(gbase) + voffB[0], bufoff, 0); PG8_GLDS((const char*)(gbase) + voffB[1], bufoff, 1); } while (0)
#define PG8_STAGE_A(bufoff, h, kb) do { if constexpr (GATHER) { PG8_GLDS(Ab + (size_t)g[h][0] + (kb), bufoff, 0); PG8_GLDS(Ab + (size_t)g[h][1] + (kb), bufoff, 1); } \
        else { PG8_GLDS(cA + (h) * hstep + (kb) + voffA[0], bufoff, 0); PG8_GLDS(cA + (h) * hstep + (kb) + voffA[1], bufoff, 1); } } while (0)
#define PG8_CAT(x0, x1) __builtin_shufflevector(x0, x1, 0, 1, 2, 3, 4, 5, 6, 7)
#define PG8_LO(x) __builtin_bit_cast(bf16x8, __builtin_shufflevector(x, x, 0, 1, 2, 3))
#define PG8_HI(x) __builtin_bit_cast(bf16x8, __builtin_shufflevector(x, x, 4, 5, 6, 7))
#define PG8_LDA(dst, b, h) do { _Pragma("unroll") for (int m = 0; m < 4; ++m) dst[m] = PG8_CAT(*(const PG8_LAS v4i_t*)(lds + PG8_SA(b, h) + aoff + m * 2048), *(const PG8_LAS v4i_t*)(lds + PG8_SA(b, h) + aoff + m * 2048 + 1024)); } while (0)
#define PG8_LDB(dst, b, h) do { _Pragma("unroll") for (int n = 0; n < 2; ++n) dst[n] = PG8_CAT(*(const PG8_LAS v4i_t*)(lds + PG8_SB(b, h) + boff + n * 2048), *(const PG8_LAS v4i_t*)(lds + PG8_SB(b, h) + boff + n * 2048 + 1024)); } while (0)
#define PG8_MMA(ai, bj, At, Bt) do { __builtin_amdgcn_s_setprio(1); _Pragma("unroll") for (int m = 0; m < 4; ++m) _Pragma("unroll") for (int n = 0; n < 2; ++n) { \
        if constexpr (FP8) acc[ai][bj][m][n] = __builtin_amdgcn_mfma_scale_f32_16x16x128_f8f6f4(Bt[n], At[m], acc[ai][bj][m][n], 0, 0, 0, 0x79797979, 0, 0x7f7f7f7f); \
        else { acc[ai][bj][m][n] = __builtin_amdgcn_mfma_f32_16x16x32_bf16(PG8_LO(Bt[n]), PG8_LO(At[m]), acc[ai][bj][m][n], 0, 0, 0); \
               acc[ai][bj][m][n] = __builtin_amdgcn_mfma_f32_16x16x32_bf16(PG8_HI(Bt[n]), PG8_HI(At[m]), acc[ai][bj][m][n], 0, 0, 0); } } \
        __builtin_amdgcn_s_setprio(0); } while (0)
#define PG8_WAIT_V(n) asm volatile("s_waitcnt vmcnt(" #n ")" ::: "memory")
#define PG8_WAIT_L(n) asm volatile("s_waitcnt lgkmcnt(" #n ")" ::: "memory")
#define PG8_BAR __builtin_amdgcn_s_barrier()
#define PG8_SCHED __builtin_amdgcn_sched_barrier(0)
    Unit cur, nxt; int ui = 0;
    if (!S.next(0, cur)) return;
    f32x4 acc[2][2][4][2];
#pragma unroll
    for (int a = 0; a < 2; ++a)
#pragma unroll
        for (int b = 0; b < 2; ++b)
#pragma unroll
            for (int m = 0; m < 4; ++m)
#pragma unroll
                for (int n = 0; n < 2; ++n) acc[a][b][m][n] = (f32x4){0.f, 0.f, 0.f, 0.f};
    if constexpr (Epi::HAS_INIT) { f32x4 iv[2][2]; E.init_load(iv, cur, wc, fq); E.init_apply(acc, iv); }
    v8i_t At[4], B0[2], B1[2];
    unsigned g[2][2], gn[2][2];
    const char* cA = Ab; const char* nA = Ab;
    if constexpr (GATHER) {
#pragma unroll
        for (int h = 0; h < 2; ++h)
#pragma unroll
            for (int i = 0; i < 2; ++i) { g[h][i] = P.goff(cur, h, voffA[i]); gn[h][i] = g[h][i]; }
    } else { cA = Ab + P.aoff(cur); nA = cA; }
    const char* cB = (const char*)P.bbase(cur);
    PG8_STAGE_B(PG8_SB(0, 0), cB); PG8_STAGE_B(PG8_SB(0, 1), cB + hstep); PG8_STAGE_A(PG8_SA(0, 0), 0, 0); PG8_STAGE_A(PG8_SA(0, 1), 1, 0);
    if (wr == 1) PG8_BAR;
    PG8_WAIT_V(2); PG8_BAR;
    PG8_STAGE_B(PG8_SB(1, 0), cB + kstep); PG8_STAGE_A(PG8_SA(1, 0), 0, kstep); PG8_STAGE_B(PG8_SB(1, 1), cB + hstep + kstep);
    PG8_WAIT_V(6); PG8_BAR;
    for (;;) {
        const bool has_next = S.next(ui + 1, nxt);
        const char* nB = cB;
        if (has_next) { nB = (const char*)P.bbase(nxt);
            if constexpr (GATHER) {
#pragma unroll
                for (int h = 0; h < 2; ++h)
#pragma unroll
                    for (int i = 0; i < 2; ++i) gn[h][i] = P.goff(nxt, h, voffA[i]);
            } else nA = Ab + P.aoff(nxt); }
        for (int t = 0; t < nt; t += 2) {
            const bool last = (t == nt - 2);
            const size_t k1 = (size_t)(t + 1) * kstep;
            const size_t k2 = last ? 0 : (size_t)(t + 2) * kstep, k3 = k2 + kstep;
            if constexpr (Epi::MID_T > 0) { if (t == Epi::MID_T) E.mid(acc, cur, wr, wc, fr, fq); }
            PG8_LDB(B0, 0, 0); PG8_LDB(B1, 0, 1); PG8_SCHED; PG8_LDA(At, 0, 0); PG8_STAGE_A(PG8_SA(1, 1), 1, k1);
            if (last) { cB = nB; if constexpr (GATHER) { g[0][0] = gn[0][0]; g[0][1] = gn[0][1]; g[1][0] = gn[1][0]; g[1][1] = gn[1][1]; } else cA = nA; }
            PG8_WAIT_V(8); PG8_WAIT_L(0); PG8_BAR; PG8_MMA(0, 0, At, B0); PG8_MMA(0, 1, At, B1); PG8_BAR; PG8_SCHED;
            PG8_LDA(At, 0, 1); PG8_STAGE_B(PG8_SB(0, 0), cB + k2); PG8_STAGE_B(PG8_SB(0, 1), cB + k2 + hstep); PG8_STAGE_A(PG8_SA(0, 0), 0, k2);
            PG8_WAIT_V(8); PG8_WAIT_L(0); PG8_BAR; PG8_MMA(1, 0, At, B0); PG8_MMA(1, 1, At, B1); PG8_BAR; PG8_SCHED;
            PG8_LDB(B0, 1, 0); PG8_LDB(B1, 1, 1); PG8_SCHED; PG8_LDA(At, 1, 0); PG8_STAGE_A(PG8_SA(0, 1), 1, k2);
            PG8_WAIT_V(8); PG8_WAIT_L(0); PG8_BAR; PG8_MMA(0, 0, At, B0); PG8_MMA(0, 1, At, B1); PG8_BAR; PG8_SCHED;
            PG8_LDA(At, 1, 1); PG8_STAGE_B(PG8_SB(1, 0), cB + k3); PG8_STAGE_B(PG8_SB(1, 1), cB + k3 + hstep); PG8_STAGE_A(PG8_SA(1, 0), 0, k3);
            PG8_WAIT_V(8); PG8_WAIT_L(0); PG8_BAR; PG8_MMA(1, 0, At, B0); PG8_MMA(1, 1, At, B1); PG8_BAR; PG8_SCHED;
        }
        if constexpr (ALIGN_EPI) { if (wr == 0) PG8_BAR; }
        f32x4 iv[2][2];
        if constexpr (Epi::HAS_INIT) { if (has_next) E.init_load(iv, nxt, wc, fq); }
        E(acc, cur, wr, wc, fr, fq);
        if (!has_next) break;
#pragma unroll
        for (int a = 0; a < 2; ++a)
#pragma unroll
            for (int b = 0; b < 2; ++b)
#pragma unroll
                for (int m = 0; m < 4; ++m)
#pragma unroll
                    for (int n = 0; n < 2; ++n) acc[a][b][m][n] = (f32x4){0.f, 0.f, 0.f, 0.f};
        if constexpr (Epi::HAS_INIT) E.init_apply(acc, iv);
        cur = nxt; ++ui;
        if constexpr (ALIGN_EPI) { if (wr == 1) PG8_BAR; }
    }
    PG8_WAIT_V(0);
    if constexpr (!ALIGN_EPI) { if (wr == 0) PG8_BAR; }
    PG8_BAR;
#undef PG8_SA
#undef PG8_SB
#undef PG8_GLDS
#undef PG8_STAGE_A
#undef PG8_STAGE_B
#undef PG8_LDA
#undef PG8_LDB
#undef PG8_MMA
#undef PG8_CAT
#undef PG8_LO
#undef PG8_HI
#undef PG8_WAIT_V
#undef PG8_WAIT_L
#undef PG8_BAR
#undef PG8_SCHED
}
}


constexpr int MT_OFF = 131072;
struct MoeTab { const LAS int* e_of; const LAS int* rt; const LAS float* rp; };
template <bool WITH_P> __device__ __forceinline__ int moe_tables(const Params& p, unsigned char* lds, int tid, int nN, int nb, int bid, MoeTab& mt) {
    LAS int* cnt = (LAS int*)(lds + MT_OFF); LAS int* pstart = cnt + 32; LAS int* e_of = cnt + 72; constexpr int MAXU = WITH_P ? 5 : 9;
    LAS int* rt = cnt + 112; LAS float* rp = (LAS float*)(rt + MAXU * 256);
    __syncthreads();
    if (tid < NE) cnt[tid] = __hip_atomic_load((const int*)(p.ws + WS_CTL) + CW_ECNT + 64 * tid, __ATOMIC_RELAXED, __HIP_MEMORY_SCOPE_AGENT);
    __syncthreads();
    if (tid == 0) { int st = 0; for (int e = 0; e < NE; ++e) { pstart[e] = st; st += (cnt[e] + 255) & ~255; } pstart[32] = st; }
    __syncthreads();
    const int n_mt = __builtin_amdgcn_readfirstlane(pstart[32] >> 8);
    pg8::Order O; O.init(n_mt, nN, nb, bid);
    LAS int* pm_of = cnt + 88;
    if (tid < MAXU) { pg8::Unit u; int e = 0, pm = -1;
        if (O.next(tid, u)) { pm = u.pm; for (int q = 1; q < NE; ++q) if (pm * 256 >= pstart[q]) e = q; }
        e_of[tid] = e; pm_of[tid] = pm; }
    __syncthreads();
    for (int idx = tid; idx < MAXU * 256; idx += 512) { const int i = idx >> 8, r = idx & 255, pm = pm_of[i];
        if (pm >= 0) { const int e = e_of[i]; const int pos = pm * 256 + r - pstart[e]; const bool ok = pos < cnt[e];
            rt[idx] = ok ? ((const int*)(p.ws + WS_ELIST))[e * T + pos] : -1;
            if (WITH_P) rp[idx] = ok ? ((const float*)(p.ws + WS_EP))[e * T + pos] : 0.f; } }
    __syncthreads();
    mt.e_of = e_of; mt.rt = rt; mt.rp = rp;
    return n_mt;
}
struct ProbPlain {
    static constexpr bool GATHER = false, FP8 = false;
    const bf16* A; const bf16* Bt; int K;
    __device__ __forceinline__ const bf16* abase() const { return A; }
    __device__ __forceinline__ size_t aoff(const pg8::Unit& u) const { return (size_t)u.pm * 256 * K * 2; }
    __device__ __forceinline__ unsigned goff(const pg8::Unit&, int, unsigned) const { return 0u; }
    __device__ __forceinline__ const bf16* bbase(const pg8::Unit& u) const { return Bt + (size_t)u.pn * 256 * K; }
};
struct ProbPlainOff {
    static constexpr bool GATHER = true, FP8 = false;
    const bf16* A; const bf16* Bt; int K;
    __device__ __forceinline__ const bf16* abase() const { return A; }
    __device__ __forceinline__ size_t aoff(const pg8::Unit& u) const { return (size_t)u.pm * 256 * K * 2; }
    __device__ __forceinline__ unsigned goff(const pg8::Unit& u, int h, unsigned voff) const { return (unsigned)(u.pm * 256 + h * 128) * ((unsigned)K * 2u) + voff; }
    __device__ __forceinline__ const bf16* bbase(const pg8::Unit& u) const { return Bt + (size_t)u.pn * 256 * K; }
};
struct ProbPlainF8 {
    static constexpr bool GATHER = true, FP8 = true;
    const bf16* A; const bf16* Bt; int K;
    __device__ __forceinline__ const bf16* abase() const { return A; }
    __device__ __forceinline__ size_t aoff(const pg8::Unit& u) const { return (size_t)u.pm * 256 * K * 2; }
    __device__ __forceinline__ unsigned goff(const pg8::Unit& u, int h, unsigned voff) const { return (unsigned)(u.pm * 256 + h * 128) * ((unsigned)K * 2u) + voff; }
    __device__ __forceinline__ const bf16* bbase(const pg8::Unit& u) const { return Bt + (size_t)u.pn * 256 * K; }
};
template <bool G, bool F8> struct ProbMoE {
    static constexpr bool GATHER = true, FP8 = F8;
    const bf16* A; const bf16* Bt; int K; MoeTab mt; int rows_e;
    __device__ __forceinline__ const bf16* abase() const { return A; }
    __device__ __forceinline__ size_t aoff(const pg8::Unit& u) const { return (size_t)u.pm * 256 * K * 2; }
    __device__ __forceinline__ unsigned goff(const pg8::Unit& u, int h, unsigned voff) const {
        const unsigned pitch = (unsigned)K * 2u;
        if constexpr (!G) return (unsigned)(u.pm * 256 + h * 128) * pitch + voff;
        const unsigned R = voff / pitch, inrow = voff - R * pitch;
        const int a = mt.rt[u.slot * 256 + h * 128 + (int)R]; const int row = a < 0 ? 0 : (a >> 2);
        return (unsigned)row * pitch + inrow; }
    __device__ __forceinline__ const bf16* bbase(const pg8::Unit& u) const { const int e = __builtin_amdgcn_readfirstlane(mt.e_of[u.slot]); return Bt + ((size_t)e * rows_e + (size_t)u.pn * 256) * K; }
};
struct EpiInProj {
    static constexpr bool HAS_INIT = false; static constexpr int MID_T = 0; static constexpr bool PERM = true; Params p;
    __device__ __forceinline__ void operator()(const f32x4 (&acc)[2][2][4][2], const pg8::Unit& u, int wr, int wc, int fr, int fq) const {
        unsigned char* ws = p.ws; const int pn = u.pn;
        bf16* dst; int ld, ct; int kind = 0; const float* gb = nullptr;
        if (pn < 2) { dst = (bf16*)(ws + WS_QA); ld = WA; ct = pn * 256; kind = 1; }
        else if (pn < 4) { dst = (bf16*)(ws + WS_KA); ld = WA; ct = (pn - 2) * 256; kind = 1; }
        else if (pn < 6) { dst = (bf16*)(ws + WS_VA); ld = WA; ct = (pn - 4) * 256; }
        else if (pn < 9) { dst = (bf16*)(ws + WS_QB); ld = WB; ct = (pn - 6) * 256; kind = 1; }
        else if (pn < 12) { dst = (bf16*)(ws + WS_KB); ld = WB; ct = (pn - 9) * 256; kind = 1; }
        else if (pn < 15) { dst = (bf16*)(ws + WS_VB); ld = WB; ct = (pn - 12) * 256; }
        else if (pn < 19) { dst = (bf16*)(ws + WS_SA); ld = D; ct = (pn - 15) * 256; kind = 2; gb = p.b_gate_a; }
        else { dst = (bf16*)(ws + WS_SB); ld = D; ct = (pn - 19) * 256; kind = 2; gb = p.b_gate_b; }
        const int row0 = u.pm * 256 + wr * 64 + fr, col0 = ct + wc * 32 + 8 * fq;
        f32x4 bv[2][2];
#pragma unroll
        for (int bj = 0; bj < 2; ++bj)
#pragma unroll
            for (int n = 0; n < 2; ++n) bv[bj][n] = (kind == 2) ? *(const f32x4*)(gb + col0 + bj * 128 + 4 * n) : (f32x4){0.f, 0.f, 0.f, 0.f};
        const bool dorope = (kind == 1) && ((wc & 1) == 0);
        const bool dokm = (pn == 2) || (pn == 3);
        f32x4 ks[2][2];
#pragma unroll
        for (int bj = 0; bj < 2; ++bj) { ks[bj][0] = (f32x4){0.f, 0.f, 0.f, 0.f}; ks[bj][1] = (f32x4){0.f, 0.f, 0.f, 0.f}; }
        const float sgn = (fq == 0) ? -1.0f : 1.0f; const bool rl = fq < 2;
#pragma unroll
        for (int ai = 0; ai < 2; ++ai)
#pragma unroll
            for (int m = 0; m < 4; ++m) {
                const int row = row0 + ai * 128 + m * 16;
                f32x4 cs[4];
                if (dorope) { const f32x4* rp = (const f32x4*)(ws + WS_ROPE) + (size_t)(row % S) * 4;
#pragma unroll
                    for (int i = 0; i < 4; ++i) cs[i] = rp[i]; }
                bf16* rowp = dst + (size_t)row * ld + col0;
#pragma unroll
                for (int bj = 0; bj < 2; ++bj) {
                    f32x4 v0 = acc[ai][bj][m][0], v1 = acc[ai][bj][m][1];
                    if (dorope) {
                        f32x4 q0, q1;
#pragma unroll
                        for (int j = 0; j < 4; ++j) { q0[j] = __shfl_xor(v0[j], 16); q1[j] = __shfl_xor(v1[j], 16); }
                        if (rl) {
                            v0[0] = v0[0] * cs[0][0] + sgn * q0[0] * cs[0][1]; v0[1] = v0[1] * cs[0][2] + sgn * q0[1] * cs[0][3];
                            v0[2] = v0[2] * cs[1][0] + sgn * q0[2] * cs[1][1]; v0[3] = v0[3] * cs[1][2] + sgn * q0[3] * cs[1][3];
                            v1[0] = v1[0] * cs[2][0] + sgn * q1[0] * cs[2][1]; v1[1] = v1[1] * cs[2][2] + sgn * q1[1] * cs[2][3];
                            v1[2] = v1[2] * cs[3][0] + sgn * q1[2] * cs[3][1]; v1[3] = v1[3] * cs[3][2] + sgn * q1[3] * cs[3][3]; }
                    }
                    if (dokm) { ks[bj][0] += v0; ks[bj][1] += v1; }
                    if (kind == 2) {
                        v0 = v0 + bv[bj][0]; v1 = v1 + bv[bj][1];
#pragma unroll
                        for (int j = 0; j < 4; ++j) { v0[j] = fast_sigmoid(v0[j]); v1[j] = fast_sigmoid(v1[j]); } }
                    u32x4 w; w.x = cvtpk(v0[0], v0[1]); w.y = cvtpk(v0[2], v0[3]); w.z = cvtpk(v1[0], v1[1]); w.w = cvtpk(v1[2], v1[3]);
                    *(u32x4*)(rowp + bj * 128) = w;
                }
            }
        if (dokm) {
            float* km = (float*)(ws + WS_KMEAN) + (size_t)((u.pm >> 5) * NHA * NBLK + (u.pm & 31)) * HD;
#pragma unroll
            for (int bj = 0; bj < 2; ++bj)
#pragma unroll
                for (int n = 0; n < 2; ++n)
#pragma unroll
                    for (int j = 0; j < 4; ++j) { float v = ks[bj][n][j]; v += __shfl_xor(v, 1); v += __shfl_xor(v, 2); v += __shfl_xor(v, 4); v += __shfl_xor(v, 8);
                        if (fr == 0) { const int c = col0 + bj * 128 + 4 * n + j; atomicAdd(km + (size_t)(c >> 6) * NBLK * HD + (c & 63), v * (1.0f / MBLK)); } }
        }
    }
};
template <int PASS> struct EpiMix {
    static constexpr bool HAS_INIT = false; static constexpr int MID_T = 0; static constexpr bool PERM = true; Params p;
    __device__ __forceinline__ void operator()(const f32x4 (&acc)[2][2][4][2], const pg8::Unit& u, int wr, int wc, int fr, int fq) const {
        const int row0 = u.pm * 256 + wr * 64 + fr, col0 = u.pn * 256 + wc * 32 + 8 * fq;
        const bf16* G = (const bf16*)(p.ws + (PASS == 0 ? WS_SA : WS_SB)); bf16* M = (bf16*)(p.ws + WS_MIX);
#pragma unroll
        for (int ai = 0; ai < 2; ++ai)
#pragma unroll
            for (int m = 0; m < 4; ++m) {
                const size_t ro = (size_t)(row0 + ai * 128 + m * 16) * D + col0;
#pragma unroll
                for (int bj = 0; bj < 2; ++bj) {
                    const u32x4 g = *(const u32x4*)(G + ro + bj * 128);
                    f32x4 v0 = acc[ai][bj][m][0], v1 = acc[ai][bj][m][1];
                    v0[0] *= __uint_as_float(g.x << 16); v0[1] *= __uint_as_float(g.x & 0xffff0000u); v0[2] *= __uint_as_float(g.y << 16); v0[3] *= __uint_as_float(g.y & 0xffff0000u);
                    v1[0] *= __uint_as_float(g.z << 16); v1[1] *= __uint_as_float(g.z & 0xffff0000u); v1[2] *= __uint_as_float(g.w << 16); v1[3] *= __uint_as_float(g.w & 0xffff0000u);
                    if (PASS == 1) { const u32x4 t = *(const u32x4*)(M + ro + bj * 128);
                        v0[0] += __uint_as_float(t.x << 16); v0[1] += __uint_as_float(t.x & 0xffff0000u); v0[2] += __uint_as_float(t.y << 16); v0[3] += __uint_as_float(t.y & 0xffff0000u);
                        v1[0] += __uint_as_float(t.z << 16); v1[1] += __uint_as_float(t.z & 0xffff0000u); v1[2] += __uint_as_float(t.w << 16); v1[3] += __uint_as_float(t.w & 0xffff0000u); }
                    u32x4 w; w.x = cvtpk(v0[0], v0[1]); w.y = cvtpk(v0[2], v0[3]); w.z = cvtpk(v1[0], v1[1]); w.w = cvtpk(v1[2], v1[3]);
                    *(u32x4*)(M + ro + bj * 128) = w;
                }
            }
    }
};
struct EpiMixCat {
    static constexpr bool HAS_INIT = false; static constexpr int MID_T = 8; static constexpr bool PERM = true; Params p;
    __device__ __forceinline__ void mid(f32x4 (&acc)[2][2][4][2], const pg8::Unit& u, int wr, int wc, int fr, int fq) const {
        int row0 = u.pm * 256 + wr * 64 + fr, col0 = u.pn * 256 + wc * 32 + 8 * fq;
        asm volatile("" : "+v"(row0), "+v"(col0));
        const bf16* GA = (const bf16*)(p.ws + WS_SA); const bf16* GB = (const bf16*)(p.ws + WS_SB);
#pragma unroll
        for (int ai = 0; ai < 2; ++ai)
#pragma unroll
            for (int m = 0; m < 4; ++m) {
                const size_t ro = (size_t)(row0 + ai * 128 + m * 16) * D + col0;
#pragma unroll
                for (int bj = 0; bj < 2; ++bj) {
                    const u32x4 a = *(const u32x4*)(GA + ro + bj * 128), b = *(const u32x4*)(GB + ro + bj * 128);
#pragma unroll
                    for (int j = 0; j < 4; ++j) { const float r0 = __uint_as_float(a[j] << 16) * __builtin_amdgcn_rcpf(__uint_as_float(b[j] << 16)), r1 = __uint_as_float(a[j] & 0xffff0000u) * __builtin_amdgcn_rcpf(__uint_as_float(b[j] & 0xffff0000u));
                        if (j < 2) { acc[ai][bj][m][0][2 * j] *= r0; acc[ai][bj][m][0][2 * j + 1] *= r1; } else { acc[ai][bj][m][1][2 * j - 4] *= r0; acc[ai][bj][m][1][2 * j - 3] *= r1; } }
                }
                asm volatile("" ::: "memory");
            }
    }
    __device__ __forceinline__ void operator()(const f32x4 (&acc)[2][2][4][2], const pg8::Unit& u, int wr, int wc, int fr, int fq) const {
        const int row0 = u.pm * 256 + wr * 64 + fr, col0 = u.pn * 256 + wc * 32 + 8 * fq;
        const bf16* GB = (const bf16*)(p.ws + WS_SB); bf16* M = (bf16*)(p.ws + WS_MIX);
#pragma unroll
        for (int ai = 0; ai < 2; ++ai)
#pragma unroll
            for (int m = 0; m < 4; ++m) {
                const size_t ro = (size_t)(row0 + ai * 128 + m * 16) * D + col0;
#pragma unroll
                for (int bj = 0; bj < 2; ++bj) {
                    const u32x4 g = *(const u32x4*)(GB + ro + bj * 128);
                    f32x4 v0 = acc[ai][bj][m][0], v1 = acc[ai][bj][m][1];
                    v0[0] *= __uint_as_float(g.x << 16); v0[1] *= __uint_as_float(g.x & 0xffff0000u); v0[2] *= __uint_as_float(g.y << 16); v0[3] *= __uint_as_float(g.y & 0xffff0000u);
                    v1[0] *= __uint_as_float(g.z << 16); v1[1] *= __uint_as_float(g.z & 0xffff0000u); v1[2] *= __uint_as_float(g.w << 16); v1[3] *= __uint_as_float(g.w & 0xffff0000u);
                    u32x4 w; w.x = cvtpk(v0[0], v0[1]); w.y = cvtpk(v0[2], v0[3]); w.z = cvtpk(v1[0], v1[1]); w.w = cvtpk(v1[2], v1[3]);
                    *(u32x4*)(M + ro + bj * 128) = w;
                }
            }
    }
};
struct EpiOut {
    static constexpr bool HAS_INIT = false; static constexpr int MID_T = 0; static constexpr bool PERM = false; Params p;
    __device__ __forceinline__ void operator()(const f32x4 (&acc)[2][2][4][2], const pg8::Unit& u, int wr, int wc, int fr, int fq) const {
        const int row0 = u.pm * 256 + wr * 64 + fr, col0 = u.pn * 256 + wc * 32 + 4 * fq;
#pragma unroll
        for (int ai = 0; ai < 2; ++ai)
#pragma unroll
            for (int m = 0; m < 4; ++m) { const size_t ro = (size_t)(row0 + ai * 128 + m * 16) * D + col0;
#pragma unroll
                for (int bj = 0; bj < 2; ++bj)
#pragma unroll
                    for (int n = 0; n < 2; ++n) { const size_t o = ro + bj * 128 + n * 16; *(f32x4*)(p.out + o) = *(const f32x4*)(p.x + o) + acc[ai][bj][m][n]; } }
    }
};
struct EpiGateUp {
    static constexpr bool HAS_INIT = true; static constexpr int MID_T = 0; static constexpr bool PERM = false; Params p; MoeTab mt;
    __device__ __forceinline__ void init_load(f32x4 (&iv)[2][2], const pg8::Unit& u, int wc, int fq) const {
        const int e = __builtin_amdgcn_readfirstlane(mt.e_of[u.slot]);
#pragma unroll
        for (int bj = 0; bj < 2; ++bj) { const int cc = 16 * (8 * u.pn + 4 * bj + wc) + 4 * fq; iv[bj][0] = *(const f32x4*)(p.b_gate + e * FF + cc); iv[bj][1] = *(const f32x4*)(p.b_up + e * FF + cc); }
    }
    __device__ __forceinline__ void init_apply(f32x4 (&acc)[2][2][4][2], const f32x4 (&iv)[2][2]) const {
#pragma unroll
        for (int ai = 0; ai < 2; ++ai)
#pragma unroll
            for (int bj = 0; bj < 2; ++bj)
#pragma unroll
                for (int m = 0; m < 4; ++m) { acc[ai][bj][m][0] = iv[bj][0]; acc[ai][bj][m][1] = iv[bj][1] + 1.0f; }
    }
    __device__ __forceinline__ void operator()(const f32x4 (&acc)[2][2][4][2], const pg8::Unit& u, int wr, int wc, int fr, int fq) const {
        const int row0 = u.pm * 256 + wr * 64 + fr;
#pragma unroll
        for (int ai = 0; ai < 2; ++ai)
#pragma unroll
            for (int m = 0; m < 4; ++m) {
#pragma unroll
                for (int bj = 0; bj < 2; ++bj) { const int cc = 16 * (8 * u.pn + 4 * bj + wc) + 4 * fq; const f32x4 g = acc[ai][bj][m][0], uu = acc[ai][bj][m][1]; f32x4 a;
#pragma unroll
                    for (int j = 0; j < 4; ++j) { const float gg = fminf(g[j], 7.0f), u1 = fminf(fmaxf(uu[j], -6.0f), 8.0f);
                        a[j] = gg * __builtin_amdgcn_rcpf(1.0f + __builtin_amdgcn_exp2f(-2.4554669595930156f * gg)) * u1; }
#if FP8_DN
                    int w = __builtin_amdgcn_cvt_pk_fp8_f32(a[0], a[1], 0, false); w = __builtin_amdgcn_cvt_pk_fp8_f32(a[2], a[3], w, true);
                    *(int*)((unsigned char*)(p.ws + WS_A2) + (size_t)(row0 + ai * 128 + m * 16) * FF + cc) = w;
#else
                    u32x2 w; w.x = cvtpk(a[0], a[1]); w.y = cvtpk(a[2], a[3]); *(u32x2*)((bf16*)(p.ws + WS_A2) + (size_t)(row0 + ai * 128 + m * 16) * FF + cc) = w;
#endif
                } }
    }
};
struct EpiDown {
    static constexpr bool HAS_INIT = false; static constexpr int MID_T = 0; static constexpr bool PERM = true; Params p; MoeTab mt;
    __device__ __forceinline__ void operator()(const f32x4 (&acc)[2][2][4][2], const pg8::Unit& u, int wr, int wc, int fr, int fq) const {
        const int e = __builtin_amdgcn_readfirstlane(mt.e_of[u.slot]);
        const int row0 = u.pm * 256 + wr * 64 + fr, col0 = u.pn * 256 + wc * 32 + 8 * fq;
        const float* bd = p.b_down + e * D + col0;
        int asg[2][4]; float pw[2][4];
#pragma unroll
        for (int ai = 0; ai < 2; ++ai)
#pragma unroll
            for (int m = 0; m < 4; ++m) { const int rl = u.slot * 256 + wr * 64 + fr + ai * 128 + m * 16; asg[ai][m] = mt.rt[rl]; pw[ai][m] = mt.rp[rl]; }
        f32x4 bv[2][2];
#pragma unroll
        for (int bj = 0; bj < 2; ++bj) { bv[bj][0] = *(const f32x4*)(bd + bj * 128); bv[bj][1] = *(const f32x4*)(bd + bj * 128 + 4); }
#pragma unroll
        for (int ai = 0; ai < 2; ++ai)
#pragma unroll
            for (int m = 0; m < 4; ++m) {
                if (asg[ai][m] >= 0) { bf16* rowp = (bf16*)(p.ws + WS_Y) + (size_t)asg[ai][m] * D + col0; const float pp = pw[ai][m] * (FP8_Y ? 16.0f : 1.0f);
#pragma unroll
                    for (int bj = 0; bj < 2; ++bj) { const f32x4 v0 = (acc[ai][bj][m][0] + bv[bj][0]) * pp, v1 = (acc[ai][bj][m][1] + bv[bj][1]) * pp;
#if FP8_Y
                        int w0 = __builtin_amdgcn_cvt_pk_fp8_f32(v0[0], v0[1], 0, false); w0 = __builtin_amdgcn_cvt_pk_fp8_f32(v0[2], v0[3], w0, true);
                        int w1 = __builtin_amdgcn_cvt_pk_fp8_f32(v1[0], v1[1], 0, false); w1 = __builtin_amdgcn_cvt_pk_fp8_f32(v1[2], v1[3], w1, true);
                        u32x2 w; w.x = (unsigned)w0; w.y = (unsigned)w1; *(u32x2*)((unsigned char*)(p.ws + WS_Y) + (size_t)asg[ai][m] * D + col0 + bj * 128) = w; (void)rowp;
#else
                        u32x4 w; w.x = cvtpk(v0[0], v0[1]); w.y = cvtpk(v0[2], v0[3]); w.z = cvtpk(v1[0], v1[1]); w.w = cvtpk(v1[2], v1[3]);
                        *(u32x4*)(rowp + bj * 128) = w;
#endif
                    } } }
    }
};

__device__ __forceinline__ void phase_kmean(const Params& p, int gw, int ngw, int lane) {
    for (int it = gw; it < NB * NHA * NBLK; it += ngw) {
        const int n = it % NBLK, h = (it / NBLK) % NHA, b = it / (NBLK * NHA), d = lane;
        const bf16* k = (const bf16*)(p.ws + WS_KA) + ((size_t)b * S + (size_t)n * MBLK) * WA + h * HD + d;
        float s = 0.f; for (int r = 0; r < MBLK; ++r) s += bf2f(k[(size_t)r * WA]);
        ((float*)(p.ws + WS_KMEAN))[(size_t)it * HD + d] = s * (1.0f / MBLK);
    }
}
__device__ __forceinline__ void phase_select(const Params& p, int gtid, int ngt) {
    for (int idx = gtid; idx < T * NHA; idx += ngt) {
        const int h = idx % NHA, t = idx / NHA, b = t / S, s = t % S, blk = s / MBLK;
        const bf16* q = (const bf16*)(p.ws + WS_QA) + (size_t)t * WA + h * HD;
        const float* km = (const float*)(p.ws + WS_KMEAN) + (size_t)(b * NHA + h) * NBLK * HD;
        float best0 = -INFINITY, best1 = -INFINITY, best2 = -INFINITY; int b0 = -1, b1 = -1, b2 = -1;
        for (int n = 0; n < blk; ++n) {
            float g = 0.f; for (int d = 0; d < HD; ++d) g += bf2f(q[d]) * km[n * HD + d];
            if (g > best0) { best2 = best1; b2 = b1; best1 = best0; b1 = b0; best0 = g; b0 = n; }
            else if (g > best1) { best2 = best1; b2 = b1; best1 = g; b1 = n; }
            else if (g > best2) { best2 = g; b2 = n; }
        }
        signed char* sel = (signed char*)(p.ws + WS_SEL) + (size_t)idx * 4;
        sel[0] = (signed char)b0; sel[1] = (signed char)b1; sel[2] = (signed char)b2; sel[3] = -1;
    }
}
__device__ __forceinline__ float dot64(const float* qs, const bf16* kr) {
    float a = 0.f;
    for (int d8 = 0; d8 < 8; ++d8) { float kv[8]; ldact8(kr + d8 * 8, kv);
#pragma unroll
        for (int i = 0; i < 8; ++i) a += qs[d8 * 8 + i] * kv[i]; }
    return a;
}
#define WAVE_LDS_FENCE() asm volatile("s_waitcnt lgkmcnt(0)" ::: "memory")
__device__ __forceinline__ void phase_moba_naive(const Params& p, int gw, int ngw, int lane, float* wl, bf16* oa_dst) {
    float* qs = wl; float* sc = wl + 64;
    for (int it = gw; it < T * NHA; it += ngw) {
        const int h = it % NHA, t = it / NHA, b = t / S, s = t % S, blk = s / MBLK;
        WAVE_LDS_FENCE();
        qs[lane] = bf2f(((const bf16*)(p.ws + WS_QA))[(size_t)t * WA + h * HD + lane]);
        WAVE_LDS_FENCE();
        const signed char* sel = (const signed char*)(p.ws + WS_SEL) + ((size_t)t * NHA + h) * 4;
        const int kb0 = blk, kb1 = sel[0], kb2 = sel[1], kb3 = sel[2];
        const bf16* K = (const bf16*)(p.ws + WS_KA) + (size_t)b * S * WA + h * HD; const bf16* V = (const bf16*)(p.ws + WS_VA) + (size_t)b * S * WA + h * HD;
        float mx = -INFINITY;
        for (int g = 0; g < 4; ++g) { const int kbg = g == 0 ? kb0 : g == 1 ? kb1 : g == 2 ? kb2 : kb3;
            for (int c = 0; c < 4; ++c) {
                const int kk = c * 64 + lane; float v = -INFINITY;
                if (kbg >= 0) { const int key = kbg * MBLK + kk; if (g > 0 || key <= s) v = dot64(qs, K + (size_t)key * WA) * 0.125f; }
                sc[g * 256 + kk] = v; mx = fmaxf(mx, v);
            } }
#pragma unroll
        for (int o = 1; o < 64; o <<= 1) mx = fmaxf(mx, __shfl_xor(mx, o));
        WAVE_LDS_FENCE();
        float l = 0.f;
        for (int i = lane; i < 1024; i += 64) { const float e = (sc[i] == -INFINITY) ? 0.f : expf(sc[i] - mx); sc[i] = e; l += e; }
        l = wave_sum(l);
        WAVE_LDS_FENCE();
        float o = 0.f;
        for (int g = 0; g < 4; ++g) { const int kbg = g == 0 ? kb0 : g == 1 ? kb1 : g == 2 ? kb2 : kb3; if (kbg < 0) continue;
            for (int kk = 0; kk < 256; ++kk) { const float pr = sc[g * 256 + kk]; if (pr != 0.f) o += pr * bf2f(V[(size_t)(kbg * MBLK + kk) * WA + lane]); } }
        oa_dst[(size_t)t * WA + h * HD + lane] = (bf16)f2bf(o / l);
    }
}
__device__ __forceinline__ void phase_dil_naive(const Params& p, int gw, int ngw, int lane, float* wl, bf16* ob_dst) {
    float* qs = wl; float* sc = wl + 192;
    for (int it = gw; it < T * 4; it += ngw) {
        const int j = it % 4, t = it / 4, b = t / S, s = t % S;
        WAVE_LDS_FENCE();
        for (int g = 0; g < 3; ++g) qs[g * 64 + lane] = bf2f(((const bf16*)(p.ws + WS_QB))[(size_t)t * WB + (4 * g + j) * HD + lane]);
        WAVE_LDS_FENCE();
        float mx = -INFINITY;
        for (int g = 0; g < 3; ++g) { const int dl = g == 0 ? 1 : g == 1 ? 4 : 16; const bf16* K = (const bf16*)(p.ws + WS_KB) + (size_t)b * S * WB + (4 * g + j) * HD;
            for (int i = lane; i <= 128; i += 64) { const int key = s - i * dl; float v = -INFINITY;
                if (key >= 0) v = dot64(qs + g * 64, K + (size_t)key * WB) * 0.125f;
                sc[g * 129 + i] = v; mx = fmaxf(mx, v); } }
#pragma unroll
        for (int o = 1; o < 64; o <<= 1) mx = fmaxf(mx, __shfl_xor(mx, o));
        WAVE_LDS_FENCE();
        float l = 0.f;
        for (int i = lane; i < 3 * 129; i += 64) { const float e = (sc[i] == -INFINITY) ? 0.f : expf(sc[i] - mx); sc[i] = e; l += e; }
        l = wave_sum(l);
        WAVE_LDS_FENCE();
        float o = 0.f;
        for (int g = 0; g < 3; ++g) { const int dl = g == 0 ? 1 : g == 1 ? 4 : 16; const bf16* V = (const bf16*)(p.ws + WS_VB) + (size_t)b * S * WB + (4 * g + j) * HD;
            for (int i = 0; i <= 128; ++i) { const float pr = sc[g * 129 + i]; const int key = s - i * dl; if (key >= 0 && pr != 0.f) o += pr * bf2f(V[(size_t)key * WB + lane]); } }
        ob_dst[(size_t)t * WBO + j * HD + lane] = (bf16)f2bf(o / l);
    }
}

__device__ __forceinline__ void phase_router(const Params& p, int bid, int nb, unsigned char* lds, int tid) {
    const int lane = tid & 63, w = tid >> 6, h = lane >> 5, r32 = lane & 31;
    float* part = (float*)lds;
    float* ssqp = (float*)(lds + 65536);
    float* rstd_s = (float*)(lds + 65536 + 2048);
    int4* rec = (int4*)(lds + 65536 + 4096);
    int* lc = (int*)(lds + 65536 + 8192); int* gbase = lc + 32;
    bf16x8v whi[8], wlo[8];
#pragma unroll
    for (int sidx = 0; sidx < 8; ++sidx) { const int k0 = 128 * w + 16 * sidx + 8 * h; float wv[8];
        const f32x4 g0 = *(const f32x4*)(p.ln_ffn_g + k0), g1 = *(const f32x4*)(p.ln_ffn_g + k0 + 4);
#pragma unroll
        for (int j = 0; j < 8; ++j) wv[j] = p.w_router[(size_t)(k0 + j) * NE + r32] * (j < 4 ? g0[j] : g1[j - 4]);
        u32x4 hi, lo;
#pragma unroll
        for (int j = 0; j < 4; ++j) { const unsigned hp = cvtpk(wv[2 * j], wv[2 * j + 1]); hi[j] = hp;
            lo[j] = cvtpk(wv[2 * j] - __uint_as_float(hp << 16), wv[2 * j + 1] - __uint_as_float(hp & 0xffff0000u)); }
        whi[sidx] = __builtin_bit_cast(bf16x8v, hi); wlo[sidx] = __builtin_bit_cast(bf16x8v, lo); }
    for (int tg = bid; tg < T / 64; tg += nb) {
        __syncthreads();
        if (tid < 256) rec[tid] = make_int4(-1, 0, 0, 0);
        if (tid < 32) lc[tid] = 0;
#pragma unroll
        for (int tt = 0; tt < 2; ++tt) {
            const float* xr = p.out + (size_t)(tg * 64 + 32 * tt + r32) * D + 128 * w + 8 * h;
            f32x16 acc = {0.f, 0.f, 0.f, 0.f, 0.f, 0.f, 0.f, 0.f, 0.f, 0.f, 0.f, 0.f, 0.f, 0.f, 0.f, 0.f}; float ssq = 0.f;
#pragma unroll
            for (int sidx = 0; sidx < 8; ++sidx) { const f32x4 x0 = *(const f32x4*)(xr + 16 * sidx), x1 = *(const f32x4*)(xr + 16 * sidx + 4);
                ssq += (x0.x * x0.x + x0.y * x0.y) + (x0.z * x0.z + x0.w * x0.w) + (x1.x * x1.x + x1.y * x1.y) + (x1.z * x1.z + x1.w * x1.w);
                u32x4 hi, lo;
                hi.x = cvtpk(x0.x, x0.y); hi.y = cvtpk(x0.z, x0.w); hi.z = cvtpk(x1.x, x1.y); hi.w = cvtpk(x1.z, x1.w);
                lo.x = cvtpk(x0.x - __uint_as_float(hi.x << 16), x0.y - __uint_as_float(hi.x & 0xffff0000u)); lo.y = cvtpk(x0.z - __uint_as_float(hi.y << 16), x0.w - __uint_as_float(hi.y & 0xffff0000u));
                lo.z = cvtpk(x1.x - __uint_as_float(hi.z << 16), x1.y - __uint_as_float(hi.z & 0xffff0000u)); lo.w = cvtpk(x1.z - __uint_as_float(hi.w << 16), x1.w - __uint_as_float(hi.w & 0xffff0000u));
                const bf16x8v xh = __builtin_bit_cast(bf16x8v, hi), xl = __builtin_bit_cast(bf16x8v, lo);
                acc = __builtin_amdgcn_mfma_f32_32x32x16_bf16(xh, whi[sidx], acc, 0, 0, 0);
                acc = __builtin_amdgcn_mfma_f32_32x32x16_bf16(xh, wlo[sidx], acc, 0, 0, 0);
                acc = __builtin_amdgcn_mfma_f32_32x32x16_bf16(xl, whi[sidx], acc, 0, 0, 0); }
#pragma unroll
            for (int r = 0; r < 16; ++r) part[(w * 64 + 32 * tt + crow(r, h)) * 32 + r32] = acc[r];
            ssq += __shfl_xor(ssq, 32);
            if (h == 0) ssqp[w * 64 + 32 * tt + r32] = ssq;
        }
        __syncthreads();
        if (tid < 64) {
            const int t = tg * 64 + tid;
            float sq = 0.f;
#pragma unroll
            for (int i = 0; i < 8; ++i) sq += ssqp[i * 64 + tid];
            const float rstd = 1.0f / sqrtf(sq * (1.0f / D) + NORM_EPS); rstd_s[tid] = rstd;
            float v0 = -INFINITY, v1 = -INFINITY, v2 = -INFINITY, v3 = -INFINITY; int e0 = 0, e1 = 0, e2 = 0, e3 = 0;
            for (int e = 0; e < NE; ++e) { float a = 0.f;
#pragma unroll
                for (int i = 0; i < 8; ++i) a += part[(i * 64 + tid) * 32 + ((e + tid) & 31)];
                const int ee = (e + tid) & 31; const float lg = a * rstd + p.b_router[ee];
                if (lg > v0 || (lg == v0 && ee < e0)) { v3 = v2; e3 = e2; v2 = v1; e2 = e1; v1 = v0; e1 = e0; v0 = lg; e0 = ee; }
                else if (lg > v1 || (lg == v1 && ee < e1)) { v3 = v2; e3 = e2; v2 = v1; e2 = e1; v1 = lg; e1 = ee; }
                else if (lg > v2 || (lg == v2 && ee < e2)) { v3 = v2; e3 = e2; v2 = lg; e2 = ee; }
                else if (lg > v3 || (lg == v3 && ee < e3)) { v3 = lg; e3 = ee; } }
            const float x1 = expf(v1 - v0), x2 = expf(v2 - v0), x3 = expf(v3 - v0); const float inv = 1.0f / (1.0f + x1 + x2 + x3);
            { const int lp = atomicAdd(&lc[e0], 1); rec[tid * 4 + 0] = make_int4(e0, lp, t * 4 + 0, __float_as_int(inv)); }
            { const int lp = atomicAdd(&lc[e1], 1); rec[tid * 4 + 1] = make_int4(e1, lp, t * 4 + 1, __float_as_int(x1 * inv)); }
            { const int lp = atomicAdd(&lc[e2], 1); rec[tid * 4 + 2] = make_int4(e2, lp, t * 4 + 2, __float_as_int(x2 * inv)); }
            { const int lp = atomicAdd(&lc[e3], 1); rec[tid * 4 + 3] = make_int4(e3, lp, t * 4 + 3, __float_as_int(x3 * inv)); }
        }
        __syncthreads();
        if (tid < NE) gbase[tid] = lc[tid] > 0 ? atomicAdd((int*)(p.ws + WS_CTL) + CW_ECNT + 64 * tid, lc[tid]) : 0;
        for (int idx = tid; idx < 64 * 256; idx += 512) { const int tk = idx >> 8, c4 = idx & 255; const size_t t = (size_t)tg * 64 + tk;
            const f32x4 x = *(const f32x4*)(p.out + t * D + 4 * c4), g = *(const f32x4*)(p.ln_ffn_g + 4 * c4); const float rs = rstd_s[tk];
            const float h0 = x.x * rs * g.x, h1 = x.y * rs * g.y, h2 = x.z * rs * g.z, h3 = x.w * rs * g.w;
#if FP8_GU
            int o = __builtin_amdgcn_cvt_pk_fp8_f32(h0, h1, 0, false); o = __builtin_amdgcn_cvt_pk_fp8_f32(h2, h3, o, true); ((int*)((unsigned char*)(p.ws + WS_H) + t * D))[c4] = o;
#else
            u32x2 o; o.x = cvtpk(h0, h1); o.y = cvtpk(h2, h3); ((u32x2*)((bf16*)(p.ws + WS_H) + t * D))[c4] = o;
#endif
        }
        __syncthreads();
        if (tid < 256) { const int4 r = rec[tid]; if (r.x >= 0) { const int pos = gbase[r.x] + r.y; ((int*)(p.ws + WS_ELIST))[r.x * T + pos] = r.z; ((float*)(p.ws + WS_EP))[r.x * T + pos] = __int_as_float(r.w); } }
    }
}
__device__ __forceinline__ void phase_final(const Params& p, int gw, int ngw, int lane) {
    for (int t = gw; t < T; t += ngw) {
        f32x4* xr = (f32x4*)(p.out + (size_t)t * D) + lane; const f32x4* gr = (const f32x4*)p.ln_final_g + lane;
        f32x4 v[4]; float ss = 0.f;
#pragma unroll
        for (int j = 0; j < 4; ++j) { v[j] = xr[64 * j];
#pragma unroll
            for (int k = 0; k < 4; ++k) {
#if FP8_Y
                const int y = ((const int*)((const unsigned char*)(p.ws + WS_Y) + ((size_t)t * 4 + k) * D))[lane + 64 * j];
                const f32x2 y01 = __builtin_amdgcn_cvt_pk_f32_fp8(y, false), y23 = __builtin_amdgcn_cvt_pk_f32_fp8(y, true);
                v[j].x += y01.x * 0.0625f; v[j].y += y01.y * 0.0625f; v[j].z += y23.x * 0.0625f; v[j].w += y23.y * 0.0625f;
#else
                const u32x2 y = ((const u32x2*)((const bf16*)(p.ws + WS_Y) + ((size_t)t * 4 + k) * D))[lane + 64 * j];
                v[j].x += __uint_as_float(y.x << 16); v[j].y += __uint_as_float(y.x & 0xffff0000u); v[j].z += __uint_as_float(y.y << 16); v[j].w += __uint_as_float(y.y & 0xffff0000u);
#endif
            }
            ss += (v[j].x * v[j].x + v[j].y * v[j].y) + (v[j].z * v[j].z + v[j].w * v[j].w); }
        float rstd = 1.0f / sqrtf(wave_sum(ss) * (1.0f / D) + NORM_EPS);
#if DBG
        { const float num = ((const float*)(p.ws + WS_CTL))[CW_DNUM], den = ((const float*)(p.ws + WS_CTL))[CW_DDEN]; rstd *= 1.0f + DBG_GAIN * sqrtf(num / fmaxf(den, 1e-30f)); }
#endif
#if TIMEB_LO >= 0
        { const unsigned long long* ts = (const unsigned long long*)(p.ws + WS_CTL + 917504); rstd *= 1.0f + TIMEB_GAIN * (float)(ts[TIMEB_HI] - ts[TIMEB_LO]) * 1e-6f; }
#endif
#pragma unroll
        for (int j = 0; j < 4; ++j) { const f32x4 g = gr[64 * j]; f32x4 o; o.x = v[j].x * rstd * g.x; o.y = v[j].y * rstd * g.y; o.z = v[j].z * rstd * g.z; o.w = v[j].w * rstd * g.w; xr[64 * j] = o; }
    }
}


#define LDSP __attribute__((address_space(3)))
#define LDS_BARRIER() do { asm volatile("s_waitcnt lgkmcnt(0)" ::: "memory"); __builtin_amdgcn_s_barrier(); asm volatile("" ::: "memory"); } while (0)
constexpr int AT_RS = 144;
constexpr int AT_KOFF = 0, AT_VOFF = 384 * AT_RS, AT_PFX = 131072;
constexpr float AT_C = 0.125f * 1.4426950408889634f;
__device__ __forceinline__ s16x4 vtr(unsigned addr) { return __builtin_bit_cast(s16x4, __builtin_amdgcn_ds_read_tr16_b64_v4i16((LDSP s16x4*)(uintptr_t)addr)); }

struct AttnState { f32x16 o0, o1; float m, l; };
template <bool MASKED> __device__ __forceinline__ void attn_wave(AttnState& st, const bf16x8v (&qf)[4], unsigned kbase, unsigned vbase, int c0, int c1, int clo, int chi, int lane) {
    const int h = lane >> 5, ql = lane & 31;
    if (c0 >= c1) return;
    bf16x8v kf[4];
    { const unsigned ka = kbase + (unsigned)c0 * (32 * AT_RS);
#pragma unroll
      for (int ks = 0; ks < 4; ++ks) kf[ks] = *(const LDSP bf16x8v*)(uintptr_t)(ka + ks * 32); }
#pragma unroll 1
    for (int c = c0; c < c1; ++c) {
        const unsigned va = vbase + (unsigned)c * (32 * AT_RS);
        s16x4 vlo[2][2], vhi[2][2];
#pragma unroll
        for (int ks = 0; ks < 2; ++ks)
#pragma unroll
            for (int db = 0; db < 2; ++db) { vlo[ks][db] = vtr(va + ks * (16 * AT_RS) + db * 64); vhi[ks][db] = vtr(va + ks * (16 * AT_RS) + 8 * AT_RS + db * 64); }
        f32x16 s = {0.f, 0.f, 0.f, 0.f, 0.f, 0.f, 0.f, 0.f, 0.f, 0.f, 0.f, 0.f, 0.f, 0.f, 0.f, 0.f};
#pragma unroll
        for (int ks = 0; ks < 4; ++ks) s = __builtin_amdgcn_mfma_f32_32x32x16_bf16(kf[ks], qf[ks], s, 0, 0, 0);
        { const unsigned kn = kbase + (unsigned)((c + 1 < c1) ? c + 1 : c) * (32 * AT_RS);
#pragma unroll
          for (int ks = 0; ks < 4; ++ks) kf[ks] = *(const LDSP bf16x8v*)(uintptr_t)(kn + ks * 32); }
        float t[16]; float cmax = -INFINITY;
#pragma unroll
        for (int r = 0; r < 16; ++r) { t[r] = s[r];
            if (MASKED) { const int cr = crow(r, h); if ((c == clo && cr < ql) || (c == chi && cr > ql)) t[r] = -INFINITY; }
            cmax = fmaxf(cmax, t[r]); }
        cmax = fmaxf(cmax, __shfl_xor(cmax, 32)) * AT_C;
        const float mn = fmaxf(st.m, cmax); const float mu = (mn == -INFINITY) ? 0.f : mn;
        const float alpha = __builtin_amdgcn_exp2f(st.m - mu);
        float psum = 0.f; float pr[16];
#pragma unroll
        for (int r = 0; r < 16; ++r) { pr[r] = __builtin_amdgcn_exp2f(__builtin_fmaf(t[r], AT_C, -mu)); psum += pr[r]; }
        st.l = st.l * alpha + psum; st.m = mn;
        if (!__all(alpha == 1.0f)) {
#pragma unroll
            for (int r = 0; r < 16; ++r) { st.o0[r] *= alpha; st.o1[r] *= alpha; } }
#pragma unroll
        for (int ks = 0; ks < 2; ++ks) {
            u32x4 pw; pw.x = cvtpk(pr[8 * ks + 0], pr[8 * ks + 1]); pw.y = cvtpk(pr[8 * ks + 2], pr[8 * ks + 3]); pw.z = cvtpk(pr[8 * ks + 4], pr[8 * ks + 5]); pw.w = cvtpk(pr[8 * ks + 6], pr[8 * ks + 7]);
            const bf16x8v pf = __builtin_bit_cast(bf16x8v, pw);
            const bf16x8v vf0 = {vlo[ks][0][0], vlo[ks][0][1], vlo[ks][0][2], vlo[ks][0][3], vhi[ks][0][0], vhi[ks][0][1], vhi[ks][0][2], vhi[ks][0][3]};
            const bf16x8v vf1 = {vlo[ks][1][0], vlo[ks][1][1], vlo[ks][1][2], vlo[ks][1][3], vhi[ks][1][0], vhi[ks][1][1], vhi[ks][1][2], vhi[ks][1][3]};
            st.o0 = __builtin_amdgcn_mfma_f32_32x32x16_bf16(vf0, pf, st.o0, 0, 0, 0);
            st.o1 = __builtin_amdgcn_mfma_f32_32x32x16_bf16(vf1, pf, st.o1, 0, 0, 0);
        }
    }
}
__device__ __forceinline__ void attn_init(AttnState& st) {
#pragma unroll
    for (int r = 0; r < 16; ++r) { st.o0[r] = 0.f; st.o1[r] = 0.f; }
    st.m = -INFINITY; st.l = 0.f;
}
__device__ __forceinline__ void attn_stage(unsigned char* lds, int dst, const unsigned char* src, size_t pitch, int nrows, int skip, int tid) {
    for (int idx = tid; idx < nrows * 8; idx += 512) { const int row = idx >> 3, ch = idx & 7;
        if (row >= skip) { const u32x4 v = *(const u32x4*)(src + (size_t)row * pitch + ch * 16); *(u32x4*)(lds + dst + row * AT_RS + ch * 16) = v; } }
}
__device__ __forceinline__ void attn_qload(bf16x8v (&qf)[4], const bf16* qrow, int h) {
#pragma unroll
    for (int ks = 0; ks < 4; ++ks) qf[ks] = *(const bf16x8v*)(qrow + 16 * ks + 8 * h);
}
__device__ __forceinline__ void attn_store_partial(const AttnState& st, float inv_l, bf16* dst, int h) {
#pragma unroll
    for (int rg = 0; rg < 4; ++rg) {
        u32x2 w0, w1; w0.x = cvtpk(st.o0[4 * rg] * inv_l, st.o0[4 * rg + 1] * inv_l); w0.y = cvtpk(st.o0[4 * rg + 2] * inv_l, st.o0[4 * rg + 3] * inv_l);
        w1.x = cvtpk(st.o1[4 * rg] * inv_l, st.o1[4 * rg + 1] * inv_l); w1.y = cvtpk(st.o1[4 * rg + 2] * inv_l, st.o1[4 * rg + 3] * inv_l);
        *(u32x2*)(dst + 8 * rg + 4 * h) = w0; *(u32x2*)(dst + 32 + 8 * rg + 4 * h) = w1; }
}
__device__ __forceinline__ void attn_acc_partial(f32x16& a0, f32x16& a1, float w, const bf16* src, int h) {
#pragma unroll
    for (int rg = 0; rg < 4; ++rg) { const u32x2 w0 = *(const u32x2*)(src + 8 * rg + 4 * h), w1 = *(const u32x2*)(src + 32 + 8 * rg + 4 * h);
        a0[4 * rg] += w * __uint_as_float(w0.x << 16); a0[4 * rg + 1] += w * __uint_as_float(w0.x & 0xffff0000u); a0[4 * rg + 2] += w * __uint_as_float(w0.y << 16); a0[4 * rg + 3] += w * __uint_as_float(w0.y & 0xffff0000u);
        a1[4 * rg] += w * __uint_as_float(w1.x << 16); a1[4 * rg + 1] += w * __uint_as_float(w1.x & 0xffff0000u); a1[4 * rg + 2] += w * __uint_as_float(w1.y << 16); a1[4 * rg + 3] += w * __uint_as_float(w1.y & 0xffff0000u); }
}


template <int NIT> struct KVRegs { u32x4 k[NIT], v[NIT]; };
template <int NIT> __device__ __forceinline__ void kv_load(KVRegs<NIT>& R, const unsigned char* ksrc, const unsigned char* vsrc, size_t pitch, int skip, int tid) {
#pragma unroll
    for (int i = 0; i < NIT; ++i) { const int idx = tid + 512 * i, row = idx >> 3, ch = idx & 7;
        if (row >= skip) { R.k[i] = *(const u32x4*)(ksrc + (size_t)row * pitch + ch * 16); R.v[i] = *(const u32x4*)(vsrc + (size_t)row * pitch + ch * 16); } }
}
template <int NIT> __device__ __forceinline__ void kv_commit(const KVRegs<NIT>& R, unsigned char* lds, int skip, int tid) {
#pragma unroll
    for (int i = 0; i < NIT; ++i) { const int idx = tid + 512 * i, row = idx >> 3, ch = idx & 7;
        if (row >= skip) { *(u32x4*)(lds + AT_KOFF + row * AT_RS + ch * 16) = R.k[i]; *(u32x4*)(lds + AT_VOFF + row * AT_RS + ch * 16) = R.v[i]; } }
}
__device__ __forceinline__ void phase_select_lists(const Params& p, int bid, int nb, unsigned char* lds, int tid) {
    float* km = (float*)lds;
    for (int it = bid; it < NB * NBLK * 4; it += nb) {
        const int hp = it & 3, n = (it >> 2) % NBLK, b = it / (4 * NBLK);
        __syncthreads();
        for (int i = tid; i < 2 * NBLK * HD; i += 512) { const int hh = i / (NBLK * HD), rest = i % (NBLK * HD); km[i] = ((const float*)(p.ws + WS_KMEAN))[(size_t)(b * NHA + 2 * hp + hh) * NBLK * HD + rest]; }
        __syncthreads();
        const int hh = tid >> 8, h = 2 * hp + hh, s = n * MBLK + (tid & 255), t = b * S + s;
        float q[HD];
        { const u32x4* qp = (const u32x4*)((const bf16*)(p.ws + WS_QA) + (size_t)t * WA + h * HD);
#pragma unroll
            for (int i = 0; i < 8; ++i) { const u32x4 v = qp[i];
#pragma unroll
                for (int j = 0; j < 4; ++j) { q[8 * i + 2 * j] = __uint_as_float(v[j] << 16); q[8 * i + 2 * j + 1] = __uint_as_float(v[j] & 0xffff0000u); } } }
        float best0 = -INFINITY, best1 = -INFINITY, best2 = -INFINITY; int b0 = -1, b1 = -1, b2 = -1;
        const float* kmh = km + hh * (NBLK * HD);
        for (int nn = 0; nn < n; ++nn) {
            float g = 0.f;
#pragma unroll
            for (int d4 = 0; d4 < 16; ++d4) { const f32x4 kv = *(const f32x4*)(kmh + nn * HD + 4 * d4); g += q[4 * d4] * kv.x; g += q[4 * d4 + 1] * kv.y; g += q[4 * d4 + 2] * kv.z; g += q[4 * d4 + 3] * kv.w; }
            if (g > best0) { best2 = best1; b2 = b1; best1 = best0; b1 = b0; best0 = g; b0 = nn; }
            else if (g > best1) { best2 = best1; b2 = b1; best1 = g; b1 = nn; }
            else if (g > best2) { best2 = g; b2 = nn; }
        }
        signed char* sel = (signed char*)(p.ws + WS_SEL) + ((size_t)t * NHA + h) * 4;
        *(unsigned*)sel = (unsigned)(b0 & 0xff) | ((unsigned)(b1 & 0xff) << 8) | ((unsigned)(b2 & 0xff) << 16) | 0xff000000u;
        int* lc = (int*)(lds + 32768); int* gb = lc + 64;
        if (tid < 64) lc[tid] = 0;
        __syncthreads();
        int lp0 = 0, lp1 = 0, lp2 = 0;
        if (b0 >= 0) lp0 = atomicAdd(&lc[hh * 32 + b0], 1);
        if (b1 >= 0) lp1 = atomicAdd(&lc[hh * 32 + b1], 1);
        if (b2 >= 0) lp2 = atomicAdd(&lc[hh * 32 + b2], 1);
        __syncthreads();
        if (tid < 64) { const int c = lc[tid]; gb[tid] = c > 0 ? atomicAdd((int*)(p.ws + WS_CTL) + CW_LCNT + (b * NHA + 2 * hp + (tid >> 5)) * NBLK + (tid & 31), c) : 0; }
        __syncthreads();
        unsigned short* lists = (unsigned short*)(p.ws + WS_LIST) + (size_t)(b * NHA + h) * NBLK * LIST_CAP;
        if (b0 >= 0) lists[(size_t)b0 * LIST_CAP + gb[hh * 32 + b0] + lp0] = (unsigned short)(s | (0 << 13));
        if (b1 >= 0) lists[(size_t)b1 * LIST_CAP + gb[hh * 32 + b1] + lp1] = (unsigned short)(s | (1 << 13));
        if (b2 >= 0) lists[(size_t)b2 * LIST_CAP + gb[hh * 32 + b2] + lp2] = (unsigned short)(s | (2 << 13));
    }
}
__device__ __forceinline__ void phase_dilated(const Params& p, int bid, int nb, unsigned char* lds, int tid) {
    const int lane = tid & 63, w = tid >> 6, h = lane >> 5, ql = lane & 31;
    const unsigned lb = (unsigned)(uintptr_t)lds;
    constexpr int NITM = NB * NHB * 32;
    KVRegs<6> R;
#define DIL_DECODE(it_) const int sub = (it_) & 31, head = ((it_) >> 5) % NHB, b = (it_) / (32 * NHB), g = head >> 2, j = head & 3; \
        const int dl = g == 0 ? 1 : g == 1 ? 4 : 16, r = sub % dl, np = sub / dl; const size_t pitch = (size_t)dl * WB * 2; \
        const long tok0 = (long)b * S + (long)(128 * (2 * np - 1)) * dl + r; const int wq = w & 3, nq = 2 * np + (w >> 2); \
        const size_t tq = (size_t)b * S + (size_t)(128 * nq + 32 * wq + ql) * dl + r; (void)j; (void)pitch; (void)tok0; (void)tq; (void)nq; (void)wq;
    int it = bid;
    if (it < NITM) { DIL_DECODE(it)
        kv_load<6>(R, (const unsigned char*)((const bf16*)(p.ws + WS_KB) + tok0 * WB + head * HD), (const unsigned char*)((const bf16*)(p.ws + WS_VB) + tok0 * WB + head * HD), pitch, np == 0 ? 128 : 0, tid); }
    while (it < NITM) {
        DIL_DECODE(it)
        bf16x8v qf[4]; attn_qload(qf, (const bf16*)(p.ws + WS_QB) + tq * WB + head * HD, h);
        LDS_BARRIER();
        kv_commit<6>(R, lds, np == 0 ? 128 : 0, tid);
        LDS_BARRIER();
        const int nit = it + nb;
        if (nit < NITM) { const int it2 = nit; const int sub2 = it2 & 31, head2 = (it2 >> 5) % NHB, b2 = it2 / (32 * NHB), g2 = head2 >> 2; const int dl2 = g2 == 0 ? 1 : g2 == 1 ? 4 : 16, r2 = sub2 % dl2, np2 = sub2 / dl2;
            const size_t pitch2 = (size_t)dl2 * WB * 2; const long tok02 = (long)b2 * S + (long)(128 * (2 * np2 - 1)) * dl2 + r2;
            kv_load<6>(R, (const unsigned char*)((const bf16*)(p.ws + WS_KB) + tok02 * WB + head2 * HD), (const unsigned char*)((const bf16*)(p.ws + WS_VB) + tok02 * WB + head2 * HD), pitch2, np2 == 0 ? 128 : 0, tid); }
        const int winoff = 128 * (w >> 2);
        AttnState st; attn_init(st);
        const unsigned kbase = lb + AT_KOFF + (unsigned)(winoff + ql) * AT_RS + 16 * h;
        const unsigned vbase = lb + AT_VOFF + (unsigned)(winoff + 4 * h + ((lane & 15) >> 2)) * AT_RS + 32 * ((lane >> 4) & 1) + 8 * (lane & 3);
        const int c0 = (nq == 0) ? 4 : wq;
        attn_wave<true>(st, qf, kbase, vbase, c0, wq + 5, wq, wq + 4, lane);
        const float lt = st.l + __shfl_xor(st.l, 32);
        bf16* dst = (bf16*)(p.ws + WS_PARTB) + (((size_t)g * T + tq) * 4 + j) * HD;
        attn_store_partial(st, 1.0f / lt, dst, h);
        if (h == 0) ((float*)(p.ws + WS_LSEB))[((size_t)g * T + tq) * 4 + j] = st.m + __builtin_amdgcn_logf(lt);
        it = nit;
    }
#undef DIL_DECODE
}
__device__ __forceinline__ void phase_moba_past(const Params& p, int bid, int nb, unsigned char* lds, int tid) {
    const int lane = tid & 63, w = tid >> 6, h = lane >> 5, ql = lane & 31;
    const unsigned lb = (unsigned)(uintptr_t)lds;
    unsigned* pfx = (unsigned*)(lds + AT_PFX);
    const int* lcnt = (const int*)(p.ws + WS_CTL) + CW_LCNT;
    int* cntl = (int*)(lds + AT_PFX + 4096);
    unsigned* pfp = pfx + 2048;
    { const int c = __hip_atomic_load(lcnt + tid, __ATOMIC_RELAXED, __HIP_MEMORY_SCOPE_AGENT); unsigned v = (unsigned)(c >> 8), vp = (c & 255) ? 1u : 0u; cntl[tid] = c;
#pragma unroll
      for (int o = 1; o < 64; o <<= 1) { const unsigned u = __shfl_up(v, o), up = __shfl_up(vp, o); if (lane >= o) { v += u; vp += up; } }
      unsigned* wtot = pfx + 520;
      if (lane == 63) { wtot[w] = v; wtot[8 + w] = vp; }
      __syncthreads();
      unsigned base = 0, basep = 0;
#pragma unroll
      for (int i = 0; i < 8; ++i) if (i < w) { base += wtot[i]; basep += wtot[8 + i]; }
      pfx[tid + 1] = v + base; pfp[tid + 1] = vp + basep; if (tid == 0) { pfx[0] = 0; pfp[0] = 0; } }
    __syncthreads();
    const int nfull = (int)pfx[512];
    const int ntot = nfull + (int)pfp[512];
    KVRegs<4> R; bf16x8v qn[4];
    int liA = 0, tileA = 0, cntA = 0; unsigned entA = 0; int liB = 0, tileB = 0, cntB = 0; unsigned entB = 0;
    int* itab = (int*)(lds + AT_PFX + 12288);
    if (tid < 16) { const int it_ = bid + tid * nb; int li_ = 0, tile_ = 0, cnt_ = 0;
        if (it_ < ntot) { const bool part_ = it_ >= nfull; const unsigned* pf_ = part_ ? pfp : pfx; const int key_ = part_ ? it_ - nfull : it_;
            int lo_ = 0, hi_ = 512; while (hi_ - lo_ > 1) { const int mid_ = (lo_ + hi_) >> 1; if ((int)pf_[mid_] <= key_) lo_ = mid_; else hi_ = mid_; }
            li_ = lo_; cnt_ = cntl[lo_]; tile_ = part_ ? (cnt_ >> 8) : key_ - (int)pfx[lo_]; }
        itab[tid * 4] = li_; itab[tid * 4 + 1] = tile_; itab[tid * 4 + 2] = cnt_; }
    __syncthreads();
#define PAST_DECODE(it_, li_, tile_, cnt_, ent_) do { const int k_ = (it_ == itA) ? kA : kB; li_ = itab[k_ * 4]; tile_ = itab[k_ * 4 + 1]; cnt_ = itab[k_ * 4 + 2]; \
        ent_ = ((const unsigned short*)(p.ws + WS_LIST))[(size_t)li_ * LIST_CAP + tile_ * 256 + 32 * w + ql]; } while (0)
#define PAST_KVQ(li_, ent_) do { const int jb_ = (li_) & 31, hd_ = ((li_) >> 5) & 7, b_ = (li_) >> 8; const size_t row0_ = (size_t)b_ * S + (size_t)jb_ * MBLK; \
        kv_load<4>(R, (const unsigned char*)((const bf16*)(p.ws + WS_KA) + row0_ * WA + hd_ * HD), (const unsigned char*)((const bf16*)(p.ws + WS_VA) + row0_ * WA + hd_ * HD), (size_t)WA * 2, 0, tid); \
        attn_qload(qn, (const bf16*)(p.ws + WS_QA) + ((size_t)b_ * S + ((ent_) & 8191)) * WA + hd_ * HD, h); } while (0)
    int itA = bid, itB = bid + nb; int kA = 0, kB = 1;
    if (itA < ntot) { PAST_DECODE(itA, liA, tileA, cntA, entA); PAST_KVQ(liA, entA); }
    if (itB < ntot) PAST_DECODE(itB, liB, tileB, cntB, entB);
    while (itA < ntot) {
        LDS_BARRIER();
        kv_commit<4>(R, lds, 0, tid);
        LDS_BARRIER();
        const int li = liA, tile = tileA, cnt = cntA; const unsigned ent = entA;
        const int hd = (li >> 5) & 7, b = li >> 8, slot = (int)(ent >> 13); const size_t tq = (size_t)b * S + (ent & 8191);
        const bool valid = tile * 256 + 32 * w + ql < cnt;
        bf16x8v qf[4];
#pragma unroll
        for (int i = 0; i < 4; ++i) qf[i] = qn[i];
        itA = itB; liA = liB; tileA = tileB; cntA = cntB; entA = entB; kA = kB;
        if (itA < ntot) PAST_KVQ(liA, entA);
        itB += nb; kB += 1;
        if (itB < ntot) PAST_DECODE(itB, liB, tileB, cntB, entB);
        AttnState st; attn_init(st);
        const unsigned kbase = lb + AT_KOFF + (unsigned)ql * AT_RS + 16 * h;
        const unsigned vbase = lb + AT_VOFF + (unsigned)(4 * h + ((lane & 15) >> 2)) * AT_RS + 32 * ((lane >> 4) & 1) + 8 * (lane & 3);
        if (32 * w + tile * 256 < cnt) {
            attn_wave<false>(st, qf, kbase, vbase, 0, 8, -1, -1, lane);
            const float lt = st.l + __shfl_xor(st.l, 32);
            if (valid) { attn_store_partial(st, 1.0f / lt, (bf16*)(p.ws + WS_PARTA) + (((size_t)slot * T + tq) * NHA + hd) * HD, h);
                if (h == 0) ((float*)(p.ws + WS_LSEA))[((size_t)slot * T + tq) * NHA + hd] = st.m + __builtin_amdgcn_logf(lt); }
        }
    }
#undef PAST_DECODE
#undef PAST_KVQ
}
__device__ __forceinline__ void phase_moba_own(const Params& p, int bid, int nb, unsigned char* lds, int tid) {
    const int lane = tid & 63, w = tid >> 6, h = lane >> 5, ql = lane & 31;
    const unsigned lb = (unsigned)(uintptr_t)lds;
    constexpr int NITM = NB * NHA * NBLK;
    KVRegs<4> R; bf16x8v qn[4];
#define OWN_FETCH(it_) do { const int n_ = (it_) % NBLK, hd_ = ((it_) / NBLK) % NHA, b_ = (it_) / (NBLK * NHA); const size_t row0_ = (size_t)b_ * S + (size_t)n_ * MBLK; \
        kv_load<4>(R, (const unsigned char*)((const bf16*)(p.ws + WS_KA) + row0_ * WA + hd_ * HD), (const unsigned char*)((const bf16*)(p.ws + WS_VA) + row0_ * WA + hd_ * HD), (size_t)WA * 2, 0, tid); \
        attn_qload(qn, (const bf16*)(p.ws + WS_QA) + (row0_ + 32 * w + ql) * WA + hd_ * HD, h); } while (0)
    int it = bid;
    if (it < NITM) OWN_FETCH(it);
    while (it < NITM) {
        const int n = it % NBLK, hd = (it / NBLK) % NHA, b = it / (NBLK * NHA);
        const size_t row0 = (size_t)b * S + (size_t)n * MBLK;
        LDS_BARRIER();
        kv_commit<4>(R, lds, 0, tid);
        LDS_BARRIER();
        bf16x8v qf[4];
#pragma unroll
        for (int i = 0; i < 4; ++i) qf[i] = qn[i];
        const int nit = it + nb;
        if (nit < NITM) OWN_FETCH(nit);
        const size_t tq = row0 + 32 * w + ql;
        const unsigned selw = *(const unsigned*)((const signed char*)(p.ws + WS_SEL) + (tq * NHA + hd) * 4);
        float lse[3];
#pragma unroll
        for (int k = 0; k < 3; ++k) lse[k] = ((const float*)(p.ws + WS_LSEA))[((size_t)k * T + tq) * NHA + hd];
        AttnState st; attn_init(st);
        const unsigned kbase = lb + AT_KOFF + (unsigned)ql * AT_RS + 16 * h;
        const unsigned vbase = lb + AT_VOFF + (unsigned)(4 * h + ((lane & 15) >> 2)) * AT_RS + 32 * ((lane >> 4) & 1) + 8 * (lane & 3);
        attn_wave<true>(st, qf, kbase, vbase, 0, w + 1, -1, w, lane);
        const float lt = st.l + __shfl_xor(st.l, 32);
        const float lse_own = st.m + __builtin_amdgcn_logf(lt);
        float M = lse_own;
#pragma unroll
        for (int k = 0; k < 3; ++k) { const bool ok = ((selw >> (8 * k)) & 0x80u) == 0u; if (!ok) lse[k] = -INFINITY; M = fmaxf(M, lse[k]); }
        const float w_own = __builtin_amdgcn_exp2f(lse_own - M); float wsum = w_own;
        const float so = w_own / lt;
#pragma unroll
        for (int r = 0; r < 16; ++r) { st.o0[r] *= so; st.o1[r] *= so; }
#pragma unroll
        for (int k = 0; k < 3; ++k) { const float wk = __builtin_amdgcn_exp2f(lse[k] - M); wsum += wk;
            if (lse[k] != -INFINITY) attn_acc_partial(st.o0, st.o1, wk, (const bf16*)(p.ws + WS_PARTA) + (((size_t)k * T + tq) * NHA + hd) * HD, h); }
        attn_store_partial(st, 1.0f / wsum, (bf16*)p.out + tq * (WA + WBO) + hd * HD, h);
        it = nit;
    }
#undef OWN_FETCH
}
__device__ __forceinline__ void phase_dil_merge(const Params& p, int gtid, int ngt) {
    for (int idx = gtid; idx < T * 4 * 8; idx += ngt) {
        const int ch = idx & 7, j = (idx >> 3) & 3; const size_t t = idx >> 5;
        float l0 = ((const float*)(p.ws + WS_LSEB))[((size_t)0 * T + t) * 4 + j], l1 = ((const float*)(p.ws + WS_LSEB))[((size_t)1 * T + t) * 4 + j], l2 = ((const float*)(p.ws + WS_LSEB))[((size_t)2 * T + t) * 4 + j];
        const float M = fmaxf(l0, fmaxf(l1, l2)); const float w0 = __builtin_amdgcn_exp2f(l0 - M), w1 = __builtin_amdgcn_exp2f(l1 - M), w2 = __builtin_amdgcn_exp2f(l2 - M); const float inv = 1.0f / (w0 + w1 + w2);
        float o[8];
#pragma unroll
        for (int i = 0; i < 8; ++i) o[i] = 0.f;
#pragma unroll
        for (int g = 0; g < 3; ++g) { const float wg = (g == 0 ? w0 : g == 1 ? w1 : w2) * inv; const u32x4 v = *(const u32x4*)((const bf16*)(p.ws + WS_PARTB) + (((size_t)g * T + t) * 4 + j) * HD + 8 * ch);
#pragma unroll
            for (int i = 0; i < 4; ++i) { o[2 * i] += wg * __uint_as_float(v[i] << 16); o[2 * i + 1] += wg * __uint_as_float(v[i] & 0xffff0000u); } }
        u32x4 wv; wv.x = cvtpk(o[0], o[1]); wv.y = cvtpk(o[2], o[3]); wv.z = cvtpk(o[4], o[5]); wv.w = cvtpk(o[6], o[7]);
        *(u32x4*)((bf16*)p.out + t * (WA + WBO) + WA + j * HD + 8 * ch) = wv;
    }
}

__device__ __forceinline__ void phase_check(const Params& p, const bf16* a, const bf16* b, size_t n, int gtid, int ngt) {
    float num = 0.f, den = 0.f;
    for (size_t i = gtid; i < n; i += ngt) { const float x = bf2f(a[i]), y = bf2f(b[i]); num += (x - y) * (x - y); den += y * y; }
    num = wave_sum(num); den = wave_sum(den);
    if ((threadIdx.x & 63) == 0) { atomicAdd((float*)(p.ws + WS_CTL) + CW_DNUM, num); atomicAdd((float*)(p.ws + WS_CTL) + CW_DDEN, den); }
}

#define XB_TMO      128
#define XB_XCNT(j)  (256  + 64 * (j))
#define XB_XSUB(j)  (1280 + 64 * (j))
#define XB_XGEN(j)  (2304 + 64 * (j))
#define XB_TOP      3328
#define XB_TOPGEN   3392
#define XCD_BAR_WORDS 3456
#define XB_SPIN_CAP (1u << 18)
__device__ __forceinline__ unsigned xb_ld(unsigned* p)              { return __hip_atomic_load(p, __ATOMIC_RELAXED, __HIP_MEMORY_SCOPE_AGENT); }
__device__ __forceinline__ unsigned xb_add(unsigned* p, unsigned v) { return __hip_atomic_fetch_add(p, v, __ATOMIC_RELAXED, __HIP_MEMORY_SCOPE_AGENT); }
__device__ __forceinline__ unsigned xb_xcc_id() { return (unsigned)__builtin_amdgcn_s_getreg((3 << 11) | 20) & 0xFu; }
#define XB_SPIN(cond, bar) do { unsigned _sp = 0; while (cond) { __builtin_amdgcn_s_sleep(1); \
    if ((++_sp & 255u) == 0u) { if (xb_ld(&(bar)[XB_TMO])) break; if (_sp > XB_SPIN_CAP) { atomicAdd(&(bar)[XB_TMO], 1u); break; } } } } while (0)
struct XcdBarrier { unsigned* bar; unsigned x; volatile LAS unsigned* st; };
__device__ __forceinline__ XcdBarrier xcd_barrier_post(unsigned* bar, volatile LAS unsigned* st) {
    XcdBarrier b; b.bar = bar; b.x = xb_xcc_id(); b.st = st;
    if (threadIdx.x == 0) (void)xb_add(&bar[XB_XCNT(b.x)], 1u);
    return b;
}
__device__ __forceinline__ void xcd_barrier_complete(unsigned* bar, unsigned x, unsigned& nloc, unsigned& nx) {
    const unsigned G = gridDim.x * gridDim.y * gridDim.z;
    unsigned sum, cnt, mine, sp = 0u;
    for (;;) {
        sum = 0u; cnt = 0u; mine = 0u;
#pragma unroll
        for (unsigned j = 0; j < 16; ++j) { const unsigned c = xb_ld(&bar[XB_XCNT(j)]); sum += c; cnt += (c > 0u) ? 1u : 0u; mine = (j == x) ? c : mine; }
        if (sum == G) break;
        __builtin_amdgcn_s_sleep(1);
        if ((++sp & 255u) == 0u) { if (xb_ld(&bar[XB_TMO])) break; if (sp > XB_SPIN_CAP) { atomicAdd(&bar[XB_TMO], 1u); break; } }
    }
    nloc = mine > 0u ? mine : 1u; nx = cnt > 0u ? cnt : 1u;
}
__device__ __forceinline__ void xcd_barrier(const XcdBarrier& b) {
    asm volatile("s_waitcnt vmcnt(0)" ::: "memory");
    __syncthreads();
    if (threadIdx.x == 0) {
        unsigned* bar = b.bar;
        __builtin_amdgcn_s_waitcnt(0);
        unsigned nloc = b.st[0], nx = b.st[1];
        if (nloc == 0u) { xcd_barrier_complete(bar, b.x, nloc, nx); b.st[0] = nloc; b.st[1] = nx; }
        const unsigned old = xb_add(&bar[XB_XSUB(b.x)], 1u);
        const unsigned gen = old / nloc;
        if (old + 1u == (gen + 1u) * nloc) {
            __builtin_amdgcn_fence(__ATOMIC_RELEASE, "agent");
            asm volatile("s_waitcnt vmcnt(0)" ::: "memory");
            const unsigned og = xb_add(&bar[XB_TOP], 1u);
            const unsigned tg = og / nx;
            if (og + 1u == (tg + 1u) * nx) xb_add(&bar[XB_TOPGEN], 1u);
            else XB_SPIN(xb_ld(&bar[XB_TOPGEN]) == tg, bar);
            __builtin_amdgcn_fence(__ATOMIC_ACQUIRE, "agent");
            xb_add(&bar[XB_XGEN(b.x)], 1u);
            asm volatile("s_waitcnt vmcnt(0)" ::: "memory");
        } else {
            XB_SPIN(xb_ld(&bar[XB_XGEN(b.x)]) == gen, bar);
            __builtin_amdgcn_fence(__ATOMIC_ACQUIRE, "agent");
            asm volatile("s_waitcnt vmcnt(0)" ::: "memory");
        }
    }
    __syncthreads();
}
constexpr int HELPERS = 104;
constexpr int LDS_BYTES = 147456;
__global__ void __launch_bounds__(512, 2) mega_fwd(Params p) {
    extern __shared__ __attribute__((aligned(16))) unsigned char lds[];
    cg::grid_group grid = cg::this_grid();
    const int bid = blockIdx.x, nb = gridDim.x;
#define COORDS() int tid = threadIdx.x; asm volatile("" : "+v"(tid)); const int lane = tid & 63, wave = tid >> 6; const int gw = bid * 8 + wave, ngw = nb * 8, gtid = bid * 512 + tid, ngt = nb * 512; float* wl = (float*)lds + wave * 1152; (void)lane; (void)gw; (void)ngw; (void)gtid; (void)ngt; (void)wl;
    volatile LAS unsigned* bst = (volatile LAS unsigned*)(lds + LDS_BYTES - 64);
    if (threadIdx.x < 16) bst[threadIdx.x] = 0u;
    __syncthreads();
    const XcdBarrier xbar = xcd_barrier_post((unsigned*)(p.ws + WS_CTL) + CW_BAR, bst);
#ifndef TIME_LO
#define TIME_LO -1
#endif
#ifndef TIME_HI
#define TIME_HI -1
#endif
#ifndef TIME_MULT
#define TIME_MULT 2
#endif
    int n_stamp = 0;
#if TIME_LO >= 0
#define STAMP() do { if (bid == 0 && threadIdx.x == 0) ((unsigned long long*)(p.ws + WS_CTL + 917504))[n_stamp] = __builtin_amdgcn_s_memrealtime(); ++n_stamp; } while (0)
#else
#define STAMP() do { } while (0)
#endif
    STAMP();
#define GRID_BAR() do { xcd_barrier(xbar); STAMP(); } while (0)
    phase_prep_a(p, bid, nb, lds);
    if (p.use_cg) grid.sync(); else xcd_barrier(xbar);
    STAMP();
    if (!(bid < HELPERS && nb > 2 * HELPERS)) {
        const int hsub = (nb > 2 * HELPERS) ? HELPERS : 0;
        pg8::Order O; O.init(T / 256, NCOL / 256, nb - hsub, bid - hsub); EpiInProj E{p};
#if FP8_IN
        ProbPlainF8 P{(const bf16*)(p.ws + WS_H), (const bf16*)(p.ws + WS_WIN), D / 2}; pg8::gemm_phase<EpiInProj, ProbPlainF8, true>((PG8_LAS unsigned char*)lds, P, O, E);
#else
        ProbPlain P{(const bf16*)(p.ws + WS_H), (const bf16*)(p.ws + WS_WIN), D}; pg8::gemm_phase<EpiInProj, ProbPlain, true>((PG8_LAS unsigned char*)lds, P, O, E);
#endif
#if TIME_LO >= 0
        if (threadIdx.x == 0) atomicMax((unsigned long long*)(p.ws + WS_CTL + 917504) + 21, (unsigned long long)__builtin_amdgcn_s_memrealtime());
#endif
    }
    phase_prep_b(p, lds);
#if TIME_LO >= 0
    if (threadIdx.x == 0) atomicMax((unsigned long long*)(p.ws + WS_CTL + 917504) + 20, (unsigned long long)__builtin_amdgcn_s_memrealtime());
#endif
    GRID_BAR();
#if DBG == 1
    { InProjN f{p, true}; phase_naive_gemm(f, T, C_VB, bid, nb, lds); }
    GRID_BAR();
    { COORDS(); phase_check(p, (const bf16*)(p.ws + WS_QA), (const bf16*)(p.ws + 426 * MiB), (size_t)T * WA, gtid, ngt);
      phase_check(p, (const bf16*)(p.ws + WS_KA), (const bf16*)(p.ws + 442 * MiB), (size_t)T * WA, gtid, ngt);
      phase_check(p, (const bf16*)(p.ws + WS_QB), (const bf16*)(p.ws + 458 * MiB), (size_t)T * WB, gtid, ngt);
      phase_check(p, (const bf16*)(p.ws + WS_KB), (const bf16*)(p.ws + 482 * MiB), (size_t)T * WB, gtid, ngt); }
    GRID_BAR();
#endif
    { COORDS(); phase_select_lists(p, bid, nb, lds, tid); phase_dilated(p, bid, nb, lds, tid); }
    GRID_BAR();
    { COORDS(); phase_moba_past(p, bid, nb, lds, tid); }
    GRID_BAR();
    { COORDS(); phase_moba_own(p, bid, nb, lds, tid); phase_dil_merge(p, gtid, ngt); }
    GRID_BAR();
#if DBG == 2
    { COORDS(); phase_moba_naive(p, gw, ngw, lane, wl, (bf16*)p.out); phase_dil_naive(p, gw, ngw, lane, wl, (bf16*)p.out + (size_t)T * WA); }
    GRID_BAR();
    { COORDS();
#if DBG_SUB == 0
      phase_check(p, (const bf16*)(p.ws + WS_OA), (const bf16*)p.out, (size_t)T * WA, gtid, ngt);
#else
      phase_check(p, (const bf16*)(p.ws + WS_OB), (const bf16*)p.out + (size_t)T * WA, (size_t)T * WBO, gtid, ngt);
#endif
    }
    GRID_BAR();
#endif
    { pg8::Order O; O.init(T / 256, D / 256, nb, bid); ProbPlainOff P{(const bf16*)p.out, (const bf16*)(p.ws + WS_WOA), WA + WBO}; EpiMixCat E{p};
      pg8::gemm_phase<EpiMixCat, ProbPlainOff, true>((PG8_LAS unsigned char*)lds, P, O, E); }
    GRID_BAR();
    { ProbPlain P{(const bf16*)(p.ws + WS_MIX), (const bf16*)(p.ws + WS_WOUT), D}; pg8::Order O; O.init(T / 256, D / 256, nb, bid); EpiOut E{p};
      pg8::gemm_phase<EpiOut, ProbPlain, true>((PG8_LAS unsigned char*)lds, P, O, E); }
    GRID_BAR();
    { COORDS(); phase_router(p, bid, nb, lds, tid); }
    GRID_BAR();
    { COORDS(); MoeTab mt; const int n_mt = moe_tables<false>(p, lds, tid, 2 * FF / 256, nb, bid, mt);
      ProbMoE<true, (FP8_GU != 0)> P{(const bf16*)(p.ws + WS_H), (const bf16*)(p.ws + WS_WGU), FP8_GU ? D / 2 : D, mt, 2 * FF}; pg8::Order O; O.init(n_mt, 2 * FF / 256, nb, bid); EpiGateUp E{p, mt};
      pg8::gemm_phase<EpiGateUp, ProbMoE<true, (FP8_GU != 0)>, true>((PG8_LAS unsigned char*)lds, P, O, E); }
    GRID_BAR();
    { COORDS(); MoeTab mt; const int n_mt = moe_tables<true>(p, lds, tid, D / 256, nb, bid, mt);
      ProbMoE<false, (FP8_DN != 0)> P{(const bf16*)(p.ws + WS_A2), (const bf16*)(p.ws + WS_WD), FP8_DN ? FF / 2 : FF, mt, D}; pg8::Order O; O.init(n_mt, D / 256, nb, bid); EpiDown E{p, mt};
      pg8::gemm_phase<EpiDown, ProbMoE<false, (FP8_DN != 0)>, true>((PG8_LAS unsigned char*)lds, P, O, E); }
    GRID_BAR();
    { COORDS(); phase_final(p, gw, ngw, lane); }
#if TIME_LO >= 0
    if (bid == 0 && threadIdx.x == 0) { STAMP();
        const unsigned long long* ts = (const unsigned long long*)(p.ws + WS_CTL + 917504);
        const unsigned long long dt = (ts[TIME_HI] - ts[TIME_LO]) * TIME_MULT, t0 = __builtin_amdgcn_s_memrealtime();
        while (__builtin_amdgcn_s_memrealtime() - t0 < dt) __builtin_amdgcn_s_sleep(8); }
#endif
}

#ifdef TIME_LO
#define TIME_LO_HOST TIME_LO
#else
#define TIME_LO_HOST -1
#endif
extern "C" void kernel_launch(void* const* d_in, const int* in_sizes, int n_in, void* d_out, int out_size, void* d_ws, size_t ws_size, hipStream_t stream) {
    if (n_in != 18 || ws_size < WS_END || out_size != T * D) return;
    static int grid_blocks = 0;
    if (!grid_blocks) {
        int dev = 0, cus = 0, per_cu = 0;
        (void)hipGetDevice(&dev);
        (void)hipDeviceGetAttribute(&cus, hipDeviceAttributeMultiprocessorCount, dev);
        (void)hipFuncSetAttribute((const void*)mega_fwd, hipFuncAttributeMaxDynamicSharedMemorySize, LDS_BYTES);
        (void)hipOccupancyMaxActiveBlocksPerMultiprocessor(&per_cu, (const void*)mega_fwd, 512, LDS_BYTES);
        if (per_cu < 1) per_cu = 1;
        if (per_cu > 1) per_cu = 1;
        grid_blocks = cus * per_cu;
    }
    Params p{};
    const float** fp = (const float**)&p;
    for (int i = 0; i < 18; ++i) fp[i] = (const float*)d_in[i];
    p.out = (float*)d_out; p.ws = (unsigned char*)d_ws;
    for (int i = 0; i < 8; ++i) p.inv_freq[i] = (float)pow(500000.0, -(double)i / 8.0);
    (void)hipMemsetAsync((char*)d_ws + WS_CTL, 0, (TIME_LO_HOST >= 0) ? 1 * MiB : 64 * 1024, stream);
    void* args[] = {&p};
    (void)hipLaunchCooperativeKernel((const void*)mega_fwd, dim3(grid_blocks), dim3(512), args, LDS_BYTES, stream);
}
```

```cpp
#include <hip/hip_runtime.h>
#include <hip/hip_cooperative_groups.h>
namespace cg = cooperative_groups;
#include <stdint.h>
#include <math.h>

typedef unsigned short bf16;
typedef float f32x4 __attribute__((ext_vector_type(4)));
typedef unsigned u32x4 __attribute__((ext_vector_type(4)));
typedef unsigned u32x2 __attribute__((ext_vector_type(2)));

__device__ __forceinline__ float bf2f(bf16 v) { return __uint_as_float(((unsigned)v) << 16); }
__device__ __forceinline__ unsigned f2bf(float f) { unsigned u = __float_as_uint(f); return (u + 0x7fffu + ((u >> 16) & 1u)) >> 16; }
__device__ __forceinline__ unsigned pk2(float lo, float hi) { return f2bf(lo) | (f2bf(hi) << 16); }

typedef float f32x2 __attribute__((ext_vector_type(2)));
typedef __bf16 bf16x2_t __attribute__((ext_vector_type(2)));
__device__ __forceinline__ unsigned cvtpk(float lo, float hi) { f32x2 v = {lo, hi}; bf16x2_t b = __builtin_convertvector(v, bf16x2_t); return __builtin_bit_cast(unsigned, b); }
__device__ __forceinline__ float fast_sigmoid(float x) { return __builtin_amdgcn_rcpf(1.0f + __builtin_amdgcn_exp2f(-1.4426950408889634f * x)); }
typedef float f32x16 __attribute__((ext_vector_type(16)));
typedef short s16x4 __attribute__((ext_vector_type(4)));
typedef short bf16x8v __attribute__((ext_vector_type(8)));
__device__ __forceinline__ int crow(int r, int h) { return (r & 3) + 8 * (r >> 2) + 4 * h; }
#define GAS __attribute__((address_space(1)))
#define LAS __attribute__((address_space(3)))
typedef bf16 act;
__device__ __forceinline__ float ldact(const act* p) { return bf2f(*p); }
__device__ __forceinline__ void stact(act* p, float v) { *p = (bf16)f2bf(v); }
__device__ __forceinline__ void ldact8(const act* p, float (&o)[8]) { const u32x4 a = *(const u32x4*)p;
#pragma unroll
    for (int i = 0; i < 4; ++i) { o[2 * i] = __uint_as_float(a[i] << 16); o[2 * i + 1] = __uint_as_float(a[i] & 0xffff0000u); } }
#ifndef FP8_GU
#define FP8_GU 1
#endif
#ifndef FP8_DN
#define FP8_DN 1
#endif
#ifndef FP8_IN
#define FP8_IN 1
#endif
#ifndef FP8_Y
#define FP8_Y 1
#endif
#ifndef FP8_MOE
#define FP8_MOE 1
#endif
constexpr int NB = 2, S = 8192, T = NB * S, D = 1024, HD = 64;
constexpr int NHA = 8, NHB = 12, WA = 512, WB = 768, WBO = 256, NCOL = 5888;
constexpr int MBLK = 256, NBLK = S / MBLK;
constexpr int NE = 32, TOPK = 4, FF = 1024;
constexpr int A2ROWS = 73728;
constexpr int C_QA = 0, C_KA = 512, C_VA = 1024, C_QB = 1536, C_KB = 2304, C_VB = 3072, C_GA = 3840, C_GB = 4864;
constexpr float NORM_EPS = 1e-5f;

constexpr size_t MiB = 1u << 20;
constexpr size_t WS_CTL = 0;
constexpr size_t WS_WIN = 1 * MiB;
constexpr size_t WS_WOA = 13 * MiB;
constexpr size_t WS_WOB = 14 * MiB;
constexpr size_t WS_WOUT = 15 * MiB;
constexpr size_t WS_WGU = 17 * MiB;
constexpr size_t WS_WD = 145 * MiB;
constexpr size_t WS_ROPE = 209 * MiB;
constexpr size_t WS_KMEAN = WS_ROPE + 512 * 1024;
constexpr size_t WS_H = 210 * MiB;
constexpr size_t WS_QA = 242 * MiB, WS_KA = 258 * MiB, WS_VA = 274 * MiB;
constexpr size_t WS_QB = 290 * MiB, WS_KB = 314 * MiB, WS_VB = 338 * MiB;
constexpr size_t WS_SA = 362 * MiB, WS_SB = 394 * MiB;
constexpr size_t WS_PARTB = 210 * MiB;
constexpr size_t WS_LSEB = 234 * MiB;
constexpr size_t WS_LSEA = 235 * MiB;
constexpr size_t WS_SEL = 236 * MiB + 512 * 1024;
constexpr size_t WS_LIST = 426 * MiB;
constexpr size_t WS_PARTA = 442 * MiB;
constexpr int LIST_CAP = 8192;
constexpr size_t WS_OB = 434 * MiB;
constexpr size_t WS_OA = 490 * MiB;
constexpr size_t WS_MIX = 242 * MiB;
constexpr size_t WS_A2 = 242 * MiB;
constexpr size_t WS_ELIST = 386 * MiB;
constexpr size_t WS_EP = 388 * MiB;
constexpr size_t WS_ROWTOK = 390 * MiB;
constexpr size_t WS_ROWP = 391 * MiB;
constexpr size_t WS_TILEE = 392 * MiB;
constexpr size_t WS_Y = 17 * MiB;
constexpr size_t WS_END = 512 * MiB;
#ifndef TIMEB_LO
#define TIMEB_LO -1
#endif
#ifndef TIMEB_HI
#define TIMEB_HI -1
#endif
#ifndef TIMEB_GAIN
#define TIMEB_GAIN 1.0f
#endif
#ifndef DBG
#define DBG 0
#endif
#ifndef DBG_SUB
#define DBG_SUB 0
#endif
#ifndef DBG_GAIN
#define DBG_GAIN 100.0f
#endif
constexpr int CW_DNUM = 192, CW_DDEN = 193;
constexpr int CW_ECNT = 8192;
constexpr int CW_BAR = 4096;
constexpr int CW_LCNT = 12288;
constexpr int CW_HQ = 224;
constexpr int CW_NMT = 160;

struct Params {
    const float *x, *ln_mix_g, *w_in, *b_gate_a, *b_gate_b, *w_o_a, *w_o_b, *w_out, *ln_ffn_g, *w_router, *b_router,
        *w_gate, *b_gate, *w_up, *b_up, *w_down, *b_down, *ln_final_g;
    float* out; unsigned char* ws;
    float inv_freq[8];
    int use_cg, pad0;
};

template <int MAP> __device__ __forceinline__ int rowmap(int n) { return MAP == 0 ? n : (32 * (n >> 4) + (n & 15) + (MAP == 2 ? 16 : 0)); }
template <int MAP> __device__ __forceinline__ void transpose_item(const float* W, int K, int N, bf16* WT, float* scr, int item, int lane) {
    const int nblk = N / 64, kb = item / nblk, nb = item % nblk, k0 = 64 * kb, n0 = 64 * nb;
    f32x4 v[16];
#pragma unroll
    for (int i = 0; i < 16; ++i) v[i] = *(const f32x4*)(W + (size_t)(k0 + (lane >> 4) + 4 * i) * N + n0 + 4 * (lane & 15));
#pragma unroll
    for (int i = 0; i < 16; ++i) { float* d = scr + ((lane >> 4) + 4 * i) * 65 + 4 * (lane & 15); d[0] = v[i].x; d[1] = v[i].y; d[2] = v[i].z; d[3] = v[i].w; }
    asm volatile("s_waitcnt lgkmcnt(0)" ::: "memory");
    const int c = lane & 7;
#pragma unroll
    for (int j = 0; j < 8; ++j) { const int n = (lane >> 3) + 8 * j; const float* q = scr + (8 * c) * 65 + n;
        u32x4 o; o.x = cvtpk(q[0 * 65], q[1 * 65]); o.y = cvtpk(q[2 * 65], q[3 * 65]); o.z = cvtpk(q[4 * 65], q[5 * 65]); o.w = cvtpk(q[6 * 65], q[7 * 65]);
        *(u32x4*)(WT + (size_t)rowmap<MAP>(n0 + n) * K + k0 + 8 * c) = o; }
    asm volatile("s_waitcnt lgkmcnt(0)" ::: "memory");
}
__device__ __forceinline__ float wave_sum(float v) {
#pragma unroll
    for (int o = 1; o < 64; o <<= 1) v += __shfl_xor(v, o);
    return v;
}
__device__ __forceinline__ void sincos_acc(float ang, float& c, float& s) {
    const double a = (double)ang; const double k = rint(a * 0.63661977236758134308); const double y = a - k * 1.57079632679489661923; const double y2 = y * y;
    const double sn = y * (1.0 + y2 * (-1.0 / 6 + y2 * (1.0 / 120 + y2 * (-1.0 / 5040 + y2 * (1.0 / 362880 + y2 * (-1.0 / 39916800))))));
    const double cs = 1.0 + y2 * (-0.5 + y2 * (1.0 / 24 + y2 * (-1.0 / 720 + y2 * (1.0 / 40320 + y2 * (-1.0 / 3628800 + y2 * (1.0 / 479001600))))));
    const int q = ((int)k) & 3;
    const double ss = (q == 0) ? sn : (q == 1) ? cs : (q == 2) ? -sn : -cs;
    const double cc = (q == 0) ? cs : (q == 1) ? -sn : (q == 2) ? -cs : sn;
    c = (float)cc; s = (float)ss;
}
struct TItem { const float* W; bf16* WT; int K, N, map, k0, n0, f8, kd; };
__device__ __forceinline__ TItem titem_decode(const Params& p, int it) {
    constexpr int I_OA = (WA / 64) * (D / 32), I_OB = (WBO / 64) * (D / 32), I_OUT = (D / 64) * (D / 32), I_E = (D / 64) * (FF / 32);
    static_assert(I_E == 512 && D == 1024 && FF == 1024, "the expert-matrix decode below uses shifts");
    unsigned char* ws = p.ws; TItem t; int r = it; t.f8 = 0; t.kd = 0; t.N = D; t.map = 0;
    if (r >= I_OA + I_OB + I_OUT) {
        r -= I_OA + I_OB + I_OUT; const int which = r >> 14  , e = (r >> 9) & 31; r &= 511; t.K = D;
        t.f8 = (which == 2) ? (FP8_DN ? 1 : 0) : (FP8_GU ? 1 : 0); const size_t esz = t.f8 ? 1 : 2;
        if (which == 0) { t.W = p.w_gate + (size_t)e * D * FF; t.WT = (bf16*)(ws + WS_WGU + (size_t)e * 2 * FF * D * esz); t.map = 1; }
        else if (which == 1) { t.W = p.w_up + (size_t)e * D * FF; t.WT = (bf16*)(ws + WS_WGU + (size_t)e * 2 * FF * D * esz); t.map = 2; }
        else { t.W = p.w_down + (size_t)e * FF * D; t.WT = (bf16*)(ws + WS_WD + (size_t)e * D * FF * esz); }
    }
    else if (r < I_OA) { t.W = p.w_o_a; t.WT = (bf16*)(ws + WS_WOA); t.K = WA + WBO; }
    else if ((r -= I_OA) < I_OB) { t.W = p.w_o_b; t.WT = (bf16*)(ws + WS_WOA); t.K = WA + WBO; t.kd = WA; }
    else { r -= I_OB; t.W = p.w_out; t.WT = (bf16*)(ws + WS_WOUT); t.K = D; }
    const int pr_ = r >> 1; t.k0 = 64 * (2 * (pr_ >> 5) + (r & 1)); t.n0 = 32 * (pr_ & 31);
    return t;
}
__device__ __forceinline__ void titem_load(const TItem& t, f32x4 (&v)[8], int lane) {
#pragma unroll
    for (int i = 0; i < 8; ++i) v[i] = __builtin_nontemporal_load((const f32x4*)(t.W + (size_t)(t.k0 + (lane >> 3) + 8 * i) * t.N + t.n0 + 4 * (lane & 7)));
}
__device__ __forceinline__ void titem_store(const TItem& t, const f32x4 (&v)[8], float* scr, int lane) {
#pragma unroll
    for (int i = 0; i < 8; ++i) { float* d = scr + ((lane >> 3) + 8 * i) * 33 + 4 * (lane & 7); d[0] = v[i].x; d[1] = v[i].y; d[2] = v[i].z; d[3] = v[i].w; }
    asm volatile("s_waitcnt lgkmcnt(0)" ::: "memory");
    const int c = (lane & 3) + 4 * (lane >> 5);
#pragma unroll
    for (int j = 0; j < 4; ++j) { const int n = ((lane >> 2) & 7) + 8 * j; const float* q = scr + (8 * c) * 33 + n; const int nn = t.n0 + n;
        const int row = t.map == 0 ? nn : (32 * (nn >> 4) + (nn & 15) + (t.map == 2 ? 16 : 0));
        if (t.f8) { int w0 = __builtin_amdgcn_cvt_pk_fp8_f32(q[0 * 33] * 64.f, q[1 * 33] * 64.f, 0, false); w0 = __builtin_amdgcn_cvt_pk_fp8_f32(q[2 * 33] * 64.f, q[3 * 33] * 64.f, w0, true);
            int w1 = __builtin_amdgcn_cvt_pk_fp8_f32(q[4 * 33] * 64.f, q[5 * 33] * 64.f, 0, false); w1 = __builtin_amdgcn_cvt_pk_fp8_f32(q[6 * 33] * 64.f, q[7 * 33] * 64.f, w1, true);
            u32x2 o; o.x = (unsigned)w0; o.y = (unsigned)w1; *(u32x2*)((unsigned char*)t.WT + (size_t)row * t.K + t.kd + t.k0 + 8 * c) = o; }
        else { u32x4 o; o.x = cvtpk(q[0 * 33], q[1 * 33]); o.y = cvtpk(q[2 * 33], q[3 * 33]); o.z = cvtpk(q[4 * 33], q[5 * 33]); o.w = cvtpk(q[6 * 33], q[7 * 33]);
            *(u32x4*)(t.WT + (size_t)row * t.K + t.kd + t.k0 + 8 * c) = o; } }
    asm volatile("s_waitcnt lgkmcnt(0)" ::: "memory");
}
__device__ __forceinline__ void phase_prep_a(const Params& p, int bid, int nb, unsigned char* lds) {
    int tid = threadIdx.x; asm volatile("" : "+v"(tid)); const int lane = tid & 63, wave = tid >> 6;
    const int gw = bid * 8 + wave, NGW = nb * 8;
    unsigned char* ws = p.ws;
    float* scr = (float*)lds + wave * (64 * 33);
    constexpr int I_IN = (D / 64) * (NCOL / 32);
    for (int it = gw; it < I_IN; it += NGW) {
        TItem t; t.W = p.w_in; t.WT = (bf16*)(ws + WS_WIN); t.K = D; t.N = NCOL; t.map = 0; t.f8 = FP8_IN; t.kd = 0; t.k0 = 64 * (it / (NCOL / 32)); t.n0 = 32 * (it % (NCOL / 32));
        f32x4 v[8]; titem_load(t, v, lane); titem_store(t, v, scr, lane);
    }
    for (int m = gw; m < T; m += NGW) {
        const f32x4* xr = (const f32x4*)(p.x + (size_t)m * D) + lane; const f32x4* gr = (const f32x4*)p.ln_mix_g + lane;
        f32x4 v[4]; float s = 0.f;
#pragma unroll
        for (int j = 0; j < 4; ++j) { v[j] = xr[64 * j]; s += (v[j].x * v[j].x + v[j].y * v[j].y) + (v[j].z * v[j].z + v[j].w * v[j].w); }
        const float rstd = 1.0f / sqrtf(wave_sum(s) * (1.0f / D) + NORM_EPS);
#pragma unroll
        for (int j = 0; j < 4; ++j) { const f32x4 g = gr[64 * j];
#if FP8_IN
            int o = __builtin_amdgcn_cvt_pk_fp8_f32(v[j].x * rstd * g.x, v[j].y * rstd * g.y, 0, false); o = __builtin_amdgcn_cvt_pk_fp8_f32(v[j].z * rstd * g.z, v[j].w * rstd * g.w, o, true);
            ((int*)((unsigned char*)(ws + WS_H) + (size_t)m * D))[lane + 64 * j] = o;
#else
            u32x2 o; o.x = cvtpk(v[j].x * rstd * g.x, v[j].y * rstd * g.y); o.y = cvtpk(v[j].z * rstd * g.z, v[j].w * rstd * g.w); ((u32x2*)((bf16*)(ws + WS_H) + (size_t)m * D))[lane + 64 * j] = o;
#endif
        }
    }
    float2* rope = (float2*)(ws + WS_ROPE);
    for (int i = bid * 512 + tid; i < S * 8; i += nb * 512) { const int s = i >> 3, f = i & 7; const float ang = (float)s * p.inv_freq[f]; float c, sn; sincos_acc(ang, c, sn); rope[i] = make_float2(c, sn); }
    for (int i = bid * 512 + tid; i < NB * NHA * NBLK * HD; i += nb * 512) ((float*)(ws + WS_KMEAN))[i] = 0.f;
}
__device__ __forceinline__ void phase_prep_b(const Params& p, unsigned char* lds) {
    int tid = threadIdx.x; asm volatile("" : "+v"(tid)); const int lane = tid & 63, wave = tid >> 6;
    float* scr = (float*)lds + wave * (64 * 33);
    constexpr int NITEMS = (WA / 64) * (D / 32) + (WBO / 64) * (D / 32) + (D / 64) * (D / 32) + 3 * NE * (D / 64) * (FF / 32);
    int* ctr = (int*)(p.ws + WS_CTL) + CW_HQ;
    int qcur = 0, qend = 0; bool qdone = false;
#define TQ_NEXT(dst) do { if (qcur == qend && !qdone) { int b_ = 0; if (lane == 0) b_ = atomicAdd(ctr, 8); b_ = __builtin_amdgcn_readfirstlane(b_); \
        if (b_ >= NITEMS) qdone = true; else { qcur = b_; qend = (b_ + 8 < NITEMS) ? b_ + 8 : NITEMS; } } \
        if (qcur < qend) dst = qcur++; else dst = -1; } while (0)
    TItem ta, tb, tc; f32x4 va[8], vb[8], vc[8];
    int ia, ib, ic;
    TQ_NEXT(ia); if (ia >= 0) { ta = titem_decode(p, ia); titem_load(ta, va, lane); }
    TQ_NEXT(ib); if (ib >= 0) { tb = titem_decode(p, ib); titem_load(tb, vb, lane); }
    while (ia >= 0) {
        TQ_NEXT(ic); if (ic >= 0) { tc = titem_decode(p, ic); titem_load(tc, vc, lane); }
        titem_store(ta, va, scr, lane);
        if (ib < 0) break;
        TQ_NEXT(ia); if (ia >= 0) { ta = titem_decode(p, ia); titem_load(ta, va, lane); }
        titem_store(tb, vb, scr, lane);
        if (ic < 0) break;
        TQ_NEXT(ib); if (ib >= 0) { tb = titem_decode(p, ib); titem_load(tb, vb, lane); }
        titem_store(tc, vc, scr, lane);
    }
#undef TQ_NEXT
}

__device__ __forceinline__ int cl(int tx, int j) { return (tx & 7) + 8 * j + 32 * (tx >> 3); }
template <class F> __device__ __forceinline__ void phase_naive_gemm(const F& f, int M, int N, int bid, int nb, unsigned char* lds) {
    const int half = threadIdx.x >> 8, tid = threadIdx.x & 255, tx = tid & 15, ty = tid >> 4;
    float (*As)[33] = (float (*)[33])(lds + half * (2 * 64 * 33 * 4)); float (*Bs)[33] = As + 64;
    const int nN = N / 64, ntiles = (M / 64) * nN, stride = nb * 2;
    const int nround = (ntiles + stride - 1) / stride;
    const int lr = tid >> 2, lk = (tid & 3) * 8;
    for (int r = 0; r < nround; ++r) {
        const int it = r * stride + bid * 2 + half;
        const bool valid = it < ntiles;
        const int m0 = valid ? (it / nN) * 64 : 0, n0 = valid ? (it % nN) * 64 : 0;
        const bool act_ = valid && f.active(m0);
        float acc[F::NPASS][4][4];
#pragma unroll
        for (int ps = 0; ps < F::NPASS; ++ps)
#pragma unroll
            for (int i = 0; i < 4; ++i)
#pragma unroll
                for (int j = 0; j < 4; ++j) acc[ps][i][j] = 0.f;
#pragma unroll
        for (int ps = 0; ps < F::NPASS; ++ps) {
            const int K = f.K(ps);
            const bf16* ap = act_ ? f.arow(ps, m0 + lr) : nullptr; const bf16* bp = act_ ? f.brow(ps, m0, n0 + lr) : nullptr;
            for (int k0 = 0; k0 < K; k0 += 32) {
                float av[8], bv[8];
                if (act_) { ldact8(ap + k0 + lk, av); ldact8(bp + k0 + lk, bv); }
                else {
#pragma unroll
                    for (int i = 0; i < 8; ++i) { av[i] = 0.f; bv[i] = 0.f; } }
                __syncthreads();
#pragma unroll
                for (int i = 0; i < 8; ++i) { As[lr][lk + i] = av[i]; Bs[lr][lk + i] = bv[i]; }
                __syncthreads();
#pragma unroll 8
                for (int kk = 0; kk < 32; ++kk) {
                    float a[4], b[4];
#pragma unroll
                    for (int i = 0; i < 4; ++i) { a[i] = As[ty * 4 + i][kk]; b[i] = Bs[cl(tx, i)][kk]; }
#pragma unroll
                    for (int i = 0; i < 4; ++i)
#pragma unroll
                        for (int j = 0; j < 4; ++j) acc[ps][i][j] += a[i] * b[j];
                }
            }
        }
        if (act_) {
#pragma unroll
            for (int i = 0; i < 4; ++i) f.epi(m0 + ty * 4 + i, n0, tx, acc[0][i], acc[F::NPASS - 1][i]);
        }
    }
}

struct InProjN {
    static constexpr int NPASS = 1; Params p; bool alt;
    __device__ __forceinline__ bool active(int) const { return true; }
    __device__ __forceinline__ int K(int) const { return D; }
    __device__ __forceinline__ int ldb(int) const { return NCOL; }
    __device__ __forceinline__ const act* arow(int, int m) const { return (const act*)(p.ws + WS_H) + (size_t)m * D; }
    __device__ __forceinline__ const bf16* brow(int, int, int n) const { return (const bf16*)(p.ws + WS_WIN) + (size_t)n * D; }
    __device__ __forceinline__ void epi(int m, int n0, int tx, float (&v)[4], float (&)[4]) const {
        unsigned char* ws = p.ws;
        act* dst; int ld, cb; bool rope = false; const float* gbias = nullptr;
        if (n0 < C_KA) { dst = (act*)(ws + (alt ? 426 * MiB : WS_QA)); ld = WA; cb = n0 - C_QA; rope = true; }
        else if (n0 < C_VA) { dst = (act*)(ws + (alt ? 442 * MiB : WS_KA)); ld = WA; cb = n0 - C_KA; rope = true; }
        else if (n0 < C_QB) { if (alt) return; dst = (act*)(ws + WS_VA); ld = WA; cb = n0 - C_VA; }
        else if (n0 < C_KB) { dst = (act*)(ws + (alt ? 458 * MiB : WS_QB)); ld = WB; cb = n0 - C_QB; rope = true; }
        else if (n0 < C_VB) { dst = (act*)(ws + (alt ? 482 * MiB : WS_KB)); ld = WB; cb = n0 - C_KB; rope = true; }
        else if (alt) { return; }
        else if (n0 < C_GA) { dst = (act*)(ws + WS_VB); ld = WB; cb = n0 - C_VB; }
        else if (n0 < C_GB) { dst = (act*)(ws + WS_SA); ld = D; cb = n0 - C_GA; gbias = p.b_gate_a; }
        else { dst = (act*)(ws + WS_SB); ld = D; cb = n0 - C_GB; gbias = p.b_gate_b; }
        if (rope && (tx >> 3) == 0) {
            const float2 cs = ((const float2*)(ws + WS_ROPE))[(m % S) * 8 + (tx & 7)];
            const float x1 = v[0], x2 = v[1]; v[0] = x1 * cs.x - x2 * cs.y; v[1] = x2 * cs.x + x1 * cs.y;
        }
#pragma unroll
        for (int j = 0; j < 4; ++j) { const int c = cb + cl(tx, j); float o = v[j];
            if (gbias) { o = 1.0f / (1.0f + expf(-(o + gbias[c]))); }
            stact(dst + (size_t)m * ld + c, o); }
    }
};
struct MixN {
    static constexpr int NPASS = 2; Params p;
    __device__ __forceinline__ bool active(int) const { return true; }
    __device__ __forceinline__ int K(int ps) const { return ps == 0 ? WA : WBO; }
    __device__ __forceinline__ int ldb(int) const { return D; }
    __device__ __forceinline__ const act* arow(int ps, int m) const { return ps == 0 ? (const act*)(p.ws + WS_OA) + (size_t)m * WA : (const act*)(p.ws + WS_OB) + (size_t)m * WBO; }
    __device__ __forceinline__ const bf16* brow(int ps, int, int n) const { return ps == 0 ? (const bf16*)(p.ws + WS_WOA) + (size_t)n * WA : (const bf16*)(p.ws + WS_WOB) + (size_t)n * WBO; }
    __device__ __forceinline__ void epi(int m, int n0, int tx, float (&a)[4], float (&b)[4]) const {
#pragma unroll
        for (int j = 0; j < 4; ++j) { const int c = n0 + cl(tx, j); const size_t o = (size_t)m * D + c;
            const float sa = ldact((const act*)(p.ws + WS_SA) + o), sb = ldact((const act*)(p.ws + WS_SB) + o);
            stact((act*)(p.ws + WS_MIX) + o, sa * a[j] + sb * b[j]); }
    }
};
struct OutN {
    static constexpr int NPASS = 1; Params p;
    __device__ __forceinline__ bool active(int) const { return true; }
    __device__ __forceinline__ int K(int) const { return D; }
    __device__ __forceinline__ int ldb(int) const { return D; }
    __device__ __forceinline__ const act* arow(int, int m) const { return (const act*)(p.ws + WS_MIX) + (size_t)m * D; }
    __device__ __forceinline__ const bf16* brow(int, int, int n) const { return (const bf16*)(p.ws + WS_WOUT) + (size_t)n * D; }
    __device__ __forceinline__ void epi(int m, int n0, int tx, float (&a)[4], float (&)[4]) const {
#pragma unroll
        for (int j = 0; j < 4; ++j) { const size_t o = (size_t)m * D + n0 + cl(tx, j); p.out[o] = p.x[o] + a[j]; }
    }
};


namespace pg8 {
#define PG8_LAS __attribute__((address_space(3)))
typedef short bf16x8 __attribute__((ext_vector_type(8)));
typedef int v4i_t __attribute__((ext_vector_type(4)));
typedef int v8i_t __attribute__((ext_vector_type(8)));
constexpr int BM = 256, BK = 64, HALF = 128, HTB = HALF * BK * 2  , STAGE_BYTES = 8 * HTB, NXCD = 8, WGM = 8;
__device__ __forceinline__ int lds_byte(int r, int c) { const int st = (r >> 4) * 2 + (c >> 5), rr = r & 15, cc = c & 31, ob = rr * 64 + cc * 2; return st * 1024 + (ob ^ (((ob >> 9) & 1) << 5)); }
__device__ __forceinline__ void stage_rc(int b, int& R, int& C) { const int st = b / 1024, sb = b % 1024, swz = sb ^ (((sb >> 9) & 1) << 5); R = (st >> 1) * 16 + swz / 64; C = (st & 1) * 32 + (swz % 64) / 2; }
__device__ __forceinline__ int perm32(int rho) { const int n = rho >> 4, i = rho & 15; return 8 * (i >> 2) + 4 * n + (i & 3); }
struct Unit { int pm, pn, slot; };
struct Order {
    int nM, nN, nwg, G, c;
    __device__ __forceinline__ void init(int nM_, int nN_, int G_, int c_) { nM = nM_; nN = nN_; nwg = nM * nN; G = G_; c = c_; }
    __device__ __forceinline__ bool next(int i, Unit& u) const {
        const long L = (long)i * G + c; if (L >= nwg) return false;
        int wgid = (int)L; { const int q = nwg / NXCD, r = nwg % NXCD, xcd = wgid % NXCD, off = wgid / NXCD; wgid = (xcd < r ? xcd * (q + 1) : r * (q + 1) + (xcd - r) * q) + off; }
        const int nig = WGM * nN, gid = wgid / nig, fm = gid * WGM, gsz = (nM - fm) < WGM ? (nM - fm) : WGM;
        u.pm = fm + ((wgid % nig) % gsz); u.pn = (wgid % nig) / gsz; u.slot = i; return true;
    }
};
template <class Epi, class Prob, bool ALIGN_EPI>
__device__ __forceinline__ void gemm_phase(PG8_LAS unsigned char* lds, const Prob& P, const Order& S, const Epi& E) {
    int tid = threadIdx.x; asm volatile("" : "+v"(tid)); const int wid = __builtin_amdgcn_readfirstlane(tid >> 6), lane = tid & 63, wr = wid >> 2, wc = wid & 3, fr = lane & 15, fq = lane >> 4;
    constexpr bool GATHER = Prob::GATHER; constexpr bool FP8 = Prob::FP8;
    const int K = P.K, nt = K / BK;
    unsigned voffA[2], voffB[2];
#pragma unroll
    for (int i = 0; i < 2; ++i) { int R, C; stage_rc(tid * 16 + i * 8192, R, C); const int Rb = Epi::PERM ? ((R & ~31) + perm32(R & 31)) : R; voffA[i] = (unsigned)(R * K + C) * 2u; voffB[i] = (unsigned)(Rb * K + C) * 2u; }
    const size_t kstep = (size_t)(BK * 2);
    const size_t hstep = (size_t)HALF * K * 2;
    const unsigned ldsw = (unsigned)wid * 1024u;
    const int aoff = lds_byte(wr * 64 + fr, fq * 8), boff = lds_byte(wc * 32 + fr, fq * 8);
    const char* const Ab = (const char*)P.abase();
#define PG8_SA(b, h) (((b) * 2 + (h)) * HTB)
#define PG8_SB(b, h) ((4 + (b) * 2 + (h)) * HTB)
#define PG8_GLDS(src, bufoff, i) __builtin_amdgcn_global_load_lds((const unsigned*)(src), (PG8_LAS unsigned*)(lds + (bufoff) + ldsw + (i) * 8192), 16, 0, 0)
#define PG8_STAGE_B(bufoff, gbase) do { PG8_GLDS((const char*)(gbase) + voffB[0], bufoff, 0); PG8_GLDS((const char*)(gbase) + voffB[1], bufoff, 1); } while (0)
#define PG8_STAGE_A(bufoff, h, kb) do { if constexpr (GATHER) { PG8_GLDS(Ab + (size_t)g[h][0] + (kb), bufoff, 0); PG8_GLDS(Ab + (size_t)g[h][1] + (kb), bufoff, 1); } \
        else { PG8_GLDS(cA + (h) * hstep + (kb) + voffA[0], bufoff, 0); PG8_GLDS(cA + (h) * hstep + (kb) + voffA[1], bufoff, 1); } } while (0)
#define PG8_CAT(x0, x1) __builtin_shufflevector(x0, x1, 0, 1, 2, 3, 4, 5, 6, 7)
#define PG8_LO(x) __builtin_bit_cast(bf16x8, __builtin_shufflevector(x, x, 0, 1, 2, 3))
#define PG8_HI(x) __builtin_bit_cast(bf16x8, __builtin_shufflevector(x, x, 4, 5, 6, 7))
#define PG8_LDA(dst, b, h) do { _Pragma("unroll") for (int m = 0; m < 4; ++m) dst[m] = PG8_CAT(*(const PG8_LAS v4i_t*)(lds + PG8_SA(b, h) + aoff + m * 2048), *(const PG8_LAS v4i_t*)(lds + PG8_SA(b, h) + aoff + m * 2048 + 1024)); } while (0)
#define PG8_LDB(dst, b, h) do { _Pragma("unroll") for (int n = 0; n < 2; ++n) dst[n] = PG8_CAT(*(const PG8_LAS v4i_t*)(lds + PG8_SB(b, h) + boff + n * 2048), *(const PG8_LAS v4i_t*)(lds + PG8_SB(b, h) + boff + n * 2048 + 1024)); } while (0)
#define PG8_MMA(ai, bj, At, Bt) do { __builtin_amdgcn_s_setprio(1); _Pragma("unroll") for (int m = 0; m < 4; ++m) _Pragma("unroll") for (int n = 0; n < 2; ++n) { \
        if constexpr (FP8) acc[ai][bj][m][n] = __builtin_amdgcn_mfma_scale_f32_16x16x128_f8f6f4(Bt[n], At[m], acc[ai][bj][m][n], 0, 0, 0, 0x79797979, 0, 0x7f7f7f7f); \
        else { acc[ai][bj][m][n] = __builtin_amdgcn_mfma_f32_16x16x32_bf16(PG8_LO(Bt[n]), PG8_LO(At[m]), acc[ai][bj][m][n], 0, 0, 0); \
               acc[ai][bj][m][n] = __builtin_amdgcn_mfma_f32_16x16x32_bf16(PG8_HI(Bt[n]), PG8_HI(At[m]), acc[ai][bj][m][n], 0, 0, 0); } } \
        __builtin_amdgcn_s_setprio(0); } while (0)
#define PG8_WAIT_V(n) asm volatile("s_waitcnt vmcnt(" #n ")" ::: "memory")
#define PG8_WAIT_L(n) asm volatile("s_waitcnt lgkmcnt(" #n ")" ::: "memory")
#define PG8_BAR __builtin_amdgcn_s_barrier()
#define PG8_SCHED __builtin_amdgcn_sched_barrier(0)
    Unit cur, nxt; int ui = 0;
    if (!S.next(0, cur)) return;
    f32x4 acc[2][2][4][2];
#pragma unroll
    for (int a = 0; a < 2; ++a)
#pragma unroll
        for (int b = 0; b < 2; ++b)
#pragma unroll
            for (int m = 0; m < 4; ++m)
#pragma unroll
                for (int n = 0; n < 2; ++n) acc[a][b][m][n] = (f32x4){0.f, 0.f, 0.f, 0.f};
    if constexpr (Epi::HAS_INIT) { f32x4 iv[2][2]; E.init_load(iv, cur, wc, fq); E.init_apply(acc, iv); }
    v8i_t At[4], B0[2], B1[2];
    unsigned g[2][2], gn[2][2];
    const char* cA = Ab; const char* nA = Ab;
    if constexpr (GATHER) {
#pragma unroll
        for (int h = 0; h < 2; ++h)
#pragma unroll
            for (int i = 0; i < 2; ++i) { g[h][i] = P.goff(cur, h, voffA[i]); gn[h][i] = g[h][i]; }
    } else { cA = Ab + P.aoff(cur); nA = cA; }
    const char* cB = (const char*)P.bbase(cur);
    PG8_STAGE_B(PG8_SB(0, 0), cB); PG8_STAGE_B(PG8_SB(0, 1), cB + hstep); PG8_STAGE_A(PG8_SA(0, 0), 0, 0); PG8_STAGE_A(PG8_SA(0, 1), 1, 0);
    if (wr == 1) PG8_BAR;
    PG8_WAIT_V(2); PG8_BAR;
    PG8_STAGE_B(PG8_SB(1, 0), cB + kstep); PG8_STAGE_A(PG8_SA(1, 0), 0, kstep); PG8_STAGE_B(PG8_SB(1, 1), cB + hstep + kstep);
    PG8_WAIT_V(6); PG8_BAR;
    for (;;) {
        const bool has_next = S.next(ui + 1, nxt);
        const char* nB = cB;
        if (has_next) { nB = (const char*)P.bbase(nxt);
            if constexpr (GATHER) {
#pragma unroll
                for (int h = 0; h < 2; ++h)
#pragma unroll
                    for (int i = 0; i < 2; ++i) gn[h][i] = P.goff(nxt, h, voffA[i]);
            } else nA = Ab + P.aoff(nxt); }
        for (int t = 0; t < nt; t += 2) {
            const bool last = (t == nt - 2);
            const size_t k1 = (size_t)(t + 1) * kstep;
            const size_t k2 = last ? 0 : (size_t)(t + 2) * kstep, k3 = k2 + kstep;
            if constexpr (Epi::MID_T > 0) { if (t == Epi::MID_T) E.mid(acc, cur, wr, wc, fr, fq); }
            PG8_LDB(B0, 0, 0); PG8_LDB(B1, 0, 1); PG8_SCHED; PG8_LDA(At, 0, 0); PG8_STAGE_A(PG8_SA(1, 1), 1, k1);
            if (last) { cB = nB; if constexpr (GATHER) { g[0][0] = gn[0][0]; g[0][1] = gn[0][1]; g[1][0] = gn[1][0]; g[1][1] = gn[1][1]; } else cA = nA; }
            PG8_WAIT_V(8); PG8_WAIT_L(0); PG8_BAR; PG8_MMA(0, 0, At, B0); PG8_MMA(0, 1, At, B1); PG8_BAR; PG8_SCHED;
            PG8_LDA(At, 0, 1); PG8_STAGE_B(PG8_SB(0, 0), cB + k2); PG8_STAGE_B(PG8_SB(0, 1), cB + k2 + hstep); PG8_STAGE_A(PG8_SA(0, 0), 0, k2);
            PG8_WAIT_V(8); PG8_WAIT_L(0); PG8_BAR; PG8_MMA(1, 0, At, B0); PG8_MMA(1, 1, At, B1); PG8_BAR; PG8_SCHED;
            PG8_LDB(B0, 1, 0); PG8_LDB(B1, 1, 1); PG8_SCHED; PG8_LDA(At, 1, 0); PG8_STAGE_A(PG8_SA(0, 1), 1, k2);
            PG8_WAIT_V(8); PG8_WAIT_L(0); PG8_BAR; PG8_MMA(0, 0, At, B0); PG8_MMA(0, 1, At, B1); PG8_BAR; PG8_SCHED;
            PG8_LDA(At, 1, 1); PG8_STAGE_B(PG8_SB(1, 0), cB + k3); PG8_STAGE_B(PG8_SB(1, 1), cB + k3 + hstep); PG8_STAGE_A(PG8_SA(1, 0), 0, k3);
            PG8_WAIT_V(8); PG8_WAIT_L(0); PG8_BAR; PG8_MMA(1, 0, At, B0); PG8_MMA(1, 1, At, B1); PG8_BAR; PG8_SCHED;
        }
        if constexpr (ALIGN_EPI) { if (wr == 0) PG8_BAR; }
        f32x4 iv[2][2];
        if constexpr (Epi::HAS_INIT) { if (has_next) E.init_load(iv, nxt, wc, fq); }
        E(acc, cur, wr, wc, fr, fq);
        if (!has_next) break;
#pragma unroll
        for (int a = 0; a < 2; ++a)
#pragma unroll
            for (int b = 0; b < 2; ++b)
#pragma unroll
                for (int m = 0; m < 4; ++m)
#pragma unroll
                    for (int n = 0; n < 2; ++n) acc[a][b][m][n] = (f32x4){0.f, 0.f, 0.f, 0.f};
        if constexpr (Epi::HAS_INIT) E.init_apply(acc, iv);
        cur = nxt; ++ui;
        if constexpr (ALIGN_EPI) { if (wr == 1) PG8_BAR; }
    }
    PG8_WAIT_V(0);
    if constexpr (!ALIGN_EPI) { if (wr == 0) PG8_BAR; }
    PG8_BAR;
#undef PG8_SA
#undef PG8_SB
#undef PG8_GLDS
#undef PG8_STAGE_A
#undef PG8_STAGE_B
#undef PG8_LDA
#undef PG8_LDB
#undef PG8_MMA
#undef PG8_CAT
#undef PG8_LO
#undef PG8_HI
#undef PG8_WAIT_V
#undef PG8_WAIT_L
#undef PG8_BAR
#undef PG8_SCHED
}
}


constexpr int MT_OFF = 131072;
struct MoeTab { const LAS int* e_of; const LAS int* rt; const LAS float* rp; };
template <bool WITH_P> __device__ __forceinline__ int moe_tables(const Params& p, unsigned char* lds, int tid, int nN, int nb, int bid, MoeTab& mt) {
    LAS int* cnt = (LAS int*)(lds + MT_OFF); LAS int* pstart = cnt + 32; LAS int* e_of = cnt + 72; constexpr int MAXU = WITH_P ? 5 : 9;
    LAS int* rt = cnt + 112; LAS float* rp = (LAS float*)(rt + MAXU * 256);
    __syncthreads();
    if (tid < NE) cnt[tid] = __hip_atomic_load((const int*)(p.ws + WS_CTL) + CW_ECNT + 64 * tid, __ATOMIC_RELAXED, __HIP_MEMORY_SCOPE_AGENT);
    __syncthreads();
    if (tid == 0) { int st = 0; for (int e = 0; e < NE; ++e) { pstart[e] = st; st += (cnt[e] + 255) & ~255; } pstart[32] = st; }
    __syncthreads();
    const int n_mt = __builtin_amdgcn_readfirstlane(pstart[32] >> 8);
    pg8::Order O; O.init(n_mt, nN, nb, bid);
    LAS int* pm_of = cnt + 88;
    if (tid < MAXU) { pg8::Unit u; int e = 0, pm = -1;
        if (O.next(tid, u)) { pm = u.pm; for (int q = 1; q < NE; ++q) if (pm * 256 >= pstart[q]) e = q; }
        e_of[tid] = e; pm_of[tid] = pm; }
    __syncthreads();
    for (int idx = tid; idx < MAXU * 256; idx += 512) { const int i = idx >> 8, r = idx & 255, pm = pm_of[i];
        if (pm >= 0) { const int e = e_of[i]; const int pos = pm * 256 + r - pstart[e]; const bool ok = pos < cnt[e];
            rt[idx] = ok ? ((const int*)(p.ws + WS_ELIST))[e * T + pos] : -1;
            if (WITH_P) rp[idx] = ok ? ((const float*)(p.ws + WS_EP))[e * T + pos] : 0.f; } }
    __syncthreads();
    mt.e_of = e_of; mt.rt = rt; mt.rp = rp;
    return n_mt;
}
struct ProbPlain {
    static constexpr bool GATHER = false, FP8 = false;
    const bf16* A; const bf16* Bt; int K;
    __device__ __forceinline__ const bf16* abase() const { return A; }
    __device__ __forceinline__ size_t aoff(const pg8::Unit& u) const { return (size_t)u.pm * 256 * K * 2; }
    __device__ __forceinline__ unsigned goff(const pg8::Unit&, int, unsigned) const { return 0u; }
    __device__ __forceinline__ const bf16* bbase(const pg8::Unit& u) const { return Bt + (size_t)u.pn * 256 * K; }
};
struct ProbPlainOff {
    static constexpr bool GATHER = true, FP8 = false;
    const bf16* A; const bf16* Bt; int K;
    __device__ __forceinline__ const bf16* abase() const { return A; }
    __device__ __forceinline__ size_t aoff(const pg8::Unit& u) const { return (size_t)u.pm * 256 * K * 2; }
    __device__ __forceinline__ unsigned goff(const pg8::Unit& u, int h, unsigned voff) const { return (unsigned)(u.pm * 256 + h * 128) * ((unsigned)K * 2u) + voff; }
    __device__ __forceinline__ const bf16* bbase(const pg8::Unit& u) const { return Bt + (size_t)u.pn * 256 * K; }
};
struct ProbPlainF8 {
    static constexpr bool GATHER = true, FP8 = true;
    const bf16* A; const bf16* Bt; int K;
    __device__ __forceinline__ const bf16* abase() const { return A; }
    __device__ __forceinline__ size_t aoff(const pg8::Unit& u) const { return (size_t)u.pm * 256 * K * 2; }
    __device__ __forceinline__ unsigned goff(const pg8::Unit& u, int h, unsigned voff) const { return (unsigned)(u.pm * 256 + h * 128) * ((unsigned)K * 2u) + voff; }
    __device__ __forceinline__ const bf16* bbase(const pg8::Unit& u) const { return Bt + (size_t)u.pn * 256 * K; }
};
template <bool G, bool F8> struct ProbMoE {
    static constexpr bool GATHER = true, FP8 = F8;
    const bf16* A; const bf16* Bt; int K; MoeTab mt; int rows_e;
    __device__ __forceinline__ const bf16* abase() const { return A; }
    __device__ __forceinline__ size_t aoff(const pg8::Unit& u) const { return (size_t)u.pm * 256 * K * 2; }
    __device__ __forceinline__ unsigned goff(const pg8::Unit& u, int h, unsigned voff) const {
        const unsigned pitch = (unsigned)K * 2u;
        if constexpr (!G) return (unsigned)(u.pm * 256 + h * 128) * pitch + voff;
        const unsigned R = voff / pitch, inrow = voff - R * pitch;
        const int a = mt.rt[u.slot * 256 + h * 128 + (int)R]; const int row = a < 0 ? 0 : (a >> 2);
        return (unsigned)row * pitch + inrow; }
    __device__ __forceinline__ const bf16* bbase(const pg8::Unit& u) const { const int e = __builtin_amdgcn_readfirstlane(mt.e_of[u.slot]); return Bt + ((size_t)e * rows_e + (size_t)u.pn * 256) * K; }
};
struct EpiInProj {
    static constexpr bool HAS_INIT = false; static constexpr int MID_T = 0; static constexpr bool PERM = true; Params p;
    __device__ __forceinline__ void operator()(const f32x4 (&acc)[2][2][4][2], const pg8::Unit& u, int wr, int wc, int fr, int fq) const {
        unsigned char* ws = p.ws; const int pn = u.pn;
        bf16* dst; int ld, ct; int kind = 0; const float* gb = nullptr;
        if (pn < 2) { dst = (bf16*)(ws + WS_QA); ld = WA; ct = pn * 256; kind = 1; }
        else if (pn < 4) { dst = (bf16*)(ws + WS_KA); ld = WA; ct = (pn - 2) * 256; kind = 1; }
        else if (pn < 6) { dst = (bf16*)(ws + WS_VA); ld = WA; ct = (pn - 4) * 256; }
        else if (pn < 9) { dst = (bf16*)(ws + WS_QB); ld = WB; ct = (pn - 6) * 256; kind = 1; }
        else if (pn < 12) { dst = (bf16*)(ws + WS_KB); ld = WB; ct = (pn - 9) * 256; kind = 1; }
        else if (pn < 15) { dst = (bf16*)(ws + WS_VB); ld = WB; ct = (pn - 12) * 256; }
        else if (pn < 19) { dst = (bf16*)(ws + WS_SA); ld = D; ct = (pn - 15) * 256; kind = 2; gb = p.b_gate_a; }
        else { dst = (bf16*)(ws + WS_SB); ld = D; ct = (pn - 19) * 256; kind = 2; gb = p.b_gate_b; }
        const int row0 = u.pm * 256 + wr * 64 + fr, col0 = ct + wc * 32 + 8 * fq;
        f32x4 bv[2][2];
#pragma unroll
        for (int bj = 0; bj < 2; ++bj)
#pragma unroll
            for (int n = 0; n < 2; ++n) bv[bj][n] = (kind == 2) ? *(const f32x4*)(gb + col0 + bj * 128 + 4 * n) : (f32x4){0.f, 0.f, 0.f, 0.f};
        const bool dorope = (kind == 1) && ((wc & 1) == 0);
        const bool dokm = (pn == 2) || (pn == 3);
        f32x4 ks[2][2];
#pragma unroll
        for (int bj = 0; bj < 2; ++bj) { ks[bj][0] = (f32x4){0.f, 0.f, 0.f, 0.f}; ks[bj][1] = (f32x4){0.f, 0.f, 0.f, 0.f}; }
        const float sgn = (fq == 0) ? -1.0f : 1.0f; const bool rl = fq < 2;
#pragma unroll
        for (int ai = 0; ai < 2; ++ai)
#pragma unroll
            for (int m = 0; m < 4; ++m) {
                const int row = row0 + ai * 128 + m * 16;
                f32x4 cs[4];
                if (dorope) { const f32x4* rp = (const f32x4*)(ws + WS_ROPE) + (size_t)(row % S) * 4;
#pragma unroll
                    for (int i = 0; i < 4; ++i) cs[i] = rp[i]; }
                bf16* rowp = dst + (size_t)row * ld + col0;
#pragma unroll
                for (int bj = 0; bj < 2; ++bj) {
                    f32x4 v0 = acc[ai][bj][m][0], v1 = acc[ai][bj][m][1];
                    if (dorope) {
                        f32x4 q0, q1;
#pragma unroll
                        for (int j = 0; j < 4; ++j) { q0[j] = __shfl_xor(v0[j], 16); q1[j] = __shfl_xor(v1[j], 16); }
                        if (rl) {
                            v0[0] = v0[0] * cs[0][0] + sgn * q0[0] * cs[0][1]; v0[1] = v0[1] * cs[0][2] + sgn * q0[1] * cs[0][3];
                            v0[2] = v0[2] * cs[1][0] + sgn * q0[2] * cs[1][1]; v0[3] = v0[3] * cs[1][2] + sgn * q0[3] * cs[1][3];
                            v1[0] = v1[0] * cs[2][0] + sgn * q1[0] * cs[2][1]; v1[1] = v1[1] * cs[2][2] + sgn * q1[1] * cs[2][3];
                            v1[2] = v1[2] * cs[3][0] + sgn * q1[2] * cs[3][1]; v1[3] = v1[3] * cs[3][2] + sgn * q1[3] * cs[3][3]; }
                    }
                    if (dokm) { ks[bj][0] += v0; ks[bj][1] += v1; }
                    if (kind == 2) {
                        v0 = v0 + bv[bj][0]; v1 = v1 + bv[bj][1];
#pragma unroll
                        for (int j = 0; j < 4; ++j) { v0[j] = fast_sigmoid(v0[j]); v1[j] = fast_sigmoid(v1[j]); } }
                    u32x4 w; w.x = cvtpk(v0[0], v0[1]); w.y = cvtpk(v0[2], v0[3]); w.z = cvtpk(v1[0], v1[1]); w.w = cvtpk(v1[2], v1[3]);
                    *(u32x4*)(rowp + bj * 128) = w;
                }
            }
        if (dokm) {
            float* km = (float*)(ws + WS_KMEAN) + (size_t)((u.pm >> 5) * NHA * NBLK + (u.pm & 31)) * HD;
#pragma unroll
            for (int bj = 0; bj < 2; ++bj)
#pragma unroll
                for (int n = 0; n < 2; ++n)
#pragma unroll
                    for (int j = 0; j < 4; ++j) { float v = ks[bj][n][j]; v += __shfl_xor(v, 1); v += __shfl_xor(v, 2); v += __shfl_xor(v, 4); v += __shfl_xor(v, 8);
                        if (fr == 0) { const int c = col0 + bj * 128 + 4 * n + j; atomicAdd(km + (size_t)(c >> 6) * NBLK * HD + (c & 63), v * (1.0f / MBLK)); } }
        }
    }
};
template <int PASS> struct EpiMix {
    static constexpr bool HAS_INIT = false; static constexpr int MID_T = 0; static constexpr bool PERM = true; Params p;
    __device__ __forceinline__ void operator()(const f32x4 (&acc)[2][2][4][2], const pg8::Unit& u, int wr, int wc, int fr, int fq) const {
        const int row0 = u.pm * 256 + wr * 64 + fr, col0 = u.pn * 256 + wc * 32 + 8 * fq;
        const bf16* G = (const bf16*)(p.ws + (PASS == 0 ? WS_SA : WS_SB)); bf16* M = (bf16*)(p.ws + WS_MIX);
#pragma unroll
        for (int ai = 0; ai < 2; ++ai)
#pragma unroll
            for (int m = 0; m < 4; ++m) {
                const size_t ro = (size_t)(row0 + ai * 128 + m * 16) * D + col0;
#pragma unroll
                for (int bj = 0; bj < 2; ++bj) {
                    const u32x4 g = *(const u32x4*)(G + ro + bj * 128);
                    f32x4 v0 = acc[ai][bj][m][0], v1 = acc[ai][bj][m][1];
                    v0[0] *= __uint_as_float(g.x << 16); v0[1] *= __uint_as_float(g.x & 0xffff0000u); v0[2] *= __uint_as_float(g.y << 16); v0[3] *= __uint_as_float(g.y & 0xffff0000u);
                    v1[0] *= __uint_as_float(g.z << 16); v1[1] *= __uint_as_float(g.z & 0xffff0000u); v1[2] *= __uint_as_float(g.w << 16); v1[3] *= __uint_as_float(g.w & 0xffff0000u);
                    if (PASS == 1) { const u32x4 t = *(const u32x4*)(M + ro + bj * 128);
                        v0[0] += __uint_as_float(t.x << 16); v0[1] += __uint_as_float(t.x & 0xffff0000u); v0[2] += __uint_as_float(t.y << 16); v0[3] += __uint_as_float(t.y & 0xffff0000u);
                        v1[0] += __uint_as_float(t.z << 16); v1[1] += __uint_as_float(t.z & 0xffff0000u); v1[2] += __uint_as_float(t.w << 16); v1[3] += __uint_as_float(t.w & 0xffff0000u); }
                    u32x4 w; w.x = cvtpk(v0[0], v0[1]); w.y = cvtpk(v0[2], v0[3]); w.z = cvtpk(v1[0], v1[1]); w.w = cvtpk(v1[2], v1[3]);
                    *(u32x4*)(M + ro + bj * 128) = w;
                }
            }
    }
};
struct EpiMixCat {
    static constexpr bool HAS_INIT = false; static constexpr int MID_T = 8; static constexpr bool PERM = true; Params p;
    __device__ __forceinline__ void mid(f32x4 (&acc)[2][2][4][2], const pg8::Unit& u, int wr, int wc, int fr, int fq) const {
        int row0 = u.pm * 256 + wr * 64 + fr, col0 = u.pn * 256 + wc * 32 + 8 * fq;
        asm volatile("" : "+v"(row0), "+v"(col0));
        const bf16* GA = (const bf16*)(p.ws + WS_SA); const bf16* GB = (const bf16*)(p.ws + WS_SB);
#pragma unroll
        for (int ai = 0; ai < 2; ++ai)
#pragma unroll
            for (int m = 0; m < 4; ++m) {
                const size_t ro = (size_t)(row0 + ai * 128 + m * 16) * D + col0;
#pragma unroll
                for (int bj = 0; bj < 2; ++bj) {
                    const u32x4 a = *(const u32x4*)(GA + ro + bj * 128), b = *(const u32x4*)(GB + ro + bj * 128);
#pragma unroll
                    for (int j = 0; j < 4; ++j) { const float r0 = __uint_as_float(a[j] << 16) * __builtin_amdgcn_rcpf(__uint_as_float(b[j] << 16)), r1 = __uint_as_float(a[j] & 0xffff0000u) * __builtin_amdgcn_rcpf(__uint_as_float(b[j] & 0xffff0000u));
                        if (j < 2) { acc[ai][bj][m][0][2 * j] *= r0; acc[ai][bj][m][0][2 * j + 1] *= r1; } else { acc[ai][bj][m][1][2 * j - 4] *= r0; acc[ai][bj][m][1][2 * j - 3] *= r1; } }
                }
                asm volatile("" ::: "memory");
            }
    }
    __device__ __forceinline__ void operator()(const f32x4 (&acc)[2][2][4][2], const pg8::Unit& u, int wr, int wc, int fr, int fq) const {
        const int row0 = u.pm * 256 + wr * 64 + fr, col0 = u.pn * 256 + wc * 32 + 8 * fq;
        const bf16* GB = (const bf16*)(p.ws + WS_SB); bf16* M = (bf16*)(p.ws + WS_MIX);
#pragma unroll
        for (int ai = 0; ai < 2; ++ai)
#pragma unroll
            for (int m = 0; m < 4; ++m) {
                const size_t ro = (size_t)(row0 + ai * 128 + m * 16) * D + col0;
#pragma unroll
                for (int bj = 0; bj < 2; ++bj) {
                    const u32x4 g = *(const u32x4*)(GB + ro + bj * 128);
                    f32x4 v0 = acc[ai][bj][m][0], v1 = acc[ai][bj][m][1];
                    v0[0] *= __uint_as_float(g.x << 16); v0[1] *= __uint_as_float(g.x & 0xffff0000u); v0[2] *= __uint_as_float(g.y << 16); v0[3] *= __uint_as_float(g.y & 0xffff0000u);
                    v1[0] *= __uint_as_float(g.z << 16); v1[1] *= __uint_as_float(g.z & 0xffff0000u); v1[2] *= __uint_as_float(g.w << 16); v1[3] *= __uint_as_float(g.w & 0xffff0000u);
                    u32x4 w; w.x = cvtpk(v0[0], v0[1]); w.y = cvtpk(v0[2], v0[3]); w.z = cvtpk(v1[0], v1[1]); w.w = cvtpk(v1[2], v1[3]);
                    *(u32x4*)(M + ro + bj * 128) = w;
                }
            }
    }
};
struct EpiOut {
    static constexpr bool HAS_INIT = false; static constexpr int MID_T = 0; static constexpr bool PERM = false; Params p;
    __device__ __forceinline__ void operator()(const f32x4 (&acc)[2][2][4][2], const pg8::Unit& u, int wr, int wc, int fr, int fq) const {
        const int row0 = u.pm * 256 + wr * 64 + fr, col0 = u.pn * 256 + wc * 32 + 4 * fq;
#pragma unroll
        for (int ai = 0; ai < 2; ++ai)
#pragma unroll
            for (int m = 0; m < 4; ++m) { const size_t ro = (size_t)(row0 + ai * 128 + m * 16) * D + col0;
#pragma unroll
                for (int bj = 0; bj < 2; ++bj)
#pragma unroll
                    for (int n = 0; n < 2; ++n) { const size_t o = ro + bj * 128 + n * 16; *(f32x4*)(p.out + o) = *(const f32x4*)(p.x + o) + acc[ai][bj][m][n]; } }
    }
};
struct EpiGateUp {
    static constexpr bool HAS_INIT = true; static constexpr int MID_T = 0; static constexpr bool PERM = false; Params p; MoeTab mt;
    __device__ __forceinline__ void init_load(f32x4 (&iv)[2][2], const pg8::Unit& u, int wc, int fq) const {
        const int e = __builtin_amdgcn_readfirstlane(mt.e_of[u.slot]);
#pragma unroll
        for (int bj = 0; bj < 2; ++bj) { const int cc = 16 * (8 * u.pn + 4 * bj + wc) + 4 * fq; iv[bj][0] = *(const f32x4*)(p.b_gate + e * FF + cc); iv[bj][1] = *(const f32x4*)(p.b_up + e * FF + cc); }
    }
    __device__ __forceinline__ void init_apply(f32x4 (&acc)[2][2][4][2], const f32x4 (&iv)[2][2]) const {
#pragma unroll
        for (int ai = 0; ai < 2; ++ai)
#pragma unroll
            for (int bj = 0; bj < 2; ++bj)
#pragma unroll
                for (int m = 0; m < 4; ++m) { acc[ai][bj][m][0] = iv[bj][0]; acc[ai][bj][m][1] = iv[bj][1] + 1.0f; }
    }
    __device__ __forceinline__ void operator()(const f32x4 (&acc)[2][2][4][2], const pg8::Unit& u, int wr, int wc, int fr, int fq) const {
        const int row0 = u.pm * 256 + wr * 64 + fr;
#pragma unroll
        for (int ai = 0; ai < 2; ++ai)
#pragma unroll
            for (int m = 0; m < 4; ++m) {
#pragma unroll
                for (int bj = 0; bj < 2; ++bj) { const int cc = 16 * (8 * u.pn + 4 * bj + wc) + 4 * fq; const f32x4 g = acc[ai][bj][m][0], uu = acc[ai][bj][m][1]; f32x4 a;
#pragma unroll
                    for (int j = 0; j < 4; ++j) { const float gg = fminf(g[j], 7.0f), u1 = fminf(fmaxf(uu[j], -6.0f), 8.0f);
                        a[j] = gg * __builtin_amdgcn_rcpf(1.0f + __builtin_amdgcn_exp2f(-2.4554669595930156f * gg)) * u1; }
#if FP8_DN
                    int w = __builtin_amdgcn_cvt_pk_fp8_f32(a[0], a[1], 0, false); w = __builtin_amdgcn_cvt_pk_fp8_f32(a[2], a[3], w, true);
                    *(int*)((unsigned char*)(p.ws + WS_A2) + (size_t)(row0 + ai * 128 + m * 16) * FF + cc) = w;
#else
                    u32x2 w; w.x = cvtpk(a[0], a[1]); w.y = cvtpk(a[2], a[3]); *(u32x2*)((bf16*)(p.ws + WS_A2) + (size_t)(row0 + ai * 128 + m * 16) * FF + cc) = w;
#endif
                } }
    }
};
struct EpiDown {
    static constexpr bool HAS_INIT = false; static constexpr int MID_T = 0; static constexpr bool PERM = true; Params p; MoeTab mt;
    __device__ __forceinline__ void operator()(const f32x4 (&acc)[2][2][4][2], const pg8::Unit& u, int wr, int wc, int fr, int fq) const {
        const int e = __builtin_amdgcn_readfirstlane(mt.e_of[u.slot]);
        const int row0 = u.pm * 256 + wr * 64 + fr, col0 = u.pn * 256 + wc * 32 + 8 * fq;
        const float* bd = p.b_down + e * D + col0;
        int asg[2][4]; float pw[2][4];
#pragma unroll
        for (int ai = 0; ai < 2; ++ai)
#pragma unroll
            for (int m = 0; m < 4; ++m) { const int rl = u.slot * 256 + wr * 64 + fr + ai * 128 + m * 16; asg[ai][m] = mt.rt[rl]; pw[ai][m] = mt.rp[rl]; }
        f32x4 bv[2][2];
#pragma unroll
        for (int bj = 0; bj < 2; ++bj) { bv[bj][0] = *(const f32x4*)(bd + bj * 128); bv[bj][1] = *(const f32x4*)(bd + bj * 128 + 4); }
#pragma unroll
        for (int ai = 0; ai < 2; ++ai)
#pragma unroll
            for (int m = 0; m < 4; ++m) {
                if (asg[ai][m] >= 0) { bf16* rowp = (bf16*)(p.ws + WS_Y) + (size_t)asg[ai][m] * D + col0; const float pp = pw[ai][m] * (FP8_Y ? 16.0f : 1.0f);
#pragma unroll
                    for (int bj = 0; bj < 2; ++bj) { const f32x4 v0 = (acc[ai][bj][m][0] + bv[bj][0]) * pp, v1 = (acc[ai][bj][m][1] + bv[bj][1]) * pp;
#if FP8_Y
                        int w0 = __builtin_amdgcn_cvt_pk_fp8_f32(v0[0], v0[1], 0, false); w0 = __builtin_amdgcn_cvt_pk_fp8_f32(v0[2], v0[3], w0, true);
                        int w1 = __builtin_amdgcn_cvt_pk_fp8_f32(v1[0], v1[1], 0, false); w1 = __builtin_amdgcn_cvt_pk_fp8_f32(v1[2], v1[3], w1, true);
                        u32x2 w; w.x = (unsigned)w0; w.y = (unsigned)w1; *(u32x2*)((unsigned char*)(p.ws + WS_Y) + (size_t)asg[ai][m] * D + col0 + bj * 128) = w; (void)rowp;
#else
                        u32x4 w; w.x = cvtpk(v0[0], v0[1]); w.y = cvtpk(v0[2], v0[3]); w.z = cvtpk(v1[0], v1[1]); w.w = cvtpk(v1[2], v1[3]);
                        *(u32x4*)(rowp + bj * 128) = w;
#endif
                    } } }
    }
};

__device__ __forceinline__ void phase_kmean(const Params& p, int gw, int ngw, int lane) {
    for (int it = gw; it < NB * NHA * NBLK; it += ngw) {
        const int n = it % NBLK, h = (it / NBLK) % NHA, b = it / (NBLK * NHA), d = lane;
        const bf16* k = (const bf16*)(p.ws + WS_KA) + ((size_t)b * S + (size_t)n * MBLK) * WA + h * HD + d;
        float s = 0.f; for (int r = 0; r < MBLK; ++r) s += bf2f(k[(size_t)r * WA]);
        ((float*)(p.ws + WS_KMEAN))[(size_t)it * HD + d] = s * (1.0f / MBLK);
    }
}
__device__ __forceinline__ void phase_select(const Params& p, int gtid, int ngt) {
    for (int idx = gtid; idx < T * NHA; idx += ngt) {
        const int h = idx % NHA, t = idx / NHA, b = t / S, s = t % S, blk = s / MBLK;
        const bf16* q = (const bf16*)(p.ws + WS_QA) + (size_t)t * WA + h * HD;
        const float* km = (const float*)(p.ws + WS_KMEAN) + (size_t)(b * NHA + h) * NBLK * HD;
        float best0 = -INFINITY, best1 = -INFINITY, best2 = -INFINITY; int b0 = -1, b1 = -1, b2 = -1;
        for (int n = 0; n < blk; ++n) {
            float g = 0.f; for (int d = 0; d < HD; ++d) g += bf2f(q[d]) * km[n * HD + d];
            if (g > best0) { best2 = best1; b2 = b1; best1 = best0; b1 = b0; best0 = g; b0 = n; }
            else if (g > best1) { best2 = best1; b2 = b1; best1 = g; b1 = n; }
            else if (g > best2) { best2 = g; b2 = n; }
        }
        signed char* sel = (signed char*)(p.ws + WS_SEL) + (size_t)idx * 4;
        sel[0] = (signed char)b0; sel[1] = (signed char)b1; sel[2] = (signed char)b2; sel[3] = -1;
    }
}
__device__ __forceinline__ float dot64(const float* qs, const bf16* kr) {
    float a = 0.f;
    for (int d8 = 0; d8 < 8; ++d8) { float kv[8]; ldact8(kr + d8 * 8, kv);
#pragma unroll
        for (int i = 0; i < 8; ++i) a += qs[d8 * 8 + i] * kv[i]; }
    return a;
}
#define WAVE_LDS_FENCE() asm volatile("s_waitcnt lgkmcnt(0)" ::: "memory")
__device__ __forceinline__ void phase_moba_naive(const Params& p, int gw, int ngw, int lane, float* wl, bf16* oa_dst) {
    float* qs = wl; float* sc = wl + 64;
    for (int it = gw; it < T * NHA; it += ngw) {
        const int h = it % NHA, t = it / NHA, b = t / S, s = t % S, blk = s / MBLK;
        WAVE_LDS_FENCE();
        qs[lane] = bf2f(((const bf16*)(p.ws + WS_QA))[(size_t)t * WA + h * HD + lane]);
        WAVE_LDS_FENCE();
        const signed char* sel = (const signed char*)(p.ws + WS_SEL) + ((size_t)t * NHA + h) * 4;
        const int kb0 = blk, kb1 = sel[0], kb2 = sel[1], kb3 = sel[2];
        const bf16* K = (const bf16*)(p.ws + WS_KA) + (size_t)b * S * WA + h * HD; const bf16* V = (const bf16*)(p.ws + WS_VA) + (size_t)b * S * WA + h * HD;
        float mx = -INFINITY;
        for (int g = 0; g < 4; ++g) { const int kbg = g == 0 ? kb0 : g == 1 ? kb1 : g == 2 ? kb2 : kb3;
            for (int c = 0; c < 4; ++c) {
                const int kk = c * 64 + lane; float v = -INFINITY;
                if (kbg >= 0) { const int key = kbg * MBLK + kk; if (g > 0 || key <= s) v = dot64(qs, K + (size_t)key * WA) * 0.125f; }
                sc[g * 256 + kk] = v; mx = fmaxf(mx, v);
            } }
#pragma unroll
        for (int o = 1; o < 64; o <<= 1) mx = fmaxf(mx, __shfl_xor(mx, o));
        WAVE_LDS_FENCE();
        float l = 0.f;
        for (int i = lane; i < 1024; i += 64) { const float e = (sc[i] == -INFINITY) ? 0.f : expf(sc[i] - mx); sc[i] = e; l += e; }
        l = wave_sum(l);
        WAVE_LDS_FENCE();
        float o = 0.f;
        for (int g = 0; g < 4; ++g) { const int kbg = g == 0 ? kb0 : g == 1 ? kb1 : g == 2 ? kb2 : kb3; if (kbg < 0) continue;
            for (int kk = 0; kk < 256; ++kk) { const float pr = sc[g * 256 + kk]; if (pr != 0.f) o += pr * bf2f(V[(size_t)(kbg * MBLK + kk) * WA + lane]); } }
        oa_dst[(size_t)t * WA + h * HD + lane] = (bf16)f2bf(o / l);
    }
}
__device__ __forceinline__ void phase_dil_naive(const Params& p, int gw, int ngw, int lane, float* wl, bf16* ob_dst) {
    float* qs = wl; float* sc = wl + 192;
    for (int it = gw; it < T * 4; it += ngw) {
        const int j = it % 4, t = it / 4, b = t / S, s = t % S;
        WAVE_LDS_FENCE();
        for (int g = 0; g < 3; ++g) qs[g * 64 + lane] = bf2f(((const bf16*)(p.ws + WS_QB))[(size_t)t * WB + (4 * g + j) * HD + lane]);
        WAVE_LDS_FENCE();
        float mx = -INFINITY;
        for (int g = 0; g < 3; ++g) { const int dl = g == 0 ? 1 : g == 1 ? 4 : 16; const bf16* K = (const bf16*)(p.ws + WS_KB) + (size_t)b * S * WB + (4 * g + j) * HD;
            for (int i = lane; i <= 128; i += 64) { const int key = s - i * dl; float v = -INFINITY;
                if (key >= 0) v = dot64(qs + g * 64, K + (size_t)key * WB) * 0.125f;
                sc[g * 129 + i] = v; mx = fmaxf(mx, v); } }
#pragma unroll
        for (int o = 1; o < 64; o <<= 1) mx = fmaxf(mx, __shfl_xor(mx, o));
        WAVE_LDS_FENCE();
        float l = 0.f;
        for (int i = lane; i < 3 * 129; i += 64) { const float e = (sc[i] == -INFINITY) ? 0.f : expf(sc[i] - mx); sc[i] = e; l += e; }
        l = wave_sum(l);
        WAVE_LDS_FENCE();
        float o = 0.f;
        for (int g = 0; g < 3; ++g) { const int dl = g == 0 ? 1 : g == 1 ? 4 : 16; const bf16* V = (const bf16*)(p.ws + WS_VB) + (size_t)b * S * WB + (4 * g + j) * HD;
            for (int i = 0; i <= 128; ++i) { const float pr = sc[g * 129 + i]; const int key = s - i * dl; if (key >= 0 && pr != 0.f) o += pr * bf2f(V[(size_t)key * WB + lane]); } }
        ob_dst[(size_t)t * WBO + j * HD + lane] = (bf16)f2bf(o / l);
    }
}

__device__ __forceinline__ void phase_router(const Params& p, int bid, int nb, unsigned char* lds, int tid) {
    const int lane = tid & 63, w = tid >> 6, h = lane >> 5, r32 = lane & 31;
    float* part = (float*)lds;
    float* ssqp = (float*)(lds + 65536);
    float* rstd_s = (float*)(lds + 65536 + 2048);
    int4* rec = (int4*)(lds + 65536 + 4096);
    int* lc = (int*)(lds + 65536 + 8192); int* gbase = lc + 32;
    bf16x8v whi[8], wlo[8];
#pragma unroll
    for (int sidx = 0; sidx < 8; ++sidx) { const int k0 = 128 * w + 16 * sidx + 8 * h; float wv[8];
        const f32x4 g0 = *(const f32x4*)(p.ln_ffn_g + k0), g1 = *(const f32x4*)(p.ln_ffn_g + k0 + 4);
#pragma unroll
        for (int j = 0; j < 8; ++j) wv[j] = p.w_router[(size_t)(k0 + j) * NE + r32] * (j < 4 ? g0[j] : g1[j - 4]);
        u32x4 hi, lo;
#pragma unroll
        for (int j = 0; j < 4; ++j) { const unsigned hp = cvtpk(wv[2 * j], wv[2 * j + 1]); hi[j] = hp;
            lo[j] = cvtpk(wv[2 * j] - __uint_as_float(hp << 16), wv[2 * j + 1] - __uint_as_float(hp & 0xffff0000u)); }
        whi[sidx] = __builtin_bit_cast(bf16x8v, hi); wlo[sidx] = __builtin_bit_cast(bf16x8v, lo); }
    for (int tg = bid; tg < T / 64; tg += nb) {
        __syncthreads();
        if (tid < 256) rec[tid] = make_int4(-1, 0, 0, 0);
        if (tid < 32) lc[tid] = 0;
#pragma unroll
        for (int tt = 0; tt < 2; ++tt) {
            const float* xr = p.out + (size_t)(tg * 64 + 32 * tt + r32) * D + 128 * w + 8 * h;
            f32x16 acc = {0.f, 0.f, 0.f, 0.f, 0.f, 0.f, 0.f, 0.f, 0.f, 0.f, 0.f, 0.f, 0.f, 0.f, 0.f, 0.f}; float ssq = 0.f;
#pragma unroll
            for (int sidx = 0; sidx < 8; ++sidx) { const f32x4 x0 = *(const f32x4*)(xr + 16 * sidx), x1 = *(const f32x4*)(xr + 16 * sidx + 4);
                ssq += (x0.x * x0.x + x0.y * x0.y) + (x0.z * x0.z + x0.w * x0.w) + (x1.x * x1.x + x1.y * x1.y) + (x1.z * x1.z + x1.w * x1.w);
                u32x4 hi, lo;
                hi.x = cvtpk(x0.x, x0.y); hi.y = cvtpk(x0.z, x0.w); hi.z = cvtpk(x1.x, x1.y); hi.w = cvtpk(x1.z, x1.w);
                lo.x = cvtpk(x0.x - __uint_as_float(hi.x << 16), x0.y - __uint_as_float(hi.x & 0xffff0000u)); lo.y = cvtpk(x0.z - __uint_as_float(hi.y << 16), x0.w - __uint_as_float(hi.y & 0xffff0000u));
                lo.z = cvtpk(x1.x - __uint_as_float(hi.z << 16), x1.y - __uint_as_float(hi.z & 0xffff0000u)); lo.w = cvtpk(x1.z - __uint_as_float(hi.w << 16), x1.w - __uint_as_float(hi.w & 0xffff0000u));
                const bf16x8v xh = __builtin_bit_cast(bf16x8v, hi), xl = __builtin_bit_cast(bf16x8v, lo);
                acc = __builtin_amdgcn_mfma_f32_32x32x16_bf16(xh, whi[sidx], acc, 0, 0, 0);
                acc = __builtin_amdgcn_mfma_f32_32x32x16_bf16(xh, wlo[sidx], acc, 0, 0, 0);
                acc = __builtin_amdgcn_mfma_f32_32x32x16_bf16(xl, whi[sidx], acc, 0, 0, 0); }
#pragma unroll
            for (int r = 0; r < 16; ++r) part[(w * 64 + 32 * tt + crow(r, h)) * 32 + r32] = acc[r];
            ssq += __shfl_xor(ssq, 32);
            if (h == 0) ssqp[w * 64 + 32 * tt + r32] = ssq;
        }
        __syncthreads();
        if (tid < 64) {
            const int t = tg * 64 + tid;
            float sq = 0.f;
#pragma unroll
            for (int i = 0; i < 8; ++i) sq += ssqp[i * 64 + tid];
            const float rstd = 1.0f / sqrtf(sq * (1.0f / D) + NORM_EPS); rstd_s[tid] = rstd;
            float v0 = -INFINITY, v1 = -INFINITY, v2 = -INFINITY, v3 = -INFINITY; int e0 = 0, e1 = 0, e2 = 0, e3 = 0;
            for (int e = 0; e < NE; ++e) { float a = 0.f;
#pragma unroll
                for (int i = 0; i < 8; ++i) a += part[(i * 64 + tid) * 32 + ((e + tid) & 31)];
                const int ee = (e + tid) & 31; const float lg = a * rstd + p.b_router[ee];
                if (lg > v0 || (lg == v0 && ee < e0)) { v3 = v2; e3 = e2; v2 = v1; e2 = e1; v1 = v0; e1 = e0; v0 = lg; e0 = ee; }
                else if (lg > v1 || (lg == v1 && ee < e1)) { v3 = v2; e3 = e2; v2 = v1; e2 = e1; v1 = lg; e1 = ee; }
                else if (lg > v2 || (lg == v2 && ee < e2)) { v3 = v2; e3 = e2; v2 = lg; e2 = ee; }
                else if (lg > v3 || (lg == v3 && ee < e3)) { v3 = lg; e3 = ee; } }
            const float x1 = expf(v1 - v0), x2 = expf(v2 - v0), x3 = expf(v3 - v0); const float inv = 1.0f / (1.0f + x1 + x2 + x3);
            { const int lp = atomicAdd(&lc[e0], 1); rec[tid * 4 + 0] = make_int4(e0, lp, t * 4 + 0, __float_as_int(inv)); }
            { const int lp = atomicAdd(&lc[e1], 1); rec[tid * 4 + 1] = make_int4(e1, lp, t * 4 + 1, __float_as_int(x1 * inv)); }
            { const int lp = atomicAdd(&lc[e2], 1); rec[tid * 4 + 2] = make_int4(e2, lp, t * 4 + 2, __float_as_int(x2 * inv)); }
            { const int lp = atomicAdd(&lc[e3], 1); rec[tid * 4 + 3] = make_int4(e3, lp, t * 4 + 3, __float_as_int(x3 * inv)); }
        }
        __syncthreads();
        if (tid < NE) gbase[tid] = lc[tid] > 0 ? atomicAdd((int*)(p.ws + WS_CTL) + CW_ECNT + 64 * tid, lc[tid]) : 0;
        for (int idx = tid; idx < 64 * 256; idx += 512) { const int tk = idx >> 8, c4 = idx & 255; const size_t t = (size_t)tg * 64 + tk;
            const f32x4 x = *(const f32x4*)(p.out + t * D + 4 * c4), g = *(const f32x4*)(p.ln_ffn_g + 4 * c4); const float rs = rstd_s[tk];
            const float h0 = x.x * rs * g.x, h1 = x.y * rs * g.y, h2 = x.z * rs * g.z, h3 = x.w * rs * g.w;
#if FP8_GU
            int o = __builtin_amdgcn_cvt_pk_fp8_f32(h0, h1, 0, false); o = __builtin_amdgcn_cvt_pk_fp8_f32(h2, h3, o, true); ((int*)((unsigned char*)(p.ws + WS_H) + t * D))[c4] = o;
#else
            u32x2 o; o.x = cvtpk(h0, h1); o.y = cvtpk(h2, h3); ((u32x2*)((bf16*)(p.ws + WS_H) + t * D))[c4] = o;
#endif
        }
        __syncthreads();
        if (tid < 256) { const int4 r = rec[tid]; if (r.x >= 0) { const int pos = gbase[r.x] + r.y; ((int*)(p.ws + WS_ELIST))[r.x * T + pos] = r.z; ((float*)(p.ws + WS_EP))[r.x * T + pos] = __int_as_float(r.w); } }
    }
}
__device__ __forceinline__ void phase_final(const Params& p, int gw, int ngw, int lane) {
    for (int t = gw; t < T; t += ngw) {
        f32x4* xr = (f32x4*)(p.out + (size_t)t * D) + lane; const f32x4* gr = (const f32x4*)p.ln_final_g + lane;
        f32x4 v[4]; float ss = 0.f;
#pragma unroll
        for (int j = 0; j < 4; ++j) { v[j] = xr[64 * j];
#pragma unroll
            for (int k = 0; k < 4; ++k) {
#if FP8_Y
                const int y = ((const int*)((const unsigned char*)(p.ws + WS_Y) + ((size_t)t * 4 + k) * D))[lane + 64 * j];
                const f32x2 y01 = __builtin_amdgcn_cvt_pk_f32_fp8(y, false), y23 = __builtin_amdgcn_cvt_pk_f32_fp8(y, true);
                v[j].x += y01.x * 0.0625f; v[j].y += y01.y * 0.0625f; v[j].z += y23.x * 0.0625f; v[j].w += y23.y * 0.0625f;
#else
                const u32x2 y = ((const u32x2*)((const bf16*)(p.ws + WS_Y) + ((size_t)t * 4 + k) * D))[lane + 64 * j];
                v[j].x += __uint_as_float(y.x << 16); v[j].y += __uint_as_float(y.x & 0xffff0000u); v[j].z += __uint_as_float(y.y << 16); v[j].w += __uint_as_float(y.y & 0xffff0000u);
#endif
            }
            ss += (v[j].x * v[j].x + v[j].y * v[j].y) + (v[j].z * v[j].z + v[j].w * v[j].w); }
        float rstd = 1.0f / sqrtf(wave_sum(ss) * (1.0f / D) + NORM_EPS);
#if DBG
        { const float num = ((const float*)(p.ws + WS_CTL))[CW_DNUM], den = ((const float*)(p.ws + WS_CTL))[CW_DDEN]; rstd *= 1.0f + DBG_GAIN * sqrtf(num / fmaxf(den, 1e-30f)); }
#endif
#if TIMEB_LO >= 0
        { const unsigned long long* ts = (const unsigned long long*)(p.ws + WS_CTL + 917504); rstd *= 1.0f + TIMEB_GAIN * (float)(ts[TIMEB_HI] - ts[TIMEB_LO]) * 1e-6f; }
#endif
#pragma unroll
        for (int j = 0; j < 4; ++j) { const f32x4 g = gr[64 * j]; f32x4 o; o.x = v[j].x * rstd * g.x; o.y = v[j].y * rstd * g.y; o.z = v[j].z * rstd * g.z; o.w = v[j].w * rstd * g.w; xr[64 * j] = o; }
    }
}


#define LDSP __attribute__((address_space(3)))
#define LDS_BARRIER() do { asm volatile("s_waitcnt lgkmcnt(0)" ::: "memory"); __builtin_amdgcn_s_barrier(); asm volatile("" ::: "memory"); } while (0)
constexpr int AT_RS = 144;
constexpr int AT_KOFF = 0, AT_VOFF = 384 * AT_RS, AT_PFX = 131072;
constexpr float AT_C = 0.125f * 1.4426950408889634f;
__device__ __forceinline__ s16x4 vtr(unsigned addr) { return __builtin_bit_cast(s16x4, __builtin_amdgcn_ds_read_tr16_b64_v4i16((LDSP s16x4*)(uintptr_t)addr)); }

struct AttnState { f32x16 o0, o1; float m, l; };
template <bool MASKED> __device__ __forceinline__ void attn_wave(AttnState& st, const bf16x8v (&qf)[4], unsigned kbase, unsigned vbase, int c0, int c1, int clo, int chi, int lane) {
    const int h = lane >> 5, ql = lane & 31;
    if (c0 >= c1) return;
    bf16x8v kf[4];
    { const unsigned ka = kbase + (unsigned)c0 * (32 * AT_RS);
#pragma unroll
      for (int ks = 0; ks < 4; ++ks) kf[ks] = *(const LDSP bf16x8v*)(uintptr_t)(ka + ks * 32); }
#pragma unroll 1
    for (int c = c0; c < c1; ++c) {
        const unsigned va = vbase + (unsigned)c * (32 * AT_RS);
        s16x4 vlo[2][2], vhi[2][2];
#pragma unroll
        for (int ks = 0; ks < 2; ++ks)
#pragma unroll
            for (int db = 0; db < 2; ++db) { vlo[ks][db] = vtr(va + ks * (16 * AT_RS) + db * 64); vhi[ks][db] = vtr(va + ks * (16 * AT_RS) + 8 * AT_RS + db * 64); }
        f32x16 s = {0.f, 0.f, 0.f, 0.f, 0.f, 0.f, 0.f, 0.f, 0.f, 0.f, 0.f, 0.f, 0.f, 0.f, 0.f, 0.f};
#pragma unroll
        for (int ks = 0; ks < 4; ++ks) s = __builtin_amdgcn_mfma_f32_32x32x16_bf16(kf[ks], qf[ks], s, 0, 0, 0);
        { const unsigned kn = kbase + (unsigned)((c + 1 < c1) ? c + 1 : c) * (32 * AT_RS);
#pragma unroll
          for (int ks = 0; ks < 4; ++ks) kf[ks] = *(const LDSP bf16x8v*)(uintptr_t)(kn + ks * 32); }
        float t[16]; float cmax = -INFINITY;
#pragma unroll
        for (int r = 0; r < 16; ++r) { t[r] = s[r];
            if (MASKED) { const int cr = crow(r, h); if ((c == clo && cr < ql) || (c == chi && cr > ql)) t[r] = -INFINITY; }
            cmax = fmaxf(cmax, t[r]); }
        cmax = fmaxf(cmax, __shfl_xor(cmax, 32)) * AT_C;
        const float mn = fmaxf(st.m, cmax); const float mu = (mn == -INFINITY) ? 0.f : mn;
        const float alpha = __builtin_amdgcn_exp2f(st.m - mu);
        float psum = 0.f; float pr[16];
#pragma unroll
        for (int r = 0; r < 16; ++r) { pr[r] = __builtin_amdgcn_exp2f(__builtin_fmaf(t[r], AT_C, -mu)); psum += pr[r]; }
        st.l = st.l * alpha + psum; st.m = mn;
        if (!__all(alpha == 1.0f)) {
#pragma unroll
            for (int r = 0; r < 16; ++r) { st.o0[r] *= alpha; st.o1[r] *= alpha; } }
#pragma unroll
        for (int ks = 0; ks < 2; ++ks) {
            u32x4 pw; pw.x = cvtpk(pr[8 * ks + 0], pr[8 * ks + 1]); pw.y = cvtpk(pr[8 * ks + 2], pr[8 * ks + 3]); pw.z = cvtpk(pr[8 * ks + 4], pr[8 * ks + 5]); pw.w = cvtpk(pr[8 * ks + 6], pr[8 * ks + 7]);
            const bf16x8v pf = __builtin_bit_cast(bf16x8v, pw);
            const bf16x8v vf0 = {vlo[ks][0][0], vlo[ks][0][1], vlo[ks][0][2], vlo[ks][0][3], vhi[ks][0][0], vhi[ks][0][1], vhi[ks][0][2], vhi[ks][0][3]};
            const bf16x8v vf1 = {vlo[ks][1][0], vlo[ks][1][1], vlo[ks][1][2], vlo[ks][1][3], vhi[ks][1][0], vhi[ks][1][1], vhi[ks][1][2], vhi[ks][1][3]};
            st.o0 = __builtin_amdgcn_mfma_f32_32x32x16_bf16(vf0, pf, st.o0, 0, 0, 0);
            st.o1 = __builtin_amdgcn_mfma_f32_32x32x16_bf16(vf1, pf, st.o1, 0, 0, 0);
        }
    }
}
__device__ __forceinline__ void attn_init(AttnState& st) {
#pragma unroll
    for (int r = 0; r < 16; ++r) { st.o0[r] = 0.f; st.o1[r] = 0.f; }
    st.m = -INFINITY; st.l = 0.f;
}
__device__ __forceinline__ void attn_stage(unsigned char* lds, int dst, const unsigned char* src, size_t pitch, int nrows, int skip, int tid) {
    for (int idx = tid; idx < nrows * 8; idx += 512) { const int row = idx >> 3, ch = idx & 7;
        if (row >= skip) { const u32x4 v = *(const u32x4*)(src + (size_t)row * pitch + ch * 16); *(u32x4*)(lds + dst + row * AT_RS + ch * 16) = v; } }
}
__device__ __forceinline__ void attn_qload(bf16x8v (&qf)[4], const bf16* qrow, int h) {
#pragma unroll
    for (int ks = 0; ks < 4; ++ks) qf[ks] = *(const bf16x8v*)(qrow + 16 * ks + 8 * h);
}
__device__ __forceinline__ void attn_store_partial(const AttnState& st, float inv_l, bf16* dst, int h) {
#pragma unroll
    for (int rg = 0; rg < 4; ++rg) {
        u32x2 w0, w1; w0.x = cvtpk(st.o0[4 * rg] * inv_l, st.o0[4 * rg + 1] * inv_l); w0.y = cvtpk(st.o0[4 * rg + 2] * inv_l, st.o0[4 * rg + 3] * inv_l);
        w1.x = cvtpk(st.o1[4 * rg] * inv_l, st.o1[4 * rg + 1] * inv_l); w1.y = cvtpk(st.o1[4 * rg + 2] * inv_l, st.o1[4 * rg + 3] * inv_l);
        *(u32x2*)(dst + 8 * rg + 4 * h) = w0; *(u32x2*)(dst + 32 + 8 * rg + 4 * h) = w1; }
}
__device__ __forceinline__ void attn_acc_partial(f32x16& a0, f32x16& a1, float w, const bf16* src, int h) {
#pragma unroll
    for (int rg = 0; rg < 4; ++rg) { const u32x2 w0 = *(const u32x2*)(src + 8 * rg + 4 * h), w1 = *(const u32x2*)(src + 32 + 8 * rg + 4 * h);
        a0[4 * rg] += w * __uint_as_float(w0.x << 16); a0[4 * rg + 1] += w * __uint_as_float(w0.x & 0xffff0000u); a0[4 * rg + 2] += w * __uint_as_float(w0.y << 16); a0[4 * rg + 3] += w * __uint_as_float(w0.y & 0xffff0000u);
        a1[4 * rg] += w * __uint_as_float(w1.x << 16); a1[4 * rg + 1] += w * __uint_as_float(w1.x & 0xffff0000u); a1[4 * rg + 2] += w * __uint_as_float(w1.y << 16); a1[4 * rg + 3] += w * __uint_as_float(w1.y & 0xffff0000u); }
}


template <int NIT> struct KVRegs { u32x4 k[NIT], v[NIT]; };
template <int NIT> __device__ __forceinline__ void kv_load(KVRegs<NIT>& R, const unsigned char* ksrc, const unsigned char* vsrc, size_t pitch, int skip, int tid) {
#pragma unroll
    for (int i = 0; i < NIT; ++i) { const int idx = tid + 512 * i, row = idx >> 3, ch = idx & 7;
        if (row >= skip) { R.k[i] = *(const u32x4*)(ksrc + (size_t)row * pitch + ch * 16); R.v[i] = *(const u32x4*)(vsrc + (size_t)row * pitch + ch * 16); } }
}
template <int NIT> __device__ __forceinline__ void kv_commit(const KVRegs<NIT>& R, unsigned char* lds, int skip, int tid) {
#pragma unroll
    for (int i = 0; i < NIT; ++i) { const int idx = tid + 512 * i, row = idx >> 3, ch = idx & 7;
        if (row >= skip) { *(u32x4*)(lds + AT_KOFF + row * AT_RS + ch * 16) = R.k[i]; *(u32x4*)(lds + AT_VOFF + row * AT_RS + ch * 16) = R.v[i]; } }
}
__device__ __forceinline__ void phase_select_lists(const Params& p, int bid, int nb, unsigned char* lds, int tid) {
    float* km = (float*)lds;
    for (int it = bid; it < NB * NBLK * 4; it += nb) {
        const int hp = it & 3, n = (it >> 2) % NBLK, b = it / (4 * NBLK);
        __syncthreads();
        for (int i = tid; i < 2 * NBLK * HD; i += 512) { const int hh = i / (NBLK * HD), rest = i % (NBLK * HD); km[i] = ((const float*)(p.ws + WS_KMEAN))[(size_t)(b * NHA + 2 * hp + hh) * NBLK * HD + rest]; }
        __syncthreads();
        const int hh = tid >> 8, h = 2 * hp + hh, s = n * MBLK + (tid & 255), t = b * S + s;
        float q[HD];
        { const u32x4* qp = (const u32x4*)((const bf16*)(p.ws + WS_QA) + (size_t)t * WA + h * HD);
#pragma unroll
            for (int i = 0; i < 8; ++i) { const u32x4 v = qp[i];
#pragma unroll
                for (int j = 0; j < 4; ++j) { q[8 * i + 2 * j] = __uint_as_float(v[j] << 16); q[8 * i + 2 * j + 1] = __uint_as_float(v[j] & 0xffff0000u); } } }
        float best0 = -INFINITY, best1 = -INFINITY, best2 = -INFINITY; int b0 = -1, b1 = -1, b2 = -1;
        const float* kmh = km + hh * (NBLK * HD);
        for (int nn = 0; nn < n; ++nn) {
            float g = 0.f;
#pragma unroll
            for (int d4 = 0; d4 < 16; ++d4) { const f32x4 kv = *(const f32x4*)(kmh + nn * HD + 4 * d4); g += q[4 * d4] * kv.x; g += q[4 * d4 + 1] * kv.y; g += q[4 * d4 + 2] * kv.z; g += q[4 * d4 + 3] * kv.w; }
            if (g > best0) { best2 = best1; b2 = b1; best1 = best0; b1 = b0; best0 = g; b0 = nn; }
            else if (g > best1) { best2 = best1; b2 = b1; best1 = g; b1 = nn; }
            else if (g > best2) { best2 = g; b2 = nn; }
        }
        signed char* sel = (signed char*)(p.ws + WS_SEL) + ((size_t)t * NHA + h) * 4;
        *(unsigned*)sel = (unsigned)(b0 & 0xff) | ((unsigned)(b1 & 0xff) << 8) | ((unsigned)(b2 & 0xff) << 16) | 0xff000000u;
        int* lc = (int*)(lds + 32768); int* gb = lc + 64;
        if (tid < 64) lc[tid] = 0;
        __syncthreads();
        int lp0 = 0, lp1 = 0, lp2 = 0;
        if (b0 >= 0) lp0 = atomicAdd(&lc[hh * 32 + b0], 1);
        if (b1 >= 0) lp1 = atomicAdd(&lc[hh * 32 + b1], 1);
        if (b2 >= 0) lp2 = atomicAdd(&lc[hh * 32 + b2], 1);
        __syncthreads();
        if (tid < 64) { const int c = lc[tid]; gb[tid] = c > 0 ? atomicAdd((int*)(p.ws + WS_CTL) + CW_LCNT + (b * NHA + 2 * hp + (tid >> 5)) * NBLK + (tid & 31), c) : 0; }
        __syncthreads();
        unsigned short* lists = (unsigned short*)(p.ws + WS_LIST) + (size_t)(b * NHA + h) * NBLK * LIST_CAP;
        if (b0 >= 0) lists[(size_t)b0 * LIST_CAP + gb[hh * 32 + b0] + lp0] = (unsigned short)(s | (0 << 13));
        if (b1 >= 0) lists[(size_t)b1 * LIST_CAP + gb[hh * 32 + b1] + lp1] = (unsigned short)(s | (1 << 13));
        if (b2 >= 0) lists[(size_t)b2 * LIST_CAP + gb[hh * 32 + b2] + lp2] = (unsigned short)(s | (2 << 13));
    }
}
__device__ __forceinline__ void phase_dilated(const Params& p, int bid, int nb, unsigned char* lds, int tid) {
    const int lane = tid & 63, w = tid >> 6, h = lane >> 5, ql = lane & 31;
    const unsigned lb = (unsigned)(uintptr_t)lds;
    constexpr int NITM = NB * NHB * 32;
    KVRegs<6> R;
#define DIL_DECODE(it_) const int sub = (it_) & 31, head = ((it_) >> 5) % NHB, b = (it_) / (32 * NHB), g = head >> 2, j = head & 3; \
        const int dl = g == 0 ? 1 : g == 1 ? 4 : 16, r = sub % dl, np = sub / dl; const size_t pitch = (size_t)dl * WB * 2; \
        const long tok0 = (long)b * S + (long)(128 * (2 * np - 1)) * dl + r; const int wq = w & 3, nq = 2 * np + (w >> 2); \
        const size_t tq = (size_t)b * S + (size_t)(128 * nq + 32 * wq + ql) * dl + r; (void)j; (void)pitch; (void)tok0; (void)tq; (void)nq; (void)wq;
    int it = bid;
    if (it < NITM) { DIL_DECODE(it)
        kv_load<6>(R, (const unsigned char*)((const bf16*)(p.ws + WS_KB) + tok0 * WB + head * HD), (const unsigned char*)((const bf16*)(p.ws + WS_VB) + tok0 * WB + head * HD), pitch, np == 0 ? 128 : 0, tid); }
    while (it < NITM) {
        DIL_DECODE(it)
        bf16x8v qf[4]; attn_qload(qf, (const bf16*)(p.ws + WS_QB) + tq * WB + head * HD, h);
        LDS_BARRIER();
        kv_commit<6>(R, lds, np == 0 ? 128 : 0, tid);
        LDS_BARRIER();
        const int nit = it + nb;
        if (nit < NITM) { const int it2 = nit; const int sub2 = it2 & 31, head2 = (it2 >> 5) % NHB, b2 = it2 / (32 * NHB), g2 = head2 >> 2; const int dl2 = g2 == 0 ? 1 : g2 == 1 ? 4 : 16, r2 = sub2 % dl2, np2 = sub2 / dl2;
            const size_t pitch2 = (size_t)dl2 * WB * 2; const long tok02 = (long)b2 * S + (long)(128 * (2 * np2 - 1)) * dl2 + r2;
            kv_load<6>(R, (const unsigned char*)((const bf16*)(p.ws + WS_KB) + tok02 * WB + head2 * HD), (const unsigned char*)((const bf16*)(p.ws + WS_VB) + tok02 * WB + head2 * HD), pitch2, np2 == 0 ? 128 : 0, tid); }
        const int winoff = 128 * (w >> 2);
        AttnState st; attn_init(st);
        const unsigned kbase = lb + AT_KOFF + (unsigned)(winoff + ql) * AT_RS + 16 * h;
        const unsigned vbase = lb + AT_VOFF + (unsigned)(winoff + 4 * h + ((lane & 15) >> 2)) * AT_RS + 32 * ((lane >> 4) & 1) + 8 * (lane & 3);
        const int c0 = (nq == 0) ? 4 : wq;
        attn_wave<true>(st, qf, kbase, vbase, c0, wq + 5, wq, wq + 4, lane);
        const float lt = st.l + __shfl_xor(st.l, 32);
        bf16* dst = (bf16*)(p.ws + WS_PARTB) + (((size_t)g * T + tq) * 4 + j) * HD;
        attn_store_partial(st, 1.0f / lt, dst, h);
        if (h == 0) ((float*)(p.ws + WS_LSEB))[((size_t)g * T + tq) * 4 + j] = st.m + __builtin_amdgcn_logf(lt);
        it = nit;
    }
#undef DIL_DECODE
}
__device__ __forceinline__ void phase_moba_past(const Params& p, int bid, int nb, unsigned char* lds, int tid) {
    const int lane = tid & 63, w = tid >> 6, h = lane >> 5, ql = lane & 31;
    const unsigned lb = (unsigned)(uintptr_t)lds;
    unsigned* pfx = (unsigned*)(lds + AT_PFX);
    int* cntl = (int*)(lds + AT_PFX + 4096);
    const int* lcnt = (const int*)(p.ws + WS_CTL) + CW_LCNT;
    { const int c = __hip_atomic_load(lcnt + tid, __ATOMIC_RELAXED, __HIP_MEMORY_SCOPE_AGENT); unsigned v = (unsigned)((c + 255) >> 8); cntl[tid] = c;
#pragma unroll
      for (int o = 1; o < 64; o <<= 1) { const unsigned u = __shfl_up(v, o); if (lane >= o) v += u; }
      unsigned* wtot = pfx + 520;
      if (lane == 63) wtot[w] = v;
      __syncthreads();
      unsigned base = 0;
#pragma unroll
      for (int i = 0; i < 8; ++i) if (i < w) base += wtot[i];
      pfx[tid + 1] = v + base; if (tid == 0) pfx[0] = 0; }
    __syncthreads();
    const int ntot = (int)pfx[512];
    const int q_ = ntot / nb, r_ = ntot % nb; const int it0 = bid * q_ + (bid < r_ ? bid : r_), nit = q_ + (bid < r_ ? 1 : 0);
    int* itab = (int*)(lds + AT_PFX + 12288);
    if (tid < 32) { const int it_ = it0 + tid; int li_ = -1, tile_ = 0, cnt_ = 0;
        if (tid < nit) { int lo_ = 0, hi_ = 512; while (hi_ - lo_ > 1) { const int mid_ = (lo_ + hi_) >> 1; if ((int)pfx[mid_] <= it_) lo_ = mid_; else hi_ = mid_; }
            li_ = lo_; cnt_ = cntl[lo_]; tile_ = it_ - (int)pfx[lo_]; }
        itab[tid * 4] = li_; itab[tid * 4 + 1] = tile_; itab[tid * 4 + 2] = cnt_; }
    __syncthreads();
    KVRegs<4> R; bf16x8v qn[4];
#define PAST_ENT(k_, li_, tile_, cnt_, ent_) do { li_ = itab[(k_) * 4]; tile_ = itab[(k_) * 4 + 1]; cnt_ = itab[(k_) * 4 + 2]; \
        ent_ = ((const unsigned short*)(p.ws + WS_LIST))[(size_t)li_ * LIST_CAP + tile_ * 256 + 32 * w + ql]; } while (0)
#define PAST_KV(li_) do { const int jb_ = (li_) & 31, hd_ = ((li_) >> 5) & 7, b_ = (li_) >> 8; const size_t row0_ = (size_t)b_ * S + (size_t)jb_ * MBLK; \
        kv_load<4>(R, (const unsigned char*)((const bf16*)(p.ws + WS_KA) + row0_ * WA + hd_ * HD), (const unsigned char*)((const bf16*)(p.ws + WS_VA) + row0_ * WA + hd_ * HD), (size_t)WA * 2, 0, tid); } while (0)
#define PAST_Q(li_, ent_) do { const int hd_ = ((li_) >> 5) & 7, b_ = (li_) >> 8; attn_qload(qn, (const bf16*)(p.ws + WS_QA) + ((size_t)b_ * S + ((ent_) & 8191)) * WA + hd_ * HD, h); } while (0)
    int liA = -1, tileA = 0, cntA = 0; unsigned entA = 0; int liB = -1, tileB = 0, cntB = 0; unsigned entB = 0;
    int lds_li = -1;
    if (nit > 0) { PAST_ENT(0, liA, tileA, cntA, entA); PAST_KV(liA); PAST_Q(liA, entA); }
    if (nit > 1) PAST_ENT(1, liB, tileB, cntB, entB);
    for (int k = 0; k < nit; ++k) {
        if (liA != lds_li) { LDS_BARRIER(); kv_commit<4>(R, lds, 0, tid); LDS_BARRIER(); lds_li = liA; }
        const int li = liA, tile = tileA, cnt = cntA; const unsigned ent = entA;
        const int hd = (li >> 5) & 7, b = li >> 8, slot = (int)(ent >> 13); const size_t tq = (size_t)b * S + (ent & 8191);
        const bool valid = tile * 256 + 32 * w + ql < cnt;
        bf16x8v qf[4];
#pragma unroll
        for (int i = 0; i < 4; ++i) qf[i] = qn[i];
        liA = liB; tileA = tileB; cntA = cntB; entA = entB;
        if (k + 1 < nit) { if (liA != li) PAST_KV(liA); PAST_Q(liA, entA); }
        if (k + 2 < nit) PAST_ENT(k + 2, liB, tileB, cntB, entB);
        AttnState st; attn_init(st);
        const unsigned kbase = lb + AT_KOFF + (unsigned)ql * AT_RS + 16 * h;
        const unsigned vbase = lb + AT_VOFF + (unsigned)(4 * h + ((lane & 15) >> 2)) * AT_RS + 32 * ((lane >> 4) & 1) + 8 * (lane & 3);
        if (32 * w + tile * 256 < cnt) {
            attn_wave<false>(st, qf, kbase, vbase, 0, 8, -1, -1, lane);
            const float lt = st.l + __shfl_xor(st.l, 32);
            if (valid) { attn_store_partial(st, 1.0f / lt, (bf16*)(p.ws + WS_PARTA) + (((size_t)slot * T + tq) * NHA + hd) * HD, h);
                if (h == 0) ((float*)(p.ws + WS_LSEA))[((size_t)slot * T + tq) * NHA + hd] = st.m + __builtin_amdgcn_logf(lt); }
        }
    }
#undef PAST_ENT
#undef PAST_KV
#undef PAST_Q
}
__device__ __forceinline__ void phase_moba_own(const Params& p, int bid, int nb, unsigned char* lds, int tid) {
    const int lane = tid & 63, w = tid >> 6, h = lane >> 5, ql = lane & 31;
    const unsigned lb = (unsigned)(uintptr_t)lds;
    constexpr int NITM = NB * NHA * NBLK;
    KVRegs<4> R; bf16x8v qn[4];
#define OWN_FETCH(it_) do { const int n_ = (it_) % NBLK, hd_ = ((it_) / NBLK) % NHA, b_ = (it_) / (NBLK * NHA); const size_t row0_ = (size_t)b_ * S + (size_t)n_ * MBLK; \
        kv_load<4>(R, (const unsigned char*)((const bf16*)(p.ws + WS_KA) + row0_ * WA + hd_ * HD), (const unsigned char*)((const bf16*)(p.ws + WS_VA) + row0_ * WA + hd_ * HD), (size_t)WA * 2, 0, tid); \
        attn_qload(qn, (const bf16*)(p.ws + WS_QA) + (row0_ + 32 * w + ql) * WA + hd_ * HD, h); } while (0)
    int it = bid;
    if (it < NITM) OWN_FETCH(it);
    while (it < NITM) {
        const int n = it % NBLK, hd = (it / NBLK) % NHA, b = it / (NBLK * NHA);
        const size_t row0 = (size_t)b * S + (size_t)n * MBLK;
        LDS_BARRIER();
        kv_commit<4>(R, lds, 0, tid);
        LDS_BARRIER();
        bf16x8v qf[4];
#pragma unroll
        for (int i = 0; i < 4; ++i) qf[i] = qn[i];
        const int nit = it + nb;
        if (nit < NITM) OWN_FETCH(nit);
        const size_t tq = row0 + 32 * w + ql;
        const unsigned selw = *(const unsigned*)((const signed char*)(p.ws + WS_SEL) + (tq * NHA + hd) * 4);
        float lse[3];
#pragma unroll
        for (int k = 0; k < 3; ++k) lse[k] = ((const float*)(p.ws + WS_LSEA))[((size_t)k * T + tq) * NHA + hd];
        AttnState st; attn_init(st);
        const unsigned kbase = lb + AT_KOFF + (unsigned)ql * AT_RS + 16 * h;
        const unsigned vbase = lb + AT_VOFF + (unsigned)(4 * h + ((lane & 15) >> 2)) * AT_RS + 32 * ((lane >> 4) & 1) + 8 * (lane & 3);
        attn_wave<true>(st, qf, kbase, vbase, 0, w + 1, -1, w, lane);
        const float lt = st.l + __shfl_xor(st.l, 32);
        const float lse_own = st.m + __builtin_amdgcn_logf(lt);
        float M = lse_own;
#pragma unroll
        for (int k = 0; k < 3; ++k) { const bool ok = ((selw >> (8 * k)) & 0x80u) == 0u; if (!ok) lse[k] = -INFINITY; M = fmaxf(M, lse[k]); }
        const float w_own = __builtin_amdgcn_exp2f(lse_own - M); float wsum = w_own;
        const float so = w_own / lt;
#pragma unroll
        for (int r = 0; r < 16; ++r) { st.o0[r] *= so; st.o1[r] *= so; }
#pragma unroll
        for (int k = 0; k < 3; ++k) { const float wk = __builtin_amdgcn_exp2f(lse[k] - M); wsum += wk;
            if (lse[k] != -INFINITY) attn_acc_partial(st.o0, st.o1, wk, (const bf16*)(p.ws + WS_PARTA) + (((size_t)k * T + tq) * NHA + hd) * HD, h); }
        attn_store_partial(st, 1.0f / wsum, (bf16*)p.out + tq * (WA + WBO) + hd * HD, h);
        it = nit;
    }
#undef OWN_FETCH
}
__device__ __forceinline__ void phase_dil_merge(const Params& p, int gtid, int ngt) {
    for (int idx = gtid; idx < T * 4 * 8; idx += ngt) {
        const int ch = idx & 7, j = (idx >> 3) & 3; const size_t t = idx >> 5;
        float l0 = ((const float*)(p.ws + WS_LSEB))[((size_t)0 * T + t) * 4 + j], l1 = ((const float*)(p.ws + WS_LSEB))[((size_t)1 * T + t) * 4 + j], l2 = ((const float*)(p.ws + WS_LSEB))[((size_t)2 * T + t) * 4 + j];
        const float M = fmaxf(l0, fmaxf(l1, l2)); const float w0 = __builtin_amdgcn_exp2f(l0 - M), w1 = __builtin_amdgcn_exp2f(l1 - M), w2 = __builtin_amdgcn_exp2f(l2 - M); const float inv = 1.0f / (w0 + w1 + w2);
        float o[8];
#pragma unroll
        for (int i = 0; i < 8; ++i) o[i] = 0.f;
#pragma unroll
        for (int g = 0; g < 3; ++g) { const float wg = (g == 0 ? w0 : g == 1 ? w1 : w2) * inv; const u32x4 v = *(const u32x4*)((const bf16*)(p.ws + WS_PARTB) + (((size_t)g * T + t) * 4 + j) * HD + 8 * ch);
#pragma unroll
            for (int i = 0; i < 4; ++i) { o[2 * i] += wg * __uint_as_float(v[i] << 16); o[2 * i + 1] += wg * __uint_as_float(v[i] & 0xffff0000u); } }
        u32x4 wv; wv.x = cvtpk(o[0], o[1]); wv.y = cvtpk(o[2], o[3]); wv.z = cvtpk(o[4], o[5]); wv.w = cvtpk(o[6], o[7]);
        *(u32x4*)((bf16*)p.out + t * (WA + WBO) + WA + j * HD + 8 * ch) = wv;
    }
}

__device__ __forceinline__ void phase_check(const Params& p, const bf16* a, const bf16* b, size_t n, int gtid, int ngt) {
    float num = 0.f, den = 0.f;
    for (size_t i = gtid; i < n; i += ngt) { const float x = bf2f(a[i]), y = bf2f(b[i]); num += (x - y) * (x - y); den += y * y; }
    num = wave_sum(num); den = wave_sum(den);
    if ((threadIdx.x & 63) == 0) { atomicAdd((float*)(p.ws + WS_CTL) + CW_DNUM, num); atomicAdd((float*)(p.ws + WS_CTL) + CW_DDEN, den); }
}

#define XB_TMO      128
#define XB_XCNT(j)  (256  + 64 * (j))
#define XB_XSUB(j)  (1280 + 64 * (j))
#define XB_XGEN(j)  (2304 + 64 * (j))
#define XB_TOP      3328
#define XB_TOPGEN   3392
#define XCD_BAR_WORDS 3456
#define XB_SPIN_CAP (1u << 18)
__device__ __forceinline__ unsigned xb_ld(unsigned* p)              { return __hip_atomic_load(p, __ATOMIC_RELAXED, __HIP_MEMORY_SCOPE_AGENT); }
__device__ __forceinline__ unsigned xb_add(unsigned* p, unsigned v) { return __hip_atomic_fetch_add(p, v, __ATOMIC_RELAXED, __HIP_MEMORY_SCOPE_AGENT); }
__device__ __forceinline__ unsigned xb_xcc_id() { return (unsigned)__builtin_amdgcn_s_getreg((3 << 11) | 20) & 0xFu; }
#define XB_SPIN(cond, bar) do { unsigned _sp = 0; while (cond) { __builtin_amdgcn_s_sleep(1); \
    if ((++_sp & 255u) == 0u) { if (xb_ld(&(bar)[XB_TMO])) break; if (_sp > XB_SPIN_CAP) { atomicAdd(&(bar)[XB_TMO], 1u); break; } } } } while (0)
struct XcdBarrier { unsigned* bar; unsigned x; volatile LAS unsigned* st; };
__device__ __forceinline__ XcdBarrier xcd_barrier_post(unsigned* bar, volatile LAS unsigned* st) {
    XcdBarrier b; b.bar = bar; b.x = xb_xcc_id(); b.st = st;
    if (threadIdx.x == 0) (void)xb_add(&bar[XB_XCNT(b.x)], 1u);
    return b;
}
__device__ __forceinline__ void xcd_barrier_complete(unsigned* bar, unsigned x, unsigned& nloc, unsigned& nx) {
    const unsigned G = gridDim.x * gridDim.y * gridDim.z;
    unsigned sum, cnt, mine, sp = 0u;
    for (;;) {
        sum = 0u; cnt = 0u; mine = 0u;
#pragma unroll
        for (unsigned j = 0; j < 16; ++j) { const unsigned c = xb_ld(&bar[XB_XCNT(j)]); sum += c; cnt += (c > 0u) ? 1u : 0u; mine = (j == x) ? c : mine; }
        if (sum == G) break;
        __builtin_amdgcn_s_sleep(1);
        if ((++sp & 255u) == 0u) { if (xb_ld(&bar[XB_TMO])) break; if (sp > XB_SPIN_CAP) { atomicAdd(&bar[XB_TMO], 1u); break; } }
    }
    nloc = mine > 0u ? mine : 1u; nx = cnt > 0u ? cnt : 1u;
}
__device__ __forceinline__ void xcd_barrier(const XcdBarrier& b) {
    asm volatile("s_waitcnt vmcnt(0)" ::: "memory");
    __syncthreads();
    if (threadIdx.x == 0) {
        unsigned* bar = b.bar;
        __builtin_amdgcn_s_waitcnt(0);
        unsigned nloc = b.st[0], nx = b.st[1];
        if (nloc == 0u) { xcd_barrier_complete(bar, b.x, nloc, nx); b.st[0] = nloc; b.st[1] = nx; }
        const unsigned old = xb_add(&bar[XB_XSUB(b.x)], 1u);
        const unsigned gen = old / nloc;
        if (old + 1u == (gen + 1u) * nloc) {
            __builtin_amdgcn_fence(__ATOMIC_RELEASE, "agent");
            asm volatile("s_waitcnt vmcnt(0)" ::: "memory");
            const unsigned og = xb_add(&bar[XB_TOP], 1u);
            const unsigned tg = og / nx;
            if (og + 1u == (tg + 1u) * nx) xb_add(&bar[XB_TOPGEN], 1u);
            else XB_SPIN(xb_ld(&bar[XB_TOPGEN]) == tg, bar);
            __builtin_amdgcn_fence(__ATOMIC_ACQUIRE, "agent");
            xb_add(&bar[XB_XGEN(b.x)], 1u);
            asm volatile("s_waitcnt vmcnt(0)" ::: "memory");
        } else {
            XB_SPIN(xb_ld(&bar[XB_XGEN(b.x)]) == gen, bar);
            __builtin_amdgcn_fence(__ATOMIC_ACQUIRE, "agent");
            asm volatile("s_waitcnt vmcnt(0)" ::: "memory");
        }
    }
    __syncthreads();
}
constexpr int HELPERS = 104;
constexpr int LDS_BYTES = 147456;
__global__ void __launch_bounds__(512, 2) mega_fwd(Params p) {
    extern __shared__ __attribute__((aligned(16))) unsigned char lds[];
    cg::grid_group grid = cg::this_grid();
    const int bid = blockIdx.x, nb = gridDim.x;
#define COORDS() int tid = threadIdx.x; asm volatile("" : "+v"(tid)); const int lane = tid & 63, wave = tid >> 6; const int gw = bid * 8 + wave, ngw = nb * 8, gtid = bid * 512 + tid, ngt = nb * 512; float* wl = (float*)lds + wave * 1152; (void)lane; (void)gw; (void)ngw; (void)gtid; (void)ngt; (void)wl;
    volatile LAS unsigned* bst = (volatile LAS unsigned*)(lds + LDS_BYTES - 64);
    if (threadIdx.x < 16) bst[threadIdx.x] = 0u;
    __syncthreads();
    const XcdBarrier xbar = xcd_barrier_post((unsigned*)(p.ws + WS_CTL) + CW_BAR, bst);
#ifndef TIME_LO
#define TIME_LO -1
#endif
#ifndef TIME_HI
#define TIME_HI -1
#endif
#ifndef TIME_MULT
#define TIME_MULT 2
#endif
    int n_stamp = 0;
#if TIME_LO >= 0
#define STAMP() do { if (bid == 0 && threadIdx.x == 0) ((unsigned long long*)(p.ws + WS_CTL + 917504))[n_stamp] = __builtin_amdgcn_s_memrealtime(); ++n_stamp; } while (0)
#else
#define STAMP() do { } while (0)
#endif
    STAMP();
#define GRID_BAR() do { xcd_barrier(xbar); STAMP(); } while (0)
    phase_prep_a(p, bid, nb, lds);
    if (p.use_cg) grid.sync(); else xcd_barrier(xbar);
    STAMP();
    if (!(bid < HELPERS && nb > 2 * HELPERS)) {
        const int hsub = (nb > 2 * HELPERS) ? HELPERS : 0;
        pg8::Order O; O.init(T / 256, NCOL / 256, nb - hsub, bid - hsub); EpiInProj E{p};
#if FP8_IN
        ProbPlainF8 P{(const bf16*)(p.ws + WS_H), (const bf16*)(p.ws + WS_WIN), D / 2}; pg8::gemm_phase<EpiInProj, ProbPlainF8, true>((PG8_LAS unsigned char*)lds, P, O, E);
#else
        ProbPlain P{(const bf16*)(p.ws + WS_H), (const bf16*)(p.ws + WS_WIN), D}; pg8::gemm_phase<EpiInProj, ProbPlain, true>((PG8_LAS unsigned char*)lds, P, O, E);
#endif
#if TIME_LO >= 0
        if (threadIdx.x == 0) atomicMax((unsigned long long*)(p.ws + WS_CTL + 917504) + 21, (unsigned long long)__builtin_amdgcn_s_memrealtime());
#endif
    }
    phase_prep_b(p, lds);
#if TIME_LO >= 0
    if (threadIdx.x == 0) atomicMax((unsigned long long*)(p.ws + WS_CTL + 917504) + 20, (unsigned long long)__builtin_amdgcn_s_memrealtime());
#endif
    GRID_BAR();
#if DBG == 1
    { InProjN f{p, true}; phase_naive_gemm(f, T, C_VB, bid, nb, lds); }
    GRID_BAR();
    { COORDS(); phase_check(p, (const bf16*)(p.ws + WS_QA), (const bf16*)(p.ws + 426 * MiB), (size_t)T * WA, gtid, ngt);
      phase_check(p, (const bf16*)(p.ws + WS_KA), (const bf16*)(p.ws + 442 * MiB), (size_t)T * WA, gtid, ngt);
      phase_check(p, (const bf16*)(p.ws + WS_QB), (const bf16*)(p.ws + 458 * MiB), (size_t)T * WB, gtid, ngt);
      phase_check(p, (const bf16*)(p.ws + WS_KB), (const bf16*)(p.ws + 482 * MiB), (size_t)T * WB, gtid, ngt); }
    GRID_BAR();
#endif
    { COORDS(); phase_select_lists(p, bid, nb, lds, tid); phase_dilated(p, bid, nb, lds, tid); }
    GRID_BAR();
    { COORDS(); phase_moba_past(p, bid, nb, lds, tid); }
    GRID_BAR();
    { COORDS(); phase_moba_own(p, bid, nb, lds, tid); phase_dil_merge(p, gtid, ngt); }
    GRID_BAR();
#if DBG == 2
    { COORDS(); phase_moba_naive(p, gw, ngw, lane, wl, (bf16*)p.out); phase_dil_naive(p, gw, ngw, lane, wl, (bf16*)p.out + (size_t)T * WA); }
    GRID_BAR();
    { COORDS();
#if DBG_SUB == 0
      phase_check(p, (const bf16*)(p.ws + WS_OA), (const bf16*)p.out, (size_t)T * WA, gtid, ngt);
#else
      phase_check(p, (const bf16*)(p.ws + WS_OB), (const bf16*)p.out + (size_t)T * WA, (size_t)T * WBO, gtid, ngt);
#endif
    }
    GRID_BAR();
#endif
    { pg8::Order O; O.init(T / 256, D / 256, nb, bid); ProbPlainOff P{(const bf16*)p.out, (const bf16*)(p.ws + WS_WOA), WA + WBO}; EpiMixCat E{p};
      pg8::gemm_phase<EpiMixCat, ProbPlainOff, true>((PG8_LAS unsigned char*)lds, P, O, E); }
    GRID_BAR();
    { ProbPlain P{(const bf16*)(p.ws + WS_MIX), (const bf16*)(p.ws + WS_WOUT), D}; pg8::Order O; O.init(T / 256, D / 256, nb, bid); EpiOut E{p};
      pg8::gemm_phase<EpiOut, ProbPlain, true>((PG8_LAS unsigned char*)lds, P, O, E); }
    GRID_BAR();
    { COORDS(); phase_router(p, bid, nb, lds, tid); }
    GRID_BAR();
    { COORDS(); MoeTab mt; const int n_mt = moe_tables<false>(p, lds, tid, 2 * FF / 256, nb, bid, mt);
      ProbMoE<true, (FP8_GU != 0)> P{(const bf16*)(p.ws + WS_H), (const bf16*)(p.ws + WS_WGU), FP8_GU ? D / 2 : D, mt, 2 * FF}; pg8::Order O; O.init(n_mt, 2 * FF / 256, nb, bid); EpiGateUp E{p, mt};
      pg8::gemm_phase<EpiGateUp, ProbMoE<true, (FP8_GU != 0)>, true>((PG8_LAS unsigned char*)lds, P, O, E); }
    GRID_BAR();
    { COORDS(); MoeTab mt; const int n_mt = moe_tables<true>(p, lds, tid, D / 256, nb, bid, mt);
      ProbMoE<false, (FP8_DN != 0)> P{(const bf16*)(p.ws + WS_A2), (const bf16*)(p.ws + WS_WD), FP8_DN ? FF / 2 : FF, mt, D}; pg8::Order O; O.init(n_mt, D / 256, nb, bid); EpiDown E{p, mt};
      pg8::gemm_phase<EpiDown, ProbMoE<false, (FP8_DN != 0)>, true>((PG8_LAS unsigned char*)lds, P, O, E); }
    GRID_BAR();
    { COORDS(); phase_final(p, gw, ngw, lane); }
#if TIME_LO >= 0
    if (bid == 0 && threadIdx.x == 0) { STAMP();
        const unsigned long long* ts = (const unsigned long long*)(p.ws + WS_CTL + 917504);
        const unsigned long long dt = (ts[TIME_HI] - ts[TIME_LO]) * TIME_MULT, t0 = __builtin_amdgcn_s_memrealtime();
        while (__builtin_amdgcn_s_memrealtime() - t0 < dt) __builtin_amdgcn_s_sleep(8); }
#endif
}

#ifdef TIME_LO
#define TIME_LO_HOST TIME_LO
#else
#define TIME_LO_HOST -1
#endif
extern "C" void kernel_launch(void* const* d_in, const int* in_sizes, int n_in, void* d_out, int out_size, void* d_ws, size_t ws_size, hipStream_t stream) {
    if (n_in != 18 || ws_size < WS_END || out_size != T * D) return;
    static int grid_blocks = 0;
    if (!grid_blocks) {
        int dev = 0, cus = 0, per_cu = 0;
        (void)hipGetDevice(&dev);
        (void)hipDeviceGetAttribute(&cus, hipDeviceAttributeMultiprocessorCount, dev);
        (void)hipFuncSetAttribute((const void*)mega_fwd, hipFuncAttributeMaxDynamicSharedMemorySize, LDS_BYTES);
        (void)hipOccupancyMaxActiveBlocksPerMultiprocessor(&per_cu, (const void*)mega_fwd, 512, LDS_BYTES);
        if (per_cu < 1) per_cu = 1;
        if (per_cu > 1) per_cu = 1;
        grid_blocks = cus * per_cu;
    }
    Params p{};
    const float** fp = (const float**)&p;
    for (int i = 0; i < 18; ++i) fp[i] = (const float*)d_in[i];
    p.out = (float*)d_out; p.ws = (unsigned char*)d_ws;
    for (int i = 0; i < 8; ++i) p.inv_freq[i] = (float)pow(500000.0, -(double)i / 8.0);
    (void)hipMemsetAsync((char*)d_ws + WS_CTL, 0, (TIME_LO_HOST >= 0) ? 1 * MiB : 64 * 1024, stream);
    void* args[] = {&p};
    (void)hipLaunchCooperativeKernel((const void*)mega_fwd, dim3(grid_blocks), dim3(512), args, LDS_BYTES, stream);
}
```

```cpp
#include <hip/hip_runtime.h>
#include <hip/hip_cooperative_groups.h>
namespace cg = cooperative_groups;
#include <stdint.h>
#include <math.h>

typedef unsigned short bf16;
typedef float f32x4 __attribute__((ext_vector_type(4)));
typedef unsigned u32x4 __attribute__((ext_vector_type(4)));
typedef unsigned u32x2 __attribute__((ext_vector_type(2)));

__device__ __forceinline__ float bf2f(bf16 v) { return __uint_as_float(((unsigned)v) << 16); }
__device__ __forceinline__ unsigned f2bf(float f) { unsigned u = __float_as_uint(f); return (u + 0x7fffu + ((u >> 16) & 1u)) >> 16; }
__device__ __forceinline__ unsigned pk2(float lo, float hi) { return f2bf(lo) | (f2bf(hi) << 16); }

typedef float f32x2 __attribute__((ext_vector_type(2)));
typedef __bf16 bf16x2_t __attribute__((ext_vector_type(2)));
__device__ __forceinline__ unsigned cvtpk(float lo, float hi) { f32x2 v = {lo, hi}; bf16x2_t b = __builtin_convertvector(v, bf16x2_t); return __builtin_bit_cast(unsigned, b); }
__device__ __forceinline__ float fast_sigmoid(float x) { return __builtin_amdgcn_rcpf(1.0f + __builtin_amdgcn_exp2f(-1.4426950408889634f * x)); }
typedef float f32x16 __attribute__((ext_vector_type(16)));
typedef short s16x4 __attribute__((ext_vector_type(4)));
typedef short bf16x8v __attribute__((ext_vector_type(8)));
__device__ __forceinline__ int crow(int r, int h) { return (r & 3) + 8 * (r >> 2) + 4 * h; }
#define GAS __attribute__((address_space(1)))
#define LAS __attribute__((address_space(3)))
typedef bf16 act;
__device__ __forceinline__ float ldact(const act* p) { return bf2f(*p); }
__device__ __forceinline__ void stact(act* p, float v) { *p = (bf16)f2bf(v); }
__device__ __forceinline__ void ldact8(const act* p, float (&o)[8]) { const u32x4 a = *(const u32x4*)p;
#pragma unroll
    for (int i = 0; i < 4; ++i) { o[2 * i] = __uint_as_float(a[i] << 16); o[2 * i + 1] = __uint_as_float(a[i] & 0xffff0000u); } }
#ifndef FP8_GU
#define FP8_GU 1
#endif
#ifndef FP8_DN
#define FP8_DN 1
#endif
#ifndef FP8_IN
#define FP8_IN 1
#endif
#ifndef FP8_Y
#define FP8_Y 1
#endif
#ifndef FP8_MOE
#define FP8_MOE 1
#endif
constexpr int NB = 2, S = 8192, T = NB * S, D = 1024, HD = 64;
constexpr int NHA = 8, NHB = 12, WA = 512, WB = 768, WBO = 256, NCOL = 5888;
constexpr int MBLK = 256, NBLK = S / MBLK;
constexpr int NE = 32, TOPK = 4, FF = 1024;
constexpr int A2ROWS = 73728;
constexpr int C_QA = 0, C_KA = 512, C_VA = 1024, C_QB = 1536, C_KB = 2304, C_VB = 3072, C_GA = 3840, C_GB = 4864;
constexpr float NORM_EPS = 1e-5f;

constexpr size_t MiB = 1u << 20;
constexpr size_t WS_CTL = 0;
constexpr size_t WS_WIN = 1 * MiB;
constexpr size_t WS_WOA = 13 * MiB;
constexpr size_t WS_WOB = 14 * MiB;
constexpr size_t WS_WOUT = 15 * MiB;
constexpr size_t WS_WGU = 17 * MiB;
constexpr size_t WS_WD = 145 * MiB;
constexpr size_t WS_ROPE = 209 * MiB;
constexpr size_t WS_KMEAN = WS_ROPE + 512 * 1024;
constexpr size_t WS_H = 210 * MiB;
constexpr size_t WS_QA = 242 * MiB, WS_KA = 258 * MiB, WS_VA = 274 * MiB;
constexpr size_t WS_QB = 290 * MiB, WS_KB = 314 * MiB, WS_VB = 338 * MiB;
constexpr size_t WS_SA = 362 * MiB, WS_SB = 394 * MiB;
constexpr size_t WS_PARTB = 210 * MiB;
constexpr size_t WS_LSEB = 234 * MiB;
constexpr size_t WS_LSEA = 235 * MiB;
constexpr size_t WS_SEL = 236 * MiB + 512 * 1024;
constexpr size_t WS_LIST = 426 * MiB;
constexpr size_t WS_PARTA = 442 * MiB;
constexpr int LIST_CAP = 8192;
constexpr size_t WS_OB = 434 * MiB;
constexpr size_t WS_OA = 490 * MiB;
constexpr size_t WS_MIX = 242 * MiB;
constexpr size_t WS_A2 = 242 * MiB;
constexpr size_t WS_ELIST = 386 * MiB;
constexpr size_t WS_EP = 388 * MiB;
constexpr size_t WS_ROWTOK = 390 * MiB;
constexpr size_t WS_ROWP = 391 * MiB;
constexpr size_t WS_TILEE = 392 * MiB;
constexpr size_t WS_Y = 17 * MiB;
constexpr size_t WS_END = 512 * MiB;
#ifndef TIMEB_LO
#define TIMEB_LO -1
#endif
#ifndef TIMEB_HI
#define TIMEB_HI -1
#endif
#ifndef TIMEB_GAIN
#define TIMEB_GAIN 1.0f
#endif
#ifndef DBG
#define DBG 0
#endif
#ifndef DBG_SUB
#define DBG_SUB 0
#endif
#ifndef DBG_GAIN
#define DBG_GAIN 100.0f
#endif
constexpr int CW_DNUM = 192, CW_DDEN = 193;
constexpr int CW_ECNT = 8192;
constexpr int CW_BAR = 4096;
constexpr int CW_LCNT = 12288;
constexpr int CW_HQ = 224;
constexpr int CW_NMT = 160;

struct Params {
    const float *x, *ln_mix_g, *w_in, *b_gate_a, *b_gate_b, *w_o_a, *w_o_b, *w_out, *ln_ffn_g, *w_router, *b_router,
        *w_gate, *b_gate, *w_up, *b_up, *w_down, *b_down, *ln_final_g;
    float* out; unsigned char* ws;
    float inv_freq[8];
    int use_cg, pad0;
};

template <int MAP> __device__ __forceinline__ int rowmap(int n) { return MAP == 0 ? n : (32 * (n >> 4) + (n & 15) + (MAP == 2 ? 16 : 0)); }
template <int MAP> __device__ __forceinline__ void transpose_item(const float* W, int K, int N, bf16* WT, float* scr, int item, int lane) {
    const int nblk = N / 64, kb = item / nblk, nb = item % nblk, k0 = 64 * kb, n0 = 64 * nb;
    f32x4 v[16];
#pragma unroll
    for (int i = 0; i < 16; ++i) v[i] = *(const f32x4*)(W + (size_t)(k0 + (lane >> 4) + 4 * i) * N + n0 + 4 * (lane & 15));
#pragma unroll
    for (int i = 0; i < 16; ++i) { float* d = scr + ((lane >> 4) + 4 * i) * 65 + 4 * (lane & 15); d[0] = v[i].x; d[1] = v[i].y; d[2] = v[i].z; d[3] = v[i].w; }
    asm volatile("s_waitcnt lgkmcnt(0)" ::: "memory");
    const int c = lane & 7;
#pragma unroll
    for (int j = 0; j < 8; ++j) { const int n = (lane >> 3) + 8 * j; const float* q = scr + (8 * c) * 65 + n;
        u32x4 o; o.x = cvtpk(q[0 * 65], q[1 * 65]); o.y = cvtpk(q[2 * 65], q[3 * 65]); o.z = cvtpk(q[4 * 65], q[5 * 65]); o.w = cvtpk(q[6 * 65], q[7 * 65]);
        *(u32x4*)(WT + (size_t)rowmap<MAP>(n0 + n) * K + k0 + 8 * c) = o; }
    asm volatile("s_waitcnt lgkmcnt(0)" ::: "memory");
}
__device__ __forceinline__ float wave_sum(float v) {
#pragma unroll
    for (int o = 1; o < 64; o <<= 1) v += __shfl_xor(v, o);
    return v;
}
__device__ __forceinline__ void sincos_acc(float ang, float& c, float& s) {
    const double a = (double)ang; const double k = rint(a * 0.63661977236758134308); const double y = a - k * 1.57079632679489661923; const double y2 = y * y;
    const double sn = y * (1.0 + y2 * (-1.0 / 6 + y2 * (1.0 / 120 + y2 * (-1.0 / 5040 + y2 * (1.0 / 362880 + y2 * (-1.0 / 39916800))))));
    const double cs = 1.0 + y2 * (-0.5 + y2 * (1.0 / 24 + y2 * (-1.0 / 720 + y2 * (1.0 / 40320 + y2 * (-1.0 / 3628800 + y2 * (1.0 / 479001600))))));
    const int q = ((int)k) & 3;
    const double ss = (q == 0) ? sn : (q == 1) ? cs : (q == 2) ? -sn : -cs;
    const double cc = (q == 0) ? cs : (q == 1) ? -sn : (q == 2) ? -cs : sn;
    c = (float)cc; s = (float)ss;
}
struct TItem { const float* W; bf16* WT; int K, N, map, k0, n0, f8, kd; };
__device__ __forceinline__ TItem titem_decode(const Params& p, int it) {
    constexpr int I_OA = (WA / 64) * (D / 32), I_OB = (WBO / 64) * (D / 32), I_OUT = (D / 64) * (D / 32), I_E = (D / 64) * (FF / 32);
    static_assert(I_E == 512 && D == 1024 && FF == 1024, "the expert-matrix decode below uses shifts");
    unsigned char* ws = p.ws; TItem t; int r = it; t.f8 = 0; t.kd = 0; t.N = D; t.map = 0;
    if (r >= I_OA + I_OB + I_OUT) {
        r -= I_OA + I_OB + I_OUT; const int which = r >> 14  , e = (r >> 9) & 31; r &= 511; t.K = D;
        t.f8 = (which == 2) ? (FP8_DN ? 1 : 0) : (FP8_GU ? 1 : 0); const size_t esz = t.f8 ? 1 : 2;
        if (which == 0) { t.W = p.w_gate + (size_t)e * D * FF; t.WT = (bf16*)(ws + WS_WGU + (size_t)e * 2 * FF * D * esz); t.map = 1; }
        else if (which == 1) { t.W = p.w_up + (size_t)e * D * FF; t.WT = (bf16*)(ws + WS_WGU + (size_t)e * 2 * FF * D * esz); t.map = 2; }
        else { t.W = p.w_down + (size_t)e * FF * D; t.WT = (bf16*)(ws + WS_WD + (size_t)e * D * FF * esz); }
    }
    else if (r < I_OA) { t.W = p.w_o_a; t.WT = (bf16*)(ws + WS_WOA); t.K = WA + WBO; }
    else if ((r -= I_OA) < I_OB) { t.W = p.w_o_b; t.WT = (bf16*)(ws + WS_WOA); t.K = WA + WBO; t.kd = WA; }
    else { r -= I_OB; t.W = p.w_out; t.WT = (bf16*)(ws + WS_WOUT); t.K = D; }
    const int pr_ = r >> 1; t.k0 = 64 * (2 * (pr_ >> 5) + (r & 1)); t.n0 = 32 * (pr_ & 31);
    return t;
}
__device__ __forceinline__ void titem_load(const TItem& t, f32x4 (&v)[8], int lane) {
#pragma unroll
    for (int i = 0; i < 8; ++i) v[i] = __builtin_nontemporal_load((const f32x4*)(t.W + (size_t)(t.k0 + (lane >> 3) + 8 * i) * t.N + t.n0 + 4 * (lane & 7)));
}
__device__ __forceinline__ void titem_store(const TItem& t, const f32x4 (&v)[8], float* scr, int lane) {
#pragma unroll
    for (int i = 0; i < 8; ++i) { float* d = scr + ((lane >> 3) + 8 * i) * 33 + 4 * (lane & 7); d[0] = v[i].x; d[1] = v[i].y; d[2] = v[i].z; d[3] = v[i].w; }
    asm volatile("s_waitcnt lgkmcnt(0)" ::: "memory");
    const int c = (lane & 3) + 4 * (lane >> 5);
#pragma unroll
    for (int j = 0; j < 4; ++j) { const int n = ((lane >> 2) & 7) + 8 * j; const float* q = scr + (8 * c) * 33 + n; const int nn = t.n0 + n;
        const int row = t.map == 0 ? nn : (32 * (nn >> 4) + (nn & 15) + (t.map == 2 ? 16 : 0));
        if (t.f8) { int w0 = __builtin_amdgcn_cvt_pk_fp8_f32(q[0 * 33] * 64.f, q[1 * 33] * 64.f, 0, false); w0 = __builtin_amdgcn_cvt_pk_fp8_f32(q[2 * 33] * 64.f, q[3 * 33] * 64.f, w0, true);
            int w1 = __builtin_amdgcn_cvt_pk_fp8_f32(q[4 * 33] * 64.f, q[5 * 33] * 64.f, 0, false); w1 = __builtin_amdgcn_cvt_pk_fp8_f32(q[6 * 33] * 64.f, q[7 * 33] * 64.f, w1, true);
            u32x2 o; o.x = (unsigned)w0; o.y = (unsigned)w1; *(u32x2*)((unsigned char*)t.WT + (size_t)row * t.K + t.kd + t.k0 + 8 * c) = o; }
        else { u32x4 o; o.x = cvtpk(q[0 * 33], q[1 * 33]); o.y = cvtpk(q[2 * 33], q[3 * 33]); o.z = cvtpk(q[4 * 33], q[5 * 33]); o.w = cvtpk(q[6 * 33], q[7 * 33]);
            *(u32x4*)(t.WT + (size_t)row * t.K + t.kd + t.k0 + 8 * c) = o; } }
    asm volatile("s_waitcnt lgkmcnt(0)" ::: "memory");
}
__device__ __forceinline__ void phase_prep_a(const Params& p, int bid, int nb, unsigned char* lds) {
    int tid = threadIdx.x; asm volatile("" : "+v"(tid)); const int lane = tid & 63, wave = tid >> 6;
    const int gw = bid * 8 + wave, NGW = nb * 8;
    unsigned char* ws = p.ws;
    float* scr = (float*)lds + wave * (64 * 33);
    constexpr int I_IN = (D / 64) * (NCOL / 32);
    for (int it = gw; it < I_IN; it += NGW) {
        TItem t; t.W = p.w_in; t.WT = (bf16*)(ws + WS_WIN); t.K = D; t.N = NCOL; t.map = 0; t.f8 = FP8_IN; t.kd = 0; t.k0 = 64 * (it / (NCOL / 32)); t.n0 = 32 * (it % (NCOL / 32));
        f32x4 v[8]; titem_load(t, v, lane); titem_store(t, v, scr, lane);
    }
    for (int m = gw; m < T; m += NGW) {
        const f32x4* xr = (const f32x4*)(p.x + (size_t)m * D) + lane; const f32x4* gr = (const f32x4*)p.ln_mix_g + lane;
        f32x4 v[4]; float s = 0.f;
#pragma unroll
        for (int j = 0; j < 4; ++j) { v[j] = xr[64 * j]; s += (v[j].x * v[j].x + v[j].y * v[j].y) + (v[j].z * v[j].z + v[j].w * v[j].w); }
        const float rstd = 1.0f / sqrtf(wave_sum(s) * (1.0f / D) + NORM_EPS);
#pragma unroll
        for (int j = 0; j < 4; ++j) { const f32x4 g = gr[64 * j];
#if FP8_IN
            int o = __builtin_amdgcn_cvt_pk_fp8_f32(v[j].x * rstd * g.x, v[j].y * rstd * g.y, 0, false); o = __builtin_amdgcn_cvt_pk_fp8_f32(v[j].z * rstd * g.z, v[j].w * rstd * g.w, o, true);
            ((int*)((unsigned char*)(ws + WS_H) + (size_t)m * D))[lane + 64 * j] = o;
#else
            u32x2 o; o.x = cvtpk(v[j].x * rstd * g.x, v[j].y * rstd * g.y); o.y = cvtpk(v[j].z * rstd * g.z, v[j].w * rstd * g.w); ((u32x2*)((bf16*)(ws + WS_H) + (size_t)m * D))[lane + 64 * j] = o;
#endif
        }
    }
    float2* rope = (float2*)(ws + WS_ROPE);
    for (int i = bid * 512 + tid; i < S * 8; i += nb * 512) { const int s = i >> 3, f = i & 7; const float ang = (float)s * p.inv_freq[f]; float c, sn; sincos_acc(ang, c, sn); rope[i] = make_float2(c, sn); }
    for (int i = bid * 512 + tid; i < NB * NHA * NBLK * HD; i += nb * 512) ((float*)(ws + WS_KMEAN))[i] = 0.f;
}
__device__ __forceinline__ void phase_prep_b(const Params& p, unsigned char* lds) {
    int tid = threadIdx.x; asm volatile("" : "+v"(tid)); const int lane = tid & 63, wave = tid >> 6;
    float* scr = (float*)lds + wave * (64 * 33);
    constexpr int NITEMS = (WA / 64) * (D / 32) + (WBO / 64) * (D / 32) + (D / 64) * (D / 32) + 3 * NE * (D / 64) * (FF / 32);
    int* ctr = (int*)(p.ws + WS_CTL) + CW_HQ;
    int qcur = 0, qend = 0; bool qdone = false;
#define TQ_NEXT(dst) do { if (qcur == qend && !qdone) { int b_ = 0; if (lane == 0) b_ = atomicAdd(ctr, 8); b_ = __builtin_amdgcn_readfirstlane(b_); \
        if (b_ >= NITEMS) qdone = true; else { qcur = b_; qend = (b_ + 8 < NITEMS) ? b_ + 8 : NITEMS; } } \
        if (qcur < qend) dst = qcur++; else dst = -1; } while (0)
    TItem ta, tb, tc; f32x4 va[8], vb[8], vc[8];
    int ia, ib, ic;
    TQ_NEXT(ia); if (ia >= 0) { ta = titem_decode(p, ia); titem_load(ta, va, lane); }
    TQ_NEXT(ib); if (ib >= 0) { tb = titem_decode(p, ib); titem_load(tb, vb, lane); }
    while (ia >= 0) {
        TQ_NEXT(ic); if (ic >= 0) { tc = titem_decode(p, ic); titem_load(tc, vc, lane); }
        titem_store(ta, va, scr, lane);
        if (ib < 0) break;
        TQ_NEXT(ia); if (ia >= 0) { ta = titem_decode(p, ia); titem_load(ta, va, lane); }
        titem_store(tb, vb, scr, lane);
        if (ic < 0) break;
        TQ_NEXT(ib); if (ib >= 0) { tb = titem_decode(p, ib); titem_load(tb, vb, lane); }
        titem_store(tc, vc, scr, lane);
    }
#undef TQ_NEXT
}

__device__ __forceinline__ int cl(int tx, int j) { return (tx & 7) + 8 * j + 32 * (tx >> 3); }
template <class F> __device__ __forceinline__ void phase_naive_gemm(const F& f, int M, int N, int bid, int nb, unsigned char* lds) {
    const int half = threadIdx.x >> 8, tid = threadIdx.x & 255, tx = tid & 15, ty = tid >> 4;
    float (*As)[33] = (float (*)[33])(lds + half * (2 * 64 * 33 * 4)); float (*Bs)[33] = As + 64;
    const int nN = N / 64, ntiles = (M / 64) * nN, stride = nb * 2;
    const int nround = (ntiles + stride - 1) / stride;
    const int lr = tid >> 2, lk = (tid & 3) * 8;
    for (int r = 0; r < nround; ++r) {
        const int it = r * stride + bid * 2 + half;
        const bool valid = it < ntiles;
        const int m0 = valid ? (it / nN) * 64 : 0, n0 = valid ? (it % nN) * 64 : 0;
        const bool act_ = valid && f.active(m0);
        float acc[F::NPASS][4][4];
#pragma unroll
        for (int ps = 0; ps < F::NPASS; ++ps)
#pragma unroll
            for (int i = 0; i < 4; ++i)
#pragma unroll
                for (int j = 0; j < 4; ++j) acc[ps][i][j] = 0.f;
#pragma unroll
        for (int ps = 0; ps < F::NPASS; ++ps) {
            const int K = f.K(ps);
            const bf16* ap = act_ ? f.arow(ps, m0 + lr) : nullptr; const bf16* bp = act_ ? f.brow(ps, m0, n0 + lr) : nullptr;
            for (int k0 = 0; k0 < K; k0 += 32) {
                float av[8], bv[8];
                if (act_) { ldact8(ap + k0 + lk, av); ldact8(bp + k0 + lk, bv); }
                else {
#pragma unroll
                    for (int i = 0; i < 8; ++i) { av[i] = 0.f; bv[i] = 0.f; } }
                __syncthreads();
#pragma unroll
                for (int i = 0; i < 8; ++i) { As[lr][lk + i] = av[i]; Bs[lr][lk + i] = bv[i]; }
                __syncthreads();
#pragma unroll 8
                for (int kk = 0; kk < 32; ++kk) {
                    float a[4], b[4];
#pragma unroll
                    for (int i = 0; i < 4; ++i) { a[i] = As[ty * 4 + i][kk]; b[i] = Bs[cl(tx, i)][kk]; }
#pragma unroll
                    for (int i = 0; i < 4; ++i)
#pragma unroll
                        for (int j = 0; j < 4; ++j) acc[ps][i][j] += a[i] * b[j];
                }
            }
        }
        if (act_) {
#pragma unroll
            for (int i = 0; i < 4; ++i) f.epi(m0 + ty * 4 + i, n0, tx, acc[0][i], acc[F::NPASS - 1][i]);
        }
    }
}

struct InProjN {
    static constexpr int NPASS = 1; Params p; bool alt;
    __device__ __forceinline__ bool active(int) const { return true; }
    __device__ __forceinline__ int K(int) const { return D; }
    __device__ __forceinline__ int ldb(int) const { return NCOL; }
    __device__ __forceinline__ const act* arow(int, int m) const { return (const act*)(p.ws + WS_H) + (size_t)m * D; }
    __device__ __forceinline__ const bf16* brow(int, int, int n) const { return (const bf16*)(p.ws + WS_WIN) + (size_t)n * D; }
    __device__ __forceinline__ void epi(int m, int n0, int tx, float (&v)[4], float (&)[4]) const {
        unsigned char* ws = p.ws;
        act* dst; int ld, cb; bool rope = false; const float* gbias = nullptr;
        if (n0 < C_KA) { dst = (act*)(ws + (alt ? 426 * MiB : WS_QA)); ld = WA; cb = n0 - C_QA; rope = true; }
        else if (n0 < C_VA) { dst = (act*)(ws + (alt ? 442 * MiB : WS_KA)); ld = WA; cb = n0 - C_KA; rope = true; }
        else if (n0 < C_QB) { if (alt) return; dst = (act*)(ws + WS_VA); ld = WA; cb = n0 - C_VA; }
        else if (n0 < C_KB) { dst = (act*)(ws + (alt ? 458 * MiB : WS_QB)); ld = WB; cb = n0 - C_QB; rope = true; }
        else if (n0 < C_VB) { dst = (act*)(ws + (alt ? 482 * MiB : WS_KB)); ld = WB; cb = n0 - C_KB; rope = true; }
        else if (alt) { return; }
        else if (n0 < C_GA) { dst = (act*)(ws + WS_VB); ld = WB; cb = n0 - C_VB; }
        else if (n0 < C_GB) { dst = (act*)(ws + WS_SA); ld = D; cb = n0 - C_GA; gbias = p.b_gate_a; }
        else { dst = (act*)(ws + WS_SB); ld = D; cb = n0 - C_GB; gbias = p.b_gate_b; }
        if (rope && (tx >> 3) == 0) {
            const float2 cs = ((const float2*)(ws + WS_ROPE))[(m % S) * 8 + (tx & 7)];
            const float x1 = v[0], x2 = v[1]; v[0] = x1 * cs.x - x2 * cs.y; v[1] = x2 * cs.x + x1 * cs.y;
        }
#pragma unroll
        for (int j = 0; j < 4; ++j) { const int c = cb + cl(tx, j); float o = v[j];
            if (gbias) { o = 1.0f / (1.0f + expf(-(o + gbias[c]))); }
            stact(dst + (size_t)m * ld + c, o); }
    }
};
struct MixN {
    static constexpr int NPASS = 2; Params p;
    __device__ __forceinline__ bool active(int) const { return true; }
    __device__ __forceinline__ int K(int ps) const { return ps == 0 ? WA : WBO; }
    __device__ __forceinline__ int ldb(int) const { return D; }
    __device__ __forceinline__ const act* arow(int ps, int m) const { return ps == 0 ? (const act*)(p.ws + WS_OA) + (size_t)m * WA : (const act*)(p.ws + WS_OB) + (size_t)m * WBO; }
    __device__ __forceinline__ const bf16* brow(int ps, int, int n) const { return ps == 0 ? (const bf16*)(p.ws + WS_WOA) + (size_t)n * WA : (const bf16*)(p.ws + WS_WOB) + (size_t)n * WBO; }
    __device__ __forceinline__ void epi(int m, int n0, int tx, float (&a)[4], float (&b)[4]) const {
#pragma unroll
        for (int j = 0; j < 4; ++j) { const int c = n0 + cl(tx, j); const size_t o = (size_t)m * D + c;
            const float sa = ldact((const act*)(p.ws + WS_SA) + o), sb = ldact((const act*)(p.ws + WS_SB) + o);
            stact((act*)(p.ws + WS_MIX) + o, sa * a[j] + sb * b[j]); }
    }
};
struct OutN {
    static constexpr int NPASS = 1; Params p;
    __device__ __forceinline__ bool active(int) const { return true; }
    __device__ __forceinline__ int K(int) const { return D; }
    __device__ __forceinline__ int ldb(int) const { return D; }
    __device__ __forceinline__ const act* arow(int, int m) const { return (const act*)(p.ws + WS_MIX) + (size_t)m * D; }
    __device__ __forceinline__ const bf16* brow(int, int, int n) const { return (const bf16*)(p.ws + WS_WOUT) + (size_t)n * D; }
    __device__ __forceinline__ void epi(int m, int n0, int tx, float (&a)[4], float (&)[4]) const {
#pragma unroll
        for (int j = 0; j < 4; ++j) { const size_t o = (size_t)m * D + n0 + cl(tx, j); p.out[o] = p.x[o] + a[j]; }
    }
};


namespace pg8 {
#define PG8_LAS __attribute__((address_space(3)))
typedef short bf16x8 __attribute__((ext_vector_type(8)));
typedef int v4i_t __attribute__((ext_vector_type(4)));
typedef int v8i_t __attribute__((ext_vector_type(8)));
constexpr int BM = 256, BK = 64, HALF = 128, HTB = HALF * BK * 2  , STAGE_BYTES = 8 * HTB, NXCD = 8, WGM = 8;
__device__ __forceinline__ int lds_byte(int r, int c) { const int st = (r >> 4) * 2 + (c >> 5), rr = r & 15, cc = c & 31, ob = rr * 64 + cc * 2; return st * 1024 + (ob ^ (((ob >> 9) & 1) << 5)); }
__device__ __forceinline__ void stage_rc(int b, int& R, int& C) { const int st = b / 1024, sb = b % 1024, swz = sb ^ (((sb >> 9) & 1) << 5); R = (st >> 1) * 16 + swz / 64; C = (st & 1) * 32 + (swz % 64) / 2; }
__device__ __forceinline__ int perm32(int rho) { const int n = rho >> 4, i = rho & 15; return 8 * (i >> 2) + 4 * n + (i & 3); }
struct Unit { int pm, pn, slot; };
struct Order {
    int nM, nN, nwg, G, c;
    __device__ __forceinline__ void init(int nM_, int nN_, int G_, int c_) { nM = nM_; nN = nN_; nwg = nM * nN; G = G_; c = c_; }
    __device__ __forceinline__ bool next(int i, Unit& u) const {
        const long L = (long)i * G + c; if (L >= nwg) return false;
        int wgid = (int)L; { const int q = nwg / NXCD, r = nwg % NXCD, xcd = wgid % NXCD, off = wgid / NXCD; wgid = (xcd < r ? xcd * (q + 1) : r * (q + 1) + (xcd - r) * q) + off; }
        const int nig = WGM * nN, gid = wgid / nig, fm = gid * WGM, gsz = (nM - fm) < WGM ? (nM - fm) : WGM;
        u.pm = fm + ((wgid % nig) % gsz); u.pn = (wgid % nig) / gsz; u.slot = i; return true;
    }
};
template <class Epi, class Prob, bool ALIGN_EPI>
__device__ __forceinline__ void gemm_phase(PG8_LAS unsigned char* lds, const Prob& P, const Order& S, const Epi& E) {
    int tid = threadIdx.x; asm volatile("" : "+v"(tid)); const int wid = __builtin_amdgcn_readfirstlane(tid >> 6), lane = tid & 63, wr = wid >> 2, wc = wid & 3, fr = lane & 15, fq = lane >> 4;
    constexpr bool GATHER = Prob::GATHER; constexpr bool FP8 = Prob::FP8;
    const int K = P.K, nt = K / BK;
    unsigned voffA[2], voffB[2];
#pragma unroll
    for (int i = 0; i < 2; ++i) { int R, C; stage_rc(tid * 16 + i * 8192, R, C); const int Rb = Epi::PERM ? ((R & ~31) + perm32(R & 31)) : R; voffA[i] = (unsigned)(R * K + C) * 2u; voffB[i] = (unsigned)(Rb * K + C) * 2u; }
    const size_t kstep = (size_t)(BK * 2);
    const size_t hstep = (size_t)HALF * K * 2;
    const unsigned ldsw = (unsigned)wid * 1024u;
    const int aoff = lds_byte(wr * 64 + fr, fq * 8), boff = lds_byte(wc * 32 + fr, fq * 8);
    const char* const Ab = (const char*)P.abase();
#define PG8_SA(b, h) (((b) * 2 + (h)) * HTB)
#define PG8_SB(b, h) ((4 + (b) * 2 + (h)) * HTB)
#define PG8_GLDS(src, bufoff, i) __builtin_amdgcn_global_load_lds((const unsigned*)(src), (PG8_LAS unsigned*)(lds + (bufoff) + ldsw + (i) * 8192), 16, 0, 0)
#define PG8_STAGE_B(bufoff, gbase) do { PG8_GLDS((const char*)(gbase) + voffB[0], bufoff, 0); PG8_GLDS((const char*)(gbase) + voffB[1], bufoff, 1); } while (0)
#define PG8_STAGE_A(bufoff, h, kb) do { if constexpr (GATHER) { PG8_GLDS(Ab + (size_t)g[h][0] + (kb), bufoff, 0); PG8_GLDS(Ab + (size_t)g[h][1] + (kb), bufoff, 1); } \
        else { PG8_GLDS(cA + (h) * hstep + (kb) + voffA[0], bufoff, 0); PG8_GLDS(cA + (h) * hstep + (kb) + voffA[1], bufoff, 1); } } while (0)
#define PG8_CAT(x0, x1) __builtin_shufflevector(x0, x1, 0, 1, 2, 3, 4, 5, 6, 7)
#define PG8_LO(x) __builtin_bit_cast(bf16x8, __builtin_shufflevector(x, x, 0, 1, 2, 3))
#define PG8_HI(x) __builtin_bit_cast(bf16x8, __builtin_shufflevector(x, x, 4, 5, 6, 7))
#define PG8_LDA(dst, b, h) do { _Pragma("unroll") for (int m = 0; m < 4; ++m) dst[m] = PG8_CAT(*(const PG8_LAS v4i_t*)(lds + PG8_SA(b, h) + aoff + m * 2048), *(const PG8_LAS v4i_t*)(lds + PG8_SA(b, h) + aoff + m * 2048 + 1024)); } while (0)
#define PG8_LDB(dst, b, h) do { _Pragma("unroll") for (int n = 0; n < 2; ++n) dst[n] = PG8_CAT(*(const PG8_LAS v4i_t*)(lds + PG8_SB(b, h) + boff + n * 2048), *(const PG8_LAS v4i_t*)(lds + PG8_SB(b, h) + boff + n * 2048 + 1024)); } while (0)
#define PG8_MMA(ai, bj, At, Bt) do { __builtin_amdgcn_s_setprio(1); _Pragma("unroll") for (int m = 0; m < 4; ++m) _Pragma("unroll") for (int n = 0; n < 2; ++n) { \
        if constexpr (FP8) acc[ai][bj][m][n] = __builtin_amdgcn_mfma_scale_f32_16x16x128_f8f6f4(Bt[n], At[m], acc[ai][bj][m][n], 0, 0, 0, 0x79797979, 0, 0x7f7f7f7f); \
        else { acc[ai][bj][m][n] = __builtin_amdgcn_mfma_f32_16x16x32_bf16(PG8_LO(Bt[n]), PG8_LO(At[m]), acc[ai][bj][m][n], 0, 0, 0); \
               acc[ai][bj][m][n] = __builtin_amdgcn_mfma_f32_16x16x32_bf16(PG8_HI(Bt[n]), PG8_HI(At[m]), acc[ai][bj][m][n], 0, 0, 0); } } \
        __builtin_amdgcn_s_setprio(0); } while (0)
#define PG8_WAIT_V(n) asm volatile("s_waitcnt vmcnt(" #n ")" ::: "memory")
#define PG8_WAIT_L(n) asm volatile("s_waitcnt lgkmcnt(" #n ")" ::: "memory")
#define PG8_BAR __builtin_amdgcn_s_barrier()
#define PG8_SCHED __builtin_amdgcn_sched_barrier(0)
    Unit cur, nxt; int ui = 0;
    if (!S.next(0, cur)) return;
    f32x4 acc[2][2][4][2];
#pragma unroll
    for (int a = 0; a < 2; ++a)
#pragma unroll
        for (int b = 0; b < 2; ++b)
#pragma unroll
            for (int m = 0; m < 4; ++m)
#pragma unroll
                for (int n = 0; n < 2; ++n) acc[a][b][m][n] = (f32x4){0.f, 0.f, 0.f, 0.f};
    if constexpr (Epi::HAS_INIT) { f32x4 iv[2][2]; E.init_load(iv, cur, wc, fq); E.init_apply(acc, iv); }
    v8i_t At[4], B0[2], B1[2];
    unsigned g[2][2], gn[2][2];
    const char* cA = Ab; const char* nA = Ab;
    if constexpr (GATHER) {
#pragma unroll
        for (int h = 0; h < 2; ++h)
#pragma unroll
            for (int i = 0; i < 2; ++i) { g[h][i] = P.goff(cur, h, voffA[i]); gn[h][i] = g[h][i]; }
    } else { cA = Ab + P.aoff(cur); nA = cA; }
    const char* cB = (const char*)P.bbase(cur);
    PG8_STAGE_B(PG8_SB(0, 0), cB); PG8_STAGE_B(PG8_SB(0, 1), cB + hstep); PG8_STAGE_A(PG8_SA(0, 0), 0, 0); PG8_STAGE_A(PG8_SA(0, 1), 1, 0);
    if (wr == 1) PG8_BAR;
    PG8_WAIT_V(2); PG8_BAR;
    PG8_STAGE_B(PG8_SB(1, 0), cB + kstep); PG8_STAGE_A(PG8_SA(1, 0), 0, kstep); PG8_STAGE_B(PG8_SB(1, 1), cB + hstep + kstep);
    PG8_WAIT_V(6); PG8_BAR;
    for (;;) {
        const bool has_next = S.next(ui + 1, nxt);
        const char* nB = cB;
        if (has_next) { nB = (const char*)P.bbase(nxt);
            if constexpr (GATHER) {
#pragma unroll
                for (int h = 0; h < 2; ++h)
#pragma unroll
                    for (int i = 0; i < 2; ++i) gn[h][i] = P.goff(nxt, h, voffA[i]);
            } else nA = Ab + P.aoff(nxt); }
        for (int t = 0; t < nt; t += 2) {
            const bool last = (t == nt - 2);
            const size_t k1 = (size_t)(t + 1) * kstep;
            const size_t k2 = last ? 0 : (size_t)(t + 2) * kstep, k3 = k2 + kstep;
            if constexpr (Epi::MID_T > 0) { if (t == Epi::MID_T) E.mid(acc, cur, wr, wc, fr, fq); }
            PG8_LDB(B0, 0, 0); PG8_LDB(B1, 0, 1); PG8_SCHED; PG8_LDA(At, 0, 0); PG8_STAGE_A(PG8_SA(1, 1), 1, k1);
            if (last) { cB = nB; if constexpr (GATHER) { g[0][0] = gn[0][0]; g[0][1] = gn[0][1]; g[1][0] = gn[1][0]; g[1][1] = gn[1][1]; } else cA = nA; }
            PG8_WAIT_V(8); PG8_WAIT_L(0); PG8_BAR; PG8_MMA(0, 0, At, B0); PG8_MMA(0, 1, At, B1); PG8_BAR; PG8_SCHED;
            PG8_LDA(At, 0, 1); PG8_STAGE_B(PG8_SB(0, 0), cB + k2); PG8_STAGE_B(PG8_SB(0, 1), cB + k2 + hstep); PG8_STAGE_A(PG8_SA(0, 0), 0, k2);
            PG8_WAIT_V(8); PG8_WAIT_L(0); PG8_BAR; PG8_MMA(1, 0, At, B0); PG8_MMA(1, 1, At, B1); PG8_BAR; PG8_SCHED;
            PG8_LDB(B0, 1, 0); PG8_LDB(B1, 1, 1); PG8_SCHED; PG8_LDA(At, 1, 0); PG8_STAGE_A(PG8_SA(0, 1), 1, k2);
            PG8_WAIT_V(8); PG8_WAIT_L(0); PG8_BAR; PG8_MMA(0, 0, At, B0); PG8_MMA(0, 1, At, B1); PG8_BAR; PG8_SCHED;
            PG8_LDA(At, 1, 1); PG8_STAGE_B(PG8_SB(1, 0), cB + k3); PG8_STAGE_B(PG8_SB(1, 1), cB + k3 + hstep); PG8_STAGE_A(PG8_SA(1, 0), 0, k3);
            PG8_WAIT_V(8); PG8_WAIT_L(0); PG8_BAR; PG8_MMA(1, 0, At, B0); PG8_MMA(1, 1, At, B1); PG8_BAR; PG8_SCHED;
        }
        if constexpr (ALIGN_EPI) { if (wr == 0) PG8_BAR; }
        f32x4 iv[2][2];
        if constexpr (Epi::HAS_INIT) { if (has_next) E.init_load(iv, nxt, wc, fq); }
        E(acc, cur, wr, wc, fr, fq);
        if (!has_next) break;
#pragma unroll
        for (int a = 0; a < 2; ++a)
#pragma unroll
            for (int b = 0; b < 2; ++b)
#pragma unroll
                for (int m = 0; m < 4; ++m)
#pragma unroll
                    for (int n = 0; n < 2; ++n) acc[a][b][m][n] = (f32x4){0.f, 0.f, 0.f, 0.f};
        if constexpr (Epi::HAS_INIT) E.init_apply(acc, iv);
        cur = nxt; ++ui;
        if constexpr (ALIGN_EPI) { if (wr == 1) PG8_BAR; }
    }
    PG8_WAIT_V(0);
    if constexpr (!ALIGN_EPI) { if (wr == 0) PG8_BAR; }
    PG8_BAR;
#undef PG8_SA
#undef PG8_SB
#undef PG8_GLDS
#undef PG8_STAGE_A
#undef PG8_STAGE_B
#undef PG8_LDA
#undef PG8_LDB
#undef PG8_MMA
#undef PG8_CAT
#undef PG8_LO
#undef PG8_HI
#undef PG8_WAIT_V
#undef PG8_WAIT_L
#undef PG8_BAR
#undef PG8_SCHED
}
}


constexpr int MT_OFF = 131072;
struct MoeTab { const LAS int* e_of; const LAS int* rt; const LAS float* rp; };
template <bool WITH_P> __device__ __forceinline__ int moe_tables(const Params& p, unsigned char* lds, int tid, int nN, int nb, int bid, MoeTab& mt) {
    LAS int* cnt = (LAS int*)(lds + MT_OFF); LAS int* pstart = cnt + 32; LAS int* e_of = cnt + 72; constexpr int MAXU = WITH_P ? 5 : 9;
    LAS int* rt = cnt + 112; LAS float* rp = (LAS float*)(rt + MAXU * 256);
    __syncthreads();
    if (tid < NE) cnt[tid] = __hip_atomic_load((const int*)(p.ws + WS_CTL) + CW_ECNT + 64 * tid, __ATOMIC_RELAXED, __HIP_MEMORY_SCOPE_AGENT);
    __syncthreads();
    if (tid == 0) { int st = 0; for (int e = 0; e < NE; ++e) { pstart[e] = st; st += (cnt[e] + 255) & ~255; } pstart[32] = st; }
    __syncthreads();
    const int n_mt = __builtin_amdgcn_readfirstlane(pstart[32] >> 8);
    pg8::Order O; O.init(n_mt, nN, nb, bid);
    LAS int* pm_of = cnt + 88;
    if (tid < MAXU) { pg8::Unit u; int e = 0, pm = -1;
        if (O.next(tid, u)) { pm = u.pm; for (int q = 1; q < NE; ++q) if (pm * 256 >= pstart[q]) e = q; }
        e_of[tid] = e; pm_of[tid] = pm; }
    __syncthreads();
    for (int idx = tid; idx < MAXU * 256; idx += 512) { const int i = idx >> 8, r = idx & 255, pm = pm_of[i];
        if (pm >= 0) { const int e = e_of[i]; const int pos = pm * 256 + r - pstart[e]; const bool ok = pos < cnt[e];
            rt[idx] = ok ? ((const int*)(p.ws + WS_ELIST))[e * T + pos] : -1;
            if (WITH_P) rp[idx] = ok ? ((const float*)(p.ws + WS_EP))[e * T + pos] : 0.f; } }
    __syncthreads();
    mt.e_of = e_of; mt.rt = rt; mt.rp = rp;
    return n_mt;
}
struct ProbPlain {
    static constexpr bool GATHER = false, FP8 = false;
    const bf16* A; const bf16* Bt; int K;
    __device__ __forceinline__ const bf16* abase() const { return A; }
    __device__ __forceinline__ size_t aoff(const pg8::Unit& u) const { return (size_t)u.pm * 256 * K * 2; }
    __device__ __forceinline__ unsigned goff(const pg8::Unit&, int, unsigned) const { return 0u; }
    __device__ __forceinline__ const bf16* bbase(const pg8::Unit& u) const { return Bt + (size_t)u.pn * 256 * K; }
};
struct ProbPlainOff {
    static constexpr bool GATHER = true, FP8 = false;
    const bf16* A; const bf16* Bt; int K;
    __device__ __forceinline__ const bf16* abase() const { return A; }
    __device__ __forceinline__ size_t aoff(const pg8::Unit& u) const { return (size_t)u.pm * 256 * K * 2; }
    __device__ __forceinline__ unsigned goff(const pg8::Unit& u, int h, unsigned voff) const { return (unsigned)(u.pm * 256 + h * 128) * ((unsigned)K * 2u) + voff; }
    __device__ __forceinline__ const bf16* bbase(const pg8::Unit& u) const { return Bt + (size_t)u.pn * 256 * K; }
};
struct ProbPlainF8 {
    static constexpr bool GATHER = true, FP8 = true;
    const bf16* A; const bf16* Bt; int K;
    __device__ __forceinline__ const bf16* abase() const { return A; }
    __device__ __forceinline__ size_t aoff(const pg8::Unit& u) const { return (size_t)u.pm * 256 * K * 2; }
    __device__ __forceinline__ unsigned goff(const pg8::Unit& u, int h, unsigned voff) const { return (unsigned)(u.pm * 256 + h * 128) * ((unsigned)K * 2u) + voff; }
    __device__ __forceinline__ const bf16* bbase(const pg8::Unit& u) const { return Bt + (size_t)u.pn * 256 * K; }
};
template <bool G, bool F8> struct ProbMoE {
    static constexpr bool GATHER = true, FP8 = F8;
    const bf16* A; const bf16* Bt; int K; MoeTab mt; int rows_e;
    __device__ __forceinline__ const bf16* abase() const { return A; }
    __device__ __forceinline__ size_t aoff(const pg8::Unit& u) const { return (size_t)u.pm * 256 * K * 2; }
    __device__ __forceinline__ unsigned goff(const pg8::Unit& u, int h, unsigned voff) const {
        const unsigned pitch = (unsigned)K * 2u;
        if constexpr (!G) return (unsigned)(u.pm * 256 + h * 128) * pitch + voff;
        const unsigned R = voff / pitch, inrow = voff - R * pitch;
        const int a = mt.rt[u.slot * 256 + h * 128 + (int)R]; const int row = a < 0 ? 0 : (a >> 2);
        return (unsigned)row * pitch + inrow; }
    __device__ __forceinline__ const bf16* bbase(const pg8::Unit& u) const { const int e = __builtin_amdgcn_readfirstlane(mt.e_of[u.slot]); return Bt + ((size_t)e * rows_e + (size_t)u.pn * 256) * K; }
};
struct EpiInProj {
    static constexpr bool HAS_INIT = false; static constexpr int MID_T = 0; static constexpr bool PERM = true; Params p;
    __device__ __forceinline__ void operator()(const f32x4 (&acc)[2][2][4][2], const pg8::Unit& u, int wr, int wc, int fr, int fq) const {
        unsigned char* ws = p.ws; const int pn = u.pn;
        bf16* dst; int ld, ct; int kind = 0; const float* gb = nullptr;
        if (pn < 2) { dst = (bf16*)(ws + WS_QA); ld = WA; ct = pn * 256; kind = 1; }
        else if (pn < 4) { dst = (bf16*)(ws + WS_KA); ld = WA; ct = (pn - 2) * 256; kind = 1; }
        else if (pn < 6) { dst = (bf16*)(ws + WS_VA); ld = WA; ct = (pn - 4) * 256; }
        else if (pn < 9) { dst = (bf16*)(ws + WS_QB); ld = WB; ct = (pn - 6) * 256; kind = 1; }
        else if (pn < 12) { dst = (bf16*)(ws + WS_KB); ld = WB; ct = (pn - 9) * 256; kind = 1; }
        else if (pn < 15) { dst = (bf16*)(ws + WS_VB); ld = WB; ct = (pn - 12) * 256; }
        else if (pn < 19) { dst = (bf16*)(ws + WS_SA); ld = D; ct = (pn - 15) * 256; kind = 2; gb = p.b_gate_a; }
        else { dst = (bf16*)(ws + WS_SB); ld = D; ct = (pn - 19) * 256; kind = 2; gb = p.b_gate_b; }
        const int row0 = u.pm * 256 + wr * 64 + fr, col0 = ct + wc * 32 + 8 * fq;
        f32x4 bv[2][2];
#pragma unroll
        for (int bj = 0; bj < 2; ++bj)
#pragma unroll
            for (int n = 0; n < 2; ++n) bv[bj][n] = (kind == 2) ? *(const f32x4*)(gb + col0 + bj * 128 + 4 * n) : (f32x4){0.f, 0.f, 0.f, 0.f};
        const bool dorope = (kind == 1) && ((wc & 1) == 0);
        const bool dokm = (pn == 2) || (pn == 3);
        f32x4 ks[2][2];
#pragma unroll
        for (int bj = 0; bj < 2; ++bj) { ks[bj][0] = (f32x4){0.f, 0.f, 0.f, 0.f}; ks[bj][1] = (f32x4){0.f, 0.f, 0.f, 0.f}; }
        const float sgn = (fq == 0) ? -1.0f : 1.0f; const bool rl = fq < 2;
#pragma unroll
        for (int ai = 0; ai < 2; ++ai)
#pragma unroll
            for (int m = 0; m < 4; ++m) {
                const int row = row0 + ai * 128 + m * 16;
                f32x4 cs[4];
                if (dorope) { const f32x4* rp = (const f32x4*)(ws + WS_ROPE) + (size_t)(row % S) * 4;
#pragma unroll
                    for (int i = 0; i < 4; ++i) cs[i] = rp[i]; }
                bf16* rowp = dst + (size_t)row * ld + col0;
#pragma unroll
                for (int bj = 0; bj < 2; ++bj) {
                    f32x4 v0 = acc[ai][bj][m][0], v1 = acc[ai][bj][m][1];
                    if (dorope) {
                        f32x4 q0, q1;
#pragma unroll
                        for (int j = 0; j < 4; ++j) { q0[j] = __shfl_xor(v0[j], 16); q1[j] = __shfl_xor(v1[j], 16); }
                        if (rl) {
                            v0[0] = v0[0] * cs[0][0] + sgn * q0[0] * cs[0][1]; v0[1] = v0[1] * cs[0][2] + sgn * q0[1] * cs[0][3];
                            v0[2] = v0[2] * cs[1][0] + sgn * q0[2] * cs[1][1]; v0[3] = v0[3] * cs[1][2] + sgn * q0[3] * cs[1][3];
                            v1[0] = v1[0] * cs[2][0] + sgn * q1[0] * cs[2][1]; v1[1] = v1[1] * cs[2][2] + sgn * q1[1] * cs[2][3];
                            v1[2] = v1[2] * cs[3][0] + sgn * q1[2] * cs[3][1]; v1[3] = v1[3] * cs[3][2] + sgn * q1[3] * cs[3][3]; }
                    }
                    if (dokm) { ks[bj][0] += v0; ks[bj][1] += v1; }
                    if (kind == 2) {
                        v0 = v0 + bv[bj][0]; v1 = v1 + bv[bj][1];
#pragma unroll
                        for (int j = 0; j < 4; ++j) { v0[j] = fast_sigmoid(v0[j]); v1[j] = fast_sigmoid(v1[j]); } }
                    u32x4 w; w.x = cvtpk(v0[0], v0[1]); w.y = cvtpk(v0[2], v0[3]); w.z = cvtpk(v1[0], v1[1]); w.w = cvtpk(v1[2], v1[3]);
                    *(u32x4*)(rowp + bj * 128) = w;
                }
            }
        if (dokm) {
            float* km = (float*)(ws + WS_KMEAN) + (size_t)((u.pm >> 5) * NHA * NBLK + (u.pm & 31)) * HD;
#pragma unroll
            for (int bj = 0; bj < 2; ++bj)
#pragma unroll
                for (int n = 0; n < 2; ++n)
#pragma unroll
                    for (int j = 0; j < 4; ++j) { float v = ks[bj][n][j]; v += __shfl_xor(v, 1); v += __shfl_xor(v, 2); v += __shfl_xor(v, 4); v += __shfl_xor(v, 8);
                        if (fr == 0) { const int c = col0 + bj * 128 + 4 * n + j; atomicAdd(km + (size_t)(c >> 6) * NBLK * HD + (c & 63), v * (1.0f / MBLK)); } }
        }
    }
};
template <int PASS> struct EpiMix {
    static constexpr bool HAS_INIT = false; static constexpr int MID_T = 0; static constexpr bool PERM = true; Params p;
    __device__ __forceinline__ void operator()(const f32x4 (&acc)[2][2][4][2], const pg8::Unit& u, int wr, int wc, int fr, int fq) const {
        const int row0 = u.pm * 256 + wr * 64 + fr, col0 = u.pn * 256 + wc * 32 + 8 * fq;
        const bf16* G = (const bf16*)(p.ws + (PASS == 0 ? WS_SA : WS_SB)); bf16* M = (bf16*)(p.ws + WS_MIX);
#pragma unroll
        for (int ai = 0; ai < 2; ++ai)
#pragma unroll
            for (int m = 0; m < 4; ++m) {
                const size_t ro = (size_t)(row0 + ai * 128 + m * 16) * D + col0;
#pragma unroll
                for (int bj = 0; bj < 2; ++bj) {
                    const u32x4 g = *(const u32x4*)(G + ro + bj * 128);
                    f32x4 v0 = acc[ai][bj][m][0], v1 = acc[ai][bj][m][1];
                    v0[0] *= __uint_as_float(g.x << 16); v0[1] *= __uint_as_float(g.x & 0xffff0000u); v0[2] *= __uint_as_float(g.y << 16); v0[3] *= __uint_as_float(g.y & 0xffff0000u);
                    v1[0] *= __uint_as_float(g.z << 16); v1[1] *= __uint_as_float(g.z & 0xffff0000u); v1[2] *= __uint_as_float(g.w << 16); v1[3] *= __uint_as_float(g.w & 0xffff0000u);
                    if (PASS == 1) { const u32x4 t = *(const u32x4*)(M + ro + bj * 128);
                        v0[0] += __uint_as_float(t.x << 16); v0[1] += __uint_as_float(t.x & 0xffff0000u); v0[2] += __uint_as_float(t.y << 16); v0[3] += __uint_as_float(t.y & 0xffff0000u);
                        v1[0] += __uint_as_float(t.z << 16); v1[1] += __uint_as_float(t.z & 0xffff0000u); v1[2] += __uint_as_float(t.w << 16); v1[3] += __uint_as_float(t.w & 0xffff0000u); }
                    u32x4 w; w.x = cvtpk(v0[0], v0[1]); w.y = cvtpk(v0[2], v0[3]); w.z = cvtpk(v1[0], v1[1]); w.w = cvtpk(v1[2], v1[3]);
                    *(u32x4*)(M + ro + bj * 128) = w;
                }
            }
    }
};
struct EpiMixCat {
    static constexpr bool HAS_INIT = false; static constexpr int MID_T = 8; static constexpr bool PERM = true; Params p;
    __device__ __forceinline__ void mid(f32x4 (&acc)[2][2][4][2], const pg8::Unit& u, int wr, int wc, int fr, int fq) const {
        int row0 = u.pm * 256 + wr * 64 + fr, col0 = u.pn * 256 + wc * 32 + 8 * fq;
        asm volatile("" : "+v"(row0), "+v"(col0));
        const bf16* GA = (const bf16*)(p.ws + WS_SA); const bf16* GB = (const bf16*)(p.ws + WS_SB);
#pragma unroll
        for (int ai = 0; ai < 2; ++ai)
#pragma unroll
            for (int m = 0; m < 4; ++m) {
                const size_t ro = (size_t)(row0 + ai * 128 + m * 16) * D + col0;
#pragma unroll
                for (int bj = 0; bj < 2; ++bj) {
                    const u32x4 a = *(const u32x4*)(GA + ro + bj * 128), b = *(const u32x4*)(GB + ro + bj * 128);
#pragma unroll
                    for (int j = 0; j < 4; ++j) { const float r0 = __uint_as_float(a[j] << 16) * __builtin_amdgcn_rcpf(__uint_as_float(b[j] << 16)), r1 = __uint_as_float(a[j] & 0xffff0000u) * __builtin_amdgcn_rcpf(__uint_as_float(b[j] & 0xffff0000u));
                        if (j < 2) { acc[ai][bj][m][0][2 * j] *= r0; acc[ai][bj][m][0][2 * j + 1] *= r1; } else { acc[ai][bj][m][1][2 * j - 4] *= r0; acc[ai][bj][m][1][2 * j - 3] *= r1; } }
                }
                asm volatile("" ::: "memory");
            }
    }
    __device__ __forceinline__ void operator()(const f32x4 (&acc)[2][2][4][2], const pg8::Unit& u, int wr, int wc, int fr, int fq) const {
        const int row0 = u.pm * 256 + wr * 64 + fr, col0 = u.pn * 256 + wc * 32 + 8 * fq;
        const bf16* GB = (const bf16*)(p.ws + WS_SB); bf16* M = (bf16*)(p.ws + WS_MIX);
#pragma unroll
        for (int ai = 0; ai < 2; ++ai)
#pragma unroll
            for (int m = 0; m < 4; ++m) {
                const size_t ro = (size_t)(row0 + ai * 128 + m * 16) * D + col0;
#pragma unroll
                for (int bj = 0; bj < 2; ++bj) {
                    const u32x4 g = *(const u32x4*)(GB + ro + bj * 128);
                    f32x4 v0 = acc[ai][bj][m][0], v1 = acc[ai][bj][m][1];
                    v0[0] *= __uint_as_float(g.x << 16); v0[1] *= __uint_as_float(g.x & 0xffff0000u); v0[2] *= __uint_as_float(g.y << 16); v0[3] *= __uint_as_float(g.y & 0xffff0000u);
                    v1[0] *= __uint_as_float(g.z << 16); v1[1] *= __uint_as_float(g.z & 0xffff0000u); v1[2] *= __uint_as_float(g.w << 16); v1[3] *= __uint_as_float(g.w & 0xffff0000u);
                    u32x4 w; w.x = cvtpk(v0[0], v0[1]); w.y = cvtpk(v0[2], v0[3]); w.z = cvtpk(v1[0], v1[1]); w.w = cvtpk(v1[2], v1[3]);
                    *(u32x4*)(M + ro + bj * 128) = w;
                }
            }
    }
};
struct EpiOut {
    static constexpr bool HAS_INIT = false; static constexpr int MID_T = 0; static constexpr bool PERM = false; Params p;
    __device__ __forceinline__ void operator()(const f32x4 (&acc)[2][2][4][2], const pg8::Unit& u, int wr, int wc, int fr, int fq) const {
        const int row0 = u.pm * 256 + wr * 64 + fr, col0 = u.pn * 256 + wc * 32 + 4 * fq;
#pragma unroll
        for (int ai = 0; ai < 2; ++ai)
#pragma unroll
            for (int m = 0; m < 4; ++m) { const size_t ro = (size_t)(row0 + ai * 128 + m * 16) * D + col0;
#pragma unroll
                for (int bj = 0; bj < 2; ++bj)
#pragma unroll
                    for (int n = 0; n < 2; ++n) { const size_t o = ro + bj * 128 + n * 16; *(f32x4*)(p.out + o) = *(const f32x4*)(p.x + o) + acc[ai][bj][m][n]; } }
    }
};
struct EpiGateUp {
    static constexpr bool HAS_INIT = true; static constexpr int MID_T = 0; static constexpr bool PERM = false; Params p; MoeTab mt;
    __device__ __forceinline__ void init_load(f32x4 (&iv)[2][2], const pg8::Unit& u, int wc, int fq) const {
        const int e = __builtin_amdgcn_readfirstlane(mt.e_of[u.slot]);
#pragma unroll
        for (int bj = 0; bj < 2; ++bj) { const int cc = 16 * (8 * u.pn + 4 * bj + wc) + 4 * fq; iv[bj][0] = *(const f32x4*)(p.b_gate + e * FF + cc); iv[bj][1] = *(const f32x4*)(p.b_up + e * FF + cc); }
    }
    __device__ __forceinline__ void init_apply(f32x4 (&acc)[2][2][4][2], const f32x4 (&iv)[2][2]) const {
#pragma unroll
        for (int ai = 0; ai < 2; ++ai)
#pragma unroll
            for (int bj = 0; bj < 2; ++bj)
#pragma unroll
                for (int m = 0; m < 4; ++m) { acc[ai][bj][m][0] = iv[bj][0]; acc[ai][bj][m][1] = iv[bj][1] + 1.0f; }
    }
    __device__ __forceinline__ void operator()(const f32x4 (&acc)[2][2][4][2], const pg8::Unit& u, int wr, int wc, int fr, int fq) const {
        const int row0 = u.pm * 256 + wr * 64 + fr;
#pragma unroll
        for (int ai = 0; ai < 2; ++ai)
#pragma unroll
            for (int m = 0; m < 4; ++m) {
#pragma unroll
                for (int bj = 0; bj < 2; ++bj) { const int cc = 16 * (8 * u.pn + 4 * bj + wc) + 4 * fq; const f32x4 g = acc[ai][bj][m][0], uu = acc[ai][bj][m][1]; f32x4 a;
#pragma unroll
                    for (int j = 0; j < 4; ++j) { const float gg = fminf(g[j], 7.0f), u1 = fminf(fmaxf(uu[j], -6.0f), 8.0f);
                        a[j] = gg * __builtin_amdgcn_rcpf(1.0f + __builtin_amdgcn_exp2f(-2.4554669595930156f * gg)) * u1; }
#if FP8_DN
                    int w = __builtin_amdgcn_cvt_pk_fp8_f32(a[0], a[1], 0, false); w = __builtin_amdgcn_cvt_pk_fp8_f32(a[2], a[3], w, true);
                    *(int*)((unsigned char*)(p.ws + WS_A2) + (size_t)(row0 + ai * 128 + m * 16) * FF + cc) = w;
#else
                    u32x2 w; w.x = cvtpk(a[0], a[1]); w.y = cvtpk(a[2], a[3]); *(u32x2*)((bf16*)(p.ws + WS_A2) + (size_t)(row0 + ai * 128 + m * 16) * FF + cc) = w;
#endif
                } }
    }
};
struct EpiDown {
    static constexpr bool HAS_INIT = true; static constexpr int MID_T = 0; static constexpr bool PERM = true; Params p; MoeTab mt;
    __device__ __forceinline__ void init_load(f32x4 (&iv)[2][2], const pg8::Unit& u, int wc, int fq) const {
        const int e = __builtin_amdgcn_readfirstlane(mt.e_of[u.slot]); const float* bd = p.b_down + e * D + u.pn * 256 + wc * 32 + 8 * fq;
#pragma unroll
        for (int bj = 0; bj < 2; ++bj) { iv[bj][0] = *(const f32x4*)(bd + bj * 128); iv[bj][1] = *(const f32x4*)(bd + bj * 128 + 4); }
    }
    __device__ __forceinline__ void init_apply(f32x4 (&acc)[2][2][4][2], const f32x4 (&iv)[2][2]) const {
#pragma unroll
        for (int ai = 0; ai < 2; ++ai)
#pragma unroll
            for (int bj = 0; bj < 2; ++bj)
#pragma unroll
                for (int m = 0; m < 4; ++m) { acc[ai][bj][m][0] = iv[bj][0]; acc[ai][bj][m][1] = iv[bj][1]; }
    }
    __device__ __forceinline__ void operator()(const f32x4 (&acc)[2][2][4][2], const pg8::Unit& u, int wr, int wc, int fr, int fq) const {
        const int col0 = u.pn * 256 + wc * 32 + 8 * fq;
        int asg[2][4]; float pw[2][4];
#pragma unroll
        for (int ai = 0; ai < 2; ++ai)
#pragma unroll
            for (int m = 0; m < 4; ++m) { const int rl = u.slot * 256 + wr * 64 + fr + ai * 128 + m * 16; asg[ai][m] = mt.rt[rl]; pw[ai][m] = mt.rp[rl]; }
#pragma unroll
        for (int ai = 0; ai < 2; ++ai)
#pragma unroll
            for (int m = 0; m < 4; ++m) {
                if (asg[ai][m] >= 0) { const float pp = pw[ai][m] * (FP8_Y ? 16.0f : 1.0f);
#pragma unroll
                    for (int bj = 0; bj < 2; ++bj) { const f32x4 v0 = acc[ai][bj][m][0] * pp, v1 = acc[ai][bj][m][1] * pp;
#if FP8_Y
                        int w0 = __builtin_amdgcn_cvt_pk_fp8_f32(v0[0], v0[1], 0, false); w0 = __builtin_amdgcn_cvt_pk_fp8_f32(v0[2], v0[3], w0, true);
                        int w1 = __builtin_amdgcn_cvt_pk_fp8_f32(v1[0], v1[1], 0, false); w1 = __builtin_amdgcn_cvt_pk_fp8_f32(v1[2], v1[3], w1, true);
                        u32x2 w; w.x = (unsigned)w0; w.y = (unsigned)w1; *(u32x2*)((unsigned char*)(p.ws + WS_Y) + (size_t)asg[ai][m] * D + col0 + bj * 128) = w;
#else
                        u32x4 w; w.x = cvtpk(v0[0], v0[1]); w.y = cvtpk(v0[2], v0[3]); w.z = cvtpk(v1[0], v1[1]); w.w = cvtpk(v1[2], v1[3]);
                        *(u32x4*)((bf16*)(p.ws + WS_Y) + (size_t)asg[ai][m] * D + col0 + bj * 128) = w;
#endif
                    } } }
    }
};

__device__ __forceinline__ void phase_kmean(const Params& p, int gw, int ngw, int lane) {
    for (int it = gw; it < NB * NHA * NBLK; it += ngw) {
        const int n = it % NBLK, h = (it / NBLK) % NHA, b = it / (NBLK * NHA), d = lane;
        const bf16* k = (const bf16*)(p.ws + WS_KA) + ((size_t)b * S + (size_t)n * MBLK) * WA + h * HD + d;
        float s = 0.f; for (int r = 0; r < MBLK; ++r) s += bf2f(k[(size_t)r * WA]);
        ((float*)(p.ws + WS_KMEAN))[(size_t)it * HD + d] = s * (1.0f / MBLK);
    }
}
__device__ __forceinline__ void phase_select(const Params& p, int gtid, int ngt) {
    for (int idx = gtid; idx < T * NHA; idx += ngt) {
        const int h = idx % NHA, t = idx / NHA, b = t / S, s = t % S, blk = s / MBLK;
        const bf16* q = (const bf16*)(p.ws + WS_QA) + (size_t)t * WA + h * HD;
        const float* km = (const float*)(p.ws + WS_KMEAN) + (size_t)(b * NHA + h) * NBLK * HD;
        float best0 = -INFINITY, best1 = -INFINITY, best2 = -INFINITY; int b0 = -1, b1 = -1, b2 = -1;
        for (int n = 0; n < blk; ++n) {
            float g = 0.f; for (int d = 0; d < HD; ++d) g += bf2f(q[d]) * km[n * HD + d];
            if (g > best0) { best2 = best1; b2 = b1; best1 = best0; b1 = b0; best0 = g; b0 = n; }
            else if (g > best1) { best2 = best1; b2 = b1; best1 = g; b1 = n; }
            else if (g > best2) { best2 = g; b2 = n; }
        }
        signed char* sel = (signed char*)(p.ws + WS_SEL) + (size_t)idx * 4;
        sel[0] = (signed char)b0; sel[1] = (signed char)b1; sel[2] = (signed char)b2; sel[3] = -1;
    }
}
__device__ __forceinline__ float dot64(const float* qs, const bf16* kr) {
    float a = 0.f;
    for (int d8 = 0; d8 < 8; ++d8) { float kv[8]; ldact8(kr + d8 * 8, kv);
#pragma unroll
        for (int i = 0; i < 8; ++i) a += qs[d8 * 8 + i] * kv[i]; }
    return a;
}
#define WAVE_LDS_FENCE() asm volatile("s_waitcnt lgkmcnt(0)" ::: "memory")
__device__ __forceinline__ void phase_moba_naive(const Params& p, int gw, int ngw, int lane, float* wl, bf16* oa_dst) {
    float* qs = wl; float* sc = wl + 64;
    for (int it = gw; it < T * NHA; it += ngw) {
        const int h = it % NHA, t = it / NHA, b = t / S, s = t % S, blk = s / MBLK;
        WAVE_LDS_FENCE();
        qs[lane] = bf2f(((const bf16*)(p.ws + WS_QA))[(size_t)t * WA + h * HD + lane]);
        WAVE_LDS_FENCE();
        const signed char* sel = (const signed char*)(p.ws + WS_SEL) + ((size_t)t * NHA + h) * 4;
        const int kb0 = blk, kb1 = sel[0], kb2 = sel[1], kb3 = sel[2];
        const bf16* K = (const bf16*)(p.ws + WS_KA) + (size_t)b * S * WA + h * HD; const bf16* V = (const bf16*)(p.ws + WS_VA) + (size_t)b * S * WA + h * HD;
        float mx = -INFINITY;
        for (int g = 0; g < 4; ++g) { const int kbg = g == 0 ? kb0 : g == 1 ? kb1 : g == 2 ? kb2 : kb3;
            for (int c = 0; c < 4; ++c) {
                const int kk = c * 64 + lane; float v = -INFINITY;
                if (kbg >= 0) { const int key = kbg * MBLK + kk; if (g > 0 || key <= s) v = dot64(qs, K + (size_t)key * WA) * 0.125f; }
                sc[g * 256 + kk] = v; mx = fmaxf(mx, v);
            } }
#pragma unroll
        for (int o = 1; o < 64; o <<= 1) mx = fmaxf(mx, __shfl_xor(mx, o));
        WAVE_LDS_FENCE();
        float l = 0.f;
        for (int i = lane; i < 1024; i += 64) { const float e = (sc[i] == -INFINITY) ? 0.f : expf(sc[i] - mx); sc[i] = e; l += e; }
        l = wave_sum(l);
        WAVE_LDS_FENCE();
        float o = 0.f;
        for (int g = 0; g < 4; ++g) { const int kbg = g == 0 ? kb0 : g == 1 ? kb1 : g == 2 ? kb2 : kb3; if (kbg < 0) continue;
            for (int kk = 0; kk < 256; ++kk) { const float pr = sc[g * 256 + kk]; if (pr != 0.f) o += pr * bf2f(V[(size_t)(kbg * MBLK + kk) * WA + lane]); } }
        oa_dst[(size_t)t * WA + h * HD + lane] = (bf16)f2bf(o / l);
    }
}
__device__ __forceinline__ void phase_dil_naive(const Params& p, int gw, int ngw, int lane, float* wl, bf16* ob_dst) {
    float* qs = wl; float* sc = wl + 192;
    for (int it = gw; it < T * 4; it += ngw) {
        const int j = it % 4, t = it / 4, b = t / S, s = t % S;
        WAVE_LDS_FENCE();
        for (int g = 0; g < 3; ++g) qs[g * 64 + lane] = bf2f(((const bf16*)(p.ws + WS_QB))[(size_t)t * WB + (4 * g + j) * HD + lane]);
        WAVE_LDS_FENCE();
        float mx = -INFINITY;
        for (int g = 0; g < 3; ++g) { const int dl = g == 0 ? 1 : g == 1 ? 4 : 16; const bf16* K = (const bf16*)(p.ws + WS_KB) + (size_t)b * S * WB + (4 * g + j) * HD;
            for (int i = lane; i <= 128; i += 64) { const int key = s - i * dl; float v = -INFINITY;
                if (key >= 0) v = dot64(qs + g * 64, K + (size_t)key * WB) * 0.125f;
                sc[g * 129 + i] = v; mx = fmaxf(mx, v); } }
#pragma unroll
        for (int o = 1; o < 64; o <<= 1) mx = fmaxf(mx, __shfl_xor(mx, o));
        WAVE_LDS_FENCE();
        float l = 0.f;
        for (int i = lane; i < 3 * 129; i += 64) { const float e = (sc[i] == -INFINITY) ? 0.f : expf(sc[i] - mx); sc[i] = e; l += e; }
        l = wave_sum(l);
        WAVE_LDS_FENCE();
        float o = 0.f;
        for (int g = 0; g < 3; ++g) { const int dl = g == 0 ? 1 : g == 1 ? 4 : 16; const bf16* V = (const bf16*)(p.ws + WS_VB) + (size_t)b * S * WB + (4 * g + j) * HD;
            for (int i = 0; i <= 128; ++i) { const float pr = sc[g * 129 + i]; const int key = s - i * dl; if (key >= 0 && pr != 0.f) o += pr * bf2f(V[(size_t)key * WB + lane]); } }
        ob_dst[(size_t)t * WBO + j * HD + lane] = (bf16)f2bf(o / l);
    }
}

__device__ __forceinline__ void phase_router(const Params& p, int bid, int nb, unsigned char* lds, int tid) {
    const int lane = tid & 63, w = tid >> 6, h = lane >> 5, r32 = lane & 31;
    float* part = (float*)lds;
    float* ssqp = (float*)(lds + 65536);
    float* rstd_s = (float*)(lds + 65536 + 2048);
    int4* rec = (int4*)(lds + 65536 + 4096);
    int* lc = (int*)(lds + 65536 + 8192); int* gbase = lc + 32;
    bf16x8v whi[8], wlo[8];
#pragma unroll
    for (int sidx = 0; sidx < 8; ++sidx) { const int k0 = 128 * w + 16 * sidx + 8 * h; float wv[8];
        const f32x4 g0 = *(const f32x4*)(p.ln_ffn_g + k0), g1 = *(const f32x4*)(p.ln_ffn_g + k0 + 4);
#pragma unroll
        for (int j = 0; j < 8; ++j) wv[j] = p.w_router[(size_t)(k0 + j) * NE + r32] * (j < 4 ? g0[j] : g1[j - 4]);
        u32x4 hi, lo;
#pragma unroll
        for (int j = 0; j < 4; ++j) { const unsigned hp = cvtpk(wv[2 * j], wv[2 * j + 1]); hi[j] = hp;
            lo[j] = cvtpk(wv[2 * j] - __uint_as_float(hp << 16), wv[2 * j + 1] - __uint_as_float(hp & 0xffff0000u)); }
        whi[sidx] = __builtin_bit_cast(bf16x8v, hi); wlo[sidx] = __builtin_bit_cast(bf16x8v, lo); }
    for (int tg = bid; tg < T / 64; tg += nb) {
        __syncthreads();
        if (tid < 256) rec[tid] = make_int4(-1, 0, 0, 0);
        if (tid < 32) lc[tid] = 0;
#pragma unroll
        for (int tt = 0; tt < 2; ++tt) {
            const float* xr = p.out + (size_t)(tg * 64 + 32 * tt + r32) * D + 128 * w + 8 * h;
            f32x16 acc = {0.f, 0.f, 0.f, 0.f, 0.f, 0.f, 0.f, 0.f, 0.f, 0.f, 0.f, 0.f, 0.f, 0.f, 0.f, 0.f}; float ssq = 0.f;
#pragma unroll
            for (int sidx = 0; sidx < 8; ++sidx) { const f32x4 x0 = *(const f32x4*)(xr + 16 * sidx), x1 = *(const f32x4*)(xr + 16 * sidx + 4);
                ssq += (x0.x * x0.x + x0.y * x0.y) + (x0.z * x0.z + x0.w * x0.w) + (x1.x * x1.x + x1.y * x1.y) + (x1.z * x1.z + x1.w * x1.w);
                u32x4 hi, lo;
                hi.x = cvtpk(x0.x, x0.y); hi.y = cvtpk(x0.z, x0.w); hi.z = cvtpk(x1.x, x1.y); hi.w = cvtpk(x1.z, x1.w);
                lo.x = cvtpk(x0.x - __uint_as_float(hi.x << 16), x0.y - __uint_as_float(hi.x & 0xffff0000u)); lo.y = cvtpk(x0.z - __uint_as_float(hi.y << 16), x0.w - __uint_as_float(hi.y & 0xffff0000u));
                lo.z = cvtpk(x1.x - __uint_as_float(hi.z << 16), x1.y - __uint_as_float(hi.z & 0xffff0000u)); lo.w = cvtpk(x1.z - __uint_as_float(hi.w << 16), x1.w - __uint_as_float(hi.w & 0xffff0000u));
                const bf16x8v xh = __builtin_bit_cast(bf16x8v, hi), xl = __builtin_bit_cast(bf16x8v, lo);
                acc = __builtin_amdgcn_mfma_f32_32x32x16_bf16(xh, whi[sidx], acc, 0, 0, 0);
                acc = __builtin_amdgcn_mfma_f32_32x32x16_bf16(xh, wlo[sidx], acc, 0, 0, 0);
                acc = __builtin_amdgcn_mfma_f32_32x32x16_bf16(xl, whi[sidx], acc, 0, 0, 0); }
#pragma unroll
            for (int r = 0; r < 16; ++r) part[(w * 64 + 32 * tt + crow(r, h)) * 32 + r32] = acc[r];
            ssq += __shfl_xor(ssq, 32);
            if (h == 0) ssqp[w * 64 + 32 * tt + r32] = ssq;
        }
        __syncthreads();
        if (tid < 64) {
            const int t = tg * 64 + tid;
            float sq = 0.f;
#pragma unroll
            for (int i = 0; i < 8; ++i) sq += ssqp[i * 64 + tid];
            const float rstd = 1.0f / sqrtf(sq * (1.0f / D) + NORM_EPS); rstd_s[tid] = rstd;
            float v0 = -INFINITY, v1 = -INFINITY, v2 = -INFINITY, v3 = -INFINITY; int e0 = 0, e1 = 0, e2 = 0, e3 = 0;
            for (int e = 0; e < NE; ++e) { float a = 0.f;
#pragma unroll
                for (int i = 0; i < 8; ++i) a += part[(i * 64 + tid) * 32 + ((e + tid) & 31)];
                const int ee = (e + tid) & 31; const float lg = a * rstd + p.b_router[ee];
                if (lg > v0 || (lg == v0 && ee < e0)) { v3 = v2; e3 = e2; v2 = v1; e2 = e1; v1 = v0; e1 = e0; v0 = lg; e0 = ee; }
                else if (lg > v1 || (lg == v1 && ee < e1)) { v3 = v2; e3 = e2; v2 = v1; e2 = e1; v1 = lg; e1 = ee; }
                else if (lg > v2 || (lg == v2 && ee < e2)) { v3 = v2; e3 = e2; v2 = lg; e2 = ee; }
                else if (lg > v3 || (lg == v3 && ee < e3)) { v3 = lg; e3 = ee; } }
            const float x1 = expf(v1 - v0), x2 = expf(v2 - v0), x3 = expf(v3 - v0); const float inv = 1.0f / (1.0f + x1 + x2 + x3);
            { const int lp = atomicAdd(&lc[e0], 1); rec[tid * 4 + 0] = make_int4(e0, lp, t * 4 + 0, __float_as_int(inv)); }
            { const int lp = atomicAdd(&lc[e1], 1); rec[tid * 4 + 1] = make_int4(e1, lp, t * 4 + 1, __float_as_int(x1 * inv)); }
            { const int lp = atomicAdd(&lc[e2], 1); rec[tid * 4 + 2] = make_int4(e2, lp, t * 4 + 2, __float_as_int(x2 * inv)); }
            { const int lp = atomicAdd(&lc[e3], 1); rec[tid * 4 + 3] = make_int4(e3, lp, t * 4 + 3, __float_as_int(x3 * inv)); }
        }
        __syncthreads();
        if (tid < NE) gbase[tid] = lc[tid] > 0 ? atomicAdd((int*)(p.ws + WS_CTL) + CW_ECNT + 64 * tid, lc[tid]) : 0;
        for (int idx = tid; idx < 64 * 256; idx += 512) { const int tk = idx >> 8, c4 = idx & 255; const size_t t = (size_t)tg * 64 + tk;
            const f32x4 x = *(const f32x4*)(p.out + t * D + 4 * c4), g = *(const f32x4*)(p.ln_ffn_g + 4 * c4); const float rs = rstd_s[tk];
            const float h0 = x.x * rs * g.x, h1 = x.y * rs * g.y, h2 = x.z * rs * g.z, h3 = x.w * rs * g.w;
#if FP8_GU
            int o = __builtin_amdgcn_cvt_pk_fp8_f32(h0, h1, 0, false); o = __builtin_amdgcn_cvt_pk_fp8_f32(h2, h3, o, true); ((int*)((unsigned char*)(p.ws + WS_H) + t * D))[c4] = o;
#else
            u32x2 o; o.x = cvtpk(h0, h1); o.y = cvtpk(h2, h3); ((u32x2*)((bf16*)(p.ws + WS_H) + t * D))[c4] = o;
#endif
        }
        __syncthreads();
        if (tid < 256) { const int4 r = rec[tid]; if (r.x >= 0) { const int pos = gbase[r.x] + r.y; ((int*)(p.ws + WS_ELIST))[r.x * T + pos] = r.z; ((float*)(p.ws + WS_EP))[r.x * T + pos] = __int_as_float(r.w); } }
    }
}
__device__ __forceinline__ void phase_final(const Params& p, int gw, int ngw, int lane) {
    for (int t = gw; t < T; t += ngw) {
        f32x4* xr = (f32x4*)(p.out + (size_t)t * D) + lane; const f32x4* gr = (const f32x4*)p.ln_final_g + lane;
        f32x4 v[4]; float ss = 0.f;
#pragma unroll
        for (int j = 0; j < 4; ++j) { v[j] = xr[64 * j];
#pragma unroll
            for (int k = 0; k < 4; ++k) {
#if FP8_Y
                const int y = ((const int*)((const unsigned char*)(p.ws + WS_Y) + ((size_t)t * 4 + k) * D))[lane + 64 * j];
                const f32x2 y01 = __builtin_amdgcn_cvt_pk_f32_fp8(y, false), y23 = __builtin_amdgcn_cvt_pk_f32_fp8(y, true);
                v[j].x += y01.x * 0.0625f; v[j].y += y01.y * 0.0625f; v[j].z += y23.x * 0.0625f; v[j].w += y23.y * 0.0625f;
#else
                const u32x2 y = ((const u32x2*)((const bf16*)(p.ws + WS_Y) + ((size_t)t * 4 + k) * D))[lane + 64 * j];
                v[j].x += __uint_as_float(y.x << 16); v[j].y += __uint_as_float(y.x & 0xffff0000u); v[j].z += __uint_as_float(y.y << 16); v[j].w += __uint_as_float(y.y & 0xffff0000u);
#endif
            }
            ss += (v[j].x * v[j].x + v[j].y * v[j].y) + (v[j].z * v[j].z + v[j].w * v[j].w); }
        float rstd = 1.0f / sqrtf(wave_sum(ss) * (1.0f / D) + NORM_EPS);
#if DBG
        { const float num = ((const float*)(p.ws + WS_CTL))[CW_DNUM], den = ((const float*)(p.ws + WS_CTL))[CW_DDEN]; rstd *= 1.0f + DBG_GAIN * sqrtf(num / fmaxf(den, 1e-30f)); }
#endif
#if TIMEB_LO >= 0
        { const unsigned long long* ts = (const unsigned long long*)(p.ws + WS_CTL + 917504); rstd *= 1.0f + TIMEB_GAIN * (float)(ts[TIMEB_HI] - ts[TIMEB_LO]) * 1e-6f; }
#endif
#pragma unroll
        for (int j = 0; j < 4; ++j) { const f32x4 g = gr[64 * j]; f32x4 o; o.x = v[j].x * rstd * g.x; o.y = v[j].y * rstd * g.y; o.z = v[j].z * rstd * g.z; o.w = v[j].w * rstd * g.w; xr[64 * j] = o; }
    }
}


#define LDSP __attribute__((address_space(3)))
#define LDS_BARRIER() do { asm volatile("s_waitcnt lgkmcnt(0)" ::: "memory"); __builtin_amdgcn_s_barrier(); asm volatile("" ::: "memory"); } while (0)
constexpr int AT_RS = 144;
constexpr int AT_KOFF = 0, AT_VOFF = 384 * AT_RS, AT_PFX = 131072;
constexpr float AT_C = 0.125f * 1.4426950408889634f;
__device__ __forceinline__ s16x4 vtr(unsigned addr) { return __builtin_bit_cast(s16x4, __builtin_amdgcn_ds_read_tr16_b64_v4i16((LDSP s16x4*)(uintptr_t)addr)); }

struct AttnState { f32x16 o0, o1; float m, l; };
template <bool MASKED> __device__ __forceinline__ void attn_wave(AttnState& st, const bf16x8v (&qf)[4], unsigned kbase, unsigned vbase, int c0, int c1, int clo, int chi, int lane) {
    const int h = lane >> 5, ql = lane & 31;
    if (c0 >= c1) return;
    bf16x8v kf[4];
    { const unsigned ka = kbase + (unsigned)c0 * (32 * AT_RS);
#pragma unroll
      for (int ks = 0; ks < 4; ++ks) kf[ks] = *(const LDSP bf16x8v*)(uintptr_t)(ka + ks * 32); }
#pragma unroll 1
    for (int c = c0; c < c1; ++c) {
        const unsigned va = vbase + (unsigned)c * (32 * AT_RS);
        s16x4 vlo[2][2], vhi[2][2];
#pragma unroll
        for (int ks = 0; ks < 2; ++ks)
#pragma unroll
            for (int db = 0; db < 2; ++db) { vlo[ks][db] = vtr(va + ks * (16 * AT_RS) + db * 64); vhi[ks][db] = vtr(va + ks * (16 * AT_RS) + 8 * AT_RS + db * 64); }
        f32x16 s = {0.f, 0.f, 0.f, 0.f, 0.f, 0.f, 0.f, 0.f, 0.f, 0.f, 0.f, 0.f, 0.f, 0.f, 0.f, 0.f};
#pragma unroll
        for (int ks = 0; ks < 4; ++ks) s = __builtin_amdgcn_mfma_f32_32x32x16_bf16(kf[ks], qf[ks], s, 0, 0, 0);
        { const unsigned kn = kbase + (unsigned)((c + 1 < c1) ? c + 1 : c) * (32 * AT_RS);
#pragma unroll
          for (int ks = 0; ks < 4; ++ks) kf[ks] = *(const LDSP bf16x8v*)(uintptr_t)(kn + ks * 32); }
        float t[16]; float cmax = -INFINITY;
#pragma unroll
        for (int r = 0; r < 16; ++r) { t[r] = s[r];
            if (MASKED) { const int cr = crow(r, h); if ((c == clo && cr < ql) || (c == chi && cr > ql)) t[r] = -INFINITY; }
            cmax = fmaxf(cmax, t[r]); }
        cmax = fmaxf(cmax, __shfl_xor(cmax, 32)) * AT_C;
        const float mn = fmaxf(st.m, cmax); const float mu = (mn == -INFINITY) ? 0.f : mn;
        const float alpha = __builtin_amdgcn_exp2f(st.m - mu);
        float psum = 0.f; float pr[16];
#pragma unroll
        for (int r = 0; r < 16; ++r) { pr[r] = __builtin_amdgcn_exp2f(__builtin_fmaf(t[r], AT_C, -mu)); psum += pr[r]; }
        st.l = st.l * alpha + psum; st.m = mn;
        if (!__all(alpha == 1.0f)) {
#pragma unroll
            for (int r = 0; r < 16; ++r) { st.o0[r] *= alpha; st.o1[r] *= alpha; } }
#pragma unroll
        for (int ks = 0; ks < 2; ++ks) {
            u32x4 pw; pw.x = cvtpk(pr[8 * ks + 0], pr[8 * ks + 1]); pw.y = cvtpk(pr[8 * ks + 2], pr[8 * ks + 3]); pw.z = cvtpk(pr[8 * ks + 4], pr[8 * ks + 5]); pw.w = cvtpk(pr[8 * ks + 6], pr[8 * ks + 7]);
            const bf16x8v pf = __builtin_bit_cast(bf16x8v, pw);
            const bf16x8v vf0 = {vlo[ks][0][0], vlo[ks][0][1], vlo[ks][0][2], vlo[ks][0][3], vhi[ks][0][0], vhi[ks][0][1], vhi[ks][0][2], vhi[ks][0][3]};
            const bf16x8v vf1 = {vlo[ks][1][0], vlo[ks][1][1], vlo[ks][1][2], vlo[ks][1][3], vhi[ks][1][0], vhi[ks][1][1], vhi[ks][1][2], vhi[ks][1][3]};
            st.o0 = __builtin_amdgcn_mfma_f32_32x32x16_bf16(vf0, pf, st.o0, 0, 0, 0);
            st.o1 = __builtin_amdgcn_mfma_f32_32x32x16_bf16(vf1, pf, st.o1, 0, 0, 0);
        }
    }
}
__device__ __forceinline__ void attn_init(AttnState& st) {
#pragma unroll
    for (int r = 0; r < 16; ++r) { st.o0[r] = 0.f; st.o1[r] = 0.f; }
    st.m = -INFINITY; st.l = 0.f;
}
__device__ __forceinline__ void attn_stage(unsigned char* lds, int dst, const unsigned char* src, size_t pitch, int nrows, int skip, int tid) {
    for (int idx = tid; idx < nrows * 8; idx += 512) { const int row = idx >> 3, ch = idx & 7;
        if (row >= skip) { const u32x4 v = *(const u32x4*)(src + (size_t)row * pitch + ch * 16); *(u32x4*)(lds + dst + row * AT_RS + ch * 16) = v; } }
}
__device__ __forceinline__ void attn_qload(bf16x8v (&qf)[4], const bf16* qrow, int h) {
#pragma unroll
    for (int ks = 0; ks < 4; ++ks) qf[ks] = *(const bf16x8v*)(qrow + 16 * ks + 8 * h);
}
__device__ __forceinline__ void attn_store_partial(const AttnState& st, float inv_l, bf16* dst, int h) {
#pragma unroll
    for (int rg = 0; rg < 4; ++rg) {
        u32x2 w0, w1; w0.x = cvtpk(st.o0[4 * rg] * inv_l, st.o0[4 * rg + 1] * inv_l); w0.y = cvtpk(st.o0[4 * rg + 2] * inv_l, st.o0[4 * rg + 3] * inv_l);
        w1.x = cvtpk(st.o1[4 * rg] * inv_l, st.o1[4 * rg + 1] * inv_l); w1.y = cvtpk(st.o1[4 * rg + 2] * inv_l, st.o1[4 * rg + 3] * inv_l);
        *(u32x2*)(dst + 8 * rg + 4 * h) = w0; *(u32x2*)(dst + 32 + 8 * rg + 4 * h) = w1; }
}
__device__ __forceinline__ void attn_acc_partial(f32x16& a0, f32x16& a1, float w, const bf16* src, int h) {
#pragma unroll
    for (int rg = 0; rg < 4; ++rg) { const u32x2 w0 = *(const u32x2*)(src + 8 * rg + 4 * h), w1 = *(const u32x2*)(src + 32 + 8 * rg + 4 * h);
        a0[4 * rg] += w * __uint_as_float(w0.x << 16); a0[4 * rg + 1] += w * __uint_as_float(w0.x & 0xffff0000u); a0[4 * rg + 2] += w * __uint_as_float(w0.y << 16); a0[4 * rg + 3] += w * __uint_as_float(w0.y & 0xffff0000u);
        a1[4 * rg] += w * __uint_as_float(w1.x << 16); a1[4 * rg + 1] += w * __uint_as_float(w1.x & 0xffff0000u); a1[4 * rg + 2] += w * __uint_as_float(w1.y << 16); a1[4 * rg + 3] += w * __uint_as_float(w1.y & 0xffff0000u); }
}


template <int NIT> struct KVRegs { u32x4 k[NIT], v[NIT]; };
template <int NIT> __device__ __forceinline__ void kv_load(KVRegs<NIT>& R, const unsigned char* ksrc, const unsigned char* vsrc, size_t pitch, int skip, int tid) {
#pragma unroll
    for (int i = 0; i < NIT; ++i) { const int idx = tid + 512 * i, row = idx >> 3, ch = idx & 7;
        if (row >= skip) { R.k[i] = *(const u32x4*)(ksrc + (size_t)row * pitch + ch * 16); R.v[i] = *(const u32x4*)(vsrc + (size_t)row * pitch + ch * 16); } }
}
template <int NIT> __device__ __forceinline__ void kv_commit(const KVRegs<NIT>& R, unsigned char* lds, int skip, int tid) {
#pragma unroll
    for (int i = 0; i < NIT; ++i) { const int idx = tid + 512 * i, row = idx >> 3, ch = idx & 7;
        if (row >= skip) { *(u32x4*)(lds + AT_KOFF + row * AT_RS + ch * 16) = R.k[i]; *(u32x4*)(lds + AT_VOFF + row * AT_RS + ch * 16) = R.v[i]; } }
}
__device__ __forceinline__ void phase_select_lists(const Params& p, int bid, int nb, unsigned char* lds, int tid) {
    float* km = (float*)lds;
    for (int it = bid; it < NB * NBLK * 4; it += nb) {
        const int hp = it & 3, n = (it >> 2) % NBLK, b = it / (4 * NBLK);
        __syncthreads();
        for (int i = tid; i < 2 * NBLK * HD; i += 512) { const int hh = i / (NBLK * HD), rest = i % (NBLK * HD); km[i] = ((const float*)(p.ws + WS_KMEAN))[(size_t)(b * NHA + 2 * hp + hh) * NBLK * HD + rest]; }
        __syncthreads();
        const int hh = tid >> 8, h = 2 * hp + hh, s = n * MBLK + (tid & 255), t = b * S + s;
        float q[HD];
        { const u32x4* qp = (const u32x4*)((const bf16*)(p.ws + WS_QA) + (size_t)t * WA + h * HD);
#pragma unroll
            for (int i = 0; i < 8; ++i) { const u32x4 v = qp[i];
#pragma unroll
                for (int j = 0; j < 4; ++j) { q[8 * i + 2 * j] = __uint_as_float(v[j] << 16); q[8 * i + 2 * j + 1] = __uint_as_float(v[j] & 0xffff0000u); } } }
        float best0 = -INFINITY, best1 = -INFINITY, best2 = -INFINITY; int b0 = -1, b1 = -1, b2 = -1;
        const float* kmh = km + hh * (NBLK * HD);
        for (int nn = 0; nn < n; ++nn) {
            float g = 0.f;
#pragma unroll
            for (int d4 = 0; d4 < 16; ++d4) { const f32x4 kv = *(const f32x4*)(kmh + nn * HD + 4 * d4); g += q[4 * d4] * kv.x; g += q[4 * d4 + 1] * kv.y; g += q[4 * d4 + 2] * kv.z; g += q[4 * d4 + 3] * kv.w; }
            if (g > best0) { best2 = best1; b2 = b1; best1 = best0; b1 = b0; best0 = g; b0 = nn; }
            else if (g > best1) { best2 = best1; b2 = b1; best1 = g; b1 = nn; }
            else if (g > best2) { best2 = g; b2 = nn; }
        }
        signed char* sel = (signed char*)(p.ws + WS_SEL) + ((size_t)t * NHA + h) * 4;
        *(unsigned*)sel = (unsigned)(b0 & 0xff) | ((unsigned)(b1 & 0xff) << 8) | ((unsigned)(b2 & 0xff) << 16) | 0xff000000u;
        int* lc = (int*)(lds + 32768); int* gb = lc + 64;
        if (tid < 64) lc[tid] = 0;
        __syncthreads();
        int lp0 = 0, lp1 = 0, lp2 = 0;
        if (b0 >= 0) lp0 = atomicAdd(&lc[hh * 32 + b0], 1);
        if (b1 >= 0) lp1 = atomicAdd(&lc[hh * 32 + b1], 1);
        if (b2 >= 0) lp2 = atomicAdd(&lc[hh * 32 + b2], 1);
        __syncthreads();
        if (tid < 64) { const int c = lc[tid]; gb[tid] = c > 0 ? atomicAdd((int*)(p.ws + WS_CTL) + CW_LCNT + (b * NHA + 2 * hp + (tid >> 5)) * NBLK + (tid & 31), c) : 0; }
        __syncthreads();
        unsigned short* lists = (unsigned short*)(p.ws + WS_LIST) + (size_t)(b * NHA + h) * NBLK * LIST_CAP;
        if (b0 >= 0) lists[(size_t)b0 * LIST_CAP + gb[hh * 32 + b0] + lp0] = (unsigned short)(s | (0 << 13));
        if (b1 >= 0) lists[(size_t)b1 * LIST_CAP + gb[hh * 32 + b1] + lp1] = (unsigned short)(s | (1 << 13));
        if (b2 >= 0) lists[(size_t)b2 * LIST_CAP + gb[hh * 32 + b2] + lp2] = (unsigned short)(s | (2 << 13));
    }
}
__device__ __forceinline__ void phase_dilated(const Params& p, int bid, int nb, unsigned char* lds, int tid) {
    const int lane = tid & 63, w = tid >> 6, h = lane >> 5, ql = lane & 31;
    const unsigned lb = (unsigned)(uintptr_t)lds;
    constexpr int NITM = NB * NHB * 32;
    KVRegs<6> R;
#define DIL_DECODE(it_) const int sub = (it_) & 31, head = ((it_) >> 5) % NHB, b = (it_) / (32 * NHB), g = head >> 2, j = head & 3; \
        const int dl = g == 0 ? 1 : g == 1 ? 4 : 16, r = sub % dl, np = sub / dl; const size_t pitch = (size_t)dl * WB * 2; \
        const long tok0 = (long)b * S + (long)(128 * (2 * np - 1)) * dl + r; const int wq = w & 3, nq = 2 * np + (w >> 2); \
        const size_t tq = (size_t)b * S + (size_t)(128 * nq + 32 * wq + ql) * dl + r; (void)j; (void)pitch; (void)tok0; (void)tq; (void)nq; (void)wq;
    int it = bid;
    if (it < NITM) { DIL_DECODE(it)
        kv_load<6>(R, (const unsigned char*)((const bf16*)(p.ws + WS_KB) + tok0 * WB + head * HD), (const unsigned char*)((const bf16*)(p.ws + WS_VB) + tok0 * WB + head * HD), pitch, np == 0 ? 128 : 0, tid); }
    while (it < NITM) {
        DIL_DECODE(it)
        bf16x8v qf[4]; attn_qload(qf, (const bf16*)(p.ws + WS_QB) + tq * WB + head * HD, h);
        LDS_BARRIER();
        kv_commit<6>(R, lds, np == 0 ? 128 : 0, tid);
        LDS_BARRIER();
        const int nit = it + nb;
        if (nit < NITM) { const int it2 = nit; const int sub2 = it2 & 31, head2 = (it2 >> 5) % NHB, b2 = it2 / (32 * NHB), g2 = head2 >> 2; const int dl2 = g2 == 0 ? 1 : g2 == 1 ? 4 : 16, r2 = sub2 % dl2, np2 = sub2 / dl2;
            const size_t pitch2 = (size_t)dl2 * WB * 2; const long tok02 = (long)b2 * S + (long)(128 * (2 * np2 - 1)) * dl2 + r2;
            kv_load<6>(R, (const unsigned char*)((const bf16*)(p.ws + WS_KB) + tok02 * WB + head2 * HD), (const unsigned char*)((const bf16*)(p.ws + WS_VB) + tok02 * WB + head2 * HD), pitch2, np2 == 0 ? 128 : 0, tid); }
        const int winoff = 128 * (w >> 2);
        AttnState st; attn_init(st);
        const unsigned kbase = lb + AT_KOFF + (unsigned)(winoff + ql) * AT_RS + 16 * h;
        const unsigned vbase = lb + AT_VOFF + (unsigned)(winoff + 4 * h + ((lane & 15) >> 2)) * AT_RS + 32 * ((lane >> 4) & 1) + 8 * (lane & 3);
        const int c0 = (nq == 0) ? 4 : wq;
        attn_wave<true>(st, qf, kbase, vbase, c0, wq + 5, wq, wq + 4, lane);
        const float lt = st.l + __shfl_xor(st.l, 32);
        bf16* dst = (bf16*)(p.ws + WS_PARTB) + (((size_t)g * T + tq) * 4 + j) * HD;
        attn_store_partial(st, 1.0f / lt, dst, h);
        if (h == 0) ((float*)(p.ws + WS_LSEB))[((size_t)g * T + tq) * 4 + j] = st.m + __builtin_amdgcn_logf(lt);
        it = nit;
    }
#undef DIL_DECODE
}
__device__ __forceinline__ void phase_moba_past(const Params& p, int bid, int nb, unsigned char* lds, int tid) {
    const int lane = tid & 63, w = tid >> 6, h = lane >> 5, ql = lane & 31;
    const unsigned lb = (unsigned)(uintptr_t)lds;
    unsigned* pfx = (unsigned*)(lds + AT_PFX);
    int* cntl = (int*)(lds + AT_PFX + 4096);
    const int* lcnt = (const int*)(p.ws + WS_CTL) + CW_LCNT;
    { const int c = __hip_atomic_load(lcnt + tid, __ATOMIC_RELAXED, __HIP_MEMORY_SCOPE_AGENT); unsigned v = (unsigned)((c + 255) >> 8); cntl[tid] = c;
#pragma unroll
      for (int o = 1; o < 64; o <<= 1) { const unsigned u = __shfl_up(v, o); if (lane >= o) v += u; }
      unsigned* wtot = pfx + 520;
      if (lane == 63) wtot[w] = v;
      __syncthreads();
      unsigned base = 0;
#pragma unroll
      for (int i = 0; i < 8; ++i) if (i < w) base += wtot[i];
      pfx[tid + 1] = v + base; if (tid == 0) pfx[0] = 0; }
    __syncthreads();
    const int ntot = (int)pfx[512];
    const int q_ = ntot / nb, r_ = ntot % nb; const int it0 = bid * q_ + (bid < r_ ? bid : r_), nit = q_ + (bid < r_ ? 1 : 0);
    int* itab = (int*)(lds + AT_PFX + 12288);
    if (tid < 32) { const int it_ = it0 + tid; int li_ = -1, tile_ = 0, cnt_ = 0;
        if (tid < nit) { int lo_ = 0, hi_ = 512; while (hi_ - lo_ > 1) { const int mid_ = (lo_ + hi_) >> 1; if ((int)pfx[mid_] <= it_) lo_ = mid_; else hi_ = mid_; }
            li_ = lo_; cnt_ = cntl[lo_]; tile_ = it_ - (int)pfx[lo_]; }
        itab[tid * 4] = li_; itab[tid * 4 + 1] = tile_; itab[tid * 4 + 2] = cnt_; }
    __syncthreads();
    KVRegs<4> R; bf16x8v qn[4];
#define PAST_ENT(k_, li_, tile_, cnt_, ent_) do { li_ = itab[(k_) * 4]; tile_ = itab[(k_) * 4 + 1]; cnt_ = itab[(k_) * 4 + 2]; \
        ent_ = ((const unsigned short*)(p.ws + WS_LIST))[(size_t)li_ * LIST_CAP + tile_ * 256 + 32 * w + ql]; } while (0)
#define PAST_KV(li_) do { const int jb_ = (li_) & 31, hd_ = ((li_) >> 5) & 7, b_ = (li_) >> 8; const size_t row0_ = (size_t)b_ * S + (size_t)jb_ * MBLK; \
        kv_load<4>(R, (const unsigned char*)((const bf16*)(p.ws + WS_KA) + row0_ * WA + hd_ * HD), (const unsigned char*)((const bf16*)(p.ws + WS_VA) + row0_ * WA + hd_ * HD), (size_t)WA * 2, 0, tid); } while (0)
#define PAST_Q(li_, ent_) do { const int hd_ = ((li_) >> 5) & 7, b_ = (li_) >> 8; attn_qload(qn, (const bf16*)(p.ws + WS_QA) + ((size_t)b_ * S + ((ent_) & 8191)) * WA + hd_ * HD, h); } while (0)
    int liA = -1, tileA = 0, cntA = 0; unsigned entA = 0; int liB = -1, tileB = 0, cntB = 0; unsigned entB = 0;
    int lds_li = -1;
    if (nit > 0) { PAST_ENT(0, liA, tileA, cntA, entA); PAST_KV(liA); PAST_Q(liA, entA); }
    if (nit > 1) PAST_ENT(1, liB, tileB, cntB, entB);
    for (int k = 0; k < nit; ++k) {
        if (liA != lds_li) { LDS_BARRIER(); kv_commit<4>(R, lds, 0, tid); LDS_BARRIER(); lds_li = liA; }
        const int li = liA, tile = tileA, cnt = cntA; const unsigned ent = entA;
        const int hd = (li >> 5) & 7, b = li >> 8, slot = (int)(ent >> 13); const size_t tq = (size_t)b * S + (ent & 8191);
        const bool valid = tile * 256 + 32 * w + ql < cnt;
        bf16x8v qf[4];
#pragma unroll
        for (int i = 0; i < 4; ++i) qf[i] = qn[i];
        liA = liB; tileA = tileB; cntA = cntB; entA = entB;
        if (k + 1 < nit) { if (liA != li) PAST_KV(liA); PAST_Q(liA, entA); }
        if (k + 2 < nit) PAST_ENT(k + 2, liB, tileB, cntB, entB);
        AttnState st; attn_init(st);
        const unsigned kbase = lb + AT_KOFF + (unsigned)ql * AT_RS + 16 * h;
        const unsigned vbase = lb + AT_VOFF + (unsigned)(4 * h + ((lane & 15) >> 2)) * AT_RS + 32 * ((lane >> 4) & 1) + 8 * (lane & 3);
        if (32 * w + tile * 256 < cnt) {
            attn_wave<false>(st, qf, kbase, vbase, 0, 8, -1, -1, lane);
            const float lt = st.l + __shfl_xor(st.l, 32);
            if (valid) { attn_store_partial(st, 1.0f / lt, (bf16*)(p.ws + WS_PARTA) + (((size_t)slot * T + tq) * NHA + hd) * HD, h);
                if (h == 0) ((float*)(p.ws + WS_LSEA))[((size_t)slot * T + tq) * NHA + hd] = st.m + __builtin_amdgcn_logf(lt); }
        }
    }
#undef PAST_ENT
#undef PAST_KV
#undef PAST_Q
}
__device__ __forceinline__ void phase_moba_own(const Params& p, int bid, int nb, unsigned char* lds, int tid) {
    const int lane = tid & 63, w = tid >> 6, h = lane >> 5, ql = lane & 31;
    const unsigned lb = (unsigned)(uintptr_t)lds;
    constexpr int NITM = NB * NHA * NBLK;
    KVRegs<4> R; bf16x8v qn[4];
#define OWN_FETCH(it_) do { const int n_ = (it_) % NBLK, hd_ = ((it_) / NBLK) % NHA, b_ = (it_) / (NBLK * NHA); const size_t row0_ = (size_t)b_ * S + (size_t)n_ * MBLK; \
        kv_load<4>(R, (const unsigned char*)((const bf16*)(p.ws + WS_KA) + row0_ * WA + hd_ * HD), (const unsigned char*)((const bf16*)(p.ws + WS_VA) + row0_ * WA + hd_ * HD), (size_t)WA * 2, 0, tid); \
        attn_qload(qn, (const bf16*)(p.ws + WS_QA) + (row0_ + 32 * w + ql) * WA + hd_ * HD, h); } while (0)
    int it = bid;
    if (it < NITM) OWN_FETCH(it);
    while (it < NITM) {
        const int n = it % NBLK, hd = (it / NBLK) % NHA, b = it / (NBLK * NHA);
        const size_t row0 = (size_t)b * S + (size_t)n * MBLK;
        LDS_BARRIER();
        kv_commit<4>(R, lds, 0, tid);
        LDS_BARRIER();
        bf16x8v qf[4];
#pragma unroll
        for (int i = 0; i < 4; ++i) qf[i] = qn[i];
        const int nit = it + nb;
        if (nit < NITM) OWN_FETCH(nit);
        const size_t tq = row0 + 32 * w + ql;
        const unsigned selw = *(const unsigned*)((const signed char*)(p.ws + WS_SEL) + (tq * NHA + hd) * 4);
        float lse[3];
#pragma unroll
        for (int k = 0; k < 3; ++k) lse[k] = ((const float*)(p.ws + WS_LSEA))[((size_t)k * T + tq) * NHA + hd];
        AttnState st; attn_init(st);
        const unsigned kbase = lb + AT_KOFF + (unsigned)ql * AT_RS + 16 * h;
        const unsigned vbase = lb + AT_VOFF + (unsigned)(4 * h + ((lane & 15) >> 2)) * AT_RS + 32 * ((lane >> 4) & 1) + 8 * (lane & 3);
        attn_wave<true>(st, qf, kbase, vbase, 0, w + 1, -1, w, lane);
        const float lt = st.l + __shfl_xor(st.l, 32);
        const float lse_own = st.m + __builtin_amdgcn_logf(lt);
        float M = lse_own;
#pragma unroll
        for (int k = 0; k < 3; ++k) { const bool ok = ((selw >> (8 * k)) & 0x80u) == 0u; if (!ok) lse[k] = -INFINITY; M = fmaxf(M, lse[k]); }
        const float w_own = __builtin_amdgcn_exp2f(lse_own - M); float wsum = w_own;
        const float so = w_own / lt;
#pragma unroll
        for (int r = 0; r < 16; ++r) { st.o0[r] *= so; st.o1[r] *= so; }
#pragma unroll
        for (int k = 0; k < 3; ++k) { const float wk = __builtin_amdgcn_exp2f(lse[k] - M); wsum += wk;
            if (lse[k] != -INFINITY) attn_acc_partial(st.o0, st.o1, wk, (const bf16*)(p.ws + WS_PARTA) + (((size_t)k * T + tq) * NHA + hd) * HD, h); }
        attn_store_partial(st, 1.0f / wsum, (bf16*)p.out + tq * (WA + WBO) + hd * HD, h);
        it = nit;
    }
#undef OWN_FETCH
}
__device__ __forceinline__ void phase_dil_merge(const Params& p, int gtid, int ngt) {
    for (int idx = gtid; idx < T * 4 * 8; idx += ngt) {
        const int ch = idx & 7, j = (idx >> 3) & 3; const size_t t = idx >> 5;
        float l0 = ((const float*)(p.ws + WS_LSEB))[((size_t)0 * T + t) * 4 + j], l1 = ((const float*)(p.ws + WS_LSEB))[((size_t)1 * T + t) * 4 + j], l2 = ((const float*)(p.ws + WS_LSEB))[((size_t)2 * T + t) * 4 + j];
        const float M = fmaxf(l0, fmaxf(l1, l2)); const float w0 = __builtin_amdgcn_exp2f(l0 - M), w1 = __builtin_amdgcn_exp2f(l1 - M), w2 = __builtin_amdgcn_exp2f(l2 - M); const float inv = 1.0f / (w0 + w1 + w2);
        float o[8];
#pragma unroll
        for (int i = 0; i < 8; ++i) o[i] = 0.f;
#pragma unroll
        for (int g = 0; g < 3; ++g) { const float wg = (g == 0 ? w0 : g == 1 ? w1 : w2) * inv; const u32x4 v = *(const u32x4*)((const bf16*)(p.ws + WS_PARTB) + (((size_t)g * T + t) * 4 + j) * HD + 8 * ch);
#pragma unroll
            for (int i = 0; i < 4; ++i) { o[2 * i] += wg * __uint_as_float(v[i] << 16); o[2 * i + 1] += wg * __uint_as_float(v[i] & 0xffff0000u); } }
        u32x4 wv; wv.x = cvtpk(o[0], o[1]); wv.y = cvtpk(o[2], o[3]); wv.z = cvtpk(o[4], o[5]); wv.w = cvtpk(o[6], o[7]);
        *(u32x4*)((bf16*)p.out + t * (WA + WBO) + WA + j * HD + 8 * ch) = wv;
    }
}

__device__ __forceinline__ void phase_check(const Params& p, const bf16* a, const bf16* b, size_t n, int gtid, int ngt) {
    float num = 0.f, den = 0.f;
    for (size_t i = gtid; i < n; i += ngt) { const float x = bf2f(a[i]), y = bf2f(b[i]); num += (x - y) * (x - y); den += y * y; }
    num = wave_sum(num); den = wave_sum(den);
    if ((threadIdx.x & 63) == 0) { atomicAdd((float*)(p.ws + WS_CTL) + CW_DNUM, num); atomicAdd((float*)(p.ws + WS_CTL) + CW_DDEN, den); }
}

#define XB_TMO      128
#define XB_XCNT(j)  (256  + 64 * (j))
#define XB_XSUB(j)  (1280 + 64 * (j))
#define XB_XGEN(j)  (2304 + 64 * (j))
#define XB_TOP      3328
#define XB_TOPGEN   3392
#define XCD_BAR_WORDS 3456
#define XB_SPIN_CAP (1u << 18)
__device__ __forceinline__ unsigned xb_ld(unsigned* p)              { return __hip_atomic_load(p, __ATOMIC_RELAXED, __HIP_MEMORY_SCOPE_AGENT); }
__device__ __forceinline__ unsigned xb_add(unsigned* p, unsigned v) { return __hip_atomic_fetch_add(p, v, __ATOMIC_RELAXED, __HIP_MEMORY_SCOPE_AGENT); }
__device__ __forceinline__ unsigned xb_xcc_id() { return (unsigned)__builtin_amdgcn_s_getreg((3 << 11) | 20) & 0xFu; }
#define XB_SPIN(cond, bar) do { unsigned _sp = 0; while (cond) { __builtin_amdgcn_s_sleep(1); \
    if ((++_sp & 255u) == 0u) { if (xb_ld(&(bar)[XB_TMO])) break; if (_sp > XB_SPIN_CAP) { atomicAdd(&(bar)[XB_TMO], 1u); break; } } } } while (0)
struct XcdBarrier { unsigned* bar; unsigned x; volatile LAS unsigned* st; };
__device__ __forceinline__ XcdBarrier xcd_barrier_post(unsigned* bar, volatile LAS unsigned* st) {
    XcdBarrier b; b.bar = bar; b.x = xb_xcc_id(); b.st = st;
    if (threadIdx.x == 0) (void)xb_add(&bar[XB_XCNT(b.x)], 1u);
    return b;
}
__device__ __forceinline__ void xcd_barrier_complete(unsigned* bar, unsigned x, unsigned& nloc, unsigned& nx) {
    const unsigned G = gridDim.x * gridDim.y * gridDim.z;
    unsigned sum, cnt, mine, sp = 0u;
    for (;;) {
        sum = 0u; cnt = 0u; mine = 0u;
#pragma unroll
        for (unsigned j = 0; j < 16; ++j) { const unsigned c = xb_ld(&bar[XB_XCNT(j)]); sum += c; cnt += (c > 0u) ? 1u : 0u; mine = (j == x) ? c : mine; }
        if (sum == G) break;
        __builtin_amdgcn_s_sleep(1);
        if ((++sp & 255u) == 0u) { if (xb_ld(&bar[XB_TMO])) break; if (sp > XB_SPIN_CAP) { atomicAdd(&bar[XB_TMO], 1u); break; } }
    }
    nloc = mine > 0u ? mine : 1u; nx = cnt > 0u ? cnt : 1u;
}
__device__ __forceinline__ void xcd_barrier(const XcdBarrier& b) {
    asm volatile("s_waitcnt vmcnt(0)" ::: "memory");
    __syncthreads();
    if (threadIdx.x == 0) {
        unsigned* bar = b.bar;
        __builtin_amdgcn_s_waitcnt(0);
        unsigned nloc = b.st[0], nx = b.st[1];
        if (nloc == 0u) { xcd_barrier_complete(bar, b.x, nloc, nx); b.st[0] = nloc; b.st[1] = nx; }
        const unsigned old = xb_add(&bar[XB_XSUB(b.x)], 1u);
        const unsigned gen = old / nloc;
        if (old + 1u == (gen + 1u) * nloc) {
            __builtin_amdgcn_fence(__ATOMIC_RELEASE, "agent");
            asm volatile("s_waitcnt vmcnt(0)" ::: "memory");
            const unsigned og = xb_add(&bar[XB_TOP], 1u);
            const unsigned tg = og / nx;
            if (og + 1u == (tg + 1u) * nx) xb_add(&bar[XB_TOPGEN], 1u);
            else XB_SPIN(xb_ld(&bar[XB_TOPGEN]) == tg, bar);
            __builtin_amdgcn_fence(__ATOMIC_ACQUIRE, "agent");
            xb_add(&bar[XB_XGEN(b.x)], 1u);
            asm volatile("s_waitcnt vmcnt(0)" ::: "memory");
        } else {
            XB_SPIN(xb_ld(&bar[XB_XGEN(b.x)]) == gen, bar);
            __builtin_amdgcn_fence(__ATOMIC_ACQUIRE, "agent");
            asm volatile("s_waitcnt vmcnt(0)" ::: "memory");
        }
    }
    __syncthreads();
}
constexpr int HELPERS = 104;
constexpr int LDS_BYTES = 147456;
__global__ void __launch_bounds__(512, 2) mega_fwd(Params p) {
    extern __shared__ __attribute__((aligned(16))) unsigned char lds[];
    cg::grid_group grid = cg::this_grid();
    const int bid = blockIdx.x, nb = gridDim.x;
#define COORDS() int tid = threadIdx.x; asm volatile("" : "+v"(tid)); const int lane = tid & 63, wave = tid >> 6; const int gw = bid * 8 + wave, ngw = nb * 8, gtid = bid * 512 + tid, ngt = nb * 512; float* wl = (float*)lds + wave * 1152; (void)lane; (void)gw; (void)ngw; (void)gtid; (void)ngt; (void)wl;
    volatile LAS unsigned* bst = (volatile LAS unsigned*)(lds + LDS_BYTES - 64);
    if (threadIdx.x < 16) bst[threadIdx.x] = 0u;
    __syncthreads();
    const XcdBarrier xbar = xcd_barrier_post((unsigned*)(p.ws + WS_CTL) + CW_BAR, bst);
#ifndef TIME_LO
#define TIME_LO -1
#endif
#ifndef TIME_HI
#define TIME_HI -1
#endif
#ifndef TIME_MULT
#define TIME_MULT 2
#endif
    int n_stamp = 0;
#if TIME_LO >= 0
#define STAMP() do { if (bid == 0 && threadIdx.x == 0) ((unsigned long long*)(p.ws + WS_CTL + 917504))[n_stamp] = __builtin_amdgcn_s_memrealtime(); ++n_stamp; } while (0)
#else
#define STAMP() do { } while (0)
#endif
    STAMP();
#define GRID_BAR() do { xcd_barrier(xbar); STAMP(); } while (0)
    phase_prep_a(p, bid, nb, lds);
    if (p.use_cg) grid.sync(); else xcd_barrier(xbar);
    STAMP();
    if (!(bid < HELPERS && nb > 2 * HELPERS)) {
        const int hsub = (nb > 2 * HELPERS) ? HELPERS : 0;
        pg8::Order O; O.init(T / 256, NCOL / 256, nb - hsub, bid - hsub); EpiInProj E{p};
#if FP8_IN
        ProbPlainF8 P{(const bf16*)(p.ws + WS_H), (const bf16*)(p.ws + WS_WIN), D / 2}; pg8::gemm_phase<EpiInProj, ProbPlainF8, true>((PG8_LAS unsigned char*)lds, P, O, E);
#else
        ProbPlain P{(const bf16*)(p.ws + WS_H), (const bf16*)(p.ws + WS_WIN), D}; pg8::gemm_phase<EpiInProj, ProbPlain, true>((PG8_LAS unsigned char*)lds, P, O, E);
#endif
#if TIME_LO >= 0
        if (threadIdx.x == 0) atomicMax((unsigned long long*)(p.ws + WS_CTL + 917504) + 21, (unsigned long long)__builtin_amdgcn_s_memrealtime());
#endif
    }
    phase_prep_b(p, lds);
#if TIME_LO >= 0
    if (threadIdx.x == 0) atomicMax((unsigned long long*)(p.ws + WS_CTL + 917504) + 20, (unsigned long long)__builtin_amdgcn_s_memrealtime());
#endif
    GRID_BAR();
#if DBG == 1
    { InProjN f{p, true}; phase_naive_gemm(f, T, C_VB, bid, nb, lds); }
    GRID_BAR();
    { COORDS(); phase_check(p, (const bf16*)(p.ws + WS_QA), (const bf16*)(p.ws + 426 * MiB), (size_t)T * WA, gtid, ngt);
      phase_check(p, (const bf16*)(p.ws + WS_KA), (const bf16*)(p.ws + 442 * MiB), (size_t)T * WA, gtid, ngt);
      phase_check(p, (const bf16*)(p.ws + WS_QB), (const bf16*)(p.ws + 458 * MiB), (size_t)T * WB, gtid, ngt);
      phase_check(p, (const bf16*)(p.ws + WS_KB), (const bf16*)(p.ws + 482 * MiB), (size_t)T * WB, gtid, ngt); }
    GRID_BAR();
#endif
    { COORDS(); phase_select_lists(p, bid, nb, lds, tid); phase_dilated(p, bid, nb, lds, tid); }
    GRID_BAR();
    { COORDS(); phase_moba_past(p, bid, nb, lds, tid); }
    GRID_BAR();
    { COORDS(); phase_moba_own(p, bid, nb, lds, tid); phase_dil_merge(p, gtid, ngt); }
    GRID_BAR();
#if DBG == 2
    { COORDS(); phase_moba_naive(p, gw, ngw, lane, wl, (bf16*)p.out); phase_dil_naive(p, gw, ngw, lane, wl, (bf16*)p.out + (size_t)T * WA); }
    GRID_BAR();
    { COORDS();
#if DBG_SUB == 0
      phase_check(p, (const bf16*)(p.ws + WS_OA), (const bf16*)p.out, (size_t)T * WA, gtid, ngt);
#else
      phase_check(p, (const bf16*)(p.ws + WS_OB), (const bf16*)p.out + (size_t)T * WA, (size_t)T * WBO, gtid, ngt);
#endif
    }
    GRID_BAR();
#endif
    { pg8::Order O; O.init(T / 256, D / 256, nb, bid); ProbPlainOff P{(const bf16*)p.out, (const bf16*)(p.ws + WS_WOA), WA + WBO}; EpiMixCat E{p};
      pg8::gemm_phase<EpiMixCat, ProbPlainOff, true>((PG8_LAS unsigned char*)lds, P, O, E); }
    GRID_BAR();
    { ProbPlain P{(const bf16*)(p.ws + WS_MIX), (const bf16*)(p.ws + WS_WOUT), D}; pg8::Order O; O.init(T / 256, D / 256, nb, bid); EpiOut E{p};
      pg8::gemm_phase<EpiOut, ProbPlain, true>((PG8_LAS unsigned char*)lds, P, O, E); }
    GRID_BAR();
    { COORDS(); phase_router(p, bid, nb, lds, tid); }
    GRID_BAR();
    { COORDS(); MoeTab mt; const int n_mt = moe_tables<false>(p, lds, tid, 2 * FF / 256, nb, bid, mt);
      ProbMoE<true, (FP8_GU != 0)> P{(const bf16*)(p.ws + WS_H), (const bf16*)(p.ws + WS_WGU), FP8_GU ? D / 2 : D, mt, 2 * FF}; pg8::Order O; O.init(n_mt, 2 * FF / 256, nb, bid); EpiGateUp E{p, mt};
      pg8::gemm_phase<EpiGateUp, ProbMoE<true, (FP8_GU != 0)>, true>((PG8_LAS unsigned char*)lds, P, O, E); }
    GRID_BAR();
    { COORDS(); MoeTab mt; const int n_mt = moe_tables<true>(p, lds, tid, D / 256, nb, bid, mt);
      ProbMoE<false, (FP8_DN != 0)> P{(const bf16*)(p.ws + WS_A2), (const bf16*)(p.ws + WS_WD), FP8_DN ? FF / 2 : FF, mt, D}; pg8::Order O; O.init(n_mt, D / 256, nb, bid); EpiDown E{p, mt};
      pg8::gemm_phase<EpiDown, ProbMoE<false, (FP8_DN != 0)>, true>((PG8_LAS unsigned char*)lds, P, O, E); }
    GRID_BAR();
    { COORDS(); phase_final(p, gw, ngw, lane); }
#if TIME_LO >= 0
    if (bid == 0 && threadIdx.x == 0) { STAMP();
        const unsigned long long* ts = (const unsigned long long*)(p.ws + WS_CTL + 917504);
        const unsigned long long dt = (ts[TIME_HI] - ts[TIME_LO]) * TIME_MULT, t0 = __builtin_amdgcn_s_memrealtime();
        while (__builtin_amdgcn_s_memrealtime() - t0 < dt) __builtin_amdgcn_s_sleep(8); }
#endif
}

#ifdef TIME_LO
#define TIME_LO_HOST TIME_LO
#else
#define TIME_LO_HOST -1
#endif
extern "C" void kernel_launch(void* const* d_in, const int* in_sizes, int n_in, void* d_out, int out_size, void* d_ws, size_t ws_size, hipStream_t stream) {
    if (n_in != 18 || ws_size < WS_END || out_size != T * D) return;
    static int grid_blocks = 0;
    if (!grid_blocks) {
        int dev = 0, cus = 0, per_cu = 0;
        (void)hipGetDevice(&dev);
        (void)hipDeviceGetAttribute(&cus, hipDeviceAttributeMultiprocessorCount, dev);
        (void)hipFuncSetAttribute((const void*)mega_fwd, hipFuncAttributeMaxDynamicSharedMemorySize, LDS_BYTES);
        (void)hipOccupancyMaxActiveBlocksPerMultiprocessor(&per_cu, (const void*)mega_fwd, 512, LDS_BYTES);
        if (per_cu < 1) per_cu = 1;
        if (per_cu > 1) per_cu = 1;
        grid_blocks = cus * per_cu;
    }
    Params p{};
    const float** fp = (const float**)&p;
    for (int i = 0; i < 18; ++i) fp[i] = (const float*)d_in[i];
    p.out = (float*)d_out; p.ws = (unsigned char*)d_ws;
    for (int i = 0; i < 8; ++i) p.inv_freq[i] = (float)pow(500000.0, -(double)i / 8.0);
    (void)hipMemsetAsync((char*)d_ws + WS_CTL, 0, (TIME_LO_HOST >= 0) ? 1 * MiB : 64 * 1024, stream);
    void* args[] = {&p};
    (void)hipLaunchCooperativeKernel((const void*)mega_fwd, dim3(grid_blocks), dim3(512), args, LDS_BYTES, stream);
}
```
